# Optimizing an MI355X kernel written in HIP

```python
import numpy as np
import jax, jax.numpy as jnp
from jax import lax

D_MODEL = 1024
BATCH = 2
SEQ = 8192
DEPTH = 1

D_CONV = D_MODEL
CONV_WIDTH = 3
HEAD_DIM = 64
HEADS_PER_GROUP = 8
DILATED_GROUPS = ((128, 1), (512, 4), (2048, 16))
N_ATTN_HEADS = HEADS_PER_GROUP * len(DILATED_GROUPS)
D_ATTN = N_ATTN_HEADS * HEAD_DIM
D_ATTN_OUT = HEADS_PER_GROUP * HEAD_DIM
BLOCK = 128
ROT_DIM = HEAD_DIM // 4
ROPE_THETA = 500000.0
PEER_HEADS = 8
PEER_N_KEYS = 128
PEER_N_EXPERTS = PEER_N_KEYS * PEER_N_KEYS
PEER_TOPK = 16
PEER_D_HALF = 128
PEER_D_QUERY = 2 * PEER_D_HALF
PEER_CHUNK = 128
RMS_EPS = 1e-6

kernel_name = "hybrid_gatedconv_dilatedattn_peer"


def rms_norm(x, g):
    xf = x.astype(jnp.float32)
    y = xf * lax.rsqrt(jnp.mean(xf * xf, axis=-1, keepdims=True) + RMS_EPS)
    return (y * g.astype(jnp.float32)).astype(x.dtype)


def partial_rotary(t, positions):
    half = ROT_DIM // 2
    inv_freq = ROPE_THETA ** (-jnp.arange(half, dtype=jnp.float32) * (2.0 / ROT_DIM))
    ang = positions.astype(jnp.float32)[..., None] * inv_freq
    cos = jnp.cos(ang)[:, :, None, :]
    sin = jnp.sin(ang)[:, :, None, :]
    tr = t[..., :ROT_DIM].astype(jnp.float32)
    t1, t2 = tr[..., :half], tr[..., half:]
    rot = jnp.concatenate([t1 * cos - t2 * sin, t2 * cos + t1 * sin], axis=-1).astype(t.dtype)
    return jnp.concatenate([rot, t[..., ROT_DIM:]], axis=-1)


def dilated_window_attention(q, k, v, window, dilation):
    B, S, H, Dh = q.shape
    steps = window // dilation
    span = dilation * BLOCK
    sp = -(-S // span) * span
    nb = sp // span

    def blocks(t):
        t = jnp.pad(t, ((0, 0), (0, sp - S), (0, 0), (0, 0)))
        return t.reshape(B, nb, BLOCK, dilation, H, Dh)

    def with_prev(t):
        prev = jnp.pad(t, ((0, 0), (1, 0), (0, 0), (0, 0), (0, 0), (0, 0)))[:, :-1]
        return jnp.concatenate([prev, t], axis=2)

    qb = blocks(q)
    kk = with_prev(blocks(k))
    vv = with_prev(blocks(v))
    s = jnp.einsum('bnqrhd,bnkrhd->bnrhqk', qb, kk,
                   preferred_element_type=jnp.float32) * (Dh ** -0.5)
    qi = np.arange(BLOCK)[:, None]
    ki = np.arange(2 * BLOCK)[None, :]
    dist = BLOCK + qi - ki
    band = (dist >= 0) & (dist <= steps)
    valid = band[None] & ((np.arange(nb)[:, None, None] > 0) | (ki >= BLOCK)[None])
    s = jnp.where(valid[None, :, None, None], s, -jnp.inf)
    m = jnp.max(s, axis=-1, keepdims=True)
    p = jnp.exp(s - m)
    l = jnp.sum(p, axis=-1, keepdims=True)
    o = jnp.einsum('bnrhqk,bnkrhd->bnqrhd', (p / l).astype(v.dtype), vv)
    o = o.reshape(B, sp, H, Dh)[:, :S]
    lse = (m + jnp.log(l))[..., 0]
    lse = lse.transpose(0, 1, 4, 2, 3).reshape(B, sp, H)[:, :S]
    return o, lse


def hybrid_mixer(u, positions, w_in, conv_w, w_conv_out, w_attn_out, gate_bias, w_out):
    B, S, _ = u.shape
    sizes = [D_CONV, D_CONV, D_CONV, D_ATTN, D_ATTN, D_ATTN, D_MODEL, D_MODEL]
    split_points = [int(c) for c in np.cumsum(sizes)[:-1]]
    proj = u @ w_in
    b_gate, c_gate, xc, q, k, v, g_conv, g_attn = jnp.split(proj, split_points, axis=-1)

    z = c_gate * xc
    zp = jnp.pad(z, ((0, 0), (CONV_WIDTH - 1, 0), (0, 0)))
    conv = sum(conv_w[i] * zp[:, i:i + S] for i in range(CONV_WIDTH))
    y_conv = (b_gate * conv) @ w_conv_out

    q = partial_rotary(q.reshape(B, S, N_ATTN_HEADS, HEAD_DIM), positions)
    k = partial_rotary(k.reshape(B, S, N_ATTN_HEADS, HEAD_DIM), positions)
    v = v.reshape(B, S, N_ATTN_HEADS, HEAD_DIM)
    outs, lses = [], []
    for g, (window, dilation) in enumerate(DILATED_GROUPS):
        sl = slice(g * HEADS_PER_GROUP, (g + 1) * HEADS_PER_GROUP)
        o_g, lse_g = dilated_window_attention(q[:, :, sl], k[:, :, sl], v[:, :, sl], window, dilation)
        outs.append(o_g)
        lses.append(lse_g)
    wts = jax.nn.softmax(jnp.stack(lses, axis=0), axis=0)
    o = jnp.einsum('gbsh,gbshd->bshd', wts.astype(v.dtype), jnp.stack(outs, axis=0))
    y_attn = o.reshape(B, S, D_ATTN_OUT) @ w_attn_out

    merged = (jax.nn.sigmoid(g_conv + gate_bias[0]) * y_conv
              + jax.nn.sigmoid(g_attn + gate_bias[1]) * y_attn)
    return merged @ w_out


def peer_ffn(u, w_query, sub_keys, expert_down, expert_up):
    B, S, D = u.shape
    T = B * S
    xf = u.reshape(T, D)
    q = (xf @ w_query).reshape(T, PEER_HEADS, 2, PEER_D_HALF)
    s = jnp.einsum('thcd,hckd->thck', q, sub_keys, preferred_element_type=jnp.float32)
    top_s, top_i = lax.top_k(s, PEER_TOPK)
    cand_s = (top_s[:, :, 0, :, None] + top_s[:, :, 1, None, :]).reshape(T, PEER_HEADS, PEER_TOPK * PEER_TOPK)
    cand_i = (top_i[:, :, 0, :, None] * PEER_N_KEYS + top_i[:, :, 1, None, :]).reshape(T, PEER_HEADS, PEER_TOPK * PEER_TOPK)
    best_s, pos = lax.top_k(cand_s, PEER_TOPK)
    idx = jnp.take_along_axis(cand_i, pos, axis=-1)
    gates = jax.nn.softmax(best_s, axis=-1).astype(u.dtype)
    hk = PEER_HEADS * PEER_TOPK
    xr = xf.reshape(-1, PEER_CHUNK, D)
    ir = idx.reshape(-1, PEER_CHUNK, hk)
    gr = gates.reshape(-1, PEER_CHUNK, hk)

    def chunk(args):
        xc, ic, gc = args
        a = jax.nn.gelu(jnp.einsum('cd,ced->ce', xc, expert_down[ic]), approximate=False)
        return jnp.einsum('ce,ced->cd', gc * a, expert_up[ic])

    return lax.map(chunk, (xr, ir, gr)).reshape(B, S, D)


def setup_inputs(seed: int = 0) -> dict:
    key = jax.random.key(seed)
    ks = jax.random.split(key, 16)
    f32 = jnp.float32
    d_in = 3 * D_CONV + 3 * D_ATTN + 2 * D_MODEL
    x = jax.random.normal(ks[0], (BATCH, SEQ, D_MODEL), f32)
    offset = jax.random.randint(ks[1], (BATCH, 1), 0, 1024, dtype=jnp.int32)
    positions = (offset + jnp.arange(SEQ, dtype=jnp.int32)[None, :]).astype(jnp.int32)
    norm_mix = 1.0 + 0.01 * jax.random.normal(ks[2], (DEPTH, D_MODEL), f32)
    w_in = jax.random.normal(ks[3], (DEPTH, D_MODEL, d_in), f32) * D_MODEL ** -0.5
    conv_w = jax.random.normal(ks[4], (DEPTH, CONV_WIDTH, D_CONV), f32) * CONV_WIDTH ** -0.5
    w_conv_out = jax.random.normal(ks[5], (DEPTH, D_CONV, D_MODEL), f32) * D_CONV ** -0.5
    w_attn_out = jax.random.normal(ks[6], (DEPTH, D_ATTN_OUT, D_MODEL), f32) * D_ATTN_OUT ** -0.5
    gate_bias = 0.01 * jax.random.normal(ks[7], (DEPTH, 2, D_MODEL), f32)
    w_out = jax.random.normal(ks[8], (DEPTH, D_MODEL, D_MODEL), f32) * D_MODEL ** -0.5
    norm_ffn = 1.0 + 0.01 * jax.random.normal(ks[9], (DEPTH, D_MODEL), f32)
    peer_w_query = jax.random.normal(ks[10], (DEPTH, D_MODEL, PEER_HEADS * PEER_D_QUERY), f32) * D_MODEL ** -0.5
    peer_sub_keys = jax.random.normal(ks[11], (DEPTH, PEER_HEADS, 2, PEER_N_KEYS, PEER_D_HALF), f32) * PEER_D_HALF ** -0.5
    peer_down = jax.random.normal(ks[12], (DEPTH, PEER_N_EXPERTS, D_MODEL), f32) * D_MODEL ** -0.5
    peer_up = jax.random.normal(ks[13], (DEPTH, PEER_N_EXPERTS, D_MODEL), f32) * PEER_HEADS ** -0.5
    final_norm = 1.0 + 0.01 * jax.random.normal(ks[14], (D_MODEL,), f32)
    return {"x": x, "positions": positions, "norm_mix": norm_mix, "w_in": w_in,
            "conv_w": conv_w, "w_conv_out": w_conv_out, "w_attn_out": w_attn_out,
            "gate_bias": gate_bias, "w_out": w_out, "norm_ffn": norm_ffn,
            "peer_w_query": peer_w_query, "peer_sub_keys": peer_sub_keys,
            "peer_down": peer_down, "peer_up": peer_up, "final_norm": final_norm}


def reference(x, positions, norm_mix, w_in, conv_w, w_conv_out, w_attn_out, gate_bias, w_out,
              norm_ffn, peer_w_query, peer_sub_keys, peer_down, peer_up, final_norm):
    h = x
    for layer in range(DEPTH):
        h = h + hybrid_mixer(rms_norm(h, norm_mix[layer]), positions, w_in[layer], conv_w[layer],
                             w_conv_out[layer], w_attn_out[layer], gate_bias[layer], w_out[layer])
        h = h + peer_ffn(rms_norm(h, norm_ffn[layer]), peer_w_query[layer], peer_sub_keys[layer],
                         peer_down[layer], peer_up[layer])
    return rms_norm(h, final_norm)
```

```cpp
#include <hip/hip_runtime.h>
#include <cstdio>
#include <cstdint>
namespace pg8 {
#define PG8_LAS __attribute__((address_space(3)))
typedef unsigned short bf16_t;
typedef short bf16x8 __attribute__((ext_vector_type(8)));
typedef float f32x4 __attribute__((ext_vector_type(4)));
typedef unsigned u32x4 __attribute__((ext_vector_type(4)));
constexpr int BM = 256, BK = 64, HALF = 128, HTB = HALF * BK * 2  , STAGE_BYTES = 8 * HTB, NXCD = 8, WGM = 8;

__host__ __device__ __forceinline__ int lds_byte(int r, int c) { const int st = (r >> 4) * 2 + (c >> 5), rr = r & 15, cc = c & 31, ob = rr * 64 + cc * 2; return st * 1024 + (ob ^ (((ob >> 9) & 1) << 5)); }
__host__ __device__ __forceinline__ void stage_rc(int b, int& R, int& C) { const int st = b / 1024, sb = b % 1024, swz = sb ^ (((sb >> 9) & 1) << 5); R = (st >> 1) * 16 + swz / 64; C = (st & 1) * 32 + (swz % 64) / 2; }
__host__ __device__ __forceinline__ int perm32(int rho) { const int n = rho >> 4, i = rho & 15; return 8 * (i >> 2) + 4 * n + (i & 3); }

struct Unit { int pm, pn; };
struct Gemm { const bf16_t* A; const bf16_t* Bt; int M, N, K; };

struct StaticOrder {
    int nM, nN, nwg, G, c;
    __host__ __device__ void init(int M, int N, int G_, int c_) { nM = M / BM; nN = N / BM; nwg = nM * nN; G = G_; c = c_; }
    __host__ __device__ bool next(int i, Unit& u) const {
        const long L = (long)i * G + c; if (L >= nwg) return false;
        int wgid = (int)L; { const int q = nwg / NXCD, r = nwg % NXCD, xcd = wgid % NXCD, off = wgid / NXCD; wgid = (xcd < r ? xcd * (q + 1) : r * (q + 1) + (xcd - r) * q) + off; }
        const int nig = WGM * nN, gid = wgid / nig, fm = gid * WGM, gsz = (nM - fm) < WGM ? (nM - fm) : WGM;
        u.pm = fm + ((wgid % nig) % gsz); u.pn = (wgid % nig) / gsz; return true;
    }
    __device__ __forceinline__ void a_ready(const Unit&) const {}
    __device__ __forceinline__ void done(const Unit&) const {}
};

__device__ __forceinline__ unsigned cvt_pk_bf16(float lo, float hi) { unsigned r; asm volatile("v_cvt_pk_bf16_f32 %0, %1, %2" : "=v"(r) : "v"(lo), "v"(hi)); return r; }
typedef float f32x2 __attribute__((ext_vector_type(2)));

template <class Epi, class Sched, bool ALIGN_EPI = false, bool SP2 = false, bool STRIDED_A = false>
__device__ __forceinline__ void gemm_phase(PG8_LAS unsigned char* lds, const Gemm g, const Sched& S, const Epi& E) {
    const int tid = threadIdx.x, wid = __builtin_amdgcn_readfirstlane(tid >> 6), lane = tid & 63, wr = wid >> 2, wc = wid & 3, fr = lane & 15, fq = lane >> 4;
    const int K = g.K, nt = K / BK;
    unsigned voffA[2], voffB[2];
#pragma unroll
    for (int i = 0; i < 2; ++i) { int R, C; stage_rc(tid * 16 + i * 8192, R, C); const int Rb = Epi::PERM ? ((R & ~31) + perm32(R & 31)) : R;
        voffA[i] = (unsigned)(R * K + C) * 2u; voffB[i] = (unsigned)(Rb * K + C) * 2u; }
    unsigned rkA = 0, c2A = 0; const unsigned rk64 = 64u * (unsigned)K * 2u;
    if constexpr (STRIDED_A) { int R, C; stage_rc(tid * 16, R, C); rkA = (unsigned)(R * K) * 2u; c2A = (unsigned)C * 2u; }
    const size_t kstep = (size_t)(BK * 2);
    const size_t hstep = (size_t)HALF * K * 2;
    const size_t tstep = 2 * hstep;
    const unsigned ldsw = (unsigned)wid * 1024u;
    const int aoff = lds_byte(wr * 64 + fr, fq * 8), boff = lds_byte(wc * 32 + fr, fq * 8);
#define PG8_SA(b, h) (((b) * 2 + (h)) * HTB)
#define PG8_SB(b, h) ((4 + (b) * 2 + (h)) * HTB)
#define PG8_STAGE(bufoff, gbase, voff) do { _Pragma("unroll") for (int _i = 0; _i < 2; ++_i) \
        __builtin_amdgcn_global_load_lds((const unsigned*)((const char*)(gbase) + (voff)[_i]), (PG8_LAS unsigned*)(lds + (bufoff) + ldsw + _i * 8192), 16, 0, 0); } while (0)
#define PG8_STAGE_A(bufoff, gbase, sh) do { if constexpr (STRIDED_A) { _Pragma("unroll") for (int _i = 0; _i < 2; ++_i) { const unsigned _vo = ((rkA + _i * rk64) << (sh)) + c2A; \
        __builtin_amdgcn_global_load_lds((const unsigned*)((const char*)(gbase) + _vo), (PG8_LAS unsigned*)(lds + (bufoff) + ldsw + _i * 8192), 16, 0, 0); } } else { PG8_STAGE(bufoff, gbase, voffA); } } while (0)
#define PG8_LDA(dst, b, h) do { _Pragma("unroll") for (int m = 0; m < 4; ++m) _Pragma("unroll") for (int k = 0; k < 2; ++k) dst[m][k] = *(const PG8_LAS bf16x8*)(lds + PG8_SA(b, h) + aoff + m * 2048 + k * 1024); } while (0)
#define PG8_LDB(dst, b, h) do { _Pragma("unroll") for (int n = 0; n < 2; ++n) _Pragma("unroll") for (int k = 0; k < 2; ++k) dst[n][k] = *(const PG8_LAS bf16x8*)(lds + PG8_SB(b, h) + boff + n * 2048 + k * 1024); } while (0)
#define PG8_MMA(ai, bj, At, Bt) do { __builtin_amdgcn_s_setprio(1); _Pragma("unroll") for (int m = 0; m < 4; ++m) _Pragma("unroll") for (int n = 0; n < 2; ++n) _Pragma("unroll") for (int k = 0; k < 2; ++k) \
        acc[ai][bj][m][n] = __builtin_amdgcn_mfma_f32_16x16x32_bf16(Bt[n][k], At[m][k], acc[ai][bj][m][n], 0, 0, 0); __builtin_amdgcn_s_setprio(0); } while (0)
#define PG8_WAIT_V(n) asm volatile("s_waitcnt vmcnt(" #n ")" ::: "memory")
#define PG8_WAIT_L(n) asm volatile("s_waitcnt lgkmcnt(" #n ")" ::: "memory")
#define PG8_BAR __builtin_amdgcn_s_barrier()
#define PG8_SCHED __builtin_amdgcn_sched_barrier(0)
    Unit cur, nxt; int ui = 0;
    if (!S.next(0, cur)) return;
    f32x4 acc[2][2][4][2];
#pragma unroll
    for (int a = 0; a < 2; ++a)
#pragma unroll
        for (int b = 0; b < 2; ++b)
#pragma unroll
            for (int m = 0; m < 4; ++m)
#pragma unroll
                for (int n = 0; n < 2; ++n) acc[a][b][m][n] = (f32x4){0.f, 0.f, 0.f, 0.f};
    bf16x8 At[4][2], B0[2][2], B1[2][2];
    int csh = 0, nsh = 0;
    const char* cA; if constexpr (STRIDED_A) cA = S.a_base(cur, csh); else cA = (const char*)g.A + (size_t)cur.pm * tstep;
    const char* cB = (const char*)g.Bt + (size_t)cur.pn * tstep;
    S.a_ready(cur);
    if constexpr (SP2) {
        PG8_STAGE(PG8_SB(0, 0), cB, voffB); PG8_STAGE(PG8_SB(0, 1), cB + hstep, voffB); PG8_STAGE_A(PG8_SA(0, 0), cA, csh); PG8_STAGE_A(PG8_SA(0, 1), cA + (hstep << csh), csh);
        if (wr == 1) PG8_BAR;
        PG8_WAIT_V(2); PG8_BAR;
        PG8_STAGE(PG8_SB(1, 0), cB + kstep, voffB); PG8_STAGE_A(PG8_SA(1, 0), cA + kstep, csh); PG8_STAGE(PG8_SB(1, 1), cB + hstep + kstep, voffB);
        PG8_WAIT_V(6); PG8_BAR;
    } else {
        PG8_STAGE(PG8_SB(0, 0), cB, voffB); PG8_STAGE_A(PG8_SA(0, 0), cA, csh); PG8_STAGE(PG8_SB(0, 1), cB + hstep, voffB); PG8_STAGE_A(PG8_SA(0, 1), cA + (hstep << csh), csh);
        if (wr == 1) PG8_BAR;
        PG8_WAIT_V(4); PG8_BAR;
        PG8_STAGE(PG8_SB(1, 0), cB + kstep, voffB); PG8_STAGE_A(PG8_SA(1, 0), cA + kstep, csh); PG8_STAGE(PG8_SB(1, 1), cB + hstep + kstep, voffB);
        PG8_WAIT_V(6); PG8_BAR;
    }
    for (;;) {
        const bool has_next = S.next(ui + 1, nxt);
        const char* nA; if constexpr (STRIDED_A) { nsh = csh; nA = has_next ? S.a_base(nxt, nsh) : cA; } else nA = has_next ? (const char*)g.A + (size_t)nxt.pm * tstep : cA;
        const char* nB = has_next ? (const char*)g.Bt + (size_t)nxt.pn * tstep : cB;
        for (int t = 0; t < nt; t += 2) {
            const bool last = (t == nt - 2);
            const char* a1 = cA + (size_t)(t + 1) * kstep;
            const char* a2 = last ? nA : cA + (size_t)(t + 2) * kstep; const char* b2 = last ? nB : cB + (size_t)(t + 2) * kstep;
            const char* a3 = a2 + kstep; const char* b3 = b2 + kstep;
            const int sh2 = last ? nsh : csh; const size_t hA1 = hstep << csh, hA2 = hstep << sh2;
            if (last && has_next) S.a_ready(nxt);
            if constexpr (SP2) {
            PG8_LDB(B0, 0, 0); PG8_LDB(B1, 0, 1); PG8_SCHED; PG8_LDA(At, 0, 0); PG8_STAGE_A(PG8_SA(1, 1), a1 + hA1, csh);
            PG8_WAIT_V(8); PG8_WAIT_L(0); PG8_BAR; PG8_MMA(0, 0, At, B0); PG8_MMA(0, 1, At, B1); PG8_BAR; PG8_SCHED;
            PG8_LDA(At, 0, 1); PG8_STAGE(PG8_SB(0, 0), b2, voffB); PG8_STAGE(PG8_SB(0, 1), b2 + hstep, voffB); PG8_STAGE_A(PG8_SA(0, 0), a2, sh2);
            PG8_WAIT_V(8); PG8_WAIT_L(0); PG8_BAR; PG8_MMA(1, 0, At, B0); PG8_MMA(1, 1, At, B1); PG8_BAR; PG8_SCHED;
            PG8_LDB(B0, 1, 0); PG8_LDB(B1, 1, 1); PG8_SCHED; PG8_LDA(At, 1, 0); PG8_STAGE_A(PG8_SA(0, 1), a2 + hA2, sh2);
            PG8_WAIT_V(8); PG8_WAIT_L(0); PG8_BAR; PG8_MMA(0, 0, At, B0); PG8_MMA(0, 1, At, B1); PG8_BAR; PG8_SCHED;
            PG8_LDA(At, 1, 1); PG8_STAGE(PG8_SB(1, 0), b3, voffB); PG8_STAGE(PG8_SB(1, 1), b3 + hstep, voffB); PG8_STAGE_A(PG8_SA(1, 0), a3, sh2);
            PG8_WAIT_V(8); PG8_WAIT_L(0); PG8_BAR; PG8_MMA(1, 0, At, B0); PG8_MMA(1, 1, At, B1); PG8_BAR; PG8_SCHED;
            } else {
            PG8_LDB(B0, 0, 0); PG8_SCHED; PG8_LDA(At, 0, 0); PG8_STAGE_A(PG8_SA(1, 1), a1 + hA1, csh);
            PG8_WAIT_L(8); PG8_BAR; PG8_WAIT_L(0); PG8_MMA(0, 0, At, B0); PG8_BAR; PG8_SCHED;
            PG8_LDB(B1, 0, 1); PG8_STAGE(PG8_SB(0, 0), b2, voffB);
            PG8_BAR; PG8_WAIT_L(0); PG8_MMA(0, 1, At, B1); PG8_BAR;
            PG8_LDA(At, 0, 1); PG8_STAGE_A(PG8_SA(0, 0), a2, sh2);
            PG8_BAR; PG8_WAIT_L(0); PG8_MMA(1, 0, At, B0); PG8_BAR; PG8_SCHED;
            PG8_STAGE(PG8_SB(0, 1), b2 + hstep, voffB);
            PG8_WAIT_V(6); PG8_BAR; PG8_MMA(1, 1, At, B1); PG8_BAR;
            PG8_LDB(B0, 1, 0); PG8_SCHED; PG8_LDA(At, 1, 0); PG8_STAGE_A(PG8_SA(0, 1), a2 + hA2, sh2);
            PG8_WAIT_L(8); PG8_BAR; PG8_WAIT_L(0); PG8_MMA(0, 0, At, B0); PG8_BAR; PG8_SCHED;
            PG8_LDB(B1, 1, 1); PG8_STAGE(PG8_SB(1, 0), b3, voffB);
            PG8_BAR; PG8_WAIT_L(0); PG8_MMA(0, 1, At, B1); PG8_BAR;
            PG8_LDA(At, 1, 1); PG8_STAGE_A(PG8_SA(1, 0), a3, sh2);
            PG8_BAR; PG8_WAIT_L(0); PG8_MMA(1, 0, At, B0); PG8_BAR; PG8_SCHED;
            PG8_STAGE(PG8_SB(1, 1), b3 + hstep, voffB);
            PG8_WAIT_V(6); PG8_BAR; PG8_MMA(1, 1, At, B1); PG8_BAR;
            }
        }
        if constexpr (ALIGN_EPI) { if (wr == 0) PG8_BAR; }
        if constexpr (!Epi::AFTER_DRAIN) { E(acc, cur, wr, wc, fr, fq); S.done(cur); }
        if (!has_next) break;
#pragma unroll
        for (int a = 0; a < 2; ++a)
#pragma unroll
            for (int b = 0; b < 2; ++b)
#pragma unroll
                for (int m = 0; m < 4; ++m)
#pragma unroll
                    for (int n = 0; n < 2; ++n) acc[a][b][m][n] = (f32x4){0.f, 0.f, 0.f, 0.f};
        cur = nxt; cA = nA; cB = nB; csh = nsh; ++ui;
        if constexpr (ALIGN_EPI) { if (wr == 1) PG8_BAR; }
    }
    PG8_WAIT_V(0);
    if constexpr (!ALIGN_EPI) { if (wr == 0) PG8_BAR; }
    PG8_BAR;
    if constexpr (Epi::AFTER_DRAIN) { E.fused(acc, cur, wr, wc, fr, fq, lds, wid, lane); S.done(cur); }
#undef PG8_SA
#undef PG8_SB
#undef PG8_STAGE
#undef PG8_STAGE_A
#undef PG8_LDA
#undef PG8_LDB
#undef PG8_MMA
#undef PG8_WAIT_V
#undef PG8_WAIT_L
#undef PG8_BAR
#undef PG8_SCHED
}
}

#define GAS __attribute__((address_space(1)))
#define LAS __attribute__((address_space(3)))
typedef unsigned short bf16;
typedef unsigned v4u __attribute__((ext_vector_type(4)));
typedef float f32x4 __attribute__((ext_vector_type(4)));
typedef short bf16x8 __attribute__((ext_vector_type(8)));
typedef GAS unsigned gu32;
typedef GAS unsigned long long gu64;
#define RLX_AGENT __ATOMIC_RELAXED, __HIP_MEMORY_SCOPE_AGENT
#define LDS_WAIT() asm volatile("s_waitcnt lgkmcnt(0)" ::: "memory")
#define VM_WAIT() asm volatile("s_waitcnt vmcnt(0)" ::: "memory")
__device__ __forceinline__ unsigned long long rt() { return __builtin_amdgcn_s_memrealtime(); }
__device__ __forceinline__ unsigned f2bf(float f) { unsigned u = __builtin_bit_cast(unsigned, f); return (u + 0x7fffu + ((u >> 16) & 1u)) >> 16; }
__device__ __forceinline__ unsigned pk2(float lo, float hi) { return f2bf(lo) | (f2bf(hi) << 16); }

#define XB_TMO      128
#define XB_XCNT(j)  (256  + 64 * (j))
#define XB_XSUB(j)  (1280 + 64 * (j))
#define XB_XGEN(j)  (2304 + 64 * (j))
#define XB_TOP      3328
#define XB_TOPGEN   3392
#define XCD_BAR_WORDS 3456
#define XB_SPIN_CAP (1u << 18)

__device__ __forceinline__ unsigned xb_ld(unsigned* p)              { return __hip_atomic_load(p, __ATOMIC_RELAXED, __HIP_MEMORY_SCOPE_AGENT); }
__device__ __forceinline__ unsigned xb_add(unsigned* p, unsigned v) { return __hip_atomic_fetch_add(p, v, __ATOMIC_RELAXED, __HIP_MEMORY_SCOPE_AGENT); }
__device__ __forceinline__ unsigned xb_xcc_id() { return (unsigned)__builtin_amdgcn_s_getreg((3 << 11) | 20) & 0xFu; }
#define XB_SPIN(cond, bar) do { unsigned _sp = 0; while (cond) { __builtin_amdgcn_s_sleep(1); \
    if ((++_sp & 255u) == 0u) { if (xb_ld(&(bar)[XB_TMO])) break; if (_sp > XB_SPIN_CAP) { atomicAdd(&(bar)[XB_TMO], 1u); break; } } } } while (0)

struct XcdBarrier {
    unsigned* bar; unsigned x;
    volatile LAS unsigned* st;
};

__device__ __forceinline__ XcdBarrier xcd_barrier_post(unsigned* bar, volatile LAS unsigned* st) {
    XcdBarrier b; b.bar = bar; b.x = xb_xcc_id(); b.st = st;
    if (threadIdx.x == 0) (void)xb_add(&bar[XB_XCNT(b.x)], 1u);
    return b;
}
__device__ __forceinline__ void xcd_barrier_complete(unsigned* bar, unsigned x, unsigned& nloc, unsigned& nx) {
    const unsigned G = gridDim.x * gridDim.y * gridDim.z;
    unsigned sum, cnt, mine, sp = 0u;
    for (;;) {
        sum = 0u; cnt = 0u; mine = 0u;
#pragma unroll
        for (unsigned j = 0; j < 16; ++j) { const unsigned c = xb_ld(&bar[XB_XCNT(j)]); sum += c; cnt += (c > 0u) ? 1u : 0u; mine = (j == x) ? c : mine; }
        if (sum == G) break;
        __builtin_amdgcn_s_sleep(1);
        if ((++sp & 255u) == 0u) { if (xb_ld(&bar[XB_TMO])) break; if (sp > XB_SPIN_CAP) { atomicAdd(&bar[XB_TMO], 1u); break; } }
    }
    nloc = mine > 0u ? mine : 1u; nx = cnt > 0u ? cnt : 1u;
}

__device__ __forceinline__ void xcd_barrier(const XcdBarrier& b) {
    asm volatile("s_waitcnt vmcnt(0)" ::: "memory");
    __syncthreads();
    if (threadIdx.x == 0) {
        unsigned* bar = b.bar;
        __builtin_amdgcn_s_waitcnt(0);
        unsigned nloc = b.st[0], nx = b.st[1];
        if (nloc == 0u) { xcd_barrier_complete(bar, b.x, nloc, nx); b.st[0] = nloc; b.st[1] = nx; }
        const unsigned old = xb_add(&bar[XB_XSUB(b.x)], 1u);
        const unsigned gen = old / nloc;
        if (old + 1u == (gen + 1u) * nloc) {
            __builtin_amdgcn_fence(__ATOMIC_RELEASE, "agent");
            asm volatile("s_waitcnt vmcnt(0)" ::: "memory");
            const unsigned og = xb_add(&bar[XB_TOP], 1u);
            const unsigned tg = og / nx;
            if (og + 1u == (tg + 1u) * nx) xb_add(&bar[XB_TOPGEN], 1u);
            else XB_SPIN(xb_ld(&bar[XB_TOPGEN]) == tg, bar);
            __builtin_amdgcn_fence(__ATOMIC_ACQUIRE, "agent");
            xb_add(&bar[XB_XGEN(b.x)], 1u);
            asm volatile("s_waitcnt vmcnt(0)" ::: "memory");
        } else {
            XB_SPIN(xb_ld(&bar[XB_XGEN(b.x)]) == gen, bar);
            __builtin_amdgcn_fence(__ATOMIC_ACQUIRE, "agent");
            asm volatile("s_waitcnt vmcnt(0)" ::: "memory");
        }
    }
    __syncthreads();
}


constexpr int NWAVES = 8;
#ifndef MK_N_LAUNCHES
#define MK_N_LAUNCHES 1
#endif
constexpr int N_PHASES = 9;
constexpr int N_LAUNCHES = MK_N_LAUNCHES;
constexpr int BATCH = 2, SEQ = 8192, T = BATCH * SEQ, D = 1024;
constexpr int DIN = 9728, NQKV = 4608, NCG = 5120, GW = 512, DAO = 512;
constexpr int NEXP = 16384, PEER_H = 8, PEER_K = 16, HK = 128;
constexpr float RMS_EPS = 1e-6f;
constexpr float C2 = 0.125f * 1.4426950408889634f;
constexpr float LN2 = 0.6931471805599453f;

constexpr size_t MiB = 1u << 20;
constexpr size_t WS_CTL = 0, CTL_ZERO_BYTES = 64 * 1024;
constexpr size_t WS_ROPE = 1 * MiB, WS_RSQ = 2 * MiB, WS_LSE = 3 * MiB;
constexpr size_t WS_WQKV = 5 * MiB, WS_WCG = 14 * MiB;
constexpr size_t WS_U = 24 * MiB, WS_Q = 56 * MiB, WS_K = 104 * MiB, WS_V = 152 * MiB, WS_O = 200 * MiB;
constexpr size_t WS_BB = 104 * MiB, WS_Z = 136 * MiB, WS_SGC = 168 * MiB, WS_SGA = 216 * MiB;
constexpr size_t WS_WCONV = 248 * MiB, WS_WATTN = 250 * MiB, WS_WOUT = 251 * MiB;
constexpr size_t WS_EDOWN = 24 * MiB, WS_EUP = 56 * MiB, WS_WFOLD = 5 * MiB;
constexpr size_t WS_Y = 136 * MiB, WS_H = 168 * MiB, WS_HG = 104 * MiB;
constexpr size_t WS_IDX = 9 * MiB, WS_GATE = 248 * MiB;
constexpr size_t WS_SCR0 = 136 * MiB, WS_SCR1 = 88 * MiB, WS_SCR2 = 232 * MiB;
constexpr size_t WS_END = 256 * MiB;
constexpr int CW_TMO = 0, CW_BAR = 1024;

constexpr int RING_BYTES = 131072, MISC_OFF = RING_BYTES + 320, LDS_BYTES = 147456;

using pg8::Unit; using pg8::Gemm; using pg8::StaticOrder; using pg8::gemm_phase; using pg8::cvt_pk_bf16;
typedef unsigned short bf16;
typedef unsigned u32x4 __attribute__((ext_vector_type(4)));
typedef unsigned u32x2 __attribute__((ext_vector_type(2)));
typedef float f32x4 __attribute__((ext_vector_type(4)));
typedef short bf16x8 __attribute__((ext_vector_type(8)));
typedef short s16x4 __attribute__((ext_vector_type(4)));
typedef short v4i16_t __attribute__((ext_vector_type(4)));
#define LAS __attribute__((address_space(3)))

__device__ __forceinline__ float bf_lo(unsigned w) { return __builtin_bit_cast(float, w << 16); }
__device__ __forceinline__ float bf_hi(unsigned w) { return __builtin_bit_cast(float, w & 0xffff0000u); }
__device__ __forceinline__ u32x4 pack8(f32x4 a, f32x4 b) { u32x4 w; w.x = cvt_pk_bf16(a[0], a[1]); w.y = cvt_pk_bf16(a[2], a[3]); w.z = cvt_pk_bf16(b[0], b[1]); w.w = cvt_pk_bf16(b[2], b[3]); return w; }
__device__ __forceinline__ void unpack8(u32x4 w, f32x4& a, f32x4& b) { a = (f32x4){bf_lo(w.x), bf_hi(w.x), bf_lo(w.y), bf_hi(w.y)}; b = (f32x4){bf_lo(w.z), bf_hi(w.z), bf_lo(w.w), bf_hi(w.w)}; }
__device__ __forceinline__ float wave_sum(float v) {
#pragma unroll
    for (int o = 1; o < 64; o <<= 1) v += __shfl_xor(v, o);
    return v;
}
__device__ __forceinline__ float sigmoidf_(float x) { return 1.f / (1.f + __expf(-x)); }

struct QkvOrder : StaticOrder {
    const char* U;
    __device__ __forceinline__ const char* a_base(const Unit& u, int& sh) const {
        const int g = u.pn / 6; sh = 2 * g;
        const int b = u.pm >> 5, lp0 = (u.pm & 31) * 256;
        const int r = lp0 >> (13 - sh), i0 = lp0 & ((SEQ >> sh) - 1);
        const int t0 = b * SEQ + (i0 << sh) + r;
        return U + (size_t)t0 * (D * 2);
    }
};
struct EpiQKV {
    static constexpr bool PERM = true, AFTER_DRAIN = false;
    bf16* Q; const float* rope;
    __device__ __forceinline__ void operator()(const f32x4 (&acc)[2][2][4][2], const Unit& u, int wr, int wc, int fr, int fq) const {
        const int g = u.pn / 6, kind = (u.pn % 6) >> 1, half = u.pn & 1, sh = 2 * g;
        bf16* base = Q + (size_t)kind * ((WS_K - WS_Q) / 2) + (size_t)g * T * GW;
        const int b = u.pm >> 5, lp0 = (u.pm & 31) * 256;
        const bool rot = (kind < 2) && ((wc & 1) == 0);
        const float sc = (kind == 0) ? C2 : 1.f;
        const float sgn = (fq == 0) ? -1.f : 1.f; const bool use = fq < 2;
#pragma unroll
        for (int ai = 0; ai < 2; ++ai)
#pragma unroll
            for (int m = 0; m < 4; ++m) {
                const int rl = ai * 128 + wr * 64 + m * 16 + fr, lp = lp0 + rl;
                const int tok = b * SEQ + ((lp & ((SEQ >> sh) - 1)) << sh) + (lp >> (13 - sh));
                f32x4 c0 = {1.f, 1.f, 1.f, 1.f}, c1 = c0, s0 = {0.f, 0.f, 0.f, 0.f}, s1 = s0;
                if (rot) { const f32x4* rp = (const f32x4*)(rope + (size_t)tok * 16); c0 = rp[0]; c1 = rp[1]; s0 = rp[2]; s1 = rp[3]; }
                bf16* rowp = base + (size_t)(u.pm * 256 + rl) * GW + half * 256 + wc * 32 + fq * 8;
#pragma unroll
                for (int bj = 0; bj < 2; ++bj) {
                    f32x4 v0 = acc[ai][bj][m][0], v1 = acc[ai][bj][m][1];
                    if (rot) {
                        f32x4 o0, o1;
#pragma unroll
                        for (int e = 0; e < 4; ++e) { o0[e] = __shfl_xor(v0[e], 16); o1[e] = __shfl_xor(v1[e], 16); }
                        const f32x4 r0 = v0 * c0 + (o0 * s0) * sgn, r1 = v1 * c1 + (o1 * s1) * sgn;
                        v0 = use ? r0 : v0; v1 = use ? r1 : v1;
                    }
                    v0 = v0 * sc; v1 = v1 * sc;
                    *(u32x4*)(rowp + bj * 128) = pack8(v0, v1);
                }
            }
    }
};
struct EpiCG {
    static constexpr bool PERM = true, AFTER_DRAIN = false;
    bf16* Bb; bf16* Z; bf16* SGC; bf16* SGA; const float* gbias;
    __device__ __forceinline__ void operator()(const f32x4 (&acc)[2][2][4][2], const Unit& u, int wr, int wc, int fr, int fq) const {
        const int pn = u.pn;
#pragma unroll
        for (int ai = 0; ai < 2; ++ai)
#pragma unroll
            for (int m = 0; m < 4; ++m) {
                const size_t row = (size_t)u.pm * 256 + ai * 128 + wr * 64 + m * 16 + fr;
                if (pn < 4) {
#pragma unroll
                    for (int bj = 0; bj < 2; ++bj) *(u32x4*)(Bb + row * D + pn * 256 + bj * 128 + wc * 32 + fq * 8) = pack8(acc[ai][bj][m][0], acc[ai][bj][m][1]);
                } else if (pn < 12) {
                    const f32x4 z0 = acc[ai][0][m][0] * acc[ai][1][m][0], z1 = acc[ai][0][m][1] * acc[ai][1][m][1];
                    *(u32x4*)(Z + row * D + (pn - 4) * 128 + wc * 32 + fq * 8) = pack8(z0, z1);
                } else {
                    const int gsel = (pn >= 16) ? 1 : 0; bf16* out = gsel ? SGA : SGC;
#pragma unroll
                    for (int bj = 0; bj < 2; ++bj) {
                        const int col = (pn - 12 - 4 * gsel) * 256 + bj * 128 + wc * 32 + fq * 8;
                        const f32x4 b0 = *(const f32x4*)(gbias + gsel * D + col), b1 = *(const f32x4*)(gbias + gsel * D + col + 4);
                        f32x4 v0 = acc[ai][bj][m][0] + b0, v1 = acc[ai][bj][m][1] + b1;
#pragma unroll
                        for (int e = 0; e < 4; ++e) { v0[e] = sigmoidf_(v0[e]); v1[e] = sigmoidf_(v1[e]); }
                        *(u32x4*)(out + row * D + col) = pack8(v0, v1);
                    }
                }
            }
    }
};
template <int MODE> struct EpiY {
    static constexpr bool PERM = true, AFTER_DRAIN = false;
    bf16* Y; const bf16* G;
    __device__ __forceinline__ void operator()(const f32x4 (&acc)[2][2][4][2], const Unit& u, int wr, int wc, int fr, int fq) const {
#pragma unroll
        for (int ai = 0; ai < 2; ++ai)
#pragma unroll
            for (int m = 0; m < 4; ++m) {
                const size_t row = (size_t)u.pm * 256 + ai * 128 + wr * 64 + m * 16 + fr;
#pragma unroll
                for (int bj = 0; bj < 2; ++bj) {
                    const size_t off = row * D + u.pn * 256 + bj * 128 + wc * 32 + fq * 8;
                    f32x4 g0, g1; unpack8(*(const u32x4*)(G + off), g0, g1);
                    f32x4 v0 = acc[ai][bj][m][0] * g0, v1 = acc[ai][bj][m][1] * g1;
                    if (MODE == 1) { f32x4 y0, y1; unpack8(*(const u32x4*)(Y + off), y0, y1); v0 = v0 + y0; v1 = v1 + y1; }
                    *(u32x4*)(Y + off) = pack8(v0, v1);
                }
            }
    }
};
struct EpiOut {
    static constexpr bool PERM = true, AFTER_DRAIN = false;
    const float* X; float* H; bf16* HG; const float* nffn; float* RSQ;
    __device__ __forceinline__ void operator()(const f32x4 (&acc)[2][2][4][2], const Unit& u, int wr, int wc, int fr, int fq) const {
#pragma unroll
        for (int ai = 0; ai < 2; ++ai)
#pragma unroll
            for (int m = 0; m < 4; ++m) {
                const size_t row = (size_t)u.pm * 256 + ai * 128 + wr * 64 + m * 16 + fr;
                float ss = 0.f;
#pragma unroll
                for (int bj = 0; bj < 2; ++bj) {
                    const int col = u.pn * 256 + bj * 128 + wc * 32 + fq * 8; const size_t off = row * D + col;
                    const f32x4 h0 = *(const f32x4*)(X + off) + acc[ai][bj][m][0], h1 = *(const f32x4*)(X + off + 4) + acc[ai][bj][m][1];
                    *(f32x4*)(H + off) = h0; *(f32x4*)(H + off + 4) = h1;
                    const f32x4 n0 = *(const f32x4*)(nffn + col), n1 = *(const f32x4*)(nffn + col + 4);
                    *(u32x4*)(HG + off) = pack8(h0 * n0, h1 * n1);
                    ss += (h0[0] * h0[0] + h0[1] * h0[1]) + (h0[2] * h0[2] + h0[3] * h0[3]) + (h1[0] * h1[0] + h1[1] * h1[1]) + (h1[2] * h1[2] + h1[3] * h1[3]);
                }
                ss += __shfl_xor(ss, 16); ss += __shfl_xor(ss, 32);
                if (fq == 0) RSQ[row * 16 + u.pn * 4 + wc] = ss;
            }
    }
};
__device__ __forceinline__ int f2key(float f) { const int b = __builtin_bit_cast(int, f); return b ^ ((b >> 31) & 0x7fffffff); }
__device__ __forceinline__ float key2f(int k) { return __builtin_bit_cast(float, k ^ ((k >> 31) & 0x7fffffff)); }
#define TOPK_INS(list, x) do { _Pragma("unroll") for (int _k = 0; _k < 16; ++_k) { const int _hi = max(list[_k], x); x = min(list[_k], x); list[_k] = _hi; } } while (0)
__device__ __forceinline__ unsigned long long pack8idx(const int (&a)[16], int o) { unsigned long long r = 0ull;
#pragma unroll
    for (int k = 0; k < 8; ++k) r |= (unsigned long long)(unsigned)(a[o + k] & 127) << (8 * k);
    return r; }
__device__ __forceinline__ int lut16(unsigned long long lo, unsigned long long hi, int i) { const unsigned long long w = (i < 8) ? lo : hi; return (int)((w >> ((i & 7) * 8)) & 127ull); }
struct EpiTopk {
    static constexpr bool PERM = true, AFTER_DRAIN = false;
    float* scr; const float* RSQ; int* IDX; float* GATE;
    __device__ __forceinline__ void operator()(const f32x4 (&acc)[2][2][4][2], const Unit& u, int wr, int wc, int fr, int fq) const {
        const __amdgpu_buffer_rsrc_t rsrc = __builtin_amdgcn_make_buffer_rsrc(scr, 0, 262144, 0x00020000);
        const int voff = ((wc * 32 + fq * 8) * 256 + wr * 64 + fr) * 4;
#pragma unroll
        for (int ai = 0; ai < 2; ++ai)
#pragma unroll
            for (int m = 0; m < 4; ++m)
#pragma unroll
                for (int bj = 0; bj < 2; ++bj)
#pragma unroll
                    for (int n = 0; n < 2; ++n)
#pragma unroll
                        for (int e = 0; e < 4; ++e)
                        { const float val = acc[ai][bj][m][n][e]; __builtin_amdgcn_raw_buffer_store_b32(__builtin_bit_cast(unsigned, val), rsrc, voff, ((bj * 128 + n * 4 + e) * 256 + ai * 128 + m * 16) * 4, 0); }
        asm volatile("s_waitcnt vmcnt(0)" ::: "memory");
        __builtin_amdgcn_s_barrier();
        asm volatile("" ::: "memory");
        const int tid = threadIdx.x, row = tid >> 1, c = tid & 1;
        int v[16];
#pragma unroll
        for (int k = 0; k < 16; ++k) v[k] = (int)0x80000000;
        const int roff = (c * 128 * 256 + row) * 4;
#pragma unroll 1
        for (int k0 = 0; k0 < 128; k0 += 16) {
            float xs[16];
#pragma unroll
            for (int j = 0; j < 16; ++j) xs[j] = __builtin_bit_cast(float, __builtin_amdgcn_raw_buffer_load_b32(rsrc, roff, (k0 + j) * 1024, 2));
#pragma unroll
            for (int j = 0; j < 16; ++j) { int x = (f2key(xs[j]) & ~127) | (k0 + j); TOPK_INS(v, x); }
        }
        int A[16], B[16];
#pragma unroll
        for (int k = 0; k < 16; ++k) { const int o = __shfl_xor(v[k], 1); A[k] = c ? o : v[k]; B[k] = c ? v[k] : o; }
        int c2[16];
#pragma unroll
        for (int k = 0; k < 16; ++k) c2[k] = (int)0x80000000;
#pragma unroll
        for (int i = 0; i < 16; ++i)
#pragma unroll
            for (int j = 0; j < 16; ++j)
                if ((i + 1) * (j + 1) <= 16) { int x = (f2key(key2f(A[i]) + key2f(B[j])) & ~255) | (i * 16 + j); TOPK_INS(c2, x); }
        const size_t t = (size_t)u.pm * 256 + row;
        float ssq = 0.f;
#pragma unroll
        for (int j = 0; j < 4; ++j) { const f32x4 q = *(const f32x4*)(RSQ + t * 16 + 4 * j); ssq += (q[0] + q[1]) + (q[2] + q[3]); }
        const float rstd = __builtin_amdgcn_rsqf(ssq * (1.f / D) + RMS_EPS);
        const unsigned long long alo = pack8idx(A, 0), ahi = pack8idx(A, 8), blo = pack8idx(B, 0), bhi = pack8idx(B, 8);
        float sc[16]; int id[16]; float smax = 0.f, ssum = 0.f;
#pragma unroll
        for (int k = 0; k < 16; ++k) {
            const int cid = c2[k] & 255, i = cid >> 4, j = cid & 15;
            id[k] = lut16(alo, ahi, i) * 128 + lut16(blo, bhi, j);
            sc[k] = key2f(c2[k]) * rstd;
            if (k == 0) smax = sc[0];
            sc[k] = __expf(sc[k] - smax); ssum += sc[k];
        }
        const float inv = 1.f / ssum;
        int* ip = IDX + t * HK + u.pn * 16; float* gp = GATE + t * HK + u.pn * 16;
#pragma unroll
        for (int k = 0; k < 16; ++k) if ((k >> 3) == c) { ip[k] = id[k]; gp[k] = sc[k] * inv; }
    }
};

struct Frame {
    LAS unsigned char* lds;
    volatile LAS unsigned* MISC;
    gu32* ctl;
    int tid, lane, wave, vcu, G;
    unsigned char* ws;
    const float* in[15]; float* out;
};
enum { I_X = 0, I_POS, I_NMIX, I_WIN, I_CONVW, I_WCONV, I_WATTN, I_GBIAS, I_WOUT, I_NFFN, I_WQ, I_SUBK, I_DOWN, I_UP, I_FNORM };

__device__ __forceinline__ void transpose_item(const float* W, int ldw, int k0, int n0, bf16* dst, int ldd, LAS float* scr, int lane) {
#pragma unroll 8
    for (int i = 0; i < 32; ++i) { const int kk = 2 * i + (lane >> 5); scr[kk * 33 + (lane & 31)] = W[(size_t)(k0 + kk) * ldw + n0 + (lane & 31)]; }
    LDS_WAIT(); asm volatile("" ::: "memory");
    const int c = lane & 7;
#pragma unroll
    for (int j = 0; j < 4; ++j) { const int n = (lane >> 3) + 8 * j; const LAS float* s = scr + (8 * c) * 33 + n;
        v4u o; o.x = pk2(s[0 * 33], s[1 * 33]); o.y = pk2(s[2 * 33], s[3 * 33]); o.z = pk2(s[4 * 33], s[5 * 33]); o.w = pk2(s[6 * 33], s[7 * 33]);
        *(GAS v4u*)(dst + (size_t)n * ldd + 8 * c) = o; }
    LDS_WAIT(); asm volatile("" ::: "memory");
}
__device__ __forceinline__ bf16* win_dst_row(unsigned char* ws, int n0) {
    bf16* wqkv = (bf16*)(ws + WS_WQKV); bf16* wcg = (bf16*)(ws + WS_WCG);
    if (n0 < 1024) return wcg + (size_t)n0 * D;
    if (n0 < 2048) { const int j = n0 - 1024; return wcg + (size_t)(1024 + (j >> 7) * 256 + (j & 127)) * D; }
    if (n0 < 3072) { const int j = n0 - 2048; return wcg + (size_t)(1024 + (j >> 7) * 256 + 128 + (j & 127)) * D; }
    if (n0 < 7680) { const int j = n0 - 3072, kind = j / 1536, jj = j % 1536, g = jj >> 9, cc = jj & 511; return wqkv + (size_t)(g * 1536 + kind * 512 + cc) * D; }
    if (n0 < 8704) return wcg + (size_t)(3072 + (n0 - 7680)) * D;
    return wcg + (size_t)(4096 + (n0 - 8704)) * D;
}
__device__ __forceinline__ void p0_prologue(Frame& F) {
    LAS float* scr = (LAS float*)(F.lds + F.wave * 16384);
    const int gw = F.vcu * NWAVES + F.wave, NGW = F.G * NWAVES;
    constexpr int I_IN = 16 * (DIN / 32), I_C = 16 * 32, I_A = 8 * 32, I_O = 16 * 32, NITEMS = I_IN + I_C + I_A + I_O;
    for (int it = gw; it < NITEMS; it += NGW) {
        int r = it;
        if (r < I_IN) { const int nblk = DIN / 32, kb = r / nblk, nb = r % nblk; transpose_item(F.in[I_WIN], DIN, 64 * kb, 32 * nb, win_dst_row(F.ws, 32 * nb) + 64 * kb, D, scr, F.lane); continue; } r -= I_IN;
        if (r < I_C) { const int kb = r / 32, nb = r % 32; transpose_item(F.in[I_WCONV], D, 64 * kb, 32 * nb, (bf16*)(F.ws + WS_WCONV) + (size_t)(32 * nb) * D + 64 * kb, D, scr, F.lane); continue; } r -= I_C;
        if (r < I_A) { const int kb = r / 32, nb = r % 32; transpose_item(F.in[I_WATTN], D, 64 * kb, 32 * nb, (bf16*)(F.ws + WS_WATTN) + (size_t)(32 * nb) * DAO + 64 * kb, DAO, scr, F.lane); continue; } r -= I_A;
        { const int kb = r / 32, nb = r % 32; transpose_item(F.in[I_WOUT], D, 64 * kb, 32 * nb, (bf16*)(F.ws + WS_WOUT) + (size_t)(32 * nb) * D + 64 * kb, D, scr, F.lane); }
    }
    const float* x = F.in[I_X]; const float* nm = F.in[I_NMIX]; bf16* U = (bf16*)(F.ws + WS_U);
    f32x4 gm[4];
#pragma unroll
    for (int j = 0; j < 4; ++j) gm[j] = *((const f32x4*)nm + F.lane + 64 * j);
    for (int m = gw; m < T; m += NGW) {
        const GAS f32x4* xr = (const GAS f32x4*)(x + (size_t)m * D) + F.lane;
        f32x4 v[4]; float s = 0.f;
#pragma unroll
        for (int j = 0; j < 4; ++j) { v[j] = xr[64 * j]; s += (v[j].x * v[j].x + v[j].y * v[j].y) + (v[j].z * v[j].z + v[j].w * v[j].w); }
        const float rstd = 1.f / sqrtf(wave_sum(s) * (1.f / D) + RMS_EPS);
        GAS unsigned long long* o8 = (GAS unsigned long long*)(U + (size_t)m * D) + F.lane;
#pragma unroll
        for (int j = 0; j < 4; ++j) { const f32x4 y = v[j] * rstd * gm[j]; o8[64 * j] = (unsigned long long)pk2(y.x, y.y) | ((unsigned long long)pk2(y.z, y.w) << 32); }
    }
    const int* pos = (const int*)F.in[I_POS]; float* rope = (float*)(F.ws + WS_ROPE);
    for (int e = gw * 64 + F.lane; e < T * 8; e += NGW * 64) {
        const int t = e >> 3, j = e & 7;
        const double invf[8] = {1.0, 0.19392274474868576, 0.03760603093086393, 0.007292664737217109, 0.001414213562373095, 0.0002742481756762073, 5.318295896944988e-05, 1.031338537721246e-05};
        double f = 1.0;
#pragma unroll
        for (int q = 1; q < 8; ++q) f = (j == q) ? invf[q] : f;
        const float fi = (float)f;
        const double ang = (double)pos[t] * (double)fi;
        const double k = __builtin_rint(ang * 0.15915494309189535);
        const float r = (float)(ang - k * 6.283185307179586);
        rope[(size_t)t * 16 + j] = __cosf(r); rope[(size_t)t * 16 + 8 + j] = __sinf(r);
    }
}

__device__ __forceinline__ void attn_phase(Frame& F) {
    LAS unsigned char* Ks = F.lds; LAS unsigned char* Vs = F.lds + 40960;
    const int lane = F.lane, w = F.wave, ir = lane & 15, gq = lane >> 4;
    const int NU = 3 * 8 * 128, per = (NU + F.G - 1) / F.G;
    const int u0 = F.vcu * per, u1 = (u0 + per < NU) ? u0 + per : NU;
    bf16* Qb = (bf16*)(F.ws + WS_Q); const bf16* Kb = (const bf16*)(F.ws + WS_K); const bf16* Vb = (const bf16*)(F.ws + WS_V); float* LSE = (float*)(F.ws + WS_LSE);
    for (int uid = u0; uid < u1; ++uid) {
        const int g = uid >> 10, hh = (uid >> 7) & 7, blk = uid & 127, sh = 2 * g;
        const bool first = (blk & ((64 >> sh) - 1)) == 0;
        const size_t gbase = (size_t)g * T * GW;
        const int p0 = blk * 128;
#pragma unroll
        for (int i = 0; i < 4; ++i) {
            const int c = F.tid + 512 * i, row = c >> 3, part = c & 7;
            const bool valid = !first || row >= 128;
            u32x4 kv = {0u, 0u, 0u, 0u}, vv = {0u, 0u, 0u, 0u};
            if (valid) { const size_t off = gbase + (size_t)(p0 - 128 + row) * GW + hh * 64 + part * 8; kv = *(const u32x4*)(Kb + off); vv = *(const u32x4*)(Vb + off); }
            *(LAS u32x4*)(Ks + row * 160 + part * 16) = kv; *(LAS u32x4*)(Vs + row * 160 + part * 16) = vv;
        }
        bf16* qrow = Qb + gbase + (size_t)(p0 + 16 * w + ir) * GW + hh * 64;
        const bf16x8 qf0 = *(const bf16x8*)(qrow + 8 * gq), qf1 = *(const bf16x8*)(qrow + 32 + 8 * gq);
        __syncthreads();
        f32x4 sacc[9];
#pragma unroll
        for (int a = 0; a < 9; ++a) {
            sacc[a] = (f32x4){0.f, 0.f, 0.f, 0.f};
            const LAS unsigned char* kp = Ks + (16 * w + 16 * a + ir) * 160 + gq * 16;
            const bf16x8 k0 = *(const LAS bf16x8*)kp, k1 = *(const LAS bf16x8*)(kp + 64);
            sacc[a] = __builtin_amdgcn_mfma_f32_16x16x32_bf16(k0, qf0, sacc[a], 0, 0, 0);
            sacc[a] = __builtin_amdgcn_mfma_f32_16x16x32_bf16(k1, qf1, sacc[a], 0, 0, 0);
        }
        float mx = -INFINITY;
#pragma unroll
        for (int a = 0; a < 9; ++a)
#pragma unroll
            for (int j = 0; j < 4; ++j) {
                const int jl = 4 * gq + j;
                bool valid = (a == 0) ? (jl >= ir) : ((a == 8) ? (jl <= ir) : true);
                valid = valid && (!first || (16 * w + 16 * a + jl >= 128));
                sacc[a][j] = valid ? sacc[a][j] : -INFINITY;
                mx = fmaxf(mx, sacc[a][j]);
            }
        mx = fmaxf(mx, __shfl_xor(mx, 16)); mx = fmaxf(mx, __shfl_xor(mx, 32));
        float l = 0.f;
#pragma unroll
        for (int a = 0; a < 9; ++a)
#pragma unroll
            for (int j = 0; j < 4; ++j) { sacc[a][j] = __builtin_amdgcn_exp2f(sacc[a][j] - mx); l += sacc[a][j]; }
        l += __shfl_xor(l, 16); l += __shfl_xor(l, 32);
        f32x4 oacc[4];
#pragma unroll
        for (int dt = 0; dt < 4; ++dt) oacc[dt] = (f32x4){0.f, 0.f, 0.f, 0.f};
#pragma unroll
        for (int s = 0; s < 5; ++s) {
            u32x4 pw; pw.x = cvt_pk_bf16(sacc[2 * s][0], sacc[2 * s][1]); pw.y = cvt_pk_bf16(sacc[2 * s][2], sacc[2 * s][3]);
            if (s < 4) { pw.z = cvt_pk_bf16(sacc[2 * s + 1][0], sacc[2 * s + 1][1]); pw.w = cvt_pk_bf16(sacc[2 * s + 1][2], sacc[2 * s + 1][3]); } else { pw.z = 0u; pw.w = 0u; }
            const bf16x8 pb = __builtin_bit_cast(bf16x8, pw);
            const int q = ir >> 2, p = ir & 3;
            const LAS unsigned char* vp = Vs + (16 * w + 32 * s + 4 * gq + q) * 160 + p * 8;
#pragma unroll
            for (int dt = 0; dt < 4; ++dt) {
                const s16x4 va = __builtin_bit_cast(s16x4, __builtin_amdgcn_ds_read_tr16_b64_v4i16((LAS v4i16_t*)(vp + dt * 32)));
                s16x4 vb = {0, 0, 0, 0};
                if (s < 4) vb = __builtin_bit_cast(s16x4, __builtin_amdgcn_ds_read_tr16_b64_v4i16((LAS v4i16_t*)(vp + 16 * 160 + dt * 32)));
                const bf16x8 vf = __builtin_shufflevector(va, vb, 0, 1, 2, 3, 4, 5, 6, 7);
                oacc[dt] = __builtin_amdgcn_mfma_f32_16x16x32_bf16(vf, pb, oacc[dt], 0, 0, 0);
            }
        }
        const float inv = 1.f / l;
#pragma unroll
        for (int dt = 0; dt < 4; ++dt) {
            u32x2 o; o.x = cvt_pk_bf16(oacc[dt][0] * inv, oacc[dt][1] * inv); o.y = cvt_pk_bf16(oacc[dt][2] * inv, oacc[dt][3] * inv);
            *(u32x2*)(qrow + 16 * dt + 4 * gq) = o;
        }
        if (gq == 0) LSE[((size_t)g * T + p0 + 16 * w + ir) * 8 + hh] = (mx + __builtin_amdgcn_logf(l)) * LN2;
        __syncthreads();
    }
}

__device__ __forceinline__ void combine_phase(Frame& F) {
    const int gw = F.vcu * NWAVES + F.wave, NGW = F.G * NWAVES, lane = F.lane, hh = lane >> 3;
    const bf16* OG = (const bf16*)(F.ws + WS_Q); const float* LSE = (const float*)(F.ws + WS_LSE); bf16* O = (bf16*)(F.ws + WS_O);
    for (int t = gw; t < T; t += NGW) {
        const int b = t / SEQ, s = t % SEQ;
        float ls[3]; u32x4 og[3];
#pragma unroll
        for (int g = 0; g < 3; ++g) {
            const int sh = 2 * g, r = s & ((1 << sh) - 1), i = s >> sh;
            const size_t p = (size_t)g * T + b * SEQ + r * (SEQ >> sh) + i;
            ls[g] = LSE[p * 8 + hh]; og[g] = *(const u32x4*)(OG + p * GW + lane * 8);
        }
        const float m = fmaxf(ls[0], fmaxf(ls[1], ls[2]));
        float e[3], sum = 0.f;
#pragma unroll
        for (int g = 0; g < 3; ++g) { e[g] = __expf(ls[g] - m); sum += e[g]; }
        const float inv = 1.f / sum;
        f32x4 a0 = {0.f, 0.f, 0.f, 0.f}, a1 = a0;
#pragma unroll
        for (int g = 0; g < 3; ++g) { f32x4 v0, v1; unpack8(og[g], v0, v1); const float wg = e[g] * inv; a0 = a0 + v0 * wg; a1 = a1 + v1 * wg; }
        *(u32x4*)(O + (size_t)t * DAO + lane * 8) = pack8(a0, a1);
    }
}

__device__ __forceinline__ void p4_phase(Frame& F) {
    const int gt = (F.vcu * NWAVES + F.wave) * 64 + F.lane, NGT = F.G * NWAVES * 64;
    bf16* Bb = (bf16*)(F.ws + WS_BB); const bf16* Z = (const bf16*)(F.ws + WS_Z); const float* cw = F.in[I_CONVW];
    for (int e = gt; e < T * (D / 8); e += NGT) {
        const int t = e >> 7, c8 = (e & 127) * 8, s = t & (SEQ - 1);
        const size_t off = (size_t)t * D + c8;
        f32x4 z0a, z0b, z1a = {0.f, 0.f, 0.f, 0.f}, z1b = z1a, z2a = z1a, z2b = z1a, ba, bb;
        unpack8(*(const u32x4*)(Z + off), z0a, z0b);
        if (s >= 1) unpack8(*(const u32x4*)(Z + off - D), z1a, z1b);
        if (s >= 2) unpack8(*(const u32x4*)(Z + off - 2 * D), z2a, z2b);
        unpack8(*(const u32x4*)(Bb + off), ba, bb);
        const f32x4 w0a = *(const f32x4*)(cw + c8), w0b = *(const f32x4*)(cw + c8 + 4), w1a = *(const f32x4*)(cw + D + c8), w1b = *(const f32x4*)(cw + D + c8 + 4), w2a = *(const f32x4*)(cw + 2 * D + c8), w2b = *(const f32x4*)(cw + 2 * D + c8 + 4);
        const f32x4 ca = w0a * z2a + w1a * z1a + w2a * z0a, cb = w0b * z2b + w1b * z1b + w2b * z0b;
        *(u32x4*)(Bb + off) = pack8(ba * ca, bb * cb);
    }
    const float* dn = F.in[I_DOWN]; const float* up = F.in[I_UP]; bf16* dnb = (bf16*)(F.ws + WS_EDOWN); bf16* upb = (bf16*)(F.ws + WS_EUP);
    for (int e = gt; e < NEXP * (D / 8); e += NGT) {
        const size_t off = (size_t)e * 8;
        const f32x4 a0 = *(const f32x4*)(dn + off), a1 = *(const f32x4*)(dn + off + 4), b0 = *(const f32x4*)(up + off), b1 = *(const f32x4*)(up + off + 4);
        *(u32x4*)(dnb + off) = pack8(a0, a1); *(u32x4*)(upb + off) = pack8(b0, b1);
    }
    const int gw = F.vcu * NWAVES + F.wave, NGW = F.G * NWAVES;
    const float* Wq = F.in[I_WQ]; const float* SK = F.in[I_SUBK]; bf16* WF = (bf16*)(F.ws + WS_WFOLD);
    LAS float* sks = (LAS float*)(F.lds + F.wave * 16384);
    for (int it = gw; it < 16 * 16 * 4; it += NGW) {
        const int itu = __builtin_amdgcn_readfirstlane(it);
        const int hc = itu >> 6, kb = (itu >> 2) & 15, keyb = itu & 3, k = kb * 64 + F.lane;
#pragma unroll
        for (int j = 0; j < 16; ++j) *(LAS f32x4*)(sks + (j * 64 + F.lane) * 4) = *(const f32x4*)(SK + (size_t)(hc * 128 + keyb * 32) * 128 + (j * 64 + F.lane) * 4);
        f32x4 wq[32];
#pragma unroll
        for (int j = 0; j < 32; ++j) wq[j] = *(const f32x4*)(Wq + (size_t)k * 2048 + hc * 128 + 4 * j);
        LDS_WAIT(); asm volatile("" ::: "memory");
#pragma unroll 1
        for (int key = 0; key < 32; ++key) {
            f32x4 a = {0.f, 0.f, 0.f, 0.f};
#pragma unroll
            for (int j = 0; j < 32; ++j) a = a + wq[j] * *(const LAS f32x4*)(sks + key * 128 + 4 * j);
            WF[(size_t)(hc * 128 + keyb * 32 + key) * D + k] = (bf16)f2bf((a[0] + a[1]) + (a[2] + a[3]));
        }
        LDS_WAIT(); asm volatile("" ::: "memory");
    }
}

__device__ __forceinline__ float gelu_erf(float v) { return 0.5f * v * (1.f + erff(v * 0.70710678118654752f)); }
__device__ __forceinline__ void peer_phase(Frame& F) {
    const int gw = F.vcu * NWAVES + F.wave, NGW = F.G * NWAVES, lane = F.lane, sub = lane & 15, gq = lane >> 4;
    const bf16* HG = (const bf16*)(F.ws + WS_HG); const float* H = (const float*)(F.ws + WS_H); const float* RSQ = (const float*)(F.ws + WS_RSQ);
    const int* IDX = (const int*)(F.ws + WS_IDX); const float* GATE = (const float*)(F.ws + WS_GATE);
    const bf16* dnb = (const bf16*)(F.ws + WS_EDOWN); const bf16* upb = (const bf16*)(F.ws + WS_EUP);
    const float* fn = F.in[I_FNORM]; float* out = F.out;
    LAS float* wl = (LAS float*)(F.lds + F.wave * 512);
    for (int t = gw; t < T; t += NGW) {
        const int tu = __builtin_amdgcn_readfirstlane(t);
        float pq = (lane < 16) ? RSQ[(size_t)tu * 16 + lane] : 0.f; pq = wave_sum(pq);
        const float rstd = __builtin_amdgcn_rsqf(pq * (1.f / D) + RMS_EPS);
        const int i0 = IDX[(size_t)tu * HK + lane], i1 = IDX[(size_t)tu * HK + 64 + lane];
        const float g0 = GATE[(size_t)tu * HK + lane], g1 = GATE[(size_t)tu * HK + 64 + lane];
        f32x4 hx[8][2];
#pragma unroll
        for (int j = 0; j < 8; ++j) unpack8(*(const u32x4*)(HG + (size_t)tu * D + 8 * (sub + 16 * j)), hx[j][0], hx[j][1]);
        float areg0 = 0.f, areg1 = 0.f;
#pragma unroll 2
        for (int r = 0; r < 32; ++r) {
            const int e = 4 * r + gq;
            const int ei = __shfl((e < 64) ? i0 : i1, e & 63);
            const bf16* rowp = dnb + (size_t)ei * D + 8 * sub;
            float acc = 0.f;
#pragma unroll
            for (int j = 0; j < 8; ++j) { f32x4 d0, d1; unpack8(*(const u32x4*)(rowp + 128 * j), d0, d1);
                acc += (d0[0] * hx[j][0][0] + d0[1] * hx[j][0][1]) + (d0[2] * hx[j][0][2] + d0[3] * hx[j][0][3]) + (d1[0] * hx[j][1][0] + d1[1] * hx[j][1][1]) + (d1[2] * hx[j][1][2] + d1[3] * hx[j][1][3]); }
            acc += __shfl_xor(acc, 1); acc += __shfl_xor(acc, 2); acc += __shfl_xor(acc, 4); acc += __shfl_xor(acc, 8);
            if (sub == 0) wl[e] = acc;
        }
        LDS_WAIT(); asm volatile("" ::: "memory");
        areg0 = wl[lane]; areg1 = wl[64 + lane];
#ifdef EXP_NO_PEER
        const float w0 = 0.f * g0 * areg0, w1 = 0.f * g1 * areg1;
#else
        const float w0 = g0 * gelu_erf(areg0 * rstd), w1 = g1 * gelu_erf(areg1 * rstd);
#endif
        LDS_WAIT(); asm volatile("" ::: "memory");
        f32x4 oa[2][2];
#pragma unroll
        for (int j = 0; j < 2; ++j) { oa[j][0] = (f32x4){0.f, 0.f, 0.f, 0.f}; oa[j][1] = oa[j][0]; }
#pragma unroll 8
        for (int e = 0; e < 128; ++e) {
            const int ei = __builtin_amdgcn_readlane((e < 64) ? i0 : i1, e & 63);
            const float we = __builtin_bit_cast(float, __builtin_amdgcn_readlane(__builtin_bit_cast(int, (e < 64) ? w0 : w1), e & 63));
            const bf16* rowp = upb + (size_t)ei * D + 8 * lane;
#pragma unroll
            for (int j = 0; j < 2; ++j) { f32x4 u0, u1; unpack8(*(const u32x4*)(rowp + 512 * j), u0, u1); oa[j][0] = oa[j][0] + u0 * we; oa[j][1] = oa[j][1] + u1 * we; }
        }
        float ss = 0.f;
#pragma unroll
        for (int j = 0; j < 2; ++j) { const float* hp = H + (size_t)tu * D + 8 * (lane + 64 * j);
            oa[j][0] = oa[j][0] + *(const f32x4*)hp; oa[j][1] = oa[j][1] + *(const f32x4*)(hp + 4);
            ss += (oa[j][0][0] * oa[j][0][0] + oa[j][0][1] * oa[j][0][1]) + (oa[j][0][2] * oa[j][0][2] + oa[j][0][3] * oa[j][0][3]) + (oa[j][1][0] * oa[j][1][0] + oa[j][1][1] * oa[j][1][1]) + (oa[j][1][2] * oa[j][1][2] + oa[j][1][3] * oa[j][1][3]); }
        const float r2 = __builtin_amdgcn_rsqf(wave_sum(ss) * (1.f / D) + RMS_EPS);
#pragma unroll
        for (int j = 0; j < 2; ++j) { const int c = 8 * (lane + 64 * j); float* op = out + (size_t)tu * D + c;
            *(f32x4*)op = oa[j][0] * r2 * *(const f32x4*)(fn + c); *(f32x4*)(op + 4) = oa[j][1] * r2 * *(const f32x4*)(fn + c + 4); }
    }
}

struct Args { const float* in[15]; float* out; unsigned char* ws; int ph_lo, ph_hi, li, pad; };
__global__ void __launch_bounds__(NWAVES * 64, 2) fwd(Args args) {
    extern __shared__ __attribute__((aligned(16))) unsigned char lds[];
    Frame F;
    F.lds = (LAS unsigned char*)lds;
    F.MISC = (volatile LAS unsigned*)(F.lds + MISC_OFF);
    F.tid = threadIdx.x; F.lane = F.tid & 63; F.wave = __builtin_amdgcn_readfirstlane(F.tid >> 6);
    F.G = gridDim.x; { const int bx = blockIdx.x; F.vcu = (F.G % 8 == 0) ? (bx % 8) * (F.G / 8) + bx / 8 : bx; }
    F.ws = args.ws; F.ctl = (gu32*)(args.ws + WS_CTL);
#pragma unroll
    for (int i = 0; i < 15; ++i) F.in[i] = args.in[i];
    F.out = args.out;
    for (int u = F.tid; u < (LDS_BYTES - RING_BYTES) / 4; u += NWAVES * 64) ((LAS unsigned*)(F.lds + RING_BYTES))[u] = 0u;
    __syncthreads();
    XcdBarrier bar; bar.bar = (unsigned*)(F.ctl + CW_BAR); bar.x = 0; bar.st = nullptr;
    if (N_LAUNCHES == 1) bar = xcd_barrier_post((unsigned*)(F.ctl + CW_BAR), F.MISC + 8);
#define GRID_BAR() do { if (N_LAUNCHES == 1) xcd_barrier(bar); } while (0)
    const int lo = args.ph_lo, hi = args.ph_hi, bx = (int)blockIdx.x;
#ifndef ONLY_PHASE
#define ONLY_PHASE -1
#endif
#define IN(k) ((ONLY_PHASE < 0 || ONLY_PHASE == (k)) && lo <= (k) && (k) < hi)
#define BOTH(k) (IN(k) && IN((k) + 1))
    unsigned char* ws = args.ws;
    bf16* U = (bf16*)(ws + WS_U);

    if (IN(0)) { p0_prologue(F); if (BOTH(0)) GRID_BAR(); }

    if (IN(1)) {
        Gemm g{U, (const bf16*)(ws + WS_WQKV), T, NQKV, D}; QkvOrder S; S.init(T, NQKV, F.G, bx); S.U = (const char*)U;
        EpiQKV E{(bf16*)(ws + WS_Q), (const float*)(ws + WS_ROPE)};
        gemm_phase<EpiQKV, QkvOrder, true, true, true>(F.lds, g, S, E);
        if (BOTH(1)) GRID_BAR();
    }
    if (IN(2)) { attn_phase(F); if (BOTH(2)) GRID_BAR(); }
    if (IN(3)) {
        combine_phase(F);
        Gemm g{U, (const bf16*)(ws + WS_WCG), T, NCG, D}; StaticOrder S; S.init(T, NCG, F.G, bx);
        EpiCG E{(bf16*)(ws + WS_BB), (bf16*)(ws + WS_Z), (bf16*)(ws + WS_SGC), (bf16*)(ws + WS_SGA), F.in[I_GBIAS]};
        gemm_phase<EpiCG, StaticOrder, true, true>(F.lds, g, S, E);
        if (BOTH(3)) GRID_BAR();
    }
    if (IN(4)) { p4_phase(F); if (BOTH(4)) GRID_BAR(); }
    if (IN(5)) {
        { Gemm g{(const bf16*)(ws + WS_BB), (const bf16*)(ws + WS_WCONV), T, D, D}; StaticOrder S; S.init(T, D, F.G, bx);
          EpiY<0> E{(bf16*)(ws + WS_Y), (const bf16*)(ws + WS_SGC)};
          gemm_phase<EpiY<0>, StaticOrder, true, true>(F.lds, g, S, E); }
        { Gemm g{(const bf16*)(ws + WS_O), (const bf16*)(ws + WS_WATTN), T, D, DAO}; StaticOrder S; S.init(T, D, F.G, bx);
          EpiY<1> E{(bf16*)(ws + WS_Y), (const bf16*)(ws + WS_SGA)};
          gemm_phase<EpiY<1>, StaticOrder, true, true>(F.lds, g, S, E); }
        if (BOTH(5)) GRID_BAR();
    }
    if (IN(6)) {
        Gemm g{(const bf16*)(ws + WS_Y), (const bf16*)(ws + WS_WOUT), T, D, D}; StaticOrder S; S.init(T, D, F.G, bx);
        EpiOut E{F.in[I_X], (float*)(ws + WS_H), (bf16*)(ws + WS_HG), F.in[I_NFFN], (float*)(ws + WS_RSQ)};
        gemm_phase<EpiOut, StaticOrder, true, true>(F.lds, g, S, E);
        if (BOTH(6)) GRID_BAR();
    }
    if (IN(7)) {
        Gemm g{(const bf16*)(ws + WS_HG), (const bf16*)(ws + WS_WFOLD), T, 2048, D}; StaticOrder S; S.init(T, 2048, F.G, bx);
        float* scr = (float*)(ws + (bx < 128 ? WS_SCR0 + (size_t)bx * 262144 : (bx < 192 ? WS_SCR1 + (size_t)(bx - 128) * 262144 : WS_SCR2 + (size_t)(bx - 192) * 262144)));
        EpiTopk E{scr, (const float*)(ws + WS_RSQ), (int*)(ws + WS_IDX), (float*)(ws + WS_GATE)};
        gemm_phase<EpiTopk, StaticOrder, true, true>(F.lds, g, S, E);
        if (BOTH(7)) GRID_BAR();
    }
    if (IN(8)) { peer_phase(F); }
#undef IN
#undef BOTH
}

extern "C" void kernel_launch(void* const* d_in, const int* in_sizes, int n_in, void* d_out, int out_size, void* d_ws, size_t ws_size, hipStream_t stream) {
    static int grid = 0;
    if (grid == 0) {
        if (n_in != 15 || out_size != T * D || ws_size < WS_END) { fprintf(stderr, "kernel_launch: unexpected shapes (n_in %d, out %d, ws %zu)\n", n_in, out_size, ws_size); grid = -1; return; }
        int dev = 0, cus = 0, per_cu = 0;
        if (hipGetDevice(&dev) != hipSuccess || hipDeviceGetAttribute(&cus, hipDeviceAttributeMultiprocessorCount, dev) != hipSuccess) { grid = -1; return; }
        if (hipFuncSetAttribute((const void*)fwd, hipFuncAttributeMaxDynamicSharedMemorySize, LDS_BYTES) != hipSuccess) { fprintf(stderr, "kernel_launch: hipFuncSetAttribute failed\n"); grid = -1; return; }
        if (hipOccupancyMaxActiveBlocksPerMultiprocessor(&per_cu, (const void*)fwd, NWAVES * 64, LDS_BYTES) != hipSuccess || per_cu < 1) fprintf(stderr, "kernel_launch: occupancy query reports %d\n", per_cu);
        (void)hipGetLastError();
        grid = cus > 256 ? 256 : cus;
    }
    if (grid < 0) return;
    if (hipMemsetAsync((char*)d_ws + WS_CTL, 0, CTL_ZERO_BYTES, stream) != hipSuccess) return;
    Args a{};
    for (int i = 0; i < 15; ++i) a.in[i] = (const float*)d_in[i];
    a.out = (float*)d_out; a.ws = (unsigned char*)d_ws;
    for (int li = 0; li < N_LAUNCHES; ++li) {
        a.ph_lo = (N_LAUNCHES == 1) ? 0 : li; a.ph_hi = (N_LAUNCHES == 1) ? N_PHASES : li + 1; a.li = li; a.pad = 0;
        hipLaunchKernelGGL(fwd, dim3(grid), dim3(NWAVES * 64), LDS_BYTES, stream, a);
    }
}
```

```cpp
#include <hip/hip_runtime.h>
#include <cstdio>
#include <cstdint>
namespace pg8 {
#define PG8_LAS __attribute__((address_space(3)))
typedef unsigned short bf16_t;
typedef short bf16x8 __attribute__((ext_vector_type(8)));
typedef float f32x4 __attribute__((ext_vector_type(4)));
typedef unsigned u32x4 __attribute__((ext_vector_type(4)));
typedef int v4i32_t __attribute__((ext_vector_type(4)));
typedef int v8i32_t __attribute__((ext_vector_type(8)));
constexpr int BM = 256, BK = 64, HALF = 128, HTB = HALF * BK * 2  , STAGE_BYTES = 8 * HTB, NXCD = 8, WGM = 8;

__host__ __device__ __forceinline__ int lds_byte(int r, int c) { const int st = (r >> 4) * 2 + (c >> 5), rr = r & 15, cc = c & 31, ob = rr * 64 + cc * 2; return st * 1024 + (ob ^ (((ob >> 9) & 1) << 5)); }
__host__ __device__ __forceinline__ void stage_rc(int b, int& R, int& C) { const int st = b / 1024, sb = b % 1024, swz = sb ^ (((sb >> 9) & 1) << 5); R = (st >> 1) * 16 + swz / 64; C = (st & 1) * 32 + (swz % 64) / 2; }
__host__ __device__ __forceinline__ int perm32(int rho) { const int n = rho >> 4, i = rho & 15; return 8 * (i >> 2) + 4 * n + (i & 3); }

struct Unit { int pm, pn; };
struct Gemm { const bf16_t* A; const bf16_t* Bt; int M, N, K; };

struct StaticOrder {
    int nM, nN, nwg, G, c;
    __host__ __device__ void init(int M, int N, int G_, int c_) { nM = M / BM; nN = N / BM; nwg = nM * nN; G = G_; c = c_; }
    __host__ __device__ bool next(int i, Unit& u) const {
        const long L = (long)i * G + c; if (L >= nwg) return false;
        int wgid = (int)L; { const int q = nwg / NXCD, r = nwg % NXCD, xcd = wgid % NXCD, off = wgid / NXCD; wgid = (xcd < r ? xcd * (q + 1) : r * (q + 1) + (xcd - r) * q) + off; }
        const int nig = WGM * nN, gid = wgid / nig, fm = gid * WGM, gsz = (nM - fm) < WGM ? (nM - fm) : WGM;
        u.pm = fm + ((wgid % nig) % gsz); u.pn = (wgid % nig) / gsz; return true;
    }
    __device__ __forceinline__ void a_ready(const Unit&) const {}
    __device__ __forceinline__ void done(const Unit&) const {}
};

__device__ __forceinline__ unsigned cvt_pk_bf16(float lo, float hi) { unsigned r; asm volatile("v_cvt_pk_bf16_f32 %0, %1, %2" : "=v"(r) : "v"(lo), "v"(hi)); return r; }
typedef float f32x2 __attribute__((ext_vector_type(2)));

template <class Epi, class Sched, bool ALIGN_EPI = false, bool SP2 = false, bool STRIDED_A = false, bool I8 = false>
__device__ __forceinline__ void gemm_phase(PG8_LAS unsigned char* lds, const Gemm g, const Sched& S, const Epi& E) {
    const int tid = threadIdx.x, wid = __builtin_amdgcn_readfirstlane(tid >> 6), lane = tid & 63, wr = wid >> 2, wc = wid & 3, fr = lane & 15, fq = lane >> 4;
    const int K = g.K; int nt = K / BK;
    if constexpr (I8) asm volatile("" : "+s"(nt));
    unsigned voffA[2], voffB[2];
#pragma unroll
    for (int i = 0; i < 2; ++i) { int R, C; stage_rc(tid * 16 + i * 8192, R, C); const int Rb = Epi::PERM ? ((R & ~31) + perm32(R & 31)) : R;
        voffA[i] = (unsigned)(R * K + C) * 2u; voffB[i] = (unsigned)(Rb * K + C) * 2u; }
    unsigned rkA = 0, c2A = 0; const unsigned rk64 = 64u * (unsigned)K * 2u;
    if constexpr (STRIDED_A) { int R, C; stage_rc(tid * 16, R, C); rkA = (unsigned)(R * K) * 2u; c2A = (unsigned)C * 2u; }
    const size_t kstep = (size_t)(BK * 2);
    const size_t hstep = (size_t)HALF * K * 2;
    const size_t tstep = 2 * hstep;
    const unsigned ldsw = (unsigned)wid * 1024u;
    const int aoff = lds_byte(wr * 64 + fr, fq * 8), boff = lds_byte(wc * 32 + fr, fq * 8);
#define PG8_SA(b, h) (((b) * 2 + (h)) * HTB)
#define PG8_SB(b, h) ((4 + (b) * 2 + (h)) * HTB)
#define PG8_STAGE(bufoff, gbase, voff) do { _Pragma("unroll") for (int _i = 0; _i < 2; ++_i) \
        __builtin_amdgcn_global_load_lds((const unsigned*)((const char*)(gbase) + (voff)[_i]), (PG8_LAS unsigned*)(lds + (bufoff) + ldsw + _i * 8192), 16, 0, 0); } while (0)
#define PG8_STAGE_A(bufoff, gbase, sh) do { if constexpr (STRIDED_A) { _Pragma("unroll") for (int _i = 0; _i < 2; ++_i) { const unsigned _vo = ((rkA + _i * rk64) << (sh)) + c2A; \
        __builtin_amdgcn_global_load_lds((const unsigned*)((const char*)(gbase) + _vo), (PG8_LAS unsigned*)(lds + (bufoff) + ldsw + _i * 8192), 16, 0, 0); } } else { PG8_STAGE(bufoff, gbase, voffA); } } while (0)
#define PG8_LDA(dst, b, h) do { _Pragma("unroll") for (int m = 0; m < 4; ++m) _Pragma("unroll") for (int k = 0; k < 2; ++k) dst[m][k] = *(const PG8_LAS bf16x8*)(lds + PG8_SA(b, h) + aoff + m * 2048 + k * 1024); } while (0)
#define PG8_LDB(dst, b, h) do { _Pragma("unroll") for (int n = 0; n < 2; ++n) _Pragma("unroll") for (int k = 0; k < 2; ++k) dst[n][k] = *(const PG8_LAS bf16x8*)(lds + PG8_SB(b, h) + boff + n * 2048 + k * 1024); } while (0)
#define PG8_MMA(ai, bj, At, Bt) do { __builtin_amdgcn_s_setprio(1); _Pragma("unroll") for (int m = 0; m < 4; ++m) _Pragma("unroll") for (int n = 0; n < 2; ++n) _Pragma("unroll") for (int k = 0; k < 2; ++k) \
        { if constexpr (I8) acc[ai][bj][m][n] = __builtin_bit_cast(f32x4, __builtin_amdgcn_mfma_i32_16x16x64_i8(__builtin_bit_cast(v4i32_t, Bt[n][k]), __builtin_bit_cast(v4i32_t, At[m][k]), __builtin_bit_cast(v4i32_t, acc[ai][bj][m][n]), 0, 0, 0)); \
          else acc[ai][bj][m][n] = __builtin_amdgcn_mfma_f32_16x16x32_bf16(Bt[n][k], At[m][k], acc[ai][bj][m][n], 0, 0, 0); } __builtin_amdgcn_s_setprio(0); } while (0)
#define PG8_WAIT_V(n) asm volatile("s_waitcnt vmcnt(" #n ")" ::: "memory")
#define PG8_WAIT_L(n) asm volatile("s_waitcnt lgkmcnt(" #n ")" ::: "memory")
#define PG8_BAR __builtin_amdgcn_s_barrier()
#define PG8_SCHED __builtin_amdgcn_sched_barrier(0)
    Unit cur, nxt; int ui = 0;
    if (!S.next(0, cur)) return;
    f32x4 acc[2][2][4][2];
#pragma unroll
    for (int a = 0; a < 2; ++a)
#pragma unroll
        for (int b = 0; b < 2; ++b)
#pragma unroll
            for (int m = 0; m < 4; ++m)
#pragma unroll
                for (int n = 0; n < 2; ++n) acc[a][b][m][n] = (f32x4){0.f, 0.f, 0.f, 0.f};
    bf16x8 At[4][2], B0[2][2], B1[2][2];
    int csh = 0, nsh = 0;
    const char* cA; if constexpr (STRIDED_A) cA = S.a_base(cur, csh); else cA = (const char*)g.A + (size_t)cur.pm * tstep;
    const char* cB = (const char*)g.Bt + (size_t)cur.pn * tstep;
    S.a_ready(cur);
    if constexpr (SP2) {
        PG8_STAGE(PG8_SB(0, 0), cB, voffB); PG8_STAGE(PG8_SB(0, 1), cB + hstep, voffB); PG8_STAGE_A(PG8_SA(0, 0), cA, csh); PG8_STAGE_A(PG8_SA(0, 1), cA + (hstep << csh), csh);
        if (wr == 1) PG8_BAR;
        PG8_WAIT_V(2); PG8_BAR;
        PG8_STAGE(PG8_SB(1, 0), cB + kstep, voffB); PG8_STAGE_A(PG8_SA(1, 0), cA + kstep, csh); PG8_STAGE(PG8_SB(1, 1), cB + hstep + kstep, voffB);
        PG8_WAIT_V(6); PG8_BAR;
    } else {
        PG8_STAGE(PG8_SB(0, 0), cB, voffB); PG8_STAGE_A(PG8_SA(0, 0), cA, csh); PG8_STAGE(PG8_SB(0, 1), cB + hstep, voffB); PG8_STAGE_A(PG8_SA(0, 1), cA + (hstep << csh), csh);
        if (wr == 1) PG8_BAR;
        PG8_WAIT_V(4); PG8_BAR;
        PG8_STAGE(PG8_SB(1, 0), cB + kstep, voffB); PG8_STAGE_A(PG8_SA(1, 0), cA + kstep, csh); PG8_STAGE(PG8_SB(1, 1), cB + hstep + kstep, voffB);
        PG8_WAIT_V(6); PG8_BAR;
    }
    asm volatile(".p2align 8" ::: "memory");
    for (;;) {
        const bool has_next = S.next(ui + 1, nxt);
        const char* nA; if constexpr (STRIDED_A) { nsh = csh; nA = has_next ? S.a_base(nxt, nsh) : cA; } else nA = has_next ? (const char*)g.A + (size_t)nxt.pm * tstep : cA;
        const char* nB = has_next ? (const char*)g.Bt + (size_t)nxt.pn * tstep : cB;
        for (int t = 0; t < nt; t += 2) {
            const bool last = (t == nt - 2);
            const char* a1 = cA + (size_t)(t + 1) * kstep;
            const char* a2 = last ? nA : cA + (size_t)(t + 2) * kstep; const char* b2 = last ? nB : cB + (size_t)(t + 2) * kstep;
            const char* a3 = a2 + kstep; const char* b3 = b2 + kstep;
            const int sh2 = last ? nsh : csh; const size_t hA1 = hstep << csh, hA2 = hstep << sh2;
            if (last && has_next) S.a_ready(nxt);
            if constexpr (SP2) {
            PG8_LDB(B0, 0, 0); PG8_LDB(B1, 0, 1); PG8_SCHED; PG8_LDA(At, 0, 0); PG8_STAGE_A(PG8_SA(1, 1), a1 + hA1, csh);
            PG8_WAIT_V(8); PG8_WAIT_L(0); PG8_BAR; PG8_MMA(0, 0, At, B0); PG8_MMA(0, 1, At, B1); PG8_BAR; PG8_SCHED;
            PG8_LDA(At, 0, 1); PG8_STAGE(PG8_SB(0, 0), b2, voffB); PG8_STAGE(PG8_SB(0, 1), b2 + hstep, voffB); PG8_STAGE_A(PG8_SA(0, 0), a2, sh2);
            PG8_WAIT_V(8); PG8_WAIT_L(0); PG8_BAR; PG8_MMA(1, 0, At, B0); PG8_MMA(1, 1, At, B1); PG8_BAR; PG8_SCHED;
            PG8_LDB(B0, 1, 0); PG8_LDB(B1, 1, 1); PG8_SCHED; PG8_LDA(At, 1, 0); PG8_STAGE_A(PG8_SA(0, 1), a2 + hA2, sh2);
            PG8_WAIT_V(8); PG8_WAIT_L(0); PG8_BAR; PG8_MMA(0, 0, At, B0); PG8_MMA(0, 1, At, B1); PG8_BAR; PG8_SCHED;
            PG8_LDA(At, 1, 1); PG8_STAGE(PG8_SB(1, 0), b3, voffB); PG8_STAGE(PG8_SB(1, 1), b3 + hstep, voffB); PG8_STAGE_A(PG8_SA(1, 0), a3, sh2);
            PG8_WAIT_V(8); PG8_WAIT_L(0); PG8_BAR; PG8_MMA(1, 0, At, B0); PG8_MMA(1, 1, At, B1); PG8_BAR; PG8_SCHED;
            } else {
            PG8_LDB(B0, 0, 0); PG8_SCHED; PG8_LDA(At, 0, 0); PG8_STAGE_A(PG8_SA(1, 1), a1 + hA1, csh);
            PG8_WAIT_L(8); PG8_BAR; PG8_WAIT_L(0); PG8_MMA(0, 0, At, B0); PG8_BAR; PG8_SCHED;
            PG8_LDB(B1, 0, 1); PG8_STAGE(PG8_SB(0, 0), b2, voffB);
            PG8_BAR; PG8_WAIT_L(0); PG8_MMA(0, 1, At, B1); PG8_BAR;
            PG8_LDA(At, 0, 1); PG8_STAGE_A(PG8_SA(0, 0), a2, sh2);
            PG8_BAR; PG8_WAIT_L(0); PG8_MMA(1, 0, At, B0); PG8_BAR; PG8_SCHED;
            PG8_STAGE(PG8_SB(0, 1), b2 + hstep, voffB);
            PG8_WAIT_V(6); PG8_BAR; PG8_MMA(1, 1, At, B1); PG8_BAR;
            PG8_LDB(B0, 1, 0); PG8_SCHED; PG8_LDA(At, 1, 0); PG8_STAGE_A(PG8_SA(0, 1), a2 + hA2, sh2);
            PG8_WAIT_L(8); PG8_BAR; PG8_WAIT_L(0); PG8_MMA(0, 0, At, B0); PG8_BAR; PG8_SCHED;
            PG8_LDB(B1, 1, 1); PG8_STAGE(PG8_SB(1, 0), b3, voffB);
            PG8_BAR; PG8_WAIT_L(0); PG8_MMA(0, 1, At, B1); PG8_BAR;
            PG8_LDA(At, 1, 1); PG8_STAGE_A(PG8_SA(1, 0), a3, sh2);
            PG8_BAR; PG8_WAIT_L(0); PG8_MMA(1, 0, At, B0); PG8_BAR; PG8_SCHED;
            PG8_STAGE(PG8_SB(1, 1), b3 + hstep, voffB);
            PG8_WAIT_V(6); PG8_BAR; PG8_MMA(1, 1, At, B1); PG8_BAR;
            }
        }
        if constexpr (ALIGN_EPI) { if (wr == 0) PG8_BAR; }
        if constexpr (I8) {
#pragma unroll
            for (int a = 0; a < 2; ++a)
#pragma unroll
                for (int b = 0; b < 2; ++b)
#pragma unroll
                    for (int m = 0; m < 4; ++m)
#pragma unroll
                        for (int n = 0; n < 2; ++n) { const v4i32_t iv = __builtin_bit_cast(v4i32_t, acc[a][b][m][n]); acc[a][b][m][n] = (f32x4){(float)iv[0], (float)iv[1], (float)iv[2], (float)iv[3]}; }
        }
        if constexpr (!Epi::AFTER_DRAIN) { E(acc, cur, wr, wc, fr, fq); S.done(cur); }
        if (!has_next) break;
#pragma unroll
        for (int a = 0; a < 2; ++a)
#pragma unroll
            for (int b = 0; b < 2; ++b)
#pragma unroll
                for (int m = 0; m < 4; ++m)
#pragma unroll
                    for (int n = 0; n < 2; ++n) acc[a][b][m][n] = (f32x4){0.f, 0.f, 0.f, 0.f};
        cur = nxt; cA = nA; cB = nB; csh = nsh; ++ui;
        if constexpr (ALIGN_EPI) { if (wr == 1) PG8_BAR; }
    }
    PG8_WAIT_V(0);
    if constexpr (!ALIGN_EPI) { if (wr == 0) PG8_BAR; }
    PG8_BAR;
    if constexpr (Epi::AFTER_DRAIN) { E.fused(acc, cur, wr, wc, fr, fq, lds, wid, lane); S.done(cur); }
#undef PG8_SA
#undef PG8_SB
#undef PG8_STAGE
#undef PG8_STAGE_A
#undef PG8_LDA
#undef PG8_LDB
#undef PG8_MMA
#undef PG8_WAIT_V
#undef PG8_WAIT_L
#undef PG8_BAR
#undef PG8_SCHED
}
}

#define GAS __attribute__((address_space(1)))
#define LAS __attribute__((address_space(3)))
typedef unsigned short bf16;
typedef unsigned v4u __attribute__((ext_vector_type(4)));
typedef float f32x4 __attribute__((ext_vector_type(4)));
typedef short bf16x8 __attribute__((ext_vector_type(8)));
typedef GAS unsigned gu32;
typedef GAS unsigned long long gu64;
#define RLX_AGENT __ATOMIC_RELAXED, __HIP_MEMORY_SCOPE_AGENT
#define LDS_WAIT() asm volatile("s_waitcnt lgkmcnt(0)" ::: "memory")
#define VM_WAIT() asm volatile("s_waitcnt vmcnt(0)" ::: "memory")
__device__ __forceinline__ unsigned long long rt() { return __builtin_amdgcn_s_memrealtime(); }
__device__ __forceinline__ unsigned f2bf(float f) { unsigned u = __builtin_bit_cast(unsigned, f); return (u + 0x7fffu + ((u >> 16) & 1u)) >> 16; }
__device__ __forceinline__ unsigned pk2(float lo, float hi) { return f2bf(lo) | (f2bf(hi) << 16); }

#define XB_TMO      128
#define XB_XCNT(j)  (256  + 64 * (j))
#define XB_XSUB(j)  (1280 + 64 * (j))
#define XB_XGEN(j)  (2304 + 64 * (j))
#define XB_TOP      3328
#define XB_TOPGEN   3392
#define XCD_BAR_WORDS 3456
#define XB_SPIN_CAP (1u << 18)

__device__ __forceinline__ unsigned xb_ld(unsigned* p)              { return __hip_atomic_load(p, __ATOMIC_RELAXED, __HIP_MEMORY_SCOPE_AGENT); }
__device__ __forceinline__ unsigned xb_add(unsigned* p, unsigned v) { return __hip_atomic_fetch_add(p, v, __ATOMIC_RELAXED, __HIP_MEMORY_SCOPE_AGENT); }
__device__ __forceinline__ unsigned xb_xcc_id() { return (unsigned)__builtin_amdgcn_s_getreg((3 << 11) | 20) & 0xFu; }
#define XB_SPIN(cond, bar) do { unsigned _sp = 0; while (cond) { __builtin_amdgcn_s_sleep(1); \
    if ((++_sp & 255u) == 0u) { if (xb_ld(&(bar)[XB_TMO])) break; if (_sp > XB_SPIN_CAP) { atomicAdd(&(bar)[XB_TMO], 1u); break; } } } } while (0)

struct XcdBarrier {
    unsigned* bar; unsigned x;
    volatile LAS unsigned* st;
};

__device__ __forceinline__ XcdBarrier xcd_barrier_post(unsigned* bar, volatile LAS unsigned* st) {
    XcdBarrier b; b.bar = bar; b.x = xb_xcc_id(); b.st = st;
    if (threadIdx.x == 0) (void)xb_add(&bar[XB_XCNT(b.x)], 1u);
    return b;
}
__device__ __forceinline__ void xcd_barrier_complete(unsigned* bar, unsigned x, unsigned& nloc, unsigned& nx) {
    const unsigned G = gridDim.x * gridDim.y * gridDim.z;
    unsigned sum, cnt, mine, sp = 0u;
    for (;;) {
        sum = 0u; cnt = 0u; mine = 0u;
#pragma unroll
        for (unsigned j = 0; j < 16; ++j) { const unsigned c = xb_ld(&bar[XB_XCNT(j)]); sum += c; cnt += (c > 0u) ? 1u : 0u; mine = (j == x) ? c : mine; }
        if (sum == G) break;
        __builtin_amdgcn_s_sleep(1);
        if ((++sp & 255u) == 0u) { if (xb_ld(&bar[XB_TMO])) break; if (sp > XB_SPIN_CAP) { atomicAdd(&bar[XB_TMO], 1u); break; } }
    }
    nloc = mine > 0u ? mine : 1u; nx = cnt > 0u ? cnt : 1u;
}

__device__ __forceinline__ void xcd_barrier(const XcdBarrier& b) {
    asm volatile("s_waitcnt vmcnt(0)" ::: "memory");
    __syncthreads();
    if (threadIdx.x == 0) {
        unsigned* bar = b.bar;
        __builtin_amdgcn_s_waitcnt(0);
        unsigned nloc = b.st[0], nx = b.st[1];
        if (nloc == 0u) { xcd_barrier_complete(bar, b.x, nloc, nx); b.st[0] = nloc; b.st[1] = nx; }
        const unsigned old = xb_add(&bar[XB_XSUB(b.x)], 1u);
        const unsigned gen = old / nloc;
        if (old + 1u == (gen + 1u) * nloc) {
            __builtin_amdgcn_fence(__ATOMIC_RELEASE, "agent");
            asm volatile("s_waitcnt vmcnt(0)" ::: "memory");
            const unsigned og = xb_add(&bar[XB_TOP], 1u);
            const unsigned tg = og / nx;
            if (og + 1u == (tg + 1u) * nx) xb_add(&bar[XB_TOPGEN], 1u);
            else XB_SPIN(xb_ld(&bar[XB_TOPGEN]) == tg, bar);
            __builtin_amdgcn_fence(__ATOMIC_ACQUIRE, "agent");
            xb_add(&bar[XB_XGEN(b.x)], 1u);
            asm volatile("s_waitcnt vmcnt(0)" ::: "memory");
        } else {
            XB_SPIN(xb_ld(&bar[XB_XGEN(b.x)]) == gen, bar);
            __builtin_amdgcn_fence(__ATOMIC_ACQUIRE, "agent");
            asm volatile("s_waitcnt vmcnt(0)" ::: "memory");
        }
    }
    __syncthreads();
}


constexpr int NWAVES = 8;
#ifndef MK_N_LAUNCHES
#define MK_N_LAUNCHES 1
#endif
constexpr int N_PHASES = 11;
constexpr int N_LAUNCHES = MK_N_LAUNCHES;
constexpr int BATCH = 2, SEQ = 8192, T = BATCH * SEQ, D = 1024;
constexpr int DIN = 9728, NQKV = 4608, NCG = 5120, GW = 512, DAO = 512;
constexpr int NP1 = NQKV + 512;
constexpr int NEXP = 16384, PEER_H = 8, PEER_K = 16, HK = 128;
constexpr float RMS_EPS = 1e-6f;
constexpr float C2 = 0.125f * 1.4426950408889634f;
constexpr float LN2 = 0.6931471805599453f;

constexpr size_t MiB = 1u << 20;
constexpr size_t WS_CTL = 0, CTL_ZERO_BYTES = 64 * 1024;
constexpr size_t WS_ROPE = 1 * MiB, WS_RSQ = 2 * MiB, WS_LSE = 3 * MiB;
constexpr size_t WS_U8 = 24 * MiB, WS_WQKV8 = 5 * MiB, WS_SU = 15 * MiB, WS_SW = 15 * MiB + 65536;
constexpr size_t WS_Q = 56 * MiB, WS_K = 104 * MiB, WS_V = 152 * MiB, WS_O = 200 * MiB;
constexpr size_t WS_Z = 136 * MiB, WS_SGC = 168 * MiB, WS_SGA = 216 * MiB;
constexpr size_t OS_BB = 0, OS_EDOWN = 32 * MiB, OS_WFOLD = 48 * MiB;
constexpr size_t WS_WCONV = 248 * MiB, WS_WATTN = 250 * MiB, WS_WOUT = 251 * MiB;
constexpr size_t WS_EUP = 104 * MiB, WS_ESCALE = 253 * MiB;
constexpr size_t WS_Y = 136 * MiB, WS_H = 168 * MiB, WS_HG = 24 * MiB;
constexpr size_t WS_IDX = 9 * MiB, WS_GATE = 120 * MiB, WS_WB = 56 * MiB, WS_SS = 64 * MiB, WS_HG8 = 65 * MiB, WS_HSC = 81 * MiB;
constexpr size_t WS_SCR0 = 136 * MiB, WS_SCR1 = 88 * MiB, WS_SCR2 = 232 * MiB;
constexpr size_t WS_END = 256 * MiB;
constexpr int CW_TMO = 0, CW_BAR = 1024, CW_RANK = 8192;

constexpr int RING_BYTES = 131072, MISC_OFF = RING_BYTES + 320, LDS_BYTES = 147456;

using pg8::Unit; using pg8::Gemm; using pg8::StaticOrder; using pg8::gemm_phase; using pg8::cvt_pk_bf16;
typedef unsigned short bf16;
typedef unsigned u32x4 __attribute__((ext_vector_type(4)));
typedef unsigned u32x2 __attribute__((ext_vector_type(2)));
typedef float f32x4 __attribute__((ext_vector_type(4)));
typedef float f32x2 __attribute__((ext_vector_type(2)));
typedef short bf16x8 __attribute__((ext_vector_type(8)));
typedef short s16x4 __attribute__((ext_vector_type(4)));
typedef short v4i16_t __attribute__((ext_vector_type(4)));
#define LAS __attribute__((address_space(3)))

__device__ __forceinline__ float bf_lo(unsigned w) { return __builtin_bit_cast(float, w << 16); }
__device__ __forceinline__ float bf_hi(unsigned w) { return __builtin_bit_cast(float, w & 0xffff0000u); }
__device__ __forceinline__ u32x4 pack8(f32x4 a, f32x4 b) { u32x4 w; w.x = cvt_pk_bf16(a[0], a[1]); w.y = cvt_pk_bf16(a[2], a[3]); w.z = cvt_pk_bf16(b[0], b[1]); w.w = cvt_pk_bf16(b[2], b[3]); return w; }
__device__ __forceinline__ void unpack8(u32x4 w, f32x4& a, f32x4& b) { a = (f32x4){bf_lo(w.x), bf_hi(w.x), bf_lo(w.y), bf_hi(w.y)}; b = (f32x4){bf_lo(w.z), bf_hi(w.z), bf_lo(w.w), bf_hi(w.w)}; }
__device__ __forceinline__ float wave_sum(float v) {
#pragma unroll
    for (int o = 1; o < 64; o <<= 1) v += __shfl_xor(v, o);
    return v;
}
__device__ __forceinline__ unsigned pack4i8(f32x4 v) { const int a = (int)__builtin_rintf(v[0]), b = (int)__builtin_rintf(v[1]), c = (int)__builtin_rintf(v[2]), d = (int)__builtin_rintf(v[3]); return (unsigned)(a & 255) | ((unsigned)(b & 255) << 8) | ((unsigned)(c & 255) << 16) | ((unsigned)d << 24); }
__device__ __forceinline__ f32x4 unpack4u8(unsigned w) { return (f32x4){(float)(w & 255u), (float)((w >> 8) & 255u), (float)((w >> 16) & 255u), (float)(w >> 24)} * (1.f / 255.f); }
__device__ __forceinline__ float xor16(float v, int fq) {
    const unsigned x = __builtin_bit_cast(unsigned, v);
    const auto r = __builtin_amdgcn_permlane16_swap(x, x, false, false);
    const unsigned a = r[0], b = r[1];
    return __builtin_bit_cast(float, (fq & 1) ? a : b);
}
__device__ __forceinline__ float sigmoidf_(float x) { return 1.f / (1.f + __expf(-x)); }

struct QkvOrder : StaticOrder {
    const char* U;
    __device__ __forceinline__ const char* a_base(const Unit& u, int& sh) const {
        const int g = (u.pn < 18) ? u.pn / 6 : 0; sh = 2 * g;
        const int b = u.pm >> 5, lp0 = (u.pm & 31) * 256;
        const int r = lp0 >> (13 - sh), i0 = lp0 & ((SEQ >> sh) - 1);
        const int t0 = b * SEQ + (i0 << sh) + r;
        return U + (size_t)t0 * D;
    }
};
struct EpiQKV {
    static constexpr bool PERM = true, AFTER_DRAIN = false;
    bf16* Q; const float* rope; const float* su; const float* sw; unsigned char* SGA; const float* gbias1;
    __device__ __forceinline__ void operator()(const f32x4 (&acc)[2][2][4][2], const Unit& u, int wr, int wc, int fr, int fq) const {
        if (u.pn >= 18) {
#pragma unroll
            for (int ai = 0; ai < 2; ++ai)
#pragma unroll
                for (int m = 0; m < 4; ++m) { const size_t row = (size_t)u.pm * 256 + ai * 128 + wr * 64 + m * 16 + fr; const float sr = su[row];
#pragma unroll
                    for (int bj = 0; bj < 2; ++bj) { const int col = 512 + (u.pn - 18) * 256 + bj * 128 + wc * 32 + fq * 8;
                        const f32x4 b0 = *(const f32x4*)(gbias1 + col), b1 = *(const f32x4*)(gbias1 + col + 4);
                        const int wcol = u.pn * 256 + bj * 128 + wc * 32 + fq * 8;
                        f32x4 v0 = acc[ai][bj][m][0] * (*(const f32x4*)(sw + wcol) * sr) + b0, v1 = acc[ai][bj][m][1] * (*(const f32x4*)(sw + wcol + 4) * sr) + b1;
#pragma unroll
                        for (int e = 0; e < 4; ++e) { v0[e] = sigmoidf_(v0[e]) * 255.f; v1[e] = sigmoidf_(v1[e]) * 255.f; }
                        u32x2 g8; g8.x = pack4i8(v0); g8.y = pack4i8(v1);
                        *(u32x2*)(SGA + row * D + col) = g8; } }
            return;
        }
        asm volatile("" : "+v"(fr), "+v"(fq));
        const int g = u.pn / 6, kind = (u.pn % 6) >> 1, half = u.pn & 1, sh = 2 * g;
        bf16* base = Q + (size_t)kind * ((WS_K - WS_Q) / 2) + (size_t)g * T * GW;
        const int b = u.pm >> 5, lp0 = (u.pm & 31) * 256;
        const bool rot = (kind < 2) && ((wc & 1) == 0);
        const float sc = (kind == 0) ? C2 : 1.f;
        f32x4 swv[2][2];
#pragma unroll
        for (int bj = 0; bj < 2; ++bj) { const int wcol = u.pn * 256 + bj * 128 + wc * 32 + fq * 8; swv[bj][0] = *(const f32x4*)(sw + wcol) * sc; swv[bj][1] = *(const f32x4*)(sw + wcol + 4) * sc; }
        const float sgn = (fq == 0) ? -1.f : 1.f; const bool use = fq < 2;
#pragma unroll
        for (int ai = 0; ai < 2; ++ai)
#pragma unroll
            for (int m = 0; m < 4; ++m) {
                const int rl = ai * 128 + wr * 64 + m * 16 + fr, lp = lp0 + rl;
                const int tok = b * SEQ + ((lp & ((SEQ >> sh) - 1)) << sh) + (lp >> (13 - sh));
                const float sut = su[tok];
                f32x4 c0 = {1.f, 1.f, 1.f, 1.f}, c1 = c0, s0 = {0.f, 0.f, 0.f, 0.f}, s1 = s0;
                if (rot) { const f32x4* rp = (const f32x4*)(rope + (size_t)tok * 16); c0 = rp[0]; c1 = rp[1]; s0 = rp[2]; s1 = rp[3]; }
                bf16* rowp = base + (size_t)(u.pm * 256 + rl) * GW + half * 256 + wc * 32 + fq * 8;
#pragma unroll
                for (int bj = 0; bj < 2; ++bj) {
                    f32x4 v0 = acc[ai][bj][m][0] * (swv[bj][0] * sut), v1 = acc[ai][bj][m][1] * (swv[bj][1] * sut);
                    if (rot) {
                        f32x4 o0, o1;
#pragma unroll
                        for (int e = 0; e < 4; ++e) { o0[e] = xor16(v0[e], fq); o1[e] = xor16(v1[e], fq); }
                        const f32x4 r0 = v0 * c0 + (o0 * s0) * sgn, r1 = v1 * c1 + (o1 * s1) * sgn;
                        v0 = use ? r0 : v0; v1 = use ? r1 : v1;
                    }
                    *(u32x4*)(rowp + bj * 128) = pack8(v0, v1);
                }
            }
    }
};
struct EpiCG {
    static constexpr bool PERM = true, AFTER_DRAIN = false;
    bf16* Bb; bf16* Z; unsigned char* SGC; unsigned char* SGA; const float* gbias; const float* su; const float* sw;
    __device__ __forceinline__ void operator()(const f32x4 (&accin)[2][2][4][2], const Unit& u, int wr, int wc, int fr, int fq) const {
        const int pn = u.pn;
        f32x4 swv[2][2];
#pragma unroll
        for (int bj = 0; bj < 2; ++bj) { const int wcol = NP1 + pn * 256 + bj * 128 + wc * 32 + fq * 8; swv[bj][0] = *(const f32x4*)(sw + wcol); swv[bj][1] = *(const f32x4*)(sw + wcol + 4); }
        f32x4 acc[2][2][4][2];
#pragma unroll
        for (int ai = 0; ai < 2; ++ai)
#pragma unroll
            for (int m = 0; m < 4; ++m) { const float sr = su[(size_t)u.pm * 256 + ai * 128 + wr * 64 + m * 16 + fr];
#pragma unroll
                for (int bj = 0; bj < 2; ++bj) { acc[ai][bj][m][0] = accin[ai][bj][m][0] * (swv[bj][0] * sr); acc[ai][bj][m][1] = accin[ai][bj][m][1] * (swv[bj][1] * sr); } }
#pragma unroll
        for (int ai = 0; ai < 2; ++ai)
#pragma unroll
            for (int m = 0; m < 4; ++m) {
                const size_t row = (size_t)u.pm * 256 + ai * 128 + wr * 64 + m * 16 + fr;
                if (pn < 4) {
#pragma unroll
                    for (int bj = 0; bj < 2; ++bj) *(u32x4*)(Bb + row * D + pn * 256 + bj * 128 + wc * 32 + fq * 8) = pack8(acc[ai][bj][m][0], acc[ai][bj][m][1]);
                } else if (pn < 12) {
                    const f32x4 z0 = acc[ai][0][m][0] * acc[ai][1][m][0], z1 = acc[ai][0][m][1] * acc[ai][1][m][1];
                    *(u32x4*)(Z + row * D + (pn - 4) * 128 + wc * 32 + fq * 8) = pack8(z0, z1);
                } else {
                    const int gsel = (pn >= 16) ? 1 : 0; unsigned char* out = gsel ? SGA : SGC;
#pragma unroll
                    for (int bj = 0; bj < 2; ++bj) {
                        const int col = (pn - 12 - 4 * gsel) * 256 + bj * 128 + wc * 32 + fq * 8;
                        const f32x4 b0 = *(const f32x4*)(gbias + gsel * D + col), b1 = *(const f32x4*)(gbias + gsel * D + col + 4);
                        f32x4 v0 = acc[ai][bj][m][0] + b0, v1 = acc[ai][bj][m][1] + b1;
#pragma unroll
                        for (int e = 0; e < 4; ++e) { v0[e] = sigmoidf_(v0[e]) * 255.f; v1[e] = sigmoidf_(v1[e]) * 255.f; }
                        u32x2 g8; g8.x = pack4i8(v0); g8.y = pack4i8(v1);
                        *(u32x2*)(out + row * D + col) = g8;
                    }
                }
            }
    }
};
template <int MODE> struct EpiY {
    static constexpr bool PERM = true, AFTER_DRAIN = false;
    bf16* Y; const unsigned char* G;
    __device__ __forceinline__ void operator()(const f32x4 (&acc)[2][2][4][2], const Unit& u, int wr, int wc, int fr, int fq) const {
#pragma unroll
        for (int ai = 0; ai < 2; ++ai)
#pragma unroll
            for (int m = 0; m < 4; ++m) {
                const size_t row = (size_t)u.pm * 256 + ai * 128 + wr * 64 + m * 16 + fr;
#pragma unroll
                for (int bj = 0; bj < 2; ++bj) {
                    const size_t off = row * D + u.pn * 256 + bj * 128 + wc * 32 + fq * 8;
                    const u32x2 g8 = *(const u32x2*)(G + off);
                    const f32x4 g0 = unpack4u8(g8.x), g1 = unpack4u8(g8.y);
                    f32x4 v0 = acc[ai][bj][m][0] * g0, v1 = acc[ai][bj][m][1] * g1;
                    if (MODE == 1) { f32x4 y0, y1; unpack8(*(const u32x4*)(Y + off), y0, y1); v0 = v0 + y0; v1 = v1 + y1; }
                    *(u32x4*)(Y + off) = pack8(v0, v1);
                }
            }
    }
};
struct EpiOut {
    static constexpr bool PERM = true, AFTER_DRAIN = false;
    const float* X; bf16* HG; const float* nffn; float* RSQ; unsigned char* HG8; float* HSC;
    __device__ __forceinline__ void operator()(const f32x4 (&acc)[2][2][4][2], const Unit& u, int wr, int wc, int fr, int fq) const {
#pragma unroll
        for (int ai = 0; ai < 2; ++ai)
#pragma unroll
            for (int m = 0; m < 4; ++m) {
                const size_t row = (size_t)u.pm * 256 + ai * 128 + wr * 64 + m * 16 + fr;
                float ss = 0.f;
#pragma unroll
                for (int bj = 0; bj < 2; ++bj) {
                    const int col = u.pn * 256 + bj * 128 + wc * 32 + fq * 8; const size_t off = row * D + col;
                    const f32x4 h0 = *(const f32x4*)(X + off) + acc[ai][bj][m][0], h1 = *(const f32x4*)(X + off + 4) + acc[ai][bj][m][1];
                    const f32x4 n0 = *(const f32x4*)(nffn + col), n1 = *(const f32x4*)(nffn + col + 4);
                    const f32x4 y0 = h0 * n0, y1 = h1 * n1;
                    *(u32x4*)(HG + off) = pack8(y0, y1);
                    float am = fmaxf(fmaxf(fmaxf(fabsf(y0[0]), fabsf(y0[1])), fmaxf(fabsf(y0[2]), fabsf(y0[3]))), fmaxf(fmaxf(fabsf(y1[0]), fabsf(y1[1])), fmaxf(fabsf(y1[2]), fabsf(y1[3]))));
                    am = fmaxf(am, __shfl_xor(am, 16)); am = fmaxf(am, __shfl_xor(am, 32));
                    const float qs = (am > 0.f) ? 127.f / am : 0.f;
                    u32x2 q8; q8.x = pack4i8(y0 * qs); q8.y = pack4i8(y1 * qs);
                    *(u32x2*)(HG8 + off) = q8;
                    if (fq == 0) HSC[row * 32 + u.pn * 8 + bj * 4 + wc] = am * (1.f / 127.f);
                    ss += (h0[0] * h0[0] + h0[1] * h0[1]) + (h0[2] * h0[2] + h0[3] * h0[3]) + (h1[0] * h1[0] + h1[1] * h1[1]) + (h1[2] * h1[2] + h1[3] * h1[3]);
                }
                ss += __shfl_xor(ss, 16); ss += __shfl_xor(ss, 32);
                if (fq == 0) RSQ[row * 16 + u.pn * 4 + wc] = ss;
            }
    }
};
struct CvCtx { const float* dn; const float* up; unsigned char* ed; unsigned char* eu; float* esc; int lane; };
__device__ __forceinline__ void cv_load(const CvCtx& C, int ru, f32x4 (&v)[4]) {
    const int tb = ru >> 14, e = ru & (NEXP - 1);
    const float* src = (tb ? C.up : C.dn) + (size_t)e * D + 16 * C.lane;
#pragma unroll
    for (int q = 0; q < 4; ++q) v[q] = *(const f32x4*)(src + 4 * q);
}
__device__ __forceinline__ void cv_finish(const CvCtx& C, int ru, const f32x4 (&v)[4]) {
    const int tb = ru >> 14, e = ru & (NEXP - 1);
    float am = 0.f;
#pragma unroll
    for (int q = 0; q < 4; ++q) am = fmaxf(am, fmaxf(fmaxf(fabsf(v[q][0]), fabsf(v[q][1])), fmaxf(fabsf(v[q][2]), fabsf(v[q][3]))));
#pragma unroll
    for (int o = 1; o < 64; o <<= 1) am = fmaxf(am, __shfl_xor(am, o));
    u32x4 w;
    if (tb) {
        const float sc = (am > 0.f) ? 256.f / am : 1.f;
#pragma unroll
        for (int q = 0; q < 4; ++q) { int d = __builtin_amdgcn_cvt_pk_fp8_f32(v[q][0] * sc, v[q][1] * sc, 0, false); d = __builtin_amdgcn_cvt_pk_fp8_f32(v[q][2] * sc, v[q][3] * sc, d, true); w[q] = (unsigned)d; }
        *(u32x4*)(C.eu + (size_t)(C.lane >> 3) * (2 * MiB) + (size_t)e * 128 + 16 * (C.lane & 7)) = w;
    } else {
        const float s8 = (am > 0.f) ? 127.f / am : 0.f;
#pragma unroll
        for (int q = 0; q < 4; ++q) w[q] = pack4i8(v[q] * s8);
        *(u32x4*)(C.ed + (size_t)e * 1024 + 16 * C.lane) = w;
    }
    if (C.lane == 0) C.esc[ru] = tb ? ((am > 0.f) ? am * (1.f / 256.f) : 1.f) : am * (1.f / 127.f);
}
__device__ __forceinline__ int f2key(float f) { const int b = __builtin_bit_cast(int, f); return b ^ ((b >> 31) & 0x7fffffff); }
__device__ __forceinline__ float key2f(int k) { return __builtin_bit_cast(float, k ^ ((k >> 31) & 0x7fffffff)); }
#define TOPK_INS(list, x) do { _Pragma("unroll") for (int _k = 0; _k < 16; ++_k) { const int _hi = max(list[_k], x); x = min(list[_k], x); list[_k] = _hi; } } while (0)
__device__ __forceinline__ unsigned long long pack8idx(const int (&a)[16], int o) { unsigned long long r = 0ull;
#pragma unroll
    for (int k = 0; k < 8; ++k) r |= (unsigned long long)(unsigned)(a[o + k] & 127) << (8 * k);
    return r; }
__device__ __forceinline__ int lut16(unsigned long long lo, unsigned long long hi, int i) { const unsigned long long w = (i < 8) ? lo : hi; return (int)((w >> ((i & 7) * 8)) & 127ull); }
__device__ __forceinline__ void sort16_asc(int (&x)[16]) {
#pragma unroll
    for (int k = 2; k <= 16; k <<= 1)
#pragma unroll
        for (int j = k >> 1; j > 0; j >>= 1)
#pragma unroll
            for (int i = 0; i < 16; ++i) { const int l = i ^ j; if (l > i) { const int lo = min(x[i], x[l]), hi = max(x[i], x[l]); const bool up = (i & k) == 0; x[i] = up ? lo : hi; x[l] = up ? hi : lo; } }
}
__device__ __forceinline__ void merge16(int (&r)[16], const int (&a)[16]) {
#pragma unroll
    for (int i = 0; i < 16; ++i) r[i] = max(r[i], a[i]);
#pragma unroll
    for (int j = 8; j > 0; j >>= 1)
#pragma unroll
        for (int i = 0; i < 16; ++i) { const int l = i ^ j; if (l > i) { const int lo = min(r[i], r[l]), hi = max(r[i], r[l]); r[i] = hi; r[l] = lo; } }
}
struct EpiTopk {
    static constexpr bool PERM = true, AFTER_DRAIN = false;
    float* scr; const float* RSQ; int* IDX; float* GATE; CvCtx CV; mutable int cvr; int cvstep;
    __device__ __forceinline__ void operator()(const f32x4 (&acc)[2][2][4][2], const Unit& u, int wr, int wc, int fr, int fq) const {
        const __amdgpu_buffer_rsrc_t rsrc = __builtin_amdgcn_make_buffer_rsrc(scr, 0, 262144, 0x00020000);
        const int voff = ((wc * 32 + fq * 8) * 256 + wr * 64 + fr) * 4;
#pragma unroll
        for (int ai = 0; ai < 2; ++ai)
#pragma unroll
            for (int m = 0; m < 4; ++m)
#pragma unroll
                for (int bj = 0; bj < 2; ++bj)
#pragma unroll
                    for (int n = 0; n < 2; ++n)
#pragma unroll
                        for (int e = 0; e < 4; ++e)
                        { const float val = acc[ai][bj][m][n][e]; __builtin_amdgcn_raw_buffer_store_b32(__builtin_bit_cast(unsigned, val), rsrc, voff, ((bj * 128 + n * 4 + e) * 256 + ai * 128 + m * 16) * 4, 0); }
        asm volatile("s_waitcnt vmcnt(0)" ::: "memory");
        __builtin_amdgcn_s_barrier();
        asm volatile("" ::: "memory");
        const int tid = threadIdx.x, row = tid >> 1, c = tid & 1;
        int v[16];
#pragma unroll
        for (int k = 0; k < 16; ++k) v[k] = (int)0x80000000;
        const int roff = (c * 128 * 256 + row) * 4;
        const size_t t = (size_t)u.pm * 256 + row;
        f32x4 rq[4];
#pragma unroll
        for (int j = 0; j < 4; ++j) rq[j] = *(const f32x4*)(RSQ + t * 16 + 4 * j);
        float xs[16], xn[16];
#pragma unroll
        for (int j = 0; j < 16; ++j) xs[j] = __builtin_bit_cast(float, __builtin_amdgcn_raw_buffer_load_b32(rsrc, roff, j * 1024, 2));
#pragma unroll 1
        for (int k0 = 0; k0 < 128; k0 += 16) {
            if (k0 + 16 < 128) {
#pragma unroll
                for (int j = 0; j < 16; ++j) xn[j] = __builtin_bit_cast(float, __builtin_amdgcn_raw_buffer_load_b32(rsrc, roff, (k0 + 16 + j) * 1024, 2));
            }
            __builtin_amdgcn_sched_barrier(0);
            int kb[16];
#pragma unroll
            for (int j = 0; j < 16; ++j) kb[j] = (f2key(xs[j]) & ~127) | (k0 + j);
            sort16_asc(kb);
            if (k0 == 0) {
#pragma unroll
                for (int j = 0; j < 16; ++j) v[j] = kb[15 - j];
            } else merge16(v, kb);
            __builtin_amdgcn_sched_barrier(0);
#pragma unroll
            for (int j = 0; j < 16; ++j) xs[j] = xn[j];
        }
        int A[16], B[16];
#pragma unroll
        for (int k = 0; k < 16; ++k) { const int o = __shfl_xor(v[k], 1); A[k] = c ? o : v[k]; B[k] = c ? v[k] : o; }
        int c2[16];
#pragma unroll
        for (int k = 0; k < 16; ++k) c2[k] = (int)0x80000000;
#define CAND(i, j) ((f2key(key2f(A[i]) + key2f(B[j])) & ~255) | ((i) * 16 + (j)))
#pragma unroll
        for (int j = 0; j < 16; ++j) c2[j] = CAND(0, j);
        { int t[16]; t[0] = (int)0x80000000;
#pragma unroll
          for (int i = 1; i < 16; ++i) t[16 - i] = CAND(i, 0);
          merge16(c2, t); }
        { int t[16];
          t[0] = CAND(1, 1); t[1] = CAND(1, 2); t[2] = CAND(1, 3); t[3] = CAND(1, 4); t[4] = CAND(1, 5); t[5] = CAND(1, 6); t[6] = CAND(1, 7);
          t[7] = CAND(2, 1); t[8] = CAND(2, 2); t[9] = CAND(2, 3); t[10] = CAND(2, 4); t[11] = CAND(3, 1); t[12] = CAND(3, 2); t[13] = CAND(3, 3);
          t[14] = CAND(4, 1); t[15] = CAND(4, 2);
          sort16_asc(t); merge16(c2, t); }
        { int x = CAND(5, 1); TOPK_INS(c2, x); x = CAND(6, 1); TOPK_INS(c2, x); x = CAND(7, 1); TOPK_INS(c2, x); }
#undef CAND
        float ssq = 0.f;
#pragma unroll
        for (int j = 0; j < 4; ++j) ssq += (rq[j][0] + rq[j][1]) + (rq[j][2] + rq[j][3]);
        const float rstd = __builtin_amdgcn_rsqf(ssq * (1.f / D) + RMS_EPS);
        const unsigned long long alo = pack8idx(A, 0), ahi = pack8idx(A, 8), blo = pack8idx(B, 0), bhi = pack8idx(B, 8);
        float sc[16]; int id[16]; float smax = 0.f, ssum = 0.f;
#pragma unroll
        for (int k = 0; k < 16; ++k) {
            const int cid = c2[k] & 255, i = cid >> 4, j = cid & 15;
            id[k] = lut16(alo, ahi, i) * 128 + lut16(blo, bhi, j);
            sc[k] = key2f(c2[k]) * rstd;
            if (k == 0) smax = sc[0];
            sc[k] = __expf(sc[k] - smax); ssum += sc[k];
        }
        const float inv = 1.f / ssum;
        int* ip = IDX + t * HK + u.pn * 16; float* gp = GATE + t * HK + u.pn * 16;
#pragma unroll
        for (int k = 0; k < 16; ++k) if ((k >> 3) == c) { ip[k] = id[k]; gp[k] = sc[k] * inv; }
    }
};

struct Frame {
    LAS unsigned char* lds;
    volatile LAS unsigned* MISC;
    gu32* ctl;
    int tid, lane, wave, vcu, G;
    int xcc, xrank;
    unsigned char* ws;
    const float* in[15]; float* out;
};
enum { I_X = 0, I_POS, I_NMIX, I_WIN, I_CONVW, I_WCONV, I_WATTN, I_GBIAS, I_WOUT, I_NFFN, I_WQ, I_SUBK, I_DOWN, I_UP, I_FNORM };

__device__ __forceinline__ void transpose_item(const float* W, int ldw, int k0, int n0, bf16* dst, int ldd, LAS float* scr, int lane) {
#pragma unroll 8
    for (int i = 0; i < 32; ++i) { const int kk = 2 * i + (lane >> 5); scr[kk * 33 + (lane & 31)] = W[(size_t)(k0 + kk) * ldw + n0 + (lane & 31)]; }
    LDS_WAIT(); asm volatile("" ::: "memory");
    const int c = lane & 7;
#pragma unroll
    for (int j = 0; j < 4; ++j) { const int n = (lane >> 3) + 8 * j; const LAS float* s = scr + (8 * c) * 33 + n;
        v4u o; o.x = pk2(s[0 * 33], s[1 * 33]); o.y = pk2(s[2 * 33], s[3 * 33]); o.z = pk2(s[4 * 33], s[5 * 33]); o.w = pk2(s[6 * 33], s[7 * 33]);
        *(GAS v4u*)(dst + (size_t)n * ldd + 8 * c) = o; }
    LDS_WAIT(); asm volatile("" ::: "memory");
}
__device__ __forceinline__ void w8_column_item(const float* W, int ldw, int n0, unsigned char* dst8  , float* swp  , LAS unsigned char* lds, int wave, int lane) {
    LAS float* scr = (LAS float*)(lds + wave * 16384); LAS float* cmx = (LAS float*)(lds + 130048);
    float x[2][32]; float am = 0.f;
#pragma unroll
    for (int b = 0; b < 2; ++b)
#pragma unroll
        for (int i = 0; i < 32; ++i) { const int kk = 64 * (2 * wave + b) + 2 * i + (lane >> 5); x[b][i] = W[(size_t)kk * ldw + n0 + (lane & 31)]; am = fmaxf(am, fabsf(x[b][i])); }
    am = fmaxf(am, __shfl_xor(am, 32));
    if (lane < 32) cmx[wave * 32 + lane] = am;
    __syncthreads();
    float cm = 0.f;
#pragma unroll
    for (int w = 0; w < 8; ++w) cm = fmaxf(cm, cmx[w * 32 + (lane & 31)]);
    const float q8 = (cm > 0.f) ? 127.f / cm : 0.f;
    if (wave == 0 && lane < 32) swp[lane] = cm * (1.f / 127.f);
#pragma unroll
    for (int b = 0; b < 2; ++b) {
#pragma unroll
        for (int i = 0; i < 32; ++i) scr[(2 * i + (lane >> 5)) * 33 + (lane & 31)] = x[b][i] * q8;
        LDS_WAIT(); asm volatile("" ::: "memory");
        const int c = lane & 7;
#pragma unroll
        for (int j = 0; j < 4; ++j) { const int n = (lane >> 3) + 8 * j; const LAS float* s = scr + (8 * c) * 33 + n;
            u32x2 o; o.x = pack4i8((f32x4){s[0 * 33], s[1 * 33], s[2 * 33], s[3 * 33]}); o.y = pack4i8((f32x4){s[4 * 33], s[5 * 33], s[6 * 33], s[7 * 33]});
            *(u32x2*)(dst8 + (size_t)n * D + 64 * (2 * wave + b) + 8 * c) = o; }
        LDS_WAIT(); asm volatile("" ::: "memory");
    }
    __syncthreads();
}
__device__ __forceinline__ int win_w8_row(int n0) {
    if (n0 < 1024) return NP1 + n0;
    if (n0 < 2048) { const int j = n0 - 1024; return NP1 + 1024 + (j >> 7) * 256 + (j & 127); }
    if (n0 < 3072) { const int j = n0 - 2048; return NP1 + 1024 + (j >> 7) * 256 + 128 + (j & 127); }
    if (n0 < 7680) { const int j = n0 - 3072, kind = j / 1536, jj = j % 1536, g = jj >> 9, cc = jj & 511; return g * 1536 + kind * 512 + cc; }
    if (n0 < 8704) return NP1 + 3072 + (n0 - 7680);
    if (n0 < 9216) return NP1 + 4096 + (n0 - 8704);
    return NQKV + (n0 - 9216);
}
__device__ __forceinline__ void p0_prologue(Frame& F) {
    for (int it = F.vcu; it < DIN / 32; it += F.G) {
        const int n0 = 32 * it, drow = win_w8_row(n0);
        w8_column_item(F.in[I_WIN], DIN, n0, F.ws + WS_WQKV8 + (size_t)drow * D, (float*)(F.ws + WS_SW) + drow, F.lds, F.wave, F.lane);
    }
    LAS float* scr = (LAS float*)(F.lds + F.wave * 16384);
    const int gw = F.vcu * NWAVES + F.wave, NGW = F.G * NWAVES;
    constexpr int I_C = 16 * 32, I_A = 8 * 32, I_O = 16 * 32, NITEMS = I_C + I_A + I_O;
    for (int it = gw; it < NITEMS; it += NGW) {
        int r = it;
        if (r < I_C) { const int kb = r / 32, nb = r % 32; transpose_item(F.in[I_WCONV], D, 64 * kb, 32 * nb, (bf16*)(F.ws + WS_WCONV) + (size_t)(32 * nb) * D + 64 * kb, D, scr, F.lane); continue; } r -= I_C;
        if (r < I_A) { const int kb = r / 32, nb = r % 32; transpose_item(F.in[I_WATTN], D, 64 * kb, 32 * nb, (bf16*)(F.ws + WS_WATTN) + (size_t)(32 * nb) * DAO + 64 * kb, DAO, scr, F.lane); continue; } r -= I_A;
        { const int kb = r / 32, nb = r % 32; transpose_item(F.in[I_WOUT], D, 64 * kb, 32 * nb, (bf16*)(F.ws + WS_WOUT) + (size_t)(32 * nb) * D + 64 * kb, D, scr, F.lane); }
    }
    const float* x = F.in[I_X]; const float* nm = F.in[I_NMIX];
    f32x4 gm[4];
#pragma unroll
    for (int j = 0; j < 4; ++j) gm[j] = *((const f32x4*)nm + F.lane + 64 * j);
    for (int m = gw; m < T; m += NGW) {
        const GAS f32x4* xr = (const GAS f32x4*)(x + (size_t)m * D) + F.lane;
        f32x4 v[4]; float s = 0.f;
#pragma unroll
        for (int j = 0; j < 4; ++j) { v[j] = xr[64 * j]; s += (v[j].x * v[j].x + v[j].y * v[j].y) + (v[j].z * v[j].z + v[j].w * v[j].w); }
        const float rstd = 1.f / sqrtf(wave_sum(s) * (1.f / D) + RMS_EPS);
        f32x4 y[4]; float am = 0.f;
#pragma unroll
        for (int j = 0; j < 4; ++j) { y[j] = v[j] * rstd * gm[j];
            am = fmaxf(am, fmaxf(fmaxf(fabsf(y[j].x), fabsf(y[j].y)), fmaxf(fabsf(y[j].z), fabsf(y[j].w)))); }
#pragma unroll
        for (int o = 1; o < 64; o <<= 1) am = fmaxf(am, __shfl_xor(am, o));
        const float q8 = (am > 0.f) ? 127.f / am : 0.f;
#pragma unroll
        for (int j = 0; j < 4; ++j) ((GAS unsigned*)(F.ws + WS_U8 + (size_t)m * D))[F.lane + 64 * j] = pack4i8(y[j] * q8);
        if (F.lane == 0) ((float*)(F.ws + WS_SU))[m] = am * (1.f / 127.f);
    }
    const int* pos = (const int*)F.in[I_POS]; float* rope = (float*)(F.ws + WS_ROPE);
    for (int e = gw * 64 + F.lane; e < T * 8; e += NGW * 64) {
        const int t = e >> 3, j = e & 7;
        const double invf[8] = {1.0, 0.19392274474868576, 0.03760603093086393, 0.007292664737217109, 0.001414213562373095, 0.0002742481756762073, 5.318295896944988e-05, 1.031338537721246e-05};
        double f = 1.0;
#pragma unroll
        for (int q = 1; q < 8; ++q) f = (j == q) ? invf[q] : f;
        const float fi = (float)f;
        const double ang = (double)pos[t] * (double)fi;
        const double k = __builtin_rint(ang * 0.15915494309189535);
        const float r = (float)(ang - k * 6.283185307179586);
        rope[(size_t)t * 16 + j] = __cosf(r); rope[(size_t)t * 16 + 8 + j] = __sinf(r);
    }
}

__device__ __forceinline__ void attn_phase(Frame& F, bf16* OGb, float* LSE) {
    constexpr int SLOT = 128 * 160;
    LAS unsigned char* Ks = F.lds; LAS unsigned char* Vs = F.lds + 3 * SLOT;
    const int lane = F.lane, w = F.wave, ir = lane & 15, gq = lane >> 4;
    const int NU = 3 * 8 * 128, per = (NU + F.G - 1) / F.G;
    const int u0 = F.vcu * per, u1 = (u0 + per < NU) ? u0 + per : NU;
    const bf16* Qb = (const bf16*)(F.ws + WS_Q); const bf16* Kb = (const bf16*)(F.ws + WS_K); const bf16* Vb = (const bf16*)(F.ws + WS_V);
    u32x4 pk[2], pv[2]; bf16x8 nq0, nq1; bool havepre = false;
    for (int uid = u0, n = 0; uid < u1; ++uid, ++n) {
        const int g = uid >> 10, hh = (uid >> 7) & 7, blk = uid & 127, sh = 2 * g;
        const bool first = (blk & ((64 >> sh) - 1)) == 0;
        const size_t gbase = (size_t)g * T * GW;
        const int p0 = blk * 128;
        const int ps = n % 3, cs = (n + 1) % 3, ns = (n + 2) % 3;
        const bf16* qrow = Qb + gbase + (size_t)(p0 + 16 * w + ir) * GW + hh * 64;
        bf16* orow = OGb + gbase + (size_t)(p0 + 16 * w + ir) * GW + hh * 64;
        bf16x8 qf0, qf1;
        if (!havepre) {
            if (n > 0) __syncthreads();
#pragma unroll
            for (int i = 0; i < 4; ++i) {
                const int c = F.tid + 512 * i, row = c >> 3, part = c & 7;
                const bool valid = !first || row >= 128;
                u32x4 kv = {0u, 0u, 0u, 0u}, vv = {0u, 0u, 0u, 0u};
                if (valid) { const size_t off = gbase + (size_t)(p0 - 128 + row) * GW + hh * 64 + part * 8; kv = *(const u32x4*)(Kb + off); vv = *(const u32x4*)(Vb + off); }
                const int so = ((row < 128) ? ps : cs) * SLOT + (row & 127) * 160 + part * 16;
                *(LAS u32x4*)(Ks + so) = kv; *(LAS u32x4*)(Vs + so) = vv;
            }
            qf0 = *(const bf16x8*)(qrow + 8 * gq); qf1 = *(const bf16x8*)(qrow + 32 + 8 * gq);
        } else { qf0 = nq0; qf1 = nq1; }
        __syncthreads();
        havepre = (uid + 1 < u1) && (((uid + 1) & 127) != 0);
        if (havepre) {
#pragma unroll
            for (int i = 0; i < 2; ++i) { const int c = F.tid + 512 * i, row = c >> 3, part = c & 7; const size_t off = gbase + (size_t)(p0 + 128 + row) * GW + hh * 64 + part * 8; pk[i] = *(const u32x4*)(Kb + off); pv[i] = *(const u32x4*)(Vb + off); }
            nq0 = *(const bf16x8*)(qrow + (size_t)128 * GW + 8 * gq); nq1 = *(const bf16x8*)(qrow + (size_t)128 * GW + 32 + 8 * gq);
        }
        f32x4 sacc[9];
#pragma unroll
        for (int a = 0; a < 9; ++a) {
            sacc[a] = (f32x4){0.f, 0.f, 0.f, 0.f};
            const int R0 = 16 * w + 16 * a;
            const LAS unsigned char* kp = Ks + ((R0 < 128) ? ps : cs) * SLOT + ((R0 & 127) + ir) * 160 + gq * 16;
            const bf16x8 k0 = *(const LAS bf16x8*)kp, k1 = *(const LAS bf16x8*)(kp + 64);
            sacc[a] = __builtin_amdgcn_mfma_f32_16x16x32_bf16(k0, qf0, sacc[a], 0, 0, 0);
            sacc[a] = __builtin_amdgcn_mfma_f32_16x16x32_bf16(k1, qf1, sacc[a], 0, 0, 0);
        }
        float mx = -INFINITY;
#pragma unroll
        for (int a = 0; a < 9; ++a)
#pragma unroll
            for (int j = 0; j < 4; ++j) {
                const int jl = 4 * gq + j;
                bool valid = (a == 0) ? (jl >= ir) : ((a == 8) ? (jl <= ir) : true);
                valid = valid && (!first || (16 * w + 16 * a + jl >= 128));
                sacc[a][j] = valid ? sacc[a][j] : -INFINITY;
                mx = fmaxf(mx, sacc[a][j]);
            }
        mx = fmaxf(mx, __shfl_xor(mx, 16)); mx = fmaxf(mx, __shfl_xor(mx, 32));
        float l = 0.f;
#pragma unroll
        for (int a = 0; a < 9; ++a)
#pragma unroll
            for (int j = 0; j < 4; ++j) { sacc[a][j] = __builtin_amdgcn_exp2f(sacc[a][j] - mx); l += sacc[a][j]; }
        l += __shfl_xor(l, 16); l += __shfl_xor(l, 32);
        f32x4 oacc[4];
#pragma unroll
        for (int dt = 0; dt < 4; ++dt) oacc[dt] = (f32x4){0.f, 0.f, 0.f, 0.f};
#pragma unroll
        for (int s = 0; s < 5; ++s) {
            u32x4 pw; pw.x = cvt_pk_bf16(sacc[2 * s][0], sacc[2 * s][1]); pw.y = cvt_pk_bf16(sacc[2 * s][2], sacc[2 * s][3]);
            if (s < 4) { pw.z = cvt_pk_bf16(sacc[2 * s + 1][0], sacc[2 * s + 1][1]); pw.w = cvt_pk_bf16(sacc[2 * s + 1][2], sacc[2 * s + 1][3]); } else { pw.z = 0u; pw.w = 0u; }
            const bf16x8 pb = __builtin_bit_cast(bf16x8, pw);
            const int q = ir >> 2, p = ir & 3;
            const int Ra = 16 * w + 32 * s, Rb = Ra + 16;
            const LAS unsigned char* vpa = Vs + ((Ra < 128) ? ps : cs) * SLOT + ((Ra & 127) + 4 * gq + q) * 160 + p * 8;
            const LAS unsigned char* vpb = Vs + ((Rb < 128) ? ps : cs) * SLOT + ((Rb & 127) + 4 * gq + q) * 160 + p * 8;
#pragma unroll
            for (int dt = 0; dt < 4; ++dt) {
                const s16x4 va = __builtin_bit_cast(s16x4, __builtin_amdgcn_ds_read_tr16_b64_v4i16((LAS v4i16_t*)(vpa + dt * 32)));
                s16x4 vb = {0, 0, 0, 0};
                if (s < 4) vb = __builtin_bit_cast(s16x4, __builtin_amdgcn_ds_read_tr16_b64_v4i16((LAS v4i16_t*)(vpb + dt * 32)));
                const bf16x8 vf = __builtin_shufflevector(va, vb, 0, 1, 2, 3, 4, 5, 6, 7);
                oacc[dt] = __builtin_amdgcn_mfma_f32_16x16x32_bf16(vf, pb, oacc[dt], 0, 0, 0);
            }
        }
        const float inv = 1.f / l;
#pragma unroll
        for (int dt = 0; dt < 4; ++dt) {
            u32x2 o; o.x = cvt_pk_bf16(oacc[dt][0] * inv, oacc[dt][1] * inv); o.y = cvt_pk_bf16(oacc[dt][2] * inv, oacc[dt][3] * inv);
            *(u32x2*)(orow + 16 * dt + 4 * gq) = o;
        }
        if (gq == 0) LSE[((size_t)g * T + p0 + 16 * w + ir) * 8 + hh] = (mx + __builtin_amdgcn_logf(l)) * LN2;
        if (havepre) {
#pragma unroll
            for (int i = 0; i < 2; ++i) { const int c = F.tid + 512 * i, row = c >> 3, part = c & 7; const int so = ns * SLOT + row * 160 + part * 16; *(LAS u32x4*)(Ks + so) = pk[i]; *(LAS u32x4*)(Vs + so) = pv[i]; }
        }
    }
    __syncthreads();
}

__device__ __forceinline__ void combine_phase(Frame& F, int part, int nparts) {
    const int gw = part * NWAVES + F.wave, NGW = nparts * NWAVES, lane = F.lane, hh = lane >> 3;
    const bf16* OG = (const bf16*)(F.ws + WS_Q); const float* LSE = (const float*)(F.ws + WS_LSE); bf16* O = (bf16*)(F.ws + WS_O);
    for (int t0 = gw * 4; t0 < T; t0 += NGW * 4) {
        float ls[4][3]; u32x4 og[4][3];
#pragma unroll
        for (int q = 0; q < 4; ++q) { const int t = t0 + q, b = t / SEQ, s = t % SEQ;
#pragma unroll
            for (int g = 0; g < 3; ++g) {
                const int sh = 2 * g, r = s & ((1 << sh) - 1), i = s >> sh;
                const size_t p = (size_t)g * T + b * SEQ + r * (SEQ >> sh) + i;
                ls[q][g] = LSE[p * 8 + hh]; og[q][g] = *(const u32x4*)(OG + p * GW + lane * 8);
            } }
#pragma unroll
        for (int q = 0; q < 4; ++q) {
            const float m = fmaxf(ls[q][0], fmaxf(ls[q][1], ls[q][2]));
            float e[3], sum = 0.f;
#pragma unroll
            for (int g = 0; g < 3; ++g) { e[g] = __expf(ls[q][g] - m); sum += e[g]; }
            const float inv = 1.f / sum;
            f32x4 a0 = {0.f, 0.f, 0.f, 0.f}, a1 = a0;
#pragma unroll
            for (int g = 0; g < 3; ++g) { f32x4 v0, v1; unpack8(og[q][g], v0, v1); const float wg = e[g] * inv; a0 = a0 + v0 * wg; a1 = a1 + v1 * wg; }
            *(u32x4*)(O + (size_t)(t0 + q) * DAO + lane * 8) = pack8(a0, a1);
        }
    }
}

__device__ __forceinline__ void p4_conv(Frame& F) {
    constexpr int RUN = 16;
    const int gt = (F.vcu * NWAVES + F.wave) * 64 + F.lane, NGT = F.G * NWAVES * 64;
    bf16* Bb = (bf16*)((unsigned char*)F.out + OS_BB); const bf16* Z = (const bf16*)(F.ws + WS_Z); const float* cw = F.in[I_CONVW];
    for (int e = gt; e < (T / RUN) * (D / 8); e += NGT) {
        const int t0 = (e >> 7) * RUN, c8 = (e & 127) * 8, s0 = t0 & (SEQ - 1);
        const f32x4 w0a = *(const f32x4*)(cw + c8), w0b = *(const f32x4*)(cw + c8 + 4), w1a = *(const f32x4*)(cw + D + c8), w1b = *(const f32x4*)(cw + D + c8 + 4), w2a = *(const f32x4*)(cw + 2 * D + c8), w2b = *(const f32x4*)(cw + 2 * D + c8 + 4);
        const size_t off0 = (size_t)t0 * D + c8;
        f32x4 z1a = {0.f, 0.f, 0.f, 0.f}, z1b = z1a, z2a = z1a, z2b = z1a;
        if (s0 >= 2) { unpack8(*(const u32x4*)(Z + off0 - D), z1a, z1b); unpack8(*(const u32x4*)(Z + off0 - 2 * D), z2a, z2b); }
#pragma unroll 4
        for (int r = 0; r < RUN; ++r) {
            const size_t off = off0 + (size_t)r * D;
            f32x4 z0a, z0b, ba, bb;
            unpack8(*(const u32x4*)(Z + off), z0a, z0b); unpack8(*(const u32x4*)(Bb + off), ba, bb);
            const f32x4 ca = w0a * z2a + w1a * z1a + w2a * z0a, cb = w0b * z2b + w1b * z1b + w2b * z0b;
            *(u32x4*)(Bb + off) = pack8(ba * ca, bb * cb);
            z2a = z1a; z2b = z1b; z1a = z0a; z1b = z0b;
        }
    }
}
__device__ __forceinline__ void split8(const f32x4 a, const f32x4 b, bf16x8& hi, bf16x8& lo) {
    const u32x4 h = pack8(a, b); f32x4 ha, hb; unpack8(h, ha, hb);
    hi = __builtin_bit_cast(bf16x8, h); lo = __builtin_bit_cast(bf16x8, pack8(a - ha, b - hb));
}
__device__ __forceinline__ void p4_wfold(Frame& F) {
    const int gw = F.vcu * NWAVES + F.wave, NGW = F.G * NWAVES, i = F.lane & 15, g = F.lane >> 4;
    const float* Wq = F.in[I_WQ]; const float* SK = F.in[I_SUBK]; bf16* WF = (bf16*)((unsigned char*)F.out + OS_WFOLD);
    for (int it = gw; it < 1024; it += NGW) {
        const int itu = __builtin_amdgcn_readfirstlane(it);
        const int hc = itu >> 6, k0 = ((itu >> 1) & 31) * 32, nh = itu & 1;
        bf16x8 ah[2][4], al[2][4];
#pragma unroll
        for (int kt = 0; kt < 2; ++kt)
#pragma unroll
            for (int j = 0; j < 4; ++j) { const float* ap = Wq + (size_t)(k0 + 16 * kt + i) * 2048 + hc * 128 + 32 * j + 8 * g; split8(*(const f32x4*)ap, *(const f32x4*)(ap + 4), ah[kt][j], al[kt][j]); }
#pragma unroll 1
        for (int nt = 0; nt < 4; ++nt) {
            const int n0 = hc * 128 + nh * 64 + 16 * nt;
            bf16x8 bh[4], bl[4];
#pragma unroll
            for (int j = 0; j < 4; ++j) { const float* bp = SK + (size_t)(n0 + i) * 128 + 32 * j + 8 * g; split8(*(const f32x4*)bp, *(const f32x4*)(bp + 4), bh[j], bl[j]); }
#pragma unroll
            for (int kt = 0; kt < 2; ++kt) {
                f32x4 acc = {0.f, 0.f, 0.f, 0.f};
#pragma unroll
                for (int j = 0; j < 4; ++j) { acc = __builtin_amdgcn_mfma_f32_16x16x32_bf16(al[kt][j], bh[j], acc, 0, 0, 0); acc = __builtin_amdgcn_mfma_f32_16x16x32_bf16(ah[kt][j], bl[j], acc, 0, 0, 0); }
#pragma unroll
                for (int j = 0; j < 4; ++j) acc = __builtin_amdgcn_mfma_f32_16x16x32_bf16(ah[kt][j], bh[j], acc, 0, 0, 0);
                u32x2 o; o.x = pk2(acc[0], acc[1]); o.y = pk2(acc[2], acc[3]);
                *(u32x2*)(WF + (size_t)(n0 + i) * D + k0 + 16 * kt + 4 * g) = o;
            }
        }
    }
}
__device__ __forceinline__ float gelu_erf(float v) { return 0.5f * v * (1.f + erff(v * 0.70710678118654752f)); }
__device__ __forceinline__ void peer_down_phase(Frame& F) {
    const int lane = F.lane, sub = lane & 15, gq = lane >> 4;
    const int nloc = (int)F.MISC[8], nxc = (int)F.MISC[9]; const bool byx = (nxc == 8) && (nloc * 8 == F.G) && (F.xcc < 8);
    const int x = byx ? F.xcc : 0, nsh = byx ? 8 : 1, rank = byx ? F.xrank : (int)blockIdx.x, nrank = byx ? nloc : F.G;
    const unsigned char* HG8 = F.ws + WS_HG8; const float* HSC = (const float*)(F.ws + WS_HSC); const float* RSQ = (const float*)(F.ws + WS_RSQ);
    const int* IDX = (const int*)(F.ws + WS_IDX); const float* GATE = (const float*)(F.ws + WS_GATE);
    const unsigned char* dn8 = (const unsigned char*)F.out + OS_EDOWN; const float* esc = (const float*)(F.ws + WS_ESCALE); float* WB = (float*)(F.ws + WS_WB);
    LAS unsigned char* wb = F.lds + F.wave * 10752;
    LAS u32x4* h8s = (LAS u32x4*)wb; LAS float* hss = (LAS float*)(wb + 4096); LAS u32x2* ls = (LAS u32x2*)(wb + 4608); LAS float* av = (LAS float*)(wb + 8704);
    const int tstep = nrank * NWAVES * 4;
    for (int xs = x; xs < 8; xs += nsh) {
        int tb = (rank * NWAVES + F.wave) * 4;
        u32x4 ia, ib, h8[4]; f32x4 ga, gb; float hs[4], pq;
#define PD_META(tt) do { const size_t t_ = (size_t)(tt) + gq; ia = *(const u32x4*)(IDX + t_ * HK + sub * 8); ib = *(const u32x4*)(IDX + t_ * HK + sub * 8 + 4); \
            ga = *(const f32x4*)(GATE + t_ * HK + sub * 8); gb = *(const f32x4*)(GATE + t_ * HK + sub * 8 + 4); pq = RSQ[t_ * 16 + sub]; \
            _Pragma("unroll") for (int j_ = 0; j_ < 4; ++j_) { h8[j_] = *(const u32x4*)(HG8 + t_ * D + 16 * (sub + 16 * j_)); hs[j_] = HSC[t_ * 32 + ((sub + 16 * j_) >> 1)]; } } while (0)
        if (tb < T) PD_META(tb);
        for (; tb < T; tb += tstep) {
#pragma unroll
            for (int j = 0; j < 4; ++j) { h8s[gq * 64 + sub + 16 * j] = h8[j]; if ((sub & 1) == 0) hss[gq * 32 + ((sub + 16 * j) >> 1)] = hs[j]; }
            int total = 0;
#pragma unroll
            for (int k = 0; k < 8; ++k) {
                const int ei = (int)(k < 4 ? ia[k & 3] : ib[k & 3]); const float gk = (k < 4 ? ga[k & 3] : gb[k & 3]);
                const bool f = (ei >> 11) == xs;
                const unsigned long long m = __ballot(f);
                const int pos = total + (int)__builtin_amdgcn_mbcnt_hi((unsigned)(m >> 32), __builtin_amdgcn_mbcnt_lo((unsigned)m, 0u));
                if (f) { u32x2 ent; ent.x = (unsigned)ei | ((unsigned)(sub * 8 + k) << 14) | ((unsigned)gq << 21); ent.y = __builtin_bit_cast(unsigned, gk); ls[pos] = ent; }
                total += __popcll(m);
            }
            float rq = pq; rq += __shfl_xor(rq, 1); rq += __shfl_xor(rq, 2); rq += __shfl_xor(rq, 4); rq += __shfl_xor(rq, 8);
            const float rstd = __builtin_amdgcn_rsqf(rq * (1.f / D) + RMS_EPS);
            const int tcur = tb;
            if (tb + tstep < T) PD_META(tb + tstep);
            LDS_WAIT(); asm volatile("" ::: "memory");
            const int nr = (total + 3) >> 2;
#define PD_ISSUE(R, HH, HS, r0) do { _Pragma("unroll") for (int u_ = 0; u_ < 2; ++u_) { const int k_ = 4 * ((r0) + u_) + gq; const bool v_ = k_ < total; const u32x2 e_ = ls[v_ ? k_ : 0]; const unsigned ex_ = e_.x; \
                const unsigned ro_ = (v_ ? (ex_ & 16383u) : 0u) * 1024u + 16u * (unsigned)sub; const unsigned tk_ = (ex_ >> 21) & 3u; \
                _Pragma("unroll") for (int j_ = 0; j_ < 4; ++j_) { R[u_][j_] = *(const u32x4*)(dn8 + (ro_ + 256u * j_)); HH[u_][j_] = h8s[tk_ * 64 + sub + 16 * j_]; HS[u_][j_] = hss[tk_ * 32 + ((sub + 16 * j_) >> 1)]; } } } while (0)
#define PD_COMPUTE(R, HH, HS, r0) do { _Pragma("unroll") for (int u_ = 0; u_ < 2; ++u_) { const int k_ = 4 * ((r0) + u_) + gq; float af_ = 0.f; \
                _Pragma("unroll") for (int j_ = 0; j_ < 4; ++j_) { int ac_ = 0; _Pragma("unroll") for (int q_ = 0; q_ < 4; ++q_) { const int a_ = (int)R[u_][j_][q_], b_ = (int)HH[u_][j_][q_]; ac_ = __builtin_amdgcn_sdot4(a_, b_, ac_, false); } af_ += (float)ac_ * HS[u_][j_]; } \
                af_ += __shfl_xor(af_, 1); af_ += __shfl_xor(af_, 2); af_ += __shfl_xor(af_, 4); af_ += __shfl_xor(af_, 8); \
                if (k_ < total && sub == 0) av[k_] = af_; } } while (0)
            u32x4 RA[2][4], RB[2][4], HA[2][4], HB[2][4]; float SA[2][4], SB[2][4];
            if (nr > 0) PD_ISSUE(RA, HA, SA, 0);
#pragma unroll 1
            for (int r = 0; r < nr; r += 4) {
                if (r + 2 < nr) PD_ISSUE(RB, HB, SB, r + 2);
                __builtin_amdgcn_sched_barrier(0);
                PD_COMPUTE(RA, HA, SA, r);
                __builtin_amdgcn_sched_barrier(0);
                if (r + 4 < nr) PD_ISSUE(RA, HA, SA, r + 4);
                __builtin_amdgcn_sched_barrier(0);
                if (r + 2 < nr) PD_COMPUTE(RB, HB, SB, r + 2);
                __builtin_amdgcn_sched_barrier(0);
            }
#undef PD_ISSUE
#undef PD_COMPUTE
            LDS_WAIT(); asm volatile("" ::: "memory");
            const float rs0 = __builtin_bit_cast(float, __builtin_amdgcn_readlane(__builtin_bit_cast(int, rstd), 0)), rs1 = __builtin_bit_cast(float, __builtin_amdgcn_readlane(__builtin_bit_cast(int, rstd), 16)),
                        rs2 = __builtin_bit_cast(float, __builtin_amdgcn_readlane(__builtin_bit_cast(int, rstd), 32)), rs3 = __builtin_bit_cast(float, __builtin_amdgcn_readlane(__builtin_bit_cast(int, rstd), 48));
            for (int i = lane; i < total; i += 64) {
                const u32x2 e = ls[i]; const unsigned ex = e.x, eg = e.y; const int tk = (int)((ex >> 21) & 3u);
                const float rs = (tk == 0) ? rs0 : ((tk == 1) ? rs1 : ((tk == 2) ? rs2 : rs3));
                const float a = av[i] * esc[ex & 16383u] * rs;
                WB[(size_t)(tcur + tk) * HK + ((ex >> 14) & 127u)] = __builtin_bit_cast(float, eg) * esc[NEXP + (ex & 16383u)] * gelu_erf(a);
            }
            LDS_WAIT(); asm volatile("" ::: "memory");
        }
#undef PD_META
    }
}
__device__ __forceinline__ void peer_up_phase(Frame& F) {
    const int lane = F.lane, g8 = lane >> 3, c = lane & 7;
    const int nloc = (int)F.MISC[8], nxc = (int)F.MISC[9]; const bool byx = (nxc == 8) && (nloc * 8 == F.G) && (F.xcc < 8);
    const int x = byx ? F.xcc : 0, nsh = byx ? 8 : 1, rank = byx ? F.xrank : (int)blockIdx.x, nrank = byx ? nloc : F.G;
    const bf16* HG = (const bf16*)(F.ws + WS_HG); const float* nffn = F.in[I_NFFN]; const int* IDX = (const int*)(F.ws + WS_IDX); const float* WB = (const float*)(F.ws + WS_WB);
    float* SS = (float*)(F.ws + WS_SS); float* out = F.out;
    LAS unsigned char* wbuf = F.lds + F.wave * 16384;
    const int tstep = nrank * NWAVES * 8;
    for (int xs = x; xs < 8; xs += nsh) {
    const unsigned char* up8 = F.ws + WS_EUP + (size_t)xs * (2 * MiB);
    int tb = (rank * NWAVES + F.wave) * 8, it = 0;
#define PU_DMA(tt, bufi) do { LAS unsigned char* d_ = wbuf + (bufi) * 8192; _Pragma("unroll") for (int q_ = 0; q_ < 4; ++q_) { \
        __builtin_amdgcn_global_load_lds((const unsigned*)((const unsigned char*)(IDX + (size_t)(tt) * HK + q_ * 256) + (unsigned)(lane * 16)), (LAS unsigned*)(d_ + q_ * 1024), 16, 0, 0); \
        __builtin_amdgcn_global_load_lds((const unsigned*)((const unsigned char*)(WB + (size_t)(tt) * HK + q_ * 256) + (unsigned)(lane * 16)), (LAS unsigned*)(d_ + 4096 + q_ * 1024), 16, 0, 0); } } while (0)
    if (tb < T) PU_DMA(tb, 0);
    for (; tb < T; tb += tstep, ++it) {
        const int t = tb + g8;
        const LAS unsigned char* mi = wbuf + (it & 1) * 8192 + g8 * 512;
        asm volatile("s_waitcnt vmcnt(0)" ::: "memory");
        const unsigned hgo = (unsigned)(t * (D * 2) + 256 * xs + 32 * c);
        const u32x4 hg0 = *(const u32x4*)((const unsigned char*)HG + hgo), hg1 = *(const u32x4*)((const unsigned char*)HG + (hgo + 16u));
        f32x4 oa[4];
#pragma unroll
        for (int q = 0; q < 4; ++q) oa[q] = (f32x4){0.f, 0.f, 0.f, 0.f};
#define PU_ISSUE(R, W, st) do { const u32x4 i0_ = *(const LAS u32x4*)(mi + (st) * 32), i1_ = *(const LAS u32x4*)(mi + (st) * 32 + 16); \
            const f32x4 w0_ = *(const LAS f32x4*)(mi + 4096 + (st) * 32), w1_ = *(const LAS f32x4*)(mi + 4096 + (st) * 32 + 16); \
            _Pragma("unroll") for (int k_ = 0; k_ < 8; ++k_) { const unsigned ei_ = (k_ < 4) ? i0_[k_ & 3] : i1_[k_ & 3]; W[k_] = (k_ < 4) ? w0_[k_ & 3] : w1_[k_ & 3]; \
            R[k_] = *(const u32x4*)(up8 + (ei_ * 128u + 16u * (unsigned)c)); } } while (0)
#define PU_COMPUTE(R, W) do { _Pragma("unroll") for (int k_ = 0; k_ < 8; ++k_) { _Pragma("unroll") for (int q_ = 0; q_ < 4; ++q_) { const int d_ = (int)R[k_][q_]; \
            const f32x2 lo_ = __builtin_amdgcn_cvt_pk_f32_fp8(d_, false), hi_ = __builtin_amdgcn_cvt_pk_f32_fp8(d_, true); \
            oa[q_][0] += lo_.x * W[k_]; oa[q_][1] += lo_.y * W[k_]; oa[q_][2] += hi_.x * W[k_]; oa[q_][3] += hi_.y * W[k_]; } if (k_ & 1) __builtin_amdgcn_sched_barrier(0); } } while (0)
        u32x4 RA[8], RB[8]; float WA[8], WBk[8];
        PU_ISSUE(RA, WA, 0);
#pragma unroll 1
        for (int st = 0; st < 16; st += 2) {
            PU_ISSUE(RB, WBk, st + 1);
            if (st == 8 && tb + tstep < T) PU_DMA(tb + tstep, (it + 1) & 1);
            __builtin_amdgcn_sched_barrier(0);
            PU_COMPUTE(RA, WA);
            __builtin_amdgcn_sched_barrier(0);
            if (st + 2 < 16) PU_ISSUE(RA, WA, st + 2);
            __builtin_amdgcn_sched_barrier(0);
            PU_COMPUTE(RB, WBk);
            __builtin_amdgcn_sched_barrier(0);
        }
#undef PU_ISSUE
#undef PU_COMPUTE
        float ss = 0.f;
        const size_t off = (size_t)t * D + 128 * xs + 16 * c;
        f32x4 hv[4]; unpack8(hg0, hv[0], hv[1]); unpack8(hg1, hv[2], hv[3]);
#pragma unroll
        for (int q = 0; q < 4; ++q) { const f32x4 nf = *(const f32x4*)(nffn + 128 * xs + 16 * c + 4 * q); hv[q][0] /= nf[0]; hv[q][1] /= nf[1]; hv[q][2] /= nf[2]; hv[q][3] /= nf[3]; }
#pragma unroll
        for (int q = 0; q < 4; ++q) { oa[q] = oa[q] + hv[q]; ss += (oa[q][0] * oa[q][0] + oa[q][1] * oa[q][1]) + (oa[q][2] * oa[q][2] + oa[q][3] * oa[q][3]); *(f32x4*)(out + off + 4 * q) = oa[q]; }
        ss += __shfl_xor(ss, 1); ss += __shfl_xor(ss, 2); ss += __shfl_xor(ss, 4);
        if (c == 0) SS[(size_t)t * 8 + xs] = ss;
    }
#undef PU_DMA
    }
}
__device__ __forceinline__ void final_norm_phase(Frame& F) {
    const int gw = F.vcu * NWAVES + F.wave, NGW = F.G * NWAVES, lane = F.lane;
    const float* SS = (const float*)(F.ws + WS_SS); const float* fn = F.in[I_FNORM]; float* out = F.out;
    f32x4 g[4];
#pragma unroll
    for (int q = 0; q < 4; ++q) g[q] = *(const f32x4*)(fn + 4 * (lane + 64 * q));
    for (int t = gw; t < T; t += NGW) {
        const f32x4 s0 = *(const f32x4*)(SS + (size_t)t * 8), s1 = *(const f32x4*)(SS + (size_t)t * 8 + 4);
        const float r2 = __builtin_amdgcn_rsqf((((s0[0] + s0[1]) + (s0[2] + s0[3])) + ((s1[0] + s1[1]) + (s1[2] + s1[3]))) * (1.f / D) + RMS_EPS);
        f32x4* op = (f32x4*)(out + (size_t)t * D) + lane;
#pragma unroll
        for (int q = 0; q < 4; ++q) op[64 * q] = op[64 * q] * r2 * g[q];
    }
}

struct Args { const float* in[15]; float* out; unsigned char* ws; int ph_lo, ph_hi, li, pad; };
__global__ void __launch_bounds__(NWAVES * 64, 2) fwd(Args args) {
    extern __shared__ __attribute__((aligned(16))) unsigned char lds[];
    Frame F;
    F.lds = (LAS unsigned char*)lds;
    F.MISC = (volatile LAS unsigned*)(F.lds + MISC_OFF);
    F.tid = threadIdx.x; F.lane = F.tid & 63; F.wave = __builtin_amdgcn_readfirstlane(F.tid >> 6);
    F.G = gridDim.x; { const int bx = blockIdx.x; F.vcu = (F.G % 8 == 0) ? (bx % 8) * (F.G / 8) + bx / 8 : bx; }
    F.ws = args.ws; F.ctl = (gu32*)(args.ws + WS_CTL);
#pragma unroll
    for (int i = 0; i < 15; ++i) F.in[i] = args.in[i];
    F.out = args.out;
    for (int u = F.tid; u < (LDS_BYTES - RING_BYTES) / 4; u += NWAVES * 64) ((LAS unsigned*)(F.lds + RING_BYTES))[u] = 0u;
    __syncthreads();
    XcdBarrier bar; bar.bar = (unsigned*)(F.ctl + CW_BAR); bar.x = 0; bar.st = nullptr;
    if (N_LAUNCHES == 1) bar = xcd_barrier_post((unsigned*)(F.ctl + CW_BAR), F.MISC + 8);
    F.xcc = (int)xb_xcc_id();
    if (F.tid == 0) F.MISC[16] = xb_add((unsigned*)(F.ctl + CW_RANK + 64 * (F.xcc & 15)), 1u);
    __syncthreads();
    F.xrank = (int)F.MISC[16];
#define GRID_BAR() do { if (N_LAUNCHES == 1) xcd_barrier(bar); } while (0)
    const int lo = args.ph_lo, hi = args.ph_hi, bx = (int)blockIdx.x;
#define IN(k) (lo <= (k) && (k) < hi)
#define BOTH(k) (IN(k) && IN((k) + 1))
    unsigned char* ws = args.ws;

    if (IN(0)) { p0_prologue(F); if (BOTH(0)) GRID_BAR(); }

    if (IN(1)) {
        Gemm g{(const bf16*)(ws + WS_U8), (const bf16*)(ws + WS_WQKV8), T, NP1, D / 2}; QkvOrder S; S.init(T, NP1, F.G, bx); S.U = (const char*)(ws + WS_U8);
        EpiQKV E{(bf16*)(ws + WS_Q), (const float*)(ws + WS_ROPE), (const float*)(ws + WS_SU), (const float*)(ws + WS_SW), ws + WS_SGA, F.in[I_GBIAS] + D};
        gemm_phase<EpiQKV, QkvOrder, true, true, true, true>(F.lds, g, S, E);
        if (BOTH(1)) GRID_BAR();
    }
    if (IN(2)) { attn_phase(F, (bf16*)(ws + WS_Q), (float*)(ws + WS_LSE)); if (BOTH(2)) GRID_BAR(); }
    if (IN(3)) {
        { const int nwg = (T / 256) * ((NCG - 512) / 256), rem = nwg % F.G;
          if (rem == 0) combine_phase(F, F.vcu, F.G); else if (bx >= rem) combine_phase(F, bx - rem, F.G - rem); }
        Gemm g{(const bf16*)(ws + WS_U8), (const bf16*)(ws + WS_WQKV8 + (size_t)NP1 * D), T, NCG - 512, D / 2}; StaticOrder S; S.init(T, NCG - 512, F.G, bx);
        EpiCG E{(bf16*)((unsigned char*)F.out + OS_BB), (bf16*)(ws + WS_Z), ws + WS_SGC, ws + WS_SGA, F.in[I_GBIAS], (const float*)(ws + WS_SU), (const float*)(ws + WS_SW)};
        gemm_phase<EpiCG, StaticOrder, true, true, false, true>(F.lds, g, S, E);
        if (BOTH(3)) GRID_BAR();
    }
    if (IN(4)) { p4_wfold(F); p4_conv(F); if (BOTH(4)) GRID_BAR(); }
    if (IN(5)) {
        Gemm gc{(const bf16*)((unsigned char*)F.out + OS_BB), (const bf16*)(ws + WS_WCONV), T, D, D}, ga{(const bf16*)(ws + WS_O), (const bf16*)(ws + WS_WATTN), T, D, DAO};
        StaticOrder S; S.init(T, D, F.G, bx);
        if ((bx & 8) == 0) {
            { EpiY<0> E{(bf16*)(ws + WS_Y), ws + WS_SGC}; gemm_phase<EpiY<0>, StaticOrder, true, true>(F.lds, gc, S, E); }
            { EpiY<1> E{(bf16*)(ws + WS_Y), ws + WS_SGA}; gemm_phase<EpiY<1>, StaticOrder, true, true>(F.lds, ga, S, E); }
        } else {
            { EpiY<0> E{(bf16*)(ws + WS_Y), ws + WS_SGA}; gemm_phase<EpiY<0>, StaticOrder, true, true>(F.lds, ga, S, E); }
            { EpiY<1> E{(bf16*)(ws + WS_Y), ws + WS_SGC}; gemm_phase<EpiY<1>, StaticOrder, true, true>(F.lds, gc, S, E); }
        }
        if (BOTH(5)) GRID_BAR();
    }
    if (IN(6)) {
        Gemm g{(const bf16*)(ws + WS_Y), (const bf16*)(ws + WS_WOUT), T, D, D}; StaticOrder S; S.init(T, D, F.G, bx);
        EpiOut E{F.in[I_X], (bf16*)(ws + WS_HG), F.in[I_NFFN], (float*)(ws + WS_RSQ), ws + WS_HG8, (float*)(ws + WS_HSC)};
        gemm_phase<EpiOut, StaticOrder, true, true>(F.lds, g, S, E);

        if (BOTH(6)) GRID_BAR();
    }
    if (IN(7)) {
        Gemm g{(const bf16*)(ws + WS_HG), (const bf16*)((unsigned char*)F.out + OS_WFOLD), T, 2048, D}; StaticOrder S; S.init(T, 2048, F.G, bx);
        float* scr = (float*)(ws + (bx < 128 ? WS_SCR0 + (size_t)bx * 262144 : (bx < 192 ? WS_SCR1 + (size_t)(bx - 128) * 262144 : WS_SCR2 + (size_t)(bx - 192) * 262144)));
        EpiTopk E{scr, (const float*)(ws + WS_RSQ), (int*)(ws + WS_IDX), (float*)(ws + WS_GATE),
                  CvCtx{F.in[I_DOWN], F.in[I_UP], (unsigned char*)F.out + OS_EDOWN, ws + WS_EUP, (float*)(ws + WS_ESCALE), F.lane}, F.vcu * NWAVES + F.wave, F.G * NWAVES};
        if ((bx & 8) != 0) { for (; E.cvr < 2 * NEXP; E.cvr += E.cvstep) { f32x4 v[4]; cv_load(E.CV, E.cvr, v); cv_finish(E.CV, E.cvr, v); } }
        const int cvkeep = E.cvr; E.cvr = 2 * NEXP;
        gemm_phase<EpiTopk, StaticOrder, true, true>(F.lds, g, S, E);
        E.cvr = cvkeep;
        for (; E.cvr < 2 * NEXP; E.cvr += E.cvstep) { f32x4 v[4]; cv_load(E.CV, E.cvr, v); cv_finish(E.CV, E.cvr, v); }
        if (BOTH(7)) GRID_BAR();
    }
    if (IN(8)) { peer_down_phase(F); if (BOTH(8)) GRID_BAR(); }
    if (IN(9)) { peer_up_phase(F); if (BOTH(9)) GRID_BAR(); }
    if (IN(10)) { final_norm_phase(F); }
#undef IN
#undef BOTH
}

extern "C" void kernel_launch(void* const* d_in, const int* in_sizes, int n_in, void* d_out, int out_size, void* d_ws, size_t ws_size, hipStream_t stream) {
    static int grid = 0;
    if (grid == 0) {
        if (n_in != 15 || out_size != T * D || ws_size < WS_END) { fprintf(stderr, "kernel_launch: unexpected shapes (n_in %d, out %d, ws %zu)\n", n_in, out_size, ws_size); grid = -1; return; }
        int dev = 0, cus = 0, per_cu = 0;
        if (hipGetDevice(&dev) != hipSuccess || hipDeviceGetAttribute(&cus, hipDeviceAttributeMultiprocessorCount, dev) != hipSuccess) { grid = -1; return; }
        if (hipFuncSetAttribute((const void*)fwd, hipFuncAttributeMaxDynamicSharedMemorySize, LDS_BYTES) != hipSuccess) { fprintf(stderr, "kernel_launch: hipFuncSetAttribute failed\n"); grid = -1; return; }
        if (hipOccupancyMaxActiveBlocksPerMultiprocessor(&per_cu, (const void*)fwd, NWAVES * 64, LDS_BYTES) != hipSuccess || per_cu < 1) fprintf(stderr, "kernel_launch: occupancy query reports %d\n", per_cu);
        (void)hipGetLastError();
        grid = cus > 256 ? 256 : cus;
    }
    if (grid < 0) return;
    if (hipMemsetAsync((char*)d_ws + WS_CTL, 0, CTL_ZERO_BYTES, stream) != hipSuccess) return;
    Args a{};
    for (int i = 0; i < 15; ++i) a.in[i] = (const float*)d_in[i];
    a.out = (float*)d_out; a.ws = (unsigned char*)d_ws;
    for (int li = 0; li < N_LAUNCHES; ++li) {
        a.ph_lo = (N_LAUNCHES == 1) ? 0 : li; a.ph_hi = (N_LAUNCHES == 1) ? N_PHASES : li + 1; a.li = li; a.pad = 0;
        hipLaunchKernelGGL(fwd, dim3(grid), dim3(NWAVES * 64), LDS_BYTES, stream, a);
    }
}
```

```cpp
#include <hip/hip_runtime.h>
#include <cstdio>
#include <cstdint>
namespace pg8 {
#define PG8_LAS __attribute__((address_space(3)))
typedef unsigned short bf16_t;
typedef short bf16x8 __attribute__((ext_vector_type(8)));
typedef float f32x4 __attribute__((ext_vector_type(4)));
typedef unsigned u32x4 __attribute__((ext_vector_type(4)));
typedef int v4i32_t __attribute__((ext_vector_type(4)));
typedef int v8i32_t __attribute__((ext_vector_type(8)));
constexpr int BM = 256, BK = 64, HALF = 128, HTB = HALF * BK * 2  , STAGE_BYTES = 8 * HTB, NXCD = 8, WGM = 8;

__host__ __device__ __forceinline__ int lds_byte(int r, int c) { const int st = (r >> 4) * 2 + (c >> 5), rr = r & 15, cc = c & 31, ob = rr * 64 + cc * 2; return st * 1024 + (ob ^ (((ob >> 9) & 1) << 5)); }
__host__ __device__ __forceinline__ void stage_rc(int b, int& R, int& C) { const int st = b / 1024, sb = b % 1024, swz = sb ^ (((sb >> 9) & 1) << 5); R = (st >> 1) * 16 + swz / 64; C = (st & 1) * 32 + (swz % 64) / 2; }
__host__ __device__ __forceinline__ int perm32(int rho) { const int n = rho >> 4, i = rho & 15; return 8 * (i >> 2) + 4 * n + (i & 3); }

struct Unit { int pm, pn; };
struct Gemm { const bf16_t* A; const bf16_t* Bt; int M, N, K; };

struct StaticOrder {
    int nM, nN, nwg, G, c;
    __host__ __device__ void init(int M, int N, int G_, int c_) { nM = M / BM; nN = N / BM; nwg = nM * nN; G = G_; c = c_; }
    __host__ __device__ bool next(int i, Unit& u) const {
        const long L = (long)i * G + c; if (L >= nwg) return false;
        int wgid = (int)L; { const int q = nwg / NXCD, r = nwg % NXCD, xcd = wgid % NXCD, off = wgid / NXCD; wgid = (xcd < r ? xcd * (q + 1) : r * (q + 1) + (xcd - r) * q) + off; }
        const int nig = WGM * nN, gid = wgid / nig, fm = gid * WGM, gsz = (nM - fm) < WGM ? (nM - fm) : WGM;
        u.pm = fm + ((wgid % nig) % gsz); u.pn = (wgid % nig) / gsz; return true;
    }
    __device__ __forceinline__ void a_ready(const Unit&) const {}
    __device__ __forceinline__ void done(const Unit&) const {}
};

__device__ __forceinline__ unsigned cvt_pk_bf16(float lo, float hi) { unsigned r; asm volatile("v_cvt_pk_bf16_f32 %0, %1, %2" : "=v"(r) : "v"(lo), "v"(hi)); return r; }
typedef float f32x2 __attribute__((ext_vector_type(2)));

template <class Epi, class Sched, bool ALIGN_EPI = false, bool SP2 = false, bool STRIDED_A = false, bool I8 = false>
__device__ __forceinline__ void gemm_phase(PG8_LAS unsigned char* lds, const Gemm g, const Sched& S, const Epi& E) {
    const int tid = threadIdx.x, wid = __builtin_amdgcn_readfirstlane(tid >> 6), lane = tid & 63, wr = wid >> 2, wc = wid & 3, fr = lane & 15, fq = lane >> 4;
    const int K = g.K; int nt = K / BK;
    if constexpr (I8) asm volatile("" : "+s"(nt));
    unsigned voffA[2], voffB[2];
#pragma unroll
    for (int i = 0; i < 2; ++i) { int R, C; stage_rc(tid * 16 + i * 8192, R, C); const int Rb = Epi::PERM ? ((R & ~31) + perm32(R & 31)) : R;
        voffA[i] = (unsigned)(R * K + C) * 2u; voffB[i] = (unsigned)(Rb * K + C) * 2u; }
    unsigned rkA = 0, c2A = 0; const unsigned rk64 = 64u * (unsigned)K * 2u;
    if constexpr (STRIDED_A) { int R, C; stage_rc(tid * 16, R, C); rkA = (unsigned)(R * K) * 2u; c2A = (unsigned)C * 2u; }
    const size_t kstep = (size_t)(BK * 2);
    const size_t hstep = (size_t)HALF * K * 2;
    const size_t tstep = 2 * hstep;
    const unsigned ldsw = (unsigned)wid * 1024u;
    const int aoff = lds_byte(wr * 64 + fr, fq * 8), boff = lds_byte(wc * 32 + fr, fq * 8);
#define PG8_SA(b, h) (((b) * 2 + (h)) * HTB)
#define PG8_SB(b, h) ((4 + (b) * 2 + (h)) * HTB)
#define PG8_STAGE(bufoff, gbase, voff) do { _Pragma("unroll") for (int _i = 0; _i < 2; ++_i) \
        __builtin_amdgcn_global_load_lds((const unsigned*)((const char*)(gbase) + (voff)[_i]), (PG8_LAS unsigned*)(lds + (bufoff) + ldsw + _i * 8192), 16, 0, 0); } while (0)
#define PG8_STAGE_A(bufoff, gbase, sh) do { if constexpr (STRIDED_A) { _Pragma("unroll") for (int _i = 0; _i < 2; ++_i) { const unsigned _vo = ((rkA + _i * rk64) << (sh)) + c2A; \
        __builtin_amdgcn_global_load_lds((const unsigned*)((const char*)(gbase) + _vo), (PG8_LAS unsigned*)(lds + (bufoff) + ldsw + _i * 8192), 16, 0, 0); } } else { PG8_STAGE(bufoff, gbase, voffA); } } while (0)
#define PG8_LDA(dst, b, h) do { _Pragma("unroll") for (int m = 0; m < 4; ++m) _Pragma("unroll") for (int k = 0; k < 2; ++k) dst[m][k] = *(const PG8_LAS bf16x8*)(lds + PG8_SA(b, h) + aoff + m * 2048 + k * 1024); } while (0)
#define PG8_LDB(dst, b, h) do { _Pragma("unroll") for (int n = 0; n < 2; ++n) _Pragma("unroll") for (int k = 0; k < 2; ++k) dst[n][k] = *(const PG8_LAS bf16x8*)(lds + PG8_SB(b, h) + boff + n * 2048 + k * 1024); } while (0)
#define PG8_MMA(ai, bj, At, Bt) do { __builtin_amdgcn_s_setprio(1); _Pragma("unroll") for (int m = 0; m < 4; ++m) _Pragma("unroll") for (int n = 0; n < 2; ++n) _Pragma("unroll") for (int k = 0; k < 2; ++k) \
        { if constexpr (I8) acc[ai][bj][m][n] = __builtin_bit_cast(f32x4, __builtin_amdgcn_mfma_i32_16x16x64_i8(__builtin_bit_cast(v4i32_t, Bt[n][k]), __builtin_bit_cast(v4i32_t, At[m][k]), __builtin_bit_cast(v4i32_t, acc[ai][bj][m][n]), 0, 0, 0)); \
          else acc[ai][bj][m][n] = __builtin_amdgcn_mfma_f32_16x16x32_bf16(Bt[n][k], At[m][k], acc[ai][bj][m][n], 0, 0, 0); } __builtin_amdgcn_s_setprio(0); } while (0)
#define PG8_WAIT_V(n) asm volatile("s_waitcnt vmcnt(" #n ")" ::: "memory")
#define PG8_WAIT_L(n) asm volatile("s_waitcnt lgkmcnt(" #n ")" ::: "memory")
#define PG8_BAR __builtin_amdgcn_s_barrier()
#define PG8_SCHED __builtin_amdgcn_sched_barrier(0)
    Unit cur, nxt; int ui = 0;
    if (!S.next(0, cur)) return;
    f32x4 acc[2][2][4][2];
#pragma unroll
    for (int a = 0; a < 2; ++a)
#pragma unroll
        for (int b = 0; b < 2; ++b)
#pragma unroll
            for (int m = 0; m < 4; ++m)
#pragma unroll
                for (int n = 0; n < 2; ++n) acc[a][b][m][n] = (f32x4){0.f, 0.f, 0.f, 0.f};
    bf16x8 At[4][2], B0[2][2], B1[2][2];
    int csh = 0, nsh = 0;
    const char* cA; if constexpr (STRIDED_A) cA = S.a_base(cur, csh); else cA = (const char*)g.A + (size_t)cur.pm * tstep;
    const char* cB = (const char*)g.Bt + (size_t)cur.pn * tstep;
    S.a_ready(cur);
    if constexpr (SP2) {
        PG8_STAGE(PG8_SB(0, 0), cB, voffB); PG8_STAGE(PG8_SB(0, 1), cB + hstep, voffB); PG8_STAGE_A(PG8_SA(0, 0), cA, csh); PG8_STAGE_A(PG8_SA(0, 1), cA + (hstep << csh), csh);
        if (wr == 1) PG8_BAR;
        PG8_WAIT_V(2); PG8_BAR;
        PG8_STAGE(PG8_SB(1, 0), cB + kstep, voffB); PG8_STAGE_A(PG8_SA(1, 0), cA + kstep, csh); PG8_STAGE(PG8_SB(1, 1), cB + hstep + kstep, voffB);
        PG8_WAIT_V(6); PG8_BAR;
    } else {
        PG8_STAGE(PG8_SB(0, 0), cB, voffB); PG8_STAGE_A(PG8_SA(0, 0), cA, csh); PG8_STAGE(PG8_SB(0, 1), cB + hstep, voffB); PG8_STAGE_A(PG8_SA(0, 1), cA + (hstep << csh), csh);
        if (wr == 1) PG8_BAR;
        PG8_WAIT_V(4); PG8_BAR;
        PG8_STAGE(PG8_SB(1, 0), cB + kstep, voffB); PG8_STAGE_A(PG8_SA(1, 0), cA + kstep, csh); PG8_STAGE(PG8_SB(1, 1), cB + hstep + kstep, voffB);
        PG8_WAIT_V(6); PG8_BAR;
    }
    asm volatile(".p2align 8" ::: "memory");
    for (;;) {
        const bool has_next = S.next(ui + 1, nxt);
        const char* nA; if constexpr (STRIDED_A) { nsh = csh; nA = has_next ? S.a_base(nxt, nsh) : cA; } else nA = has_next ? (const char*)g.A + (size_t)nxt.pm * tstep : cA;
        const char* nB = has_next ? (const char*)g.Bt + (size_t)nxt.pn * tstep : cB;
        for (int t = 0; t < nt; t += 2) {
            const bool last = (t == nt - 2);
            const char* a1 = cA + (size_t)(t + 1) * kstep;
            const char* a2 = last ? nA : cA + (size_t)(t + 2) * kstep; const char* b2 = last ? nB : cB + (size_t)(t + 2) * kstep;
            const char* a3 = a2 + kstep; const char* b3 = b2 + kstep;
            const int sh2 = last ? nsh : csh; const size_t hA1 = hstep << csh, hA2 = hstep << sh2;
            if (last && has_next) S.a_ready(nxt);
            if constexpr (SP2) {
            PG8_LDB(B0, 0, 0); PG8_LDB(B1, 0, 1); PG8_SCHED; PG8_LDA(At, 0, 0); PG8_STAGE_A(PG8_SA(1, 1), a1 + hA1, csh);
            PG8_WAIT_V(8); PG8_WAIT_L(0); PG8_BAR; PG8_MMA(0, 0, At, B0); PG8_MMA(0, 1, At, B1); PG8_BAR; PG8_SCHED;
            PG8_LDA(At, 0, 1); PG8_STAGE(PG8_SB(0, 0), b2, voffB); PG8_STAGE(PG8_SB(0, 1), b2 + hstep, voffB); PG8_STAGE_A(PG8_SA(0, 0), a2, sh2);
            PG8_WAIT_V(8); PG8_WAIT_L(0); PG8_BAR; PG8_MMA(1, 0, At, B0); PG8_MMA(1, 1, At, B1); PG8_BAR; PG8_SCHED;
            PG8_LDB(B0, 1, 0); PG8_LDB(B1, 1, 1); PG8_SCHED; PG8_LDA(At, 1, 0); PG8_STAGE_A(PG8_SA(0, 1), a2 + hA2, sh2);
            PG8_WAIT_V(8); PG8_WAIT_L(0); PG8_BAR; PG8_MMA(0, 0, At, B0); PG8_MMA(0, 1, At, B1); PG8_BAR; PG8_SCHED;
            PG8_LDA(At, 1, 1); PG8_STAGE(PG8_SB(1, 0), b3, voffB); PG8_STAGE(PG8_SB(1, 1), b3 + hstep, voffB); PG8_STAGE_A(PG8_SA(1, 0), a3, sh2);
            PG8_WAIT_V(8); PG8_WAIT_L(0); PG8_BAR; PG8_MMA(1, 0, At, B0); PG8_MMA(1, 1, At, B1); PG8_BAR; PG8_SCHED;
            } else {
            PG8_LDB(B0, 0, 0); PG8_SCHED; PG8_LDA(At, 0, 0); PG8_STAGE_A(PG8_SA(1, 1), a1 + hA1, csh);
            PG8_WAIT_L(8); PG8_BAR; PG8_WAIT_L(0); PG8_MMA(0, 0, At, B0); PG8_BAR; PG8_SCHED;
            PG8_LDB(B1, 0, 1); PG8_STAGE(PG8_SB(0, 0), b2, voffB);
            PG8_BAR; PG8_WAIT_L(0); PG8_MMA(0, 1, At, B1); PG8_BAR;
            PG8_LDA(At, 0, 1); PG8_STAGE_A(PG8_SA(0, 0), a2, sh2);
            PG8_BAR; PG8_WAIT_L(0); PG8_MMA(1, 0, At, B0); PG8_BAR; PG8_SCHED;
            PG8_STAGE(PG8_SB(0, 1), b2 + hstep, voffB);
            PG8_WAIT_V(6); PG8_BAR; PG8_MMA(1, 1, At, B1); PG8_BAR;
            PG8_LDB(B0, 1, 0); PG8_SCHED; PG8_LDA(At, 1, 0); PG8_STAGE_A(PG8_SA(0, 1), a2 + hA2, sh2);
            PG8_WAIT_L(8); PG8_BAR; PG8_WAIT_L(0); PG8_MMA(0, 0, At, B0); PG8_BAR; PG8_SCHED;
            PG8_LDB(B1, 1, 1); PG8_STAGE(PG8_SB(1, 0), b3, voffB);
            PG8_BAR; PG8_WAIT_L(0); PG8_MMA(0, 1, At, B1); PG8_BAR;
            PG8_LDA(At, 1, 1); PG8_STAGE_A(PG8_SA(1, 0), a3, sh2);
            PG8_BAR; PG8_WAIT_L(0); PG8_MMA(1, 0, At, B0); PG8_BAR; PG8_SCHED;
            PG8_STAGE(PG8_SB(1, 1), b3 + hstep, voffB);
            PG8_WAIT_V(6); PG8_BAR; PG8_MMA(1, 1, At, B1); PG8_BAR;
            }
        }
        if constexpr (ALIGN_EPI) { if (wr == 0) PG8_BAR; }
        if constexpr (I8) {
#pragma unroll
            for (int a = 0; a < 2; ++a)
#pragma unroll
                for (int b = 0; b < 2; ++b)
#pragma unroll
                    for (int m = 0; m < 4; ++m)
#pragma unroll
                        for (int n = 0; n < 2; ++n) { const v4i32_t iv = __builtin_bit_cast(v4i32_t, acc[a][b][m][n]); acc[a][b][m][n] = (f32x4){(float)iv[0], (float)iv[1], (float)iv[2], (float)iv[3]}; }
        }
        if constexpr (!Epi::AFTER_DRAIN) { E(acc, cur, wr, wc, fr, fq); S.done(cur); }
        if (!has_next) break;
#pragma unroll
        for (int a = 0; a < 2; ++a)
#pragma unroll
            for (int b = 0; b < 2; ++b)
#pragma unroll
                for (int m = 0; m < 4; ++m)
#pragma unroll
                    for (int n = 0; n < 2; ++n) acc[a][b][m][n] = (f32x4){0.f, 0.f, 0.f, 0.f};
        cur = nxt; cA = nA; cB = nB; csh = nsh; ++ui;
        if constexpr (ALIGN_EPI) { if (wr == 1) PG8_BAR; }
    }
    PG8_WAIT_V(0);
    if constexpr (!ALIGN_EPI) { if (wr == 0) PG8_BAR; }
    PG8_BAR;
    if constexpr (Epi::AFTER_DRAIN) { E.fused(acc, cur, wr, wc, fr, fq, lds, wid, lane); S.done(cur); }
#undef PG8_SA
#undef PG8_SB
#undef PG8_STAGE
#undef PG8_STAGE_A
#undef PG8_LDA
#undef PG8_LDB
#undef PG8_MMA
#undef PG8_WAIT_V
#undef PG8_WAIT_L
#undef PG8_BAR
#undef PG8_SCHED
}
}

#define GAS __attribute__((address_space(1)))
#define LAS __attribute__((address_space(3)))
typedef unsigned short bf16;
typedef unsigned v4u __attribute__((ext_vector_type(4)));
typedef float f32x4 __attribute__((ext_vector_type(4)));
typedef short bf16x8 __attribute__((ext_vector_type(8)));
typedef GAS unsigned gu32;
typedef GAS unsigned long long gu64;
#define RLX_AGENT __ATOMIC_RELAXED, __HIP_MEMORY_SCOPE_AGENT
#define LDS_WAIT() asm volatile("s_waitcnt lgkmcnt(0)" ::: "memory")
#define VM_WAIT() asm volatile("s_waitcnt vmcnt(0)" ::: "memory")
__device__ __forceinline__ unsigned long long rt() { return __builtin_amdgcn_s_memrealtime(); }
__device__ __forceinline__ unsigned f2bf(float f) { unsigned u = __builtin_bit_cast(unsigned, f); return (u + 0x7fffu + ((u >> 16) & 1u)) >> 16; }
__device__ __forceinline__ unsigned pk2(float lo, float hi) { return f2bf(lo) | (f2bf(hi) << 16); }

#define XB_TMO      128
#define XB_XCNT(j)  (256  + 64 * (j))
#define XB_XSUB(j)  (1280 + 64 * (j))
#define XB_XGEN(j)  (2304 + 64 * (j))
#define XB_TOP      3328
#define XB_TOPGEN   3392
#define XCD_BAR_WORDS 3456
#define XB_SPIN_CAP (1u << 18)

__device__ __forceinline__ unsigned xb_ld(unsigned* p)              { return __hip_atomic_load(p, __ATOMIC_RELAXED, __HIP_MEMORY_SCOPE_AGENT); }
__device__ __forceinline__ unsigned xb_add(unsigned* p, unsigned v) { return __hip_atomic_fetch_add(p, v, __ATOMIC_RELAXED, __HIP_MEMORY_SCOPE_AGENT); }
__device__ __forceinline__ unsigned xb_xcc_id() { return (unsigned)__builtin_amdgcn_s_getreg((3 << 11) | 20) & 0xFu; }
#define XB_SPIN(cond, bar) do { unsigned _sp = 0; while (cond) { __builtin_amdgcn_s_sleep(1); \
    if ((++_sp & 255u) == 0u) { if (xb_ld(&(bar)[XB_TMO])) break; if (_sp > XB_SPIN_CAP) { atomicAdd(&(bar)[XB_TMO], 1u); break; } } } } while (0)

struct XcdBarrier {
    unsigned* bar; unsigned x;
    volatile LAS unsigned* st;
};

__device__ __forceinline__ XcdBarrier xcd_barrier_post(unsigned* bar, volatile LAS unsigned* st) {
    XcdBarrier b; b.bar = bar; b.x = xb_xcc_id(); b.st = st;
    if (threadIdx.x == 0) (void)xb_add(&bar[XB_XCNT(b.x)], 1u);
    return b;
}
__device__ __forceinline__ void xcd_barrier_complete(unsigned* bar, unsigned x, unsigned& nloc, unsigned& nx) {
    const unsigned G = gridDim.x * gridDim.y * gridDim.z;
    unsigned sum, cnt, mine, sp = 0u;
    for (;;) {
        sum = 0u; cnt = 0u; mine = 0u;
#pragma unroll
        for (unsigned j = 0; j < 16; ++j) { const unsigned c = xb_ld(&bar[XB_XCNT(j)]); sum += c; cnt += (c > 0u) ? 1u : 0u; mine = (j == x) ? c : mine; }
        if (sum == G) break;
        __builtin_amdgcn_s_sleep(1);
        if ((++sp & 255u) == 0u) { if (xb_ld(&bar[XB_TMO])) break; if (sp > XB_SPIN_CAP) { atomicAdd(&bar[XB_TMO], 1u); break; } }
    }
    nloc = mine > 0u ? mine : 1u; nx = cnt > 0u ? cnt : 1u;
}

__device__ __forceinline__ void xcd_barrier(const XcdBarrier& b) {
    asm volatile("s_waitcnt vmcnt(0)" ::: "memory");
    __syncthreads();
    if (threadIdx.x == 0) {
        unsigned* bar = b.bar;
        __builtin_amdgcn_s_waitcnt(0);
        unsigned nloc = b.st[0], nx = b.st[1];
        if (nloc == 0u) { xcd_barrier_complete(bar, b.x, nloc, nx); b.st[0] = nloc; b.st[1] = nx; }
        const unsigned old = xb_add(&bar[XB_XSUB(b.x)], 1u);
        const unsigned gen = old / nloc;
        if (old + 1u == (gen + 1u) * nloc) {
            __builtin_amdgcn_fence(__ATOMIC_RELEASE, "agent");
            asm volatile("s_waitcnt vmcnt(0)" ::: "memory");
            const unsigned og = xb_add(&bar[XB_TOP], 1u);
            const unsigned tg = og / nx;
            if (og + 1u == (tg + 1u) * nx) xb_add(&bar[XB_TOPGEN], 1u);
            else XB_SPIN(xb_ld(&bar[XB_TOPGEN]) == tg, bar);
            __builtin_amdgcn_fence(__ATOMIC_ACQUIRE, "agent");
            xb_add(&bar[XB_XGEN(b.x)], 1u);
            asm volatile("s_waitcnt vmcnt(0)" ::: "memory");
        } else {
            XB_SPIN(xb_ld(&bar[XB_XGEN(b.x)]) == gen, bar);
            __builtin_amdgcn_fence(__ATOMIC_ACQUIRE, "agent");
            asm volatile("s_waitcnt vmcnt(0)" ::: "memory");
        }
    }
    __syncthreads();
}


constexpr int NWAVES = 8;
#ifndef MK_N_LAUNCHES
#define MK_N_LAUNCHES 1
#endif
constexpr int N_PHASES = 11;
constexpr int N_LAUNCHES = MK_N_LAUNCHES;
constexpr int BATCH = 2, SEQ = 8192, T = BATCH * SEQ, D = 1024;
constexpr int DIN = 9728, NQKV = 4608, NCG = 5120, GW = 512, DAO = 512;
constexpr int NP1 = NQKV + 512;
constexpr int NEXP = 16384, PEER_H = 8, PEER_K = 16, HK = 128;
constexpr float RMS_EPS = 1e-6f;
constexpr float C2 = 0.125f * 1.4426950408889634f;
constexpr float LN2 = 0.6931471805599453f;

constexpr size_t MiB = 1u << 20;
constexpr size_t WS_CTL = 0, CTL_ZERO_BYTES = 64 * 1024;
constexpr size_t WS_ROPE = 1 * MiB, WS_RSQ = 2 * MiB, WS_LSE = 3 * MiB;
constexpr size_t WS_U8 = 24 * MiB, WS_WQKV8 = 5 * MiB, WS_SU = 15 * MiB, WS_SW = 15 * MiB + 65536;
constexpr size_t WS_Q = 56 * MiB, WS_K = 104 * MiB, WS_V = 152 * MiB, WS_O = 200 * MiB;
constexpr size_t WS_Z = 136 * MiB, WS_SGC = 168 * MiB, WS_SGA = 216 * MiB;
constexpr size_t OS_BB = 0, OS_EDOWN = 32 * MiB, OS_WFOLD = 48 * MiB;
constexpr size_t WS_WCONV = 248 * MiB, WS_WATTN = 250 * MiB, WS_WOUT = 251 * MiB;
constexpr size_t WS_EUP = 104 * MiB, WS_ESCALE = 253 * MiB;
constexpr size_t WS_Y = 136 * MiB, WS_H = 168 * MiB, WS_HG = 24 * MiB;
constexpr size_t WS_IDX = 9 * MiB, WS_GATE = 120 * MiB, WS_WB = 56 * MiB, WS_SS = 64 * MiB, WS_HG8 = 65 * MiB, WS_HSC = 81 * MiB;
constexpr size_t WS_SCR0 = 136 * MiB, WS_SCR1 = 88 * MiB, WS_SCR2 = 232 * MiB;
constexpr size_t WS_END = 256 * MiB;
constexpr int CW_TMO = 0, CW_BAR = 1024, CW_RANK = 8192;

constexpr int RING_BYTES = 131072, MISC_OFF = RING_BYTES + 320, LDS_BYTES = 147456;

using pg8::Unit; using pg8::Gemm; using pg8::StaticOrder; using pg8::gemm_phase; using pg8::cvt_pk_bf16;
typedef unsigned short bf16;
typedef unsigned u32x4 __attribute__((ext_vector_type(4)));
typedef unsigned u32x2 __attribute__((ext_vector_type(2)));
typedef float f32x4 __attribute__((ext_vector_type(4)));
typedef float f32x2 __attribute__((ext_vector_type(2)));
typedef short bf16x8 __attribute__((ext_vector_type(8)));
typedef short s16x4 __attribute__((ext_vector_type(4)));
typedef short v4i16_t __attribute__((ext_vector_type(4)));
#define LAS __attribute__((address_space(3)))

__device__ __forceinline__ float bf_lo(unsigned w) { return __builtin_bit_cast(float, w << 16); }
__device__ __forceinline__ float bf_hi(unsigned w) { return __builtin_bit_cast(float, w & 0xffff0000u); }
__device__ __forceinline__ u32x4 pack8(f32x4 a, f32x4 b) { u32x4 w; w.x = cvt_pk_bf16(a[0], a[1]); w.y = cvt_pk_bf16(a[2], a[3]); w.z = cvt_pk_bf16(b[0], b[1]); w.w = cvt_pk_bf16(b[2], b[3]); return w; }
__device__ __forceinline__ void unpack8(u32x4 w, f32x4& a, f32x4& b) { a = (f32x4){bf_lo(w.x), bf_hi(w.x), bf_lo(w.y), bf_hi(w.y)}; b = (f32x4){bf_lo(w.z), bf_hi(w.z), bf_lo(w.w), bf_hi(w.w)}; }
__device__ __forceinline__ float wave_sum(float v) {
#pragma unroll
    for (int o = 1; o < 64; o <<= 1) v += __shfl_xor(v, o);
    return v;
}
__device__ __forceinline__ unsigned pack4i8(f32x4 v) { const int a = (int)__builtin_rintf(v[0]), b = (int)__builtin_rintf(v[1]), c = (int)__builtin_rintf(v[2]), d = (int)__builtin_rintf(v[3]); return (unsigned)(a & 255) | ((unsigned)(b & 255) << 8) | ((unsigned)(c & 255) << 16) | ((unsigned)d << 24); }
__device__ __forceinline__ f32x4 unpack4u8(unsigned w) { return (f32x4){(float)(w & 255u), (float)((w >> 8) & 255u), (float)((w >> 16) & 255u), (float)(w >> 24)} * (1.f / 255.f); }
__device__ __forceinline__ float xor16(float v, int fq) {
    const unsigned x = __builtin_bit_cast(unsigned, v);
    const auto r = __builtin_amdgcn_permlane16_swap(x, x, false, false);
    const unsigned a = r[0], b = r[1];
    return __builtin_bit_cast(float, (fq & 1) ? a : b);
}
__device__ __forceinline__ float sigmoidf_(float x) { return 1.f / (1.f + __expf(-x)); }

struct QkvOrder : StaticOrder {
    const char* U;
    __device__ __forceinline__ const char* a_base(const Unit& u, int& sh) const {
        const int g = (u.pn < 18) ? u.pn / 6 : 0; sh = 2 * g;
        const int b = u.pm >> 5, lp0 = (u.pm & 31) * 256;
        const int r = lp0 >> (13 - sh), i0 = lp0 & ((SEQ >> sh) - 1);
        const int t0 = b * SEQ + (i0 << sh) + r;
        return U + (size_t)t0 * D;
    }
};
struct EpiQKV {
    static constexpr bool PERM = true, AFTER_DRAIN = false;
    bf16* Q; const float* rope; const float* su; const float* sw; unsigned char* SGA; const float* gbias1;
    __device__ __forceinline__ void operator()(const f32x4 (&acc)[2][2][4][2], const Unit& u, int wr, int wc, int fr, int fq) const {
        if (u.pn >= 18) {
#pragma unroll
            for (int ai = 0; ai < 2; ++ai)
#pragma unroll
                for (int m = 0; m < 4; ++m) { const size_t row = (size_t)u.pm * 256 + ai * 128 + wr * 64 + m * 16 + fr; const float sr = su[row];
#pragma unroll
                    for (int bj = 0; bj < 2; ++bj) { const int col = 512 + (u.pn - 18) * 256 + bj * 128 + wc * 32 + fq * 8;
                        const f32x4 b0 = *(const f32x4*)(gbias1 + col), b1 = *(const f32x4*)(gbias1 + col + 4);
                        const int wcol = u.pn * 256 + bj * 128 + wc * 32 + fq * 8;
                        f32x4 v0 = acc[ai][bj][m][0] * (*(const f32x4*)(sw + wcol) * sr) + b0, v1 = acc[ai][bj][m][1] * (*(const f32x4*)(sw + wcol + 4) * sr) + b1;
#pragma unroll
                        for (int e = 0; e < 4; ++e) { v0[e] = sigmoidf_(v0[e]) * 255.f; v1[e] = sigmoidf_(v1[e]) * 255.f; }
                        u32x2 g8; g8.x = pack4i8(v0); g8.y = pack4i8(v1);
                        *(u32x2*)(SGA + row * D + col) = g8; } }
            return;
        }
        asm volatile("" : "+v"(fr), "+v"(fq));
        const int g = u.pn / 6, kind = (u.pn % 6) >> 1, half = u.pn & 1, sh = 2 * g;
        bf16* base = Q + (size_t)kind * ((WS_K - WS_Q) / 2) + (size_t)g * T * GW;
        const int b = u.pm >> 5, lp0 = (u.pm & 31) * 256;
        const bool rot = (kind < 2) && ((wc & 1) == 0);
        const float sc = (kind == 0) ? C2 : 1.f;
        f32x4 swv[2][2];
#pragma unroll
        for (int bj = 0; bj < 2; ++bj) { const int wcol = u.pn * 256 + bj * 128 + wc * 32 + fq * 8; swv[bj][0] = *(const f32x4*)(sw + wcol) * sc; swv[bj][1] = *(const f32x4*)(sw + wcol + 4) * sc; }
        const float sgn = (fq == 0) ? -1.f : 1.f; const bool use = fq < 2;
#pragma unroll
        for (int ai = 0; ai < 2; ++ai)
#pragma unroll
            for (int m = 0; m < 4; ++m) {
                const int rl = ai * 128 + wr * 64 + m * 16 + fr, lp = lp0 + rl;
                const int tok = b * SEQ + ((lp & ((SEQ >> sh) - 1)) << sh) + (lp >> (13 - sh));
                const float sut = su[tok];
                f32x4 c0 = {1.f, 1.f, 1.f, 1.f}, c1 = c0, s0 = {0.f, 0.f, 0.f, 0.f}, s1 = s0;
                if (rot) { const f32x4* rp = (const f32x4*)(rope + (size_t)tok * 16); c0 = rp[0]; c1 = rp[1]; s0 = rp[2]; s1 = rp[3]; }
                bf16* rowp = base + (size_t)(u.pm * 256 + rl) * GW + half * 256 + wc * 32 + fq * 8;
#pragma unroll
                for (int bj = 0; bj < 2; ++bj) {
                    f32x4 v0 = acc[ai][bj][m][0] * (swv[bj][0] * sut), v1 = acc[ai][bj][m][1] * (swv[bj][1] * sut);
                    if (rot) {
                        f32x4 o0, o1;
#pragma unroll
                        for (int e = 0; e < 4; ++e) { o0[e] = xor16(v0[e], fq); o1[e] = xor16(v1[e], fq); }
                        const f32x4 r0 = v0 * c0 + (o0 * s0) * sgn, r1 = v1 * c1 + (o1 * s1) * sgn;
                        v0 = use ? r0 : v0; v1 = use ? r1 : v1;
                    }
                    *(u32x4*)(rowp + bj * 128) = pack8(v0, v1);
                }
            }
    }
};
struct EpiCG {
    static constexpr bool PERM = true, AFTER_DRAIN = false;
    bf16* Bb; bf16* Z; unsigned char* SGC; unsigned char* SGA; const float* gbias; const float* su; const float* sw;
    __device__ __forceinline__ void operator()(const f32x4 (&accin)[2][2][4][2], const Unit& u, int wr, int wc, int fr, int fq) const {
        const int pn = u.pn;
        f32x4 swv[2][2];
#pragma unroll
        for (int bj = 0; bj < 2; ++bj) { const int wcol = NP1 + pn * 256 + bj * 128 + wc * 32 + fq * 8; swv[bj][0] = *(const f32x4*)(sw + wcol); swv[bj][1] = *(const f32x4*)(sw + wcol + 4); }
        f32x4 acc[2][2][4][2];
#pragma unroll
        for (int ai = 0; ai < 2; ++ai)
#pragma unroll
            for (int m = 0; m < 4; ++m) { const float sr = su[(size_t)u.pm * 256 + ai * 128 + wr * 64 + m * 16 + fr];
#pragma unroll
                for (int bj = 0; bj < 2; ++bj) { acc[ai][bj][m][0] = accin[ai][bj][m][0] * (swv[bj][0] * sr); acc[ai][bj][m][1] = accin[ai][bj][m][1] * (swv[bj][1] * sr); } }
#pragma unroll
        for (int ai = 0; ai < 2; ++ai)
#pragma unroll
            for (int m = 0; m < 4; ++m) {
                const size_t row = (size_t)u.pm * 256 + ai * 128 + wr * 64 + m * 16 + fr;
                if (pn < 4) {
#pragma unroll
                    for (int bj = 0; bj < 2; ++bj) *(u32x4*)(Bb + row * D + pn * 256 + bj * 128 + wc * 32 + fq * 8) = pack8(acc[ai][bj][m][0], acc[ai][bj][m][1]);
                } else if (pn < 12) {
                    const f32x4 z0 = acc[ai][0][m][0] * acc[ai][1][m][0], z1 = acc[ai][0][m][1] * acc[ai][1][m][1];
                    *(u32x4*)(Z + row * D + (pn - 4) * 128 + wc * 32 + fq * 8) = pack8(z0, z1);
                } else {
                    const int gsel = (pn >= 16) ? 1 : 0; unsigned char* out = gsel ? SGA : SGC;
#pragma unroll
                    for (int bj = 0; bj < 2; ++bj) {
                        const int col = (pn - 12 - 4 * gsel) * 256 + bj * 128 + wc * 32 + fq * 8;
                        const f32x4 b0 = *(const f32x4*)(gbias + gsel * D + col), b1 = *(const f32x4*)(gbias + gsel * D + col + 4);
                        f32x4 v0 = acc[ai][bj][m][0] + b0, v1 = acc[ai][bj][m][1] + b1;
#pragma unroll
                        for (int e = 0; e < 4; ++e) { v0[e] = sigmoidf_(v0[e]) * 255.f; v1[e] = sigmoidf_(v1[e]) * 255.f; }
                        u32x2 g8; g8.x = pack4i8(v0); g8.y = pack4i8(v1);
                        *(u32x2*)(out + row * D + col) = g8;
                    }
                }
            }
    }
};
template <int MODE> struct EpiY {
    static constexpr bool PERM = true, AFTER_DRAIN = false;
    bf16* Y; const unsigned char* G;
    __device__ __forceinline__ void operator()(const f32x4 (&acc)[2][2][4][2], const Unit& u, int wr, int wc, int fr, int fq) const {
#pragma unroll
        for (int ai = 0; ai < 2; ++ai)
#pragma unroll
            for (int m = 0; m < 4; ++m) {
                const size_t row = (size_t)u.pm * 256 + ai * 128 + wr * 64 + m * 16 + fr;
#pragma unroll
                for (int bj = 0; bj < 2; ++bj) {
                    const size_t off = row * D + u.pn * 256 + bj * 128 + wc * 32 + fq * 8;
                    const u32x2 g8 = *(const u32x2*)(G + off);
                    const f32x4 g0 = unpack4u8(g8.x), g1 = unpack4u8(g8.y);
                    f32x4 v0 = acc[ai][bj][m][0] * g0, v1 = acc[ai][bj][m][1] * g1;
                    if (MODE == 1) { f32x4 y0, y1; unpack8(*(const u32x4*)(Y + off), y0, y1); v0 = v0 + y0; v1 = v1 + y1; }
                    *(u32x4*)(Y + off) = pack8(v0, v1);
                }
            }
    }
};
struct EpiOut {
    static constexpr bool PERM = true, AFTER_DRAIN = false;
    const float* X; bf16* HG; const float* nffn; float* RSQ; unsigned char* HG8; float* HSC;
    __device__ __forceinline__ void operator()(const f32x4 (&acc)[2][2][4][2], const Unit& u, int wr, int wc, int fr, int fq) const {
#pragma unroll
        for (int ai = 0; ai < 2; ++ai)
#pragma unroll
            for (int m = 0; m < 4; ++m) {
                const size_t row = (size_t)u.pm * 256 + ai * 128 + wr * 64 + m * 16 + fr;
                float ss = 0.f;
#pragma unroll
                for (int bj = 0; bj < 2; ++bj) {
                    const int col = u.pn * 256 + bj * 128 + wc * 32 + fq * 8; const size_t off = row * D + col;
                    const f32x4 h0 = *(const f32x4*)(X + off) + acc[ai][bj][m][0], h1 = *(const f32x4*)(X + off + 4) + acc[ai][bj][m][1];
                    const f32x4 n0 = *(const f32x4*)(nffn + col), n1 = *(const f32x4*)(nffn + col + 4);
                    const f32x4 y0 = h0 * n0, y1 = h1 * n1;
                    *(u32x4*)(HG + off) = pack8(y0, y1);
                    float am = fmaxf(fmaxf(fmaxf(fabsf(y0[0]), fabsf(y0[1])), fmaxf(fabsf(y0[2]), fabsf(y0[3]))), fmaxf(fmaxf(fabsf(y1[0]), fabsf(y1[1])), fmaxf(fabsf(y1[2]), fabsf(y1[3]))));
                    am = fmaxf(am, __shfl_xor(am, 16)); am = fmaxf(am, __shfl_xor(am, 32));
                    const float qs = (am > 0.f) ? 127.f / am : 0.f;
                    u32x2 q8; q8.x = pack4i8(y0 * qs); q8.y = pack4i8(y1 * qs);
                    *(u32x2*)(HG8 + off) = q8;
                    if (fq == 0) HSC[row * 32 + u.pn * 8 + bj * 4 + wc] = am * (1.f / 127.f);
                    ss += (h0[0] * h0[0] + h0[1] * h0[1]) + (h0[2] * h0[2] + h0[3] * h0[3]) + (h1[0] * h1[0] + h1[1] * h1[1]) + (h1[2] * h1[2] + h1[3] * h1[3]);
                }
                ss += __shfl_xor(ss, 16); ss += __shfl_xor(ss, 32);
                if (fq == 0) RSQ[row * 16 + u.pn * 4 + wc] = ss;
            }
    }
};
struct CvCtx { const float* dn; const float* up; unsigned char* ed; unsigned char* eu; float* esc; int lane; };
__device__ __forceinline__ void cv_load(const CvCtx& C, int ru, f32x4 (&v)[4]) {
    const int tb = ru >> 14, e = ru & (NEXP - 1);
    const float* src = (tb ? C.up : C.dn) + (size_t)e * D + 16 * C.lane;
#pragma unroll
    for (int q = 0; q < 4; ++q) v[q] = *(const f32x4*)(src + 4 * q);
}
__device__ __forceinline__ void cv_finish(const CvCtx& C, int ru, const f32x4 (&v)[4]) {
    const int tb = ru >> 14, e = ru & (NEXP - 1);
    float am = 0.f;
#pragma unroll
    for (int q = 0; q < 4; ++q) am = fmaxf(am, fmaxf(fmaxf(fabsf(v[q][0]), fabsf(v[q][1])), fmaxf(fabsf(v[q][2]), fabsf(v[q][3]))));
#pragma unroll
    for (int o = 1; o < 64; o <<= 1) am = fmaxf(am, __shfl_xor(am, o));
    u32x4 w;
    if (tb) {
        const float sc = (am > 0.f) ? 256.f / am : 1.f;
#pragma unroll
        for (int q = 0; q < 4; ++q) { int d = __builtin_amdgcn_cvt_pk_fp8_f32(v[q][0] * sc, v[q][1] * sc, 0, false); d = __builtin_amdgcn_cvt_pk_fp8_f32(v[q][2] * sc, v[q][3] * sc, d, true); w[q] = (unsigned)d; }
        *(u32x4*)(C.eu + (size_t)(C.lane >> 3) * (2 * MiB) + (size_t)e * 128 + 16 * (C.lane & 7)) = w;
    } else {
        const float s8 = (am > 0.f) ? 127.f / am : 0.f;
#pragma unroll
        for (int q = 0; q < 4; ++q) w[q] = pack4i8(v[q] * s8);
        *(u32x4*)(C.ed + (size_t)e * 1024 + 16 * C.lane) = w;
    }
    if (C.lane == 0) C.esc[ru] = tb ? ((am > 0.f) ? am * (1.f / 256.f) : 1.f) : am * (1.f / 127.f);
}
__device__ __forceinline__ int f2key(float f) { const int b = __builtin_bit_cast(int, f); return b ^ ((b >> 31) & 0x7fffffff); }
__device__ __forceinline__ float key2f(int k) { return __builtin_bit_cast(float, k ^ ((k >> 31) & 0x7fffffff)); }
#define TOPK_INS(list, x) do { _Pragma("unroll") for (int _k = 0; _k < 16; ++_k) { const int _hi = max(list[_k], x); x = min(list[_k], x); list[_k] = _hi; } } while (0)
__device__ __forceinline__ unsigned long long pack8idx(const int (&a)[16], int o) { unsigned long long r = 0ull;
#pragma unroll
    for (int k = 0; k < 8; ++k) r |= (unsigned long long)(unsigned)(a[o + k] & 127) << (8 * k);
    return r; }
__device__ __forceinline__ int lut16(unsigned long long lo, unsigned long long hi, int i) { const unsigned long long w = (i < 8) ? lo : hi; return (int)((w >> ((i & 7) * 8)) & 127ull); }
__device__ __forceinline__ void sort16_asc(int (&x)[16]) {
#pragma unroll
    for (int k = 2; k <= 16; k <<= 1)
#pragma unroll
        for (int j = k >> 1; j > 0; j >>= 1)
#pragma unroll
            for (int i = 0; i < 16; ++i) { const int l = i ^ j; if (l > i) { const int lo = min(x[i], x[l]), hi = max(x[i], x[l]); const bool up = (i & k) == 0; x[i] = up ? lo : hi; x[l] = up ? hi : lo; } }
}
__device__ __forceinline__ void merge16(int (&r)[16], const int (&a)[16]) {
#pragma unroll
    for (int i = 0; i < 16; ++i) r[i] = max(r[i], a[i]);
#pragma unroll
    for (int j = 8; j > 0; j >>= 1)
#pragma unroll
        for (int i = 0; i < 16; ++i) { const int l = i ^ j; if (l > i) { const int lo = min(r[i], r[l]), hi = max(r[i], r[l]); r[i] = hi; r[l] = lo; } }
}
struct EpiTopk {
    static constexpr bool PERM = true, AFTER_DRAIN = false;
    float* scr; const float* RSQ; int* IDX; float* GATE; CvCtx CV; mutable int cvr; int cvstep;
    __device__ __forceinline__ void operator()(const f32x4 (&acc)[2][2][4][2], const Unit& u, int wr, int wc, int fr, int fq) const {
        const __amdgpu_buffer_rsrc_t rsrc = __builtin_amdgcn_make_buffer_rsrc(scr, 0, 262144, 0x00020000);
        const int voff = ((wc * 32 + fq * 8) * 256 + wr * 64 + fr) * 4;
#pragma unroll
        for (int ai = 0; ai < 2; ++ai)
#pragma unroll
            for (int m = 0; m < 4; ++m)
#pragma unroll
                for (int bj = 0; bj < 2; ++bj)
#pragma unroll
                    for (int n = 0; n < 2; ++n)
#pragma unroll
                        for (int e = 0; e < 4; ++e)
                        { const float val = acc[ai][bj][m][n][e]; __builtin_amdgcn_raw_buffer_store_b32(__builtin_bit_cast(unsigned, val), rsrc, voff, ((bj * 128 + n * 4 + e) * 256 + ai * 128 + m * 16) * 4, 0); }
        asm volatile("s_waitcnt vmcnt(0)" ::: "memory");
        __builtin_amdgcn_s_barrier();
        asm volatile("" ::: "memory");
        const int tid = threadIdx.x, row = tid >> 1, c = tid & 1;
        int v[16];
#pragma unroll
        for (int k = 0; k < 16; ++k) v[k] = (int)0x80000000;
        const int roff = (c * 128 * 256 + row) * 4;
        const size_t t = (size_t)u.pm * 256 + row;
        f32x4 rq[4];
#pragma unroll
        for (int j = 0; j < 4; ++j) rq[j] = *(const f32x4*)(RSQ + t * 16 + 4 * j);
        float xs[16], xn[16];
#pragma unroll
        for (int j = 0; j < 16; ++j) xs[j] = __builtin_bit_cast(float, __builtin_amdgcn_raw_buffer_load_b32(rsrc, roff, j * 1024, 2));
#pragma unroll 1
        for (int k0 = 0; k0 < 128; k0 += 16) {
            if (k0 + 16 < 128) {
#pragma unroll
                for (int j = 0; j < 16; ++j) xn[j] = __builtin_bit_cast(float, __builtin_amdgcn_raw_buffer_load_b32(rsrc, roff, (k0 + 16 + j) * 1024, 2));
            }
            __builtin_amdgcn_sched_barrier(0);
            int kb[16];
#pragma unroll
            for (int j = 0; j < 16; ++j) kb[j] = (f2key(xs[j]) & ~127) | (k0 + j);
            sort16_asc(kb);
            if (k0 == 0) {
#pragma unroll
                for (int j = 0; j < 16; ++j) v[j] = kb[15 - j];
            } else merge16(v, kb);
            __builtin_amdgcn_sched_barrier(0);
#pragma unroll
            for (int j = 0; j < 16; ++j) xs[j] = xn[j];
        }
        int A[16], B[16];
#pragma unroll
        for (int k = 0; k < 16; ++k) { const int o = __shfl_xor(v[k], 1); A[k] = c ? o : v[k]; B[k] = c ? v[k] : o; }
        int c2[16];
#pragma unroll
        for (int k = 0; k < 16; ++k) c2[k] = (int)0x80000000;
#define CAND(i, j) ((f2key(key2f(A[i]) + key2f(B[j])) & ~255) | ((i) * 16 + (j)))
#pragma unroll
        for (int j = 0; j < 16; ++j) c2[j] = CAND(0, j);
        { int t[16]; t[0] = (int)0x80000000;
#pragma unroll
          for (int i = 1; i < 16; ++i) t[16 - i] = CAND(i, 0);
          merge16(c2, t); }
        { int t[16];
          t[0] = CAND(1, 1); t[1] = CAND(1, 2); t[2] = CAND(1, 3); t[3] = CAND(1, 4); t[4] = CAND(1, 5); t[5] = CAND(1, 6); t[6] = CAND(1, 7);
          t[7] = CAND(2, 1); t[8] = CAND(2, 2); t[9] = CAND(2, 3); t[10] = CAND(2, 4); t[11] = CAND(3, 1); t[12] = CAND(3, 2); t[13] = CAND(3, 3);
          t[14] = CAND(4, 1); t[15] = CAND(4, 2);
          sort16_asc(t); merge16(c2, t); }
        { int x = CAND(5, 1); TOPK_INS(c2, x); x = CAND(6, 1); TOPK_INS(c2, x); x = CAND(7, 1); TOPK_INS(c2, x); }
#undef CAND
        float ssq = 0.f;
#pragma unroll
        for (int j = 0; j < 4; ++j) ssq += (rq[j][0] + rq[j][1]) + (rq[j][2] + rq[j][3]);
        const float rstd = __builtin_amdgcn_rsqf(ssq * (1.f / D) + RMS_EPS);
        const unsigned long long alo = pack8idx(A, 0), ahi = pack8idx(A, 8), blo = pack8idx(B, 0), bhi = pack8idx(B, 8);
        float sc[16]; int id[16]; float smax = 0.f, ssum = 0.f;
#pragma unroll
        for (int k = 0; k < 16; ++k) {
            const int cid = c2[k] & 255, i = cid >> 4, j = cid & 15;
            id[k] = lut16(alo, ahi, i) * 128 + lut16(blo, bhi, j);
            sc[k] = key2f(c2[k]) * rstd;
            if (k == 0) smax = sc[0];
            sc[k] = __expf(sc[k] - smax); ssum += sc[k];
        }
        const float inv = 1.f / ssum;
        int* ip = IDX + t * HK + u.pn * 16; float* gp = GATE + t * HK + u.pn * 16;
#pragma unroll
        for (int k = 0; k < 16; ++k) if ((k >> 3) == c) { ip[k] = id[k]; gp[k] = sc[k] * inv; }
    }
};

struct Frame {
    LAS unsigned char* lds;
    volatile LAS unsigned* MISC;
    gu32* ctl;
    int tid, lane, wave, vcu, G;
    int xcc, xrank;
    unsigned char* ws;
    const float* in[15]; float* out;
};
enum { I_X = 0, I_POS, I_NMIX, I_WIN, I_CONVW, I_WCONV, I_WATTN, I_GBIAS, I_WOUT, I_NFFN, I_WQ, I_SUBK, I_DOWN, I_UP, I_FNORM };

__device__ __forceinline__ void transpose_item(const float* W, int ldw, int k0, int n0, bf16* dst, int ldd, LAS float* scr, int lane) {
#pragma unroll 8
    for (int i = 0; i < 32; ++i) { const int kk = 2 * i + (lane >> 5); scr[kk * 33 + (lane & 31)] = W[(size_t)(k0 + kk) * ldw + n0 + (lane & 31)]; }
    LDS_WAIT(); asm volatile("" ::: "memory");
    const int c = lane & 7;
#pragma unroll
    for (int j = 0; j < 4; ++j) { const int n = (lane >> 3) + 8 * j; const LAS float* s = scr + (8 * c) * 33 + n;
        v4u o; o.x = pk2(s[0 * 33], s[1 * 33]); o.y = pk2(s[2 * 33], s[3 * 33]); o.z = pk2(s[4 * 33], s[5 * 33]); o.w = pk2(s[6 * 33], s[7 * 33]);
        *(GAS v4u*)(dst + (size_t)n * ldd + 8 * c) = o; }
    LDS_WAIT(); asm volatile("" ::: "memory");
}
__device__ __forceinline__ void w8_column_item(const float* W, int ldw, int n0, unsigned char* dst8  , float* swp  , LAS unsigned char* lds, int wave, int lane) {
    LAS float* scr = (LAS float*)(lds + wave * 16384); LAS float* cmx = (LAS float*)(lds + 130048);
    float x[2][32]; float am = 0.f;
#pragma unroll
    for (int b = 0; b < 2; ++b)
#pragma unroll
        for (int i = 0; i < 32; ++i) { const int kk = 64 * (2 * wave + b) + 2 * i + (lane >> 5); x[b][i] = W[(size_t)kk * ldw + n0 + (lane & 31)]; am = fmaxf(am, fabsf(x[b][i])); }
    am = fmaxf(am, __shfl_xor(am, 32));
    if (lane < 32) cmx[wave * 32 + lane] = am;
    __syncthreads();
    float cm = 0.f;
#pragma unroll
    for (int w = 0; w < 8; ++w) cm = fmaxf(cm, cmx[w * 32 + (lane & 31)]);
    const float q8 = (cm > 0.f) ? 127.f / cm : 0.f;
    if (wave == 0 && lane < 32) swp[lane] = cm * (1.f / 127.f);
#pragma unroll
    for (int b = 0; b < 2; ++b) {
#pragma unroll
        for (int i = 0; i < 32; ++i) scr[(2 * i + (lane >> 5)) * 33 + (lane & 31)] = x[b][i] * q8;
        LDS_WAIT(); asm volatile("" ::: "memory");
        const int c = lane & 7;
#pragma unroll
        for (int j = 0; j < 4; ++j) { const int n = (lane >> 3) + 8 * j; const LAS float* s = scr + (8 * c) * 33 + n;
            u32x2 o; o.x = pack4i8((f32x4){s[0 * 33], s[1 * 33], s[2 * 33], s[3 * 33]}); o.y = pack4i8((f32x4){s[4 * 33], s[5 * 33], s[6 * 33], s[7 * 33]});
            *(u32x2*)(dst8 + (size_t)n * D + 64 * (2 * wave + b) + 8 * c) = o; }
        LDS_WAIT(); asm volatile("" ::: "memory");
    }
    __syncthreads();
}
__device__ __forceinline__ int win_w8_row(int n0) {
    if (n0 < 1024) return NP1 + n0;
    if (n0 < 2048) { const int j = n0 - 1024; return NP1 + 1024 + (j >> 7) * 256 + (j & 127); }
    if (n0 < 3072) { const int j = n0 - 2048; return NP1 + 1024 + (j >> 7) * 256 + 128 + (j & 127); }
    if (n0 < 7680) { const int j = n0 - 3072, kind = j / 1536, jj = j % 1536, g = jj >> 9, cc = jj & 511; return g * 1536 + kind * 512 + cc; }
    if (n0 < 8704) return NP1 + 3072 + (n0 - 7680);
    if (n0 < 9216) return NP1 + 4096 + (n0 - 8704);
    return NQKV + (n0 - 9216);
}
__device__ __forceinline__ void p0_prologue(Frame& F) {
    for (int it = F.vcu; it < DIN / 32; it += F.G) {
        const int n0 = 32 * it, drow = win_w8_row(n0);
        w8_column_item(F.in[I_WIN], DIN, n0, F.ws + WS_WQKV8 + (size_t)drow * D, (float*)(F.ws + WS_SW) + drow, F.lds, F.wave, F.lane);
    }
    LAS float* scr = (LAS float*)(F.lds + F.wave * 16384);
    const int gw = F.vcu * NWAVES + F.wave, NGW = F.G * NWAVES;
    constexpr int I_C = 16 * 32, I_A = 8 * 32, I_O = 16 * 32, NITEMS = I_C + I_A + I_O;
    for (int it = gw; it < NITEMS; it += NGW) {
        int r = it;
        if (r < I_C) { const int kb = r / 32, nb = r % 32; transpose_item(F.in[I_WCONV], D, 64 * kb, 32 * nb, (bf16*)(F.ws + WS_WCONV) + (size_t)(32 * nb) * D + 64 * kb, D, scr, F.lane); continue; } r -= I_C;
        if (r < I_A) { const int kb = r / 32, nb = r % 32; transpose_item(F.in[I_WATTN], D, 64 * kb, 32 * nb, (bf16*)(F.ws + WS_WATTN) + (size_t)(32 * nb) * DAO + 64 * kb, DAO, scr, F.lane); continue; } r -= I_A;
        { const int kb = r / 32, nb = r % 32; transpose_item(F.in[I_WOUT], D, 64 * kb, 32 * nb, (bf16*)(F.ws + WS_WOUT) + (size_t)(32 * nb) * D + 64 * kb, D, scr, F.lane); }
    }
    const float* x = F.in[I_X]; const float* nm = F.in[I_NMIX];
    f32x4 gm[4];
#pragma unroll
    for (int j = 0; j < 4; ++j) gm[j] = *((const f32x4*)nm + F.lane + 64 * j);
    for (int m = gw; m < T; m += NGW) {
        const GAS f32x4* xr = (const GAS f32x4*)(x + (size_t)m * D) + F.lane;
        f32x4 v[4]; float s = 0.f;
#pragma unroll
        for (int j = 0; j < 4; ++j) { v[j] = xr[64 * j]; s += (v[j].x * v[j].x + v[j].y * v[j].y) + (v[j].z * v[j].z + v[j].w * v[j].w); }
        const float rstd = 1.f / sqrtf(wave_sum(s) * (1.f / D) + RMS_EPS);
        f32x4 y[4]; float am = 0.f;
#pragma unroll
        for (int j = 0; j < 4; ++j) { y[j] = v[j] * rstd * gm[j];
            am = fmaxf(am, fmaxf(fmaxf(fabsf(y[j].x), fabsf(y[j].y)), fmaxf(fabsf(y[j].z), fabsf(y[j].w)))); }
#pragma unroll
        for (int o = 1; o < 64; o <<= 1) am = fmaxf(am, __shfl_xor(am, o));
        const float q8 = (am > 0.f) ? 127.f / am : 0.f;
#pragma unroll
        for (int j = 0; j < 4; ++j) ((GAS unsigned*)(F.ws + WS_U8 + (size_t)m * D))[F.lane + 64 * j] = pack4i8(y[j] * q8);
        if (F.lane == 0) ((float*)(F.ws + WS_SU))[m] = am * (1.f / 127.f);
    }
    const int* pos = (const int*)F.in[I_POS]; float* rope = (float*)(F.ws + WS_ROPE);
    for (int e = gw * 64 + F.lane; e < T * 8; e += NGW * 64) {
        const int t = e >> 3, j = e & 7;
        const double invf[8] = {1.0, 0.19392274474868576, 0.03760603093086393, 0.007292664737217109, 0.001414213562373095, 0.0002742481756762073, 5.318295896944988e-05, 1.031338537721246e-05};
        double f = 1.0;
#pragma unroll
        for (int q = 1; q < 8; ++q) f = (j == q) ? invf[q] : f;
        const float fi = (float)f;
        const double ang = (double)pos[t] * (double)fi;
        const double k = __builtin_rint(ang * 0.15915494309189535);
        const float r = (float)(ang - k * 6.283185307179586);
        rope[(size_t)t * 16 + j] = __cosf(r); rope[(size_t)t * 16 + 8 + j] = __sinf(r);
    }
}

__device__ __forceinline__ void attn_phase(Frame& F, bf16* OGb, float* LSE) {
    constexpr int SLOT = 128 * 160;
    LAS unsigned char* Ks = F.lds; LAS unsigned char* Vs = F.lds + 3 * SLOT;
    const int lane = F.lane, w = F.wave, ir = lane & 15, gq = lane >> 4;
    const int NU = 3 * 8 * 128, per = (NU + F.G - 1) / F.G;
    const int u0 = F.vcu * per, u1 = (u0 + per < NU) ? u0 + per : NU;
    const bf16* Qb = (const bf16*)(F.ws + WS_Q); const bf16* Kb = (const bf16*)(F.ws + WS_K); const bf16* Vb = (const bf16*)(F.ws + WS_V);
    u32x4 pk[2], pv[2]; bf16x8 nq0, nq1; bool havepre = false;
    for (int uid = u0, n = 0; uid < u1; ++uid, ++n) {
        const int g = uid >> 10, hh = (uid >> 7) & 7, blk = uid & 127, sh = 2 * g;
        const bool first = (blk & ((64 >> sh) - 1)) == 0;
        const size_t gbase = (size_t)g * T * GW;
        const int p0 = blk * 128;
        const int ps = n % 3, cs = (n + 1) % 3, ns = (n + 2) % 3;
        const bf16* qrow = Qb + gbase + (size_t)(p0 + 16 * w + ir) * GW + hh * 64;
        bf16* orow = OGb + gbase + (size_t)(p0 + 16 * w + ir) * GW + hh * 64;
        bf16x8 qf0, qf1;
        if (!havepre) {
            if (n > 0) __syncthreads();
#pragma unroll
            for (int i = 0; i < 4; ++i) {
                const int c = F.tid + 512 * i, row = c >> 3, part = c & 7;
                const bool valid = !first || row >= 128;
                u32x4 kv = {0u, 0u, 0u, 0u}, vv = {0u, 0u, 0u, 0u};
                if (valid) { const size_t off = gbase + (size_t)(p0 - 128 + row) * GW + hh * 64 + part * 8; kv = *(const u32x4*)(Kb + off); vv = *(const u32x4*)(Vb + off); }
                const int so = ((row < 128) ? ps : cs) * SLOT + (row & 127) * 160 + part * 16;
                *(LAS u32x4*)(Ks + so) = kv; *(LAS u32x4*)(Vs + so) = vv;
            }
            qf0 = *(const bf16x8*)(qrow + 8 * gq); qf1 = *(const bf16x8*)(qrow + 32 + 8 * gq);
        } else { qf0 = nq0; qf1 = nq1; }
        __syncthreads();
        havepre = (uid + 1 < u1) && (((uid + 1) & 127) != 0);
        if (havepre) {
#pragma unroll
            for (int i = 0; i < 2; ++i) { const int c = F.tid + 512 * i, row = c >> 3, part = c & 7; const size_t off = gbase + (size_t)(p0 + 128 + row) * GW + hh * 64 + part * 8; pk[i] = *(const u32x4*)(Kb + off); pv[i] = *(const u32x4*)(Vb + off); }
            nq0 = *(const bf16x8*)(qrow + (size_t)128 * GW + 8 * gq); nq1 = *(const bf16x8*)(qrow + (size_t)128 * GW + 32 + 8 * gq);
        }
        f32x4 sacc[9];
#pragma unroll
        for (int a = 0; a < 9; ++a) {
            sacc[a] = (f32x4){0.f, 0.f, 0.f, 0.f};
            const int R0 = 16 * w + 16 * a;
            const LAS unsigned char* kp = Ks + ((R0 < 128) ? ps : cs) * SLOT + ((R0 & 127) + ir) * 160 + gq * 16;
            const bf16x8 k0 = *(const LAS bf16x8*)kp, k1 = *(const LAS bf16x8*)(kp + 64);
            sacc[a] = __builtin_amdgcn_mfma_f32_16x16x32_bf16(k0, qf0, sacc[a], 0, 0, 0);
            sacc[a] = __builtin_amdgcn_mfma_f32_16x16x32_bf16(k1, qf1, sacc[a], 0, 0, 0);
        }
        float mx = -INFINITY;
#pragma unroll
        for (int a = 0; a < 9; ++a)
#pragma unroll
            for (int j = 0; j < 4; ++j) {
                const int jl = 4 * gq + j;
                bool valid = (a == 0) ? (jl >= ir) : ((a == 8) ? (jl <= ir) : true);
                valid = valid && (!first || (16 * w + 16 * a + jl >= 128));
                sacc[a][j] = valid ? sacc[a][j] : -INFINITY;
                mx = fmaxf(mx, sacc[a][j]);
            }
        mx = fmaxf(mx, __shfl_xor(mx, 16)); mx = fmaxf(mx, __shfl_xor(mx, 32));
        float l = 0.f;
#pragma unroll
        for (int a = 0; a < 9; ++a)
#pragma unroll
            for (int j = 0; j < 4; ++j) { sacc[a][j] = __builtin_amdgcn_exp2f(sacc[a][j] - mx); l += sacc[a][j]; }
        l += __shfl_xor(l, 16); l += __shfl_xor(l, 32);
        f32x4 oacc[4];
#pragma unroll
        for (int dt = 0; dt < 4; ++dt) oacc[dt] = (f32x4){0.f, 0.f, 0.f, 0.f};
#pragma unroll
        for (int s = 0; s < 5; ++s) {
            u32x4 pw; pw.x = cvt_pk_bf16(sacc[2 * s][0], sacc[2 * s][1]); pw.y = cvt_pk_bf16(sacc[2 * s][2], sacc[2 * s][3]);
            if (s < 4) { pw.z = cvt_pk_bf16(sacc[2 * s + 1][0], sacc[2 * s + 1][1]); pw.w = cvt_pk_bf16(sacc[2 * s + 1][2], sacc[2 * s + 1][3]); } else { pw.z = 0u; pw.w = 0u; }
            const bf16x8 pb = __builtin_bit_cast(bf16x8, pw);
            const int q = ir >> 2, p = ir & 3;
            const int Ra = 16 * w + 32 * s, Rb = Ra + 16;
            const LAS unsigned char* vpa = Vs + ((Ra < 128) ? ps : cs) * SLOT + ((Ra & 127) + 4 * gq + q) * 160 + p * 8;
            const LAS unsigned char* vpb = Vs + ((Rb < 128) ? ps : cs) * SLOT + ((Rb & 127) + 4 * gq + q) * 160 + p * 8;
#pragma unroll
            for (int dt = 0; dt < 4; ++dt) {
                const s16x4 va = __builtin_bit_cast(s16x4, __builtin_amdgcn_ds_read_tr16_b64_v4i16((LAS v4i16_t*)(vpa + dt * 32)));
                s16x4 vb = {0, 0, 0, 0};
                if (s < 4) vb = __builtin_bit_cast(s16x4, __builtin_amdgcn_ds_read_tr16_b64_v4i16((LAS v4i16_t*)(vpb + dt * 32)));
                const bf16x8 vf = __builtin_shufflevector(va, vb, 0, 1, 2, 3, 4, 5, 6, 7);
                oacc[dt] = __builtin_amdgcn_mfma_f32_16x16x32_bf16(vf, pb, oacc[dt], 0, 0, 0);
            }
        }
        const float inv = 1.f / l;
#pragma unroll
        for (int dt = 0; dt < 4; ++dt) {
            u32x2 o; o.x = cvt_pk_bf16(oacc[dt][0] * inv, oacc[dt][1] * inv); o.y = cvt_pk_bf16(oacc[dt][2] * inv, oacc[dt][3] * inv);
            *(u32x2*)(orow + 16 * dt + 4 * gq) = o;
        }
        if (gq == 0) LSE[((size_t)g * T + p0 + 16 * w + ir) * 8 + hh] = (mx + __builtin_amdgcn_logf(l)) * LN2;
        if (havepre) {
#pragma unroll
            for (int i = 0; i < 2; ++i) { const int c = F.tid + 512 * i, row = c >> 3, part = c & 7; const int so = ns * SLOT + row * 160 + part * 16; *(LAS u32x4*)(Ks + so) = pk[i]; *(LAS u32x4*)(Vs + so) = pv[i]; }
        }
    }
    __syncthreads();
}

__device__ __forceinline__ void combine_phase(Frame& F, int part, int nparts) {
    const int gw = part * NWAVES + F.wave, NGW = nparts * NWAVES, lane = F.lane, hh = lane >> 3;
    const bf16* OG = (const bf16*)(F.ws + WS_Q); const float* LSE = (const float*)(F.ws + WS_LSE); bf16* O = (bf16*)(F.ws + WS_O);
    for (int t0 = gw * 4; t0 < T; t0 += NGW * 4) {
        float ls[4][3]; u32x4 og[4][3];
#pragma unroll
        for (int q = 0; q < 4; ++q) { const int t = t0 + q, b = t / SEQ, s = t % SEQ;
#pragma unroll
            for (int g = 0; g < 3; ++g) {
                const int sh = 2 * g, r = s & ((1 << sh) - 1), i = s >> sh;
                const size_t p = (size_t)g * T + b * SEQ + r * (SEQ >> sh) + i;
                ls[q][g] = LSE[p * 8 + hh]; og[q][g] = *(const u32x4*)(OG + p * GW + lane * 8);
            } }
#pragma unroll
        for (int q = 0; q < 4; ++q) {
            const float m = fmaxf(ls[q][0], fmaxf(ls[q][1], ls[q][2]));
            float e[3], sum = 0.f;
#pragma unroll
            for (int g = 0; g < 3; ++g) { e[g] = __expf(ls[q][g] - m); sum += e[g]; }
            const float inv = 1.f / sum;
            f32x4 a0 = {0.f, 0.f, 0.f, 0.f}, a1 = a0;
#pragma unroll
            for (int g = 0; g < 3; ++g) { f32x4 v0, v1; unpack8(og[q][g], v0, v1); const float wg = e[g] * inv; a0 = a0 + v0 * wg; a1 = a1 + v1 * wg; }
            *(u32x4*)(O + (size_t)(t0 + q) * DAO + lane * 8) = pack8(a0, a1);
        }
    }
}

__device__ __forceinline__ void p4_conv(Frame& F) {
    constexpr int RUN = 16;
    const int gt = (F.vcu * NWAVES + F.wave) * 64 + F.lane, NGT = F.G * NWAVES * 64;
    bf16* Bb = (bf16*)((unsigned char*)F.out + OS_BB); const bf16* Z = (const bf16*)(F.ws + WS_Z); const float* cw = F.in[I_CONVW];
    for (int e = gt; e < (T / RUN) * (D / 8); e += NGT) {
        const int t0 = (e >> 7) * RUN, c8 = (e & 127) * 8, s0 = t0 & (SEQ - 1);
        const f32x4 w0a = *(const f32x4*)(cw + c8), w0b = *(const f32x4*)(cw + c8 + 4), w1a = *(const f32x4*)(cw + D + c8), w1b = *(const f32x4*)(cw + D + c8 + 4), w2a = *(const f32x4*)(cw + 2 * D + c8), w2b = *(const f32x4*)(cw + 2 * D + c8 + 4);
        const size_t off0 = (size_t)t0 * D + c8;
        f32x4 z1a = {0.f, 0.f, 0.f, 0.f}, z1b = z1a, z2a = z1a, z2b = z1a;
        if (s0 >= 2) { unpack8(*(const u32x4*)(Z + off0 - D), z1a, z1b); unpack8(*(const u32x4*)(Z + off0 - 2 * D), z2a, z2b); }
#pragma unroll 4
        for (int r = 0; r < RUN; ++r) {
            const size_t off = off0 + (size_t)r * D;
            f32x4 z0a, z0b, ba, bb;
            unpack8(*(const u32x4*)(Z + off), z0a, z0b); unpack8(*(const u32x4*)(Bb + off), ba, bb);
            const f32x4 ca = w0a * z2a + w1a * z1a + w2a * z0a, cb = w0b * z2b + w1b * z1b + w2b * z0b;
            *(u32x4*)(Bb + off) = pack8(ba * ca, bb * cb);
            z2a = z1a; z2b = z1b; z1a = z0a; z1b = z0b;
        }
    }
}
__device__ __forceinline__ void split8(const f32x4 a, const f32x4 b, bf16x8& hi, bf16x8& lo) {
    const u32x4 h = pack8(a, b); f32x4 ha, hb; unpack8(h, ha, hb);
    hi = __builtin_bit_cast(bf16x8, h); lo = __builtin_bit_cast(bf16x8, pack8(a - ha, b - hb));
}
__device__ __forceinline__ void p4_wfold(Frame& F) {
    const int gw = F.vcu * NWAVES + F.wave, NGW = F.G * NWAVES, i = F.lane & 15, g = F.lane >> 4;
    const float* Wq = F.in[I_WQ]; const float* SK = F.in[I_SUBK]; bf16* WF = (bf16*)((unsigned char*)F.out + OS_WFOLD);
    for (int it = gw; it < 1024; it += NGW) {
        const int itu = __builtin_amdgcn_readfirstlane(it);
        const int hc = itu >> 6, k0 = ((itu >> 1) & 31) * 32, nh = itu & 1;
        bf16x8 ah[2][4], al[2][4];
#pragma unroll
        for (int kt = 0; kt < 2; ++kt)
#pragma unroll
            for (int j = 0; j < 4; ++j) { const float* ap = Wq + (size_t)(k0 + 16 * kt + i) * 2048 + hc * 128 + 32 * j + 8 * g; split8(*(const f32x4*)ap, *(const f32x4*)(ap + 4), ah[kt][j], al[kt][j]); }
#pragma unroll 1
        for (int nt = 0; nt < 4; ++nt) {
            const int n0 = hc * 128 + nh * 64 + 16 * nt;
            bf16x8 bh[4], bl[4];
#pragma unroll
            for (int j = 0; j < 4; ++j) { const float* bp = SK + (size_t)(n0 + i) * 128 + 32 * j + 8 * g; split8(*(const f32x4*)bp, *(const f32x4*)(bp + 4), bh[j], bl[j]); }
#pragma unroll
            for (int kt = 0; kt < 2; ++kt) {
                f32x4 acc = {0.f, 0.f, 0.f, 0.f};
#pragma unroll
                for (int j = 0; j < 4; ++j) { acc = __builtin_amdgcn_mfma_f32_16x16x32_bf16(al[kt][j], bh[j], acc, 0, 0, 0); acc = __builtin_amdgcn_mfma_f32_16x16x32_bf16(ah[kt][j], bl[j], acc, 0, 0, 0); }
#pragma unroll
                for (int j = 0; j < 4; ++j) acc = __builtin_amdgcn_mfma_f32_16x16x32_bf16(ah[kt][j], bh[j], acc, 0, 0, 0);
                u32x2 o; o.x = pk2(acc[0], acc[1]); o.y = pk2(acc[2], acc[3]);
                *(u32x2*)(WF + (size_t)(n0 + i) * D + k0 + 16 * kt + 4 * g) = o;
            }
        }
    }
}
__device__ __forceinline__ float gelu_erf(float v) { return 0.5f * v * (1.f + erff(v * 0.70710678118654752f)); }
__device__ __forceinline__ void peer_down_phase(Frame& F) {
    const int lane = F.lane, sub = lane & 15, gq = lane >> 4;
    const int nloc = (int)F.MISC[8], nxc = (int)F.MISC[9]; const bool byx = (nxc == 8) && (nloc * 8 == F.G) && (F.xcc < 8);
    const int x = byx ? F.xcc : 0, nsh = byx ? 8 : 1, rank = byx ? F.xrank : (int)blockIdx.x, nrank = byx ? nloc : F.G;
    const unsigned char* HG8 = F.ws + WS_HG8; const float* HSC = (const float*)(F.ws + WS_HSC); const float* RSQ = (const float*)(F.ws + WS_RSQ);
    const int* IDX = (const int*)(F.ws + WS_IDX); const float* GATE = (const float*)(F.ws + WS_GATE);
    const unsigned char* dn8 = (const unsigned char*)F.out + OS_EDOWN; const float* esc = (const float*)(F.ws + WS_ESCALE); float* WB = (float*)(F.ws + WS_WB);
    LAS unsigned char* wb = F.lds + F.wave * 10752;
    LAS u32x4* h8s = (LAS u32x4*)wb; LAS float* hss = (LAS float*)(wb + 4096); LAS u32x2* ls = (LAS u32x2*)(wb + 4608); LAS float* av = (LAS float*)(wb + 8704);
    const int tstep = nrank * NWAVES * 4;
    for (int xs = x; xs < 8; xs += nsh) {
        int tb = (rank * NWAVES + F.wave) * 4;
        u32x4 ia, ib, h8[4]; f32x4 ga, gb; float hs[4], pq;
#define PD_META(tt) do { const size_t t_ = (size_t)(tt) + gq; ia = *(const u32x4*)(IDX + t_ * HK + sub * 8); ib = *(const u32x4*)(IDX + t_ * HK + sub * 8 + 4); \
            ga = *(const f32x4*)(GATE + t_ * HK + sub * 8); gb = *(const f32x4*)(GATE + t_ * HK + sub * 8 + 4); pq = RSQ[t_ * 16 + sub]; \
            _Pragma("unroll") for (int j_ = 0; j_ < 4; ++j_) { h8[j_] = *(const u32x4*)(HG8 + t_ * D + 16 * (sub + 16 * j_)); hs[j_] = HSC[t_ * 32 + ((sub + 16 * j_) >> 1)]; } } while (0)
        if (tb < T) PD_META(tb);
        for (; tb < T; tb += tstep) {
#pragma unroll
            for (int j = 0; j < 4; ++j) { h8s[gq * 64 + sub + 16 * j] = h8[j]; if ((sub & 1) == 0) hss[gq * 32 + ((sub + 16 * j) >> 1)] = hs[j]; }
            int total = 0;
#pragma unroll
            for (int k = 0; k < 8; ++k) {
                const int ei = (int)(k < 4 ? ia[k & 3] : ib[k & 3]); const float gk = (k < 4 ? ga[k & 3] : gb[k & 3]);
                const bool f = (ei >> 11) == xs;
                const unsigned long long m = __ballot(f);
                const int pos = total + (int)__builtin_amdgcn_mbcnt_hi((unsigned)(m >> 32), __builtin_amdgcn_mbcnt_lo((unsigned)m, 0u));
                if (f) { u32x2 ent; ent.x = (unsigned)ei | ((unsigned)(sub * 8 + k) << 14) | ((unsigned)gq << 21); ent.y = __builtin_bit_cast(unsigned, gk); ls[pos] = ent; }
                total += __popcll(m);
            }
            float rq = pq; rq += __shfl_xor(rq, 1); rq += __shfl_xor(rq, 2); rq += __shfl_xor(rq, 4); rq += __shfl_xor(rq, 8);
            const float rstd = __builtin_amdgcn_rsqf(rq * (1.f / D) + RMS_EPS);
            const int tcur = tb;
            if (tb + tstep < T) PD_META(tb + tstep);
            LDS_WAIT(); asm volatile("" ::: "memory");
            const int nr = (total + 3) >> 2;
#define PD_ISSUE(R, HH, HS, r0) do { _Pragma("unroll") for (int u_ = 0; u_ < 2; ++u_) { const int k_ = 4 * ((r0) + u_) + gq; const bool v_ = k_ < total; const u32x2 e_ = ls[v_ ? k_ : 0]; const unsigned ex_ = e_.x; \
                const unsigned ro_ = (v_ ? (ex_ & 16383u) : 0u) * 1024u + 16u * (unsigned)sub; const unsigned tk_ = (ex_ >> 21) & 3u; \
                _Pragma("unroll") for (int j_ = 0; j_ < 4; ++j_) { R[u_][j_] = *(const u32x4*)(dn8 + (ro_ + 256u * j_)); HH[u_][j_] = h8s[tk_ * 64 + sub + 16 * j_]; HS[u_][j_] = hss[tk_ * 32 + ((sub + 16 * j_) >> 1)]; } } } while (0)
#define PD_COMPUTE(R, HH, HS, r0) do { _Pragma("unroll") for (int u_ = 0; u_ < 2; ++u_) { const int k_ = 4 * ((r0) + u_) + gq; float af_ = 0.f; \
                _Pragma("unroll") for (int j_ = 0; j_ < 4; ++j_) { int ac_ = 0; _Pragma("unroll") for (int q_ = 0; q_ < 4; ++q_) { const int a_ = (int)R[u_][j_][q_], b_ = (int)HH[u_][j_][q_]; ac_ = __builtin_amdgcn_sdot4(a_, b_, ac_, false); } af_ += (float)ac_ * HS[u_][j_]; } \
                af_ += __shfl_xor(af_, 1); af_ += __shfl_xor(af_, 2); af_ += __shfl_xor(af_, 4); af_ += __shfl_xor(af_, 8); \
                if (k_ < total && sub == 0) av[k_] = af_; } } while (0)
            u32x4 RA[2][4], RB[2][4], HA[2][4], HB[2][4]; float SA[2][4], SB[2][4];
            if (nr > 0) {
                PD_ISSUE(RA, HA, SA, 0);
                int r = 0;
#pragma unroll 1
                for (; r + 4 < nr; r += 4) {
                    PD_ISSUE(RB, HB, SB, r + 2);
                    __builtin_amdgcn_sched_barrier(0);
                    PD_COMPUTE(RA, HA, SA, r);
                    __builtin_amdgcn_sched_barrier(0);
                    PD_ISSUE(RA, HA, SA, r + 4);
                    __builtin_amdgcn_sched_barrier(0);
                    PD_COMPUTE(RB, HB, SB, r + 2);
                    __builtin_amdgcn_sched_barrier(0);
                }
                if (r + 2 < nr) {
                    PD_ISSUE(RB, HB, SB, r + 2);
                    __builtin_amdgcn_sched_barrier(0);
                    PD_COMPUTE(RA, HA, SA, r);
                    __builtin_amdgcn_sched_barrier(0);
                    PD_COMPUTE(RB, HB, SB, r + 2);
                } else {
                    PD_COMPUTE(RA, HA, SA, r);
                }
                __builtin_amdgcn_sched_barrier(0);
            }
#undef PD_ISSUE
#undef PD_COMPUTE
            LDS_WAIT(); asm volatile("" ::: "memory");
            const float rs0 = __builtin_bit_cast(float, __builtin_amdgcn_readlane(__builtin_bit_cast(int, rstd), 0)), rs1 = __builtin_bit_cast(float, __builtin_amdgcn_readlane(__builtin_bit_cast(int, rstd), 16)),
                        rs2 = __builtin_bit_cast(float, __builtin_amdgcn_readlane(__builtin_bit_cast(int, rstd), 32)), rs3 = __builtin_bit_cast(float, __builtin_amdgcn_readlane(__builtin_bit_cast(int, rstd), 48));
            for (int i = lane; i < total; i += 64) {
                const u32x2 e = ls[i]; const unsigned ex = e.x, eg = e.y; const int tk = (int)((ex >> 21) & 3u);
                const float rs = (tk == 0) ? rs0 : ((tk == 1) ? rs1 : ((tk == 2) ? rs2 : rs3));
                const float a = av[i] * esc[ex & 16383u] * rs;
                WB[(size_t)(tcur + tk) * HK + ((ex >> 14) & 127u)] = __builtin_bit_cast(float, eg) * esc[NEXP + (ex & 16383u)] * gelu_erf(a);
            }
            LDS_WAIT(); asm volatile("" ::: "memory");
        }
#undef PD_META
    }
}
__device__ __forceinline__ void peer_up_phase(Frame& F) {
    const int lane = F.lane, g8 = lane >> 3, c = lane & 7;
    const int nloc = (int)F.MISC[8], nxc = (int)F.MISC[9]; const bool byx = (nxc == 8) && (nloc * 8 == F.G) && (F.xcc < 8);
    const int x = byx ? F.xcc : 0, nsh = byx ? 8 : 1, rank = byx ? F.xrank : (int)blockIdx.x, nrank = byx ? nloc : F.G;
    const bf16* HG = (const bf16*)(F.ws + WS_HG); const float* nffn = F.in[I_NFFN]; const int* IDX = (const int*)(F.ws + WS_IDX); const float* WB = (const float*)(F.ws + WS_WB);
    float* SS = (float*)(F.ws + WS_SS); float* out = F.out;
    LAS unsigned char* wbuf = F.lds + F.wave * 16384;
    const int tstep = nrank * NWAVES * 8;
    for (int xs = x; xs < 8; xs += nsh) {
    const unsigned char* up8 = F.ws + WS_EUP + (size_t)xs * (2 * MiB);
    int tb = (rank * NWAVES + F.wave) * 8, it = 0;
#define PU_DMA(tt, bufi) do { LAS unsigned char* d_ = wbuf + (bufi) * 8192; _Pragma("unroll") for (int q_ = 0; q_ < 4; ++q_) { \
        __builtin_amdgcn_global_load_lds((const unsigned*)((const unsigned char*)(IDX + (size_t)(tt) * HK + q_ * 256) + (unsigned)(lane * 16)), (LAS unsigned*)(d_ + q_ * 1024), 16, 0, 0); \
        __builtin_amdgcn_global_load_lds((const unsigned*)((const unsigned char*)(WB + (size_t)(tt) * HK + q_ * 256) + (unsigned)(lane * 16)), (LAS unsigned*)(d_ + 4096 + q_ * 1024), 16, 0, 0); } } while (0)
    if (tb < T) PU_DMA(tb, 0);
#ifdef EXP_STAG9
    if (F.wave >= 4) { for (int z_ = 0; z_ < EXP_STAG9; ++z_) __builtin_amdgcn_s_sleep(16); }
#endif
    for (; tb < T; tb += tstep, ++it) {
        const int t = tb + g8;
        const LAS unsigned char* mi = wbuf + (it & 1) * 8192 + g8 * 512;
        asm volatile("s_waitcnt vmcnt(0)" ::: "memory");
        const unsigned hgo = (unsigned)(t * (D * 2) + 256 * xs + 32 * c);
        const u32x4 hg0 = *(const u32x4*)((const unsigned char*)HG + hgo), hg1 = *(const u32x4*)((const unsigned char*)HG + (hgo + 16u));
        f32x4 oa[4];
#pragma unroll
        for (int q = 0; q < 4; ++q) oa[q] = (f32x4){0.f, 0.f, 0.f, 0.f};
#define PU_ISSUE(R, W, st) do { const u32x4 i0_ = *(const LAS u32x4*)(mi + (st) * 32), i1_ = *(const LAS u32x4*)(mi + (st) * 32 + 16); \
            const f32x4 w0_ = *(const LAS f32x4*)(mi + 4096 + (st) * 32), w1_ = *(const LAS f32x4*)(mi + 4096 + (st) * 32 + 16); \
            _Pragma("unroll") for (int k_ = 0; k_ < 8; ++k_) { const unsigned ei_ = (k_ < 4) ? i0_[k_ & 3] : i1_[k_ & 3]; W[k_] = (k_ < 4) ? w0_[k_ & 3] : w1_[k_ & 3]; \
            R[k_] = *(const u32x4*)(up8 + (ei_ * 128u + 16u * (unsigned)c)); } } while (0)
#define PU_COMPUTE(R, W) do { _Pragma("unroll") for (int k_ = 0; k_ < 8; ++k_) { _Pragma("unroll") for (int q_ = 0; q_ < 4; ++q_) { const int d_ = (int)R[k_][q_]; \
            const f32x2 lo_ = __builtin_amdgcn_cvt_pk_f32_fp8(d_, false), hi_ = __builtin_amdgcn_cvt_pk_f32_fp8(d_, true); \
            oa[q_][0] += lo_.x * W[k_]; oa[q_][1] += lo_.y * W[k_]; oa[q_][2] += hi_.x * W[k_]; oa[q_][3] += hi_.y * W[k_]; } if (k_ & 1) __builtin_amdgcn_sched_barrier(0); } } while (0)
        u32x4 RA[8], RB[8]; float WA[8], WBk[8];
        PU_ISSUE(RA, WA, 0);
#pragma unroll 1
        for (int st = 0; st < 16; st += 2) {
            PU_ISSUE(RB, WBk, st + 1);
            if (st == 8 && tb + tstep < T) PU_DMA(tb + tstep, (it + 1) & 1);
            __builtin_amdgcn_sched_barrier(0);
            PU_COMPUTE(RA, WA);
            __builtin_amdgcn_sched_barrier(0);
            if (st + 2 < 16) PU_ISSUE(RA, WA, st + 2);
            __builtin_amdgcn_sched_barrier(0);
            PU_COMPUTE(RB, WBk);
            __builtin_amdgcn_sched_barrier(0);
        }
#undef PU_ISSUE
#undef PU_COMPUTE
        float ss = 0.f;
        const size_t off = (size_t)t * D + 128 * xs + 16 * c;
        f32x4 hv[4]; unpack8(hg0, hv[0], hv[1]); unpack8(hg1, hv[2], hv[3]);
#pragma unroll
        for (int q = 0; q < 4; ++q) { const f32x4 nf = *(const f32x4*)(nffn + 128 * xs + 16 * c + 4 * q); hv[q][0] /= nf[0]; hv[q][1] /= nf[1]; hv[q][2] /= nf[2]; hv[q][3] /= nf[3]; }
#pragma unroll
        for (int q = 0; q < 4; ++q) { oa[q] = oa[q] + hv[q]; ss += (oa[q][0] * oa[q][0] + oa[q][1] * oa[q][1]) + (oa[q][2] * oa[q][2] + oa[q][3] * oa[q][3]); *(f32x4*)(out + off + 4 * q) = oa[q]; }
        ss += __shfl_xor(ss, 1); ss += __shfl_xor(ss, 2); ss += __shfl_xor(ss, 4);
        if (c == 0) SS[(size_t)t * 8 + xs] = ss;
    }
#undef PU_DMA
    }
}
__device__ __forceinline__ void final_norm_phase(Frame& F) {
    const int gw = F.vcu * NWAVES + F.wave, NGW = F.G * NWAVES, lane = F.lane;
    const float* SS = (const float*)(F.ws + WS_SS); const float* fn = F.in[I_FNORM]; float* out = F.out;
    f32x4 g[4];
#pragma unroll
    for (int q = 0; q < 4; ++q) g[q] = *(const f32x4*)(fn + 4 * (lane + 64 * q));
    for (int t = gw; t < T; t += NGW) {
        const f32x4 s0 = *(const f32x4*)(SS + (size_t)t * 8), s1 = *(const f32x4*)(SS + (size_t)t * 8 + 4);
        const float r2 = __builtin_amdgcn_rsqf((((s0[0] + s0[1]) + (s0[2] + s0[3])) + ((s1[0] + s1[1]) + (s1[2] + s1[3]))) * (1.f / D) + RMS_EPS);
        f32x4* op = (f32x4*)(out + (size_t)t * D) + lane;
#pragma unroll
        for (int q = 0; q < 4; ++q) op[64 * q] = op[64 * q] * r2 * g[q];
    }
}

struct Args { const float* in[15]; float* out; unsigned char* ws; int ph_lo, ph_hi, li, pad; };
__global__ void __launch_bounds__(NWAVES * 64, 2) fwd(Args args) {
    extern __shared__ __attribute__((aligned(16))) unsigned char lds[];
    Frame F;
    F.lds = (LAS unsigned char*)lds;
    F.MISC = (volatile LAS unsigned*)(F.lds + MISC_OFF);
    F.tid = threadIdx.x; F.lane = F.tid & 63; F.wave = __builtin_amdgcn_readfirstlane(F.tid >> 6);
    F.G = gridDim.x; { const int bx = blockIdx.x; F.vcu = (F.G % 8 == 0) ? (bx % 8) * (F.G / 8) + bx / 8 : bx; }
    F.ws = args.ws; F.ctl = (gu32*)(args.ws + WS_CTL);
#pragma unroll
    for (int i = 0; i < 15; ++i) F.in[i] = args.in[i];
    F.out = args.out;
    for (int u = F.tid; u < (LDS_BYTES - RING_BYTES) / 4; u += NWAVES * 64) ((LAS unsigned*)(F.lds + RING_BYTES))[u] = 0u;
    __syncthreads();
    XcdBarrier bar; bar.bar = (unsigned*)(F.ctl + CW_BAR); bar.x = 0; bar.st = nullptr;
    if (N_LAUNCHES == 1) bar = xcd_barrier_post((unsigned*)(F.ctl + CW_BAR), F.MISC + 8);
    F.xcc = (int)xb_xcc_id();
    if (F.tid == 0) F.MISC[16] = xb_add((unsigned*)(F.ctl + CW_RANK + 64 * (F.xcc & 15)), 1u);
    __syncthreads();
    F.xrank = (int)F.MISC[16];
#define GRID_BAR() do { if (N_LAUNCHES == 1) xcd_barrier(bar); } while (0)
    const int lo = args.ph_lo, hi = args.ph_hi, bx = (int)blockIdx.x;
#define IN(k) (lo <= (k) && (k) < hi)
#define BOTH(k) (IN(k) && IN((k) + 1))
    unsigned char* ws = args.ws;

    if (IN(0)) { p0_prologue(F); if (BOTH(0)) GRID_BAR(); }

    if (IN(1)) {
        Gemm g{(const bf16*)(ws + WS_U8), (const bf16*)(ws + WS_WQKV8), T, NP1, D / 2}; QkvOrder S; S.init(T, NP1, F.G, bx); S.U = (const char*)(ws + WS_U8);
        EpiQKV E{(bf16*)(ws + WS_Q), (const float*)(ws + WS_ROPE), (const float*)(ws + WS_SU), (const float*)(ws + WS_SW), ws + WS_SGA, F.in[I_GBIAS] + D};
        gemm_phase<EpiQKV, QkvOrder, true, true, true, true>(F.lds, g, S, E);
        if (BOTH(1)) GRID_BAR();
    }
    if (IN(2)) { attn_phase(F, (bf16*)(ws + WS_Q), (float*)(ws + WS_LSE)); if (BOTH(2)) GRID_BAR(); }
    if (IN(3)) {
        { const int nwg = (T / 256) * ((NCG - 512) / 256), rem = nwg % F.G;
          if (rem == 0) combine_phase(F, F.vcu, F.G); else if (bx >= rem) combine_phase(F, bx - rem, F.G - rem); }
        Gemm g{(const bf16*)(ws + WS_U8), (const bf16*)(ws + WS_WQKV8 + (size_t)NP1 * D), T, NCG - 512, D / 2}; StaticOrder S; S.init(T, NCG - 512, F.G, bx);
        EpiCG E{(bf16*)((unsigned char*)F.out + OS_BB), (bf16*)(ws + WS_Z), ws + WS_SGC, ws + WS_SGA, F.in[I_GBIAS], (const float*)(ws + WS_SU), (const float*)(ws + WS_SW)};
        gemm_phase<EpiCG, StaticOrder, true, true, false, true>(F.lds, g, S, E);
        if (BOTH(3)) GRID_BAR();
    }
    if (IN(4)) { p4_wfold(F); p4_conv(F); if (BOTH(4)) GRID_BAR(); }
    if (IN(5)) {
        Gemm gc{(const bf16*)((unsigned char*)F.out + OS_BB), (const bf16*)(ws + WS_WCONV), T, D, D}, ga{(const bf16*)(ws + WS_O), (const bf16*)(ws + WS_WATTN), T, D, DAO};
        StaticOrder S; S.init(T, D, F.G, bx);
        if ((bx & 8) == 0) {
            { EpiY<0> E{(bf16*)(ws + WS_Y), ws + WS_SGC}; gemm_phase<EpiY<0>, StaticOrder, true, true>(F.lds, gc, S, E); }
            { EpiY<1> E{(bf16*)(ws + WS_Y), ws + WS_SGA}; gemm_phase<EpiY<1>, StaticOrder, true, true>(F.lds, ga, S, E); }
        } else {
            { EpiY<0> E{(bf16*)(ws + WS_Y), ws + WS_SGA}; gemm_phase<EpiY<0>, StaticOrder, true, true>(F.lds, ga, S, E); }
            { EpiY<1> E{(bf16*)(ws + WS_Y), ws + WS_SGC}; gemm_phase<EpiY<1>, StaticOrder, true, true>(F.lds, gc, S, E); }
        }
        if (BOTH(5)) GRID_BAR();
    }
    if (IN(6)) {
        Gemm g{(const bf16*)(ws + WS_Y), (const bf16*)(ws + WS_WOUT), T, D, D}; StaticOrder S; S.init(T, D, F.G, bx);
        EpiOut E{F.in[I_X], (bf16*)(ws + WS_HG), F.in[I_NFFN], (float*)(ws + WS_RSQ), ws + WS_HG8, (float*)(ws + WS_HSC)};
        gemm_phase<EpiOut, StaticOrder, true, true>(F.lds, g, S, E);

        if (BOTH(6)) GRID_BAR();
    }
    if (IN(7)) {
        Gemm g{(const bf16*)(ws + WS_HG), (const bf16*)((unsigned char*)F.out + OS_WFOLD), T, 2048, D}; StaticOrder S; S.init(T, 2048, F.G, bx);
        float* scr = (float*)(ws + (bx < 128 ? WS_SCR0 + (size_t)bx * 262144 : (bx < 192 ? WS_SCR1 + (size_t)(bx - 128) * 262144 : WS_SCR2 + (size_t)(bx - 192) * 262144)));
        EpiTopk E{scr, (const float*)(ws + WS_RSQ), (int*)(ws + WS_IDX), (float*)(ws + WS_GATE),
                  CvCtx{F.in[I_DOWN], F.in[I_UP], (unsigned char*)F.out + OS_EDOWN, ws + WS_EUP, (float*)(ws + WS_ESCALE), F.lane}, F.vcu * NWAVES + F.wave, F.G * NWAVES};
        if ((bx & 8) != 0) { for (; E.cvr < 2 * NEXP; E.cvr += E.cvstep) { f32x4 v[4]; cv_load(E.CV, E.cvr, v); cv_finish(E.CV, E.cvr, v); } }
        const int cvkeep = E.cvr; E.cvr = 2 * NEXP;
        gemm_phase<EpiTopk, StaticOrder, true, true>(F.lds, g, S, E);
        E.cvr = cvkeep;
        for (; E.cvr < 2 * NEXP; E.cvr += E.cvstep) { f32x4 v[4]; cv_load(E.CV, E.cvr, v); cv_finish(E.CV, E.cvr, v); }
        if (BOTH(7)) GRID_BAR();
    }
    if (IN(8)) { peer_down_phase(F); if (BOTH(8)) GRID_BAR(); }
    if (IN(9)) { peer_up_phase(F); if (BOTH(9)) GRID_BAR(); }
    if (IN(10)) { final_norm_phase(F); }
#undef IN
#undef BOTH
}

extern "C" void kernel_launch(void* const* d_in, const int* in_sizes, int n_in, void* d_out, int out_size, void* d_ws, size_t ws_size, hipStream_t stream) {
    static int grid = 0;
    if (grid == 0) {
        if (n_in != 15 || out_size != T * D || ws_size < WS_END) { fprintf(stderr, "kernel_launch: unexpected shapes (n_in %d, out %d, ws %zu)\n", n_in, out_size, ws_size); grid = -1; return; }
        int dev = 0, cus = 0, per_cu = 0;
        if (hipGetDevice(&dev) != hipSuccess || hipDeviceGetAttribute(&cus, hipDeviceAttributeMultiprocessorCount, dev) != hipSuccess) { grid = -1; return; }
        if (hipFuncSetAttribute((const void*)fwd, hipFuncAttributeMaxDynamicSharedMemorySize, LDS_BYTES) != hipSuccess) { fprintf(stderr, "kernel_launch: hipFuncSetAttribute failed\n"); grid = -1; return; }
        if (hipOccupancyMaxActiveBlocksPerMultiprocessor(&per_cu, (const void*)fwd, NWAVES * 64, LDS_BYTES) != hipSuccess || per_cu < 1) fprintf(stderr, "kernel_launch: occupancy query reports %d\n", per_cu);
        (void)hipGetLastError();
        grid = cus > 256 ? 256 : cus;
    }
    if (grid < 0) return;
    if (hipMemsetAsync((char*)d_ws + WS_CTL, 0, CTL_ZERO_BYTES, stream) != hipSuccess) return;
    Args a{};
    for (int i = 0; i < 15; ++i) a.in[i] = (const float*)d_in[i];
    a.out = (float*)d_out; a.ws = (unsigned char*)d_ws;
    for (int li = 0; li < N_LAUNCHES; ++li) {
        a.ph_lo = (N_LAUNCHES == 1) ? 0 : li; a.ph_hi = (N_LAUNCHES == 1) ? N_PHASES : li + 1; a.li = li; a.pad = 0;
        hipLaunchKernelGGL(fwd, dim3(grid), dim3(NWAVES * 64), LDS_BYTES, stream, a);
    }
}
```

```cpp
#include <hip/hip_runtime.h>
#include <cstdio>
#include <cstdint>
namespace pg8 {
#define PG8_LAS __attribute__((address_space(3)))
typedef unsigned short bf16_t;
typedef short bf16x8 __attribute__((ext_vector_type(8)));
typedef float f32x4 __attribute__((ext_vector_type(4)));
typedef unsigned u32x4 __attribute__((ext_vector_type(4)));
typedef int v4i32_t __attribute__((ext_vector_type(4)));
typedef int v8i32_t __attribute__((ext_vector_type(8)));
constexpr int BM = 256, BK = 64, HALF = 128, HTB = HALF * BK * 2  , STAGE_BYTES = 8 * HTB, NXCD = 8, WGM = 8;

__host__ __device__ __forceinline__ int lds_byte(int r, int c) { const int st = (r >> 4) * 2 + (c >> 5), rr = r & 15, cc = c & 31, ob = rr * 64 + cc * 2; return st * 1024 + (ob ^ (((ob >> 9) & 1) << 5)); }
__host__ __device__ __forceinline__ void stage_rc(int b, int& R, int& C) { const int st = b / 1024, sb = b % 1024, swz = sb ^ (((sb >> 9) & 1) << 5); R = (st >> 1) * 16 + swz / 64; C = (st & 1) * 32 + (swz % 64) / 2; }
__host__ __device__ __forceinline__ int perm32(int rho) { const int n = rho >> 4, i = rho & 15; return 8 * (i >> 2) + 4 * n + (i & 3); }

struct Unit { int pm, pn; };
struct Gemm { const bf16_t* A; const bf16_t* Bt; int M, N, K; };

struct StaticOrder {
    int nM, nN, nwg, G, c;
    __host__ __device__ void init(int M, int N, int G_, int c_) { nM = M / BM; nN = N / BM; nwg = nM * nN; G = G_; c = c_; }
    __host__ __device__ bool next(int i, Unit& u) const {
        const long L = (long)i * G + c; if (L >= nwg) return false;
        int wgid = (int)L; { const int q = nwg / NXCD, r = nwg % NXCD, xcd = wgid % NXCD, off = wgid / NXCD; wgid = (xcd < r ? xcd * (q + 1) : r * (q + 1) + (xcd - r) * q) + off; }
        const int nig = WGM * nN, gid = wgid / nig, fm = gid * WGM, gsz = (nM - fm) < WGM ? (nM - fm) : WGM;
        u.pm = fm + ((wgid % nig) % gsz); u.pn = (wgid % nig) / gsz; return true;
    }
    __device__ __forceinline__ void a_ready(const Unit&) const {}
    __device__ __forceinline__ void done(const Unit&) const {}
};

__device__ __forceinline__ unsigned cvt_pk_bf16(float lo, float hi) { unsigned r; asm volatile("v_cvt_pk_bf16_f32 %0, %1, %2" : "=v"(r) : "v"(lo), "v"(hi)); return r; }
typedef float f32x2 __attribute__((ext_vector_type(2)));

template <class Epi, class Sched, bool ALIGN_EPI = false, bool SP2 = false, bool STRIDED_A = false, bool I8 = false>
__device__ __forceinline__ void gemm_phase(PG8_LAS unsigned char* lds, const Gemm g, const Sched& S, const Epi& E) {
    const int tid = threadIdx.x, wid = __builtin_amdgcn_readfirstlane(tid >> 6), lane = tid & 63, wr = wid >> 2, wc = wid & 3, fr = lane & 15, fq = lane >> 4;
    const int K = g.K; int nt = K / BK;
    if constexpr (I8) asm volatile("" : "+s"(nt));
    unsigned voffA[2], voffB[2];
#pragma unroll
    for (int i = 0; i < 2; ++i) { int R, C; stage_rc(tid * 16 + i * 8192, R, C); const int Rb = Epi::PERM ? ((R & ~31) + perm32(R & 31)) : R;
        voffA[i] = (unsigned)(R * K + C) * 2u; voffB[i] = (unsigned)(Rb * K + C) * 2u; }
    unsigned rkA = 0, c2A = 0; const unsigned rk64 = 64u * (unsigned)K * 2u;
    if constexpr (STRIDED_A) { int R, C; stage_rc(tid * 16, R, C); rkA = (unsigned)(R * K) * 2u; c2A = (unsigned)C * 2u; }
    const size_t kstep = (size_t)(BK * 2);
    const size_t hstep = (size_t)HALF * K * 2;
    const size_t tstep = 2 * hstep;
    const unsigned ldsw = (unsigned)wid * 1024u;
    const int aoff = lds_byte(wr * 64 + fr, fq * 8), boff = lds_byte(wc * 32 + fr, fq * 8);
#define PG8_SA(b, h) (((b) * 2 + (h)) * HTB)
#define PG8_SB(b, h) ((4 + (b) * 2 + (h)) * HTB)
#define PG8_STAGE(bufoff, gbase, voff) do { _Pragma("unroll") for (int _i = 0; _i < 2; ++_i) \
        __builtin_amdgcn_global_load_lds((const unsigned*)((const char*)(gbase) + (voff)[_i]), (PG8_LAS unsigned*)(lds + (bufoff) + ldsw + _i * 8192), 16, 0, 0); } while (0)
#define PG8_STAGE_A(bufoff, gbase, sh) do { if constexpr (STRIDED_A) { _Pragma("unroll") for (int _i = 0; _i < 2; ++_i) { const unsigned _vo = ((rkA + _i * rk64) << (sh)) + c2A; \
        __builtin_amdgcn_global_load_lds((const unsigned*)((const char*)(gbase) + _vo), (PG8_LAS unsigned*)(lds + (bufoff) + ldsw + _i * 8192), 16, 0, 0); } } else { PG8_STAGE(bufoff, gbase, voffA); } } while (0)
#define PG8_LDA(dst, b, h) do { _Pragma("unroll") for (int m = 0; m < 4; ++m) _Pragma("unroll") for (int k = 0; k < 2; ++k) dst[m][k] = *(const PG8_LAS bf16x8*)(lds + PG8_SA(b, h) + aoff + m * 2048 + k * 1024); } while (0)
#define PG8_LDB(dst, b, h) do { _Pragma("unroll") for (int n = 0; n < 2; ++n) _Pragma("unroll") for (int k = 0; k < 2; ++k) dst[n][k] = *(const PG8_LAS bf16x8*)(lds + PG8_SB(b, h) + boff + n * 2048 + k * 1024); } while (0)
#define PG8_MMA(ai, bj, At, Bt) do { __builtin_amdgcn_s_setprio(1); _Pragma("unroll") for (int m = 0; m < 4; ++m) _Pragma("unroll") for (int n = 0; n < 2; ++n) _Pragma("unroll") for (int k = 0; k < 2; ++k) \
        { if constexpr (I8) acc[ai][bj][m][n] = __builtin_bit_cast(f32x4, __builtin_amdgcn_mfma_i32_16x16x64_i8(__builtin_bit_cast(v4i32_t, Bt[n][k]), __builtin_bit_cast(v4i32_t, At[m][k]), __builtin_bit_cast(v4i32_t, acc[ai][bj][m][n]), 0, 0, 0)); \
          else acc[ai][bj][m][n] = __builtin_amdgcn_mfma_f32_16x16x32_bf16(Bt[n][k], At[m][k], acc[ai][bj][m][n], 0, 0, 0); } __builtin_amdgcn_s_setprio(0); } while (0)
#define PG8_WAIT_V(n) asm volatile("s_waitcnt vmcnt(" #n ")" ::: "memory")
#define PG8_WAIT_L(n) asm volatile("s_waitcnt lgkmcnt(" #n ")" ::: "memory")
#define PG8_BAR __builtin_amdgcn_s_barrier()
#define PG8_SCHED __builtin_amdgcn_sched_barrier(0)
    Unit cur, nxt; int ui = 0;
    if (!S.next(0, cur)) return;
    f32x4 acc[2][2][4][2];
#pragma unroll
    for (int a = 0; a < 2; ++a)
#pragma unroll
        for (int b = 0; b < 2; ++b)
#pragma unroll
            for (int m = 0; m < 4; ++m)
#pragma unroll
                for (int n = 0; n < 2; ++n) acc[a][b][m][n] = (f32x4){0.f, 0.f, 0.f, 0.f};
    bf16x8 At[4][2], B0[2][2], B1[2][2];
    int csh = 0, nsh = 0;
    const char* cA; if constexpr (STRIDED_A) cA = S.a_base(cur, csh); else cA = (const char*)g.A + (size_t)cur.pm * tstep;
    const char* cB = (const char*)g.Bt + (size_t)cur.pn * tstep;
    S.a_ready(cur);
    if constexpr (SP2) {
        PG8_STAGE(PG8_SB(0, 0), cB, voffB); PG8_STAGE(PG8_SB(0, 1), cB + hstep, voffB); PG8_STAGE_A(PG8_SA(0, 0), cA, csh); PG8_STAGE_A(PG8_SA(0, 1), cA + (hstep << csh), csh);
        if (wr == 1) PG8_BAR;
        PG8_WAIT_V(2); PG8_BAR;
        PG8_STAGE(PG8_SB(1, 0), cB + kstep, voffB); PG8_STAGE_A(PG8_SA(1, 0), cA + kstep, csh); PG8_STAGE(PG8_SB(1, 1), cB + hstep + kstep, voffB);
        PG8_WAIT_V(6); PG8_BAR;
    } else {
        PG8_STAGE(PG8_SB(0, 0), cB, voffB); PG8_STAGE_A(PG8_SA(0, 0), cA, csh); PG8_STAGE(PG8_SB(0, 1), cB + hstep, voffB); PG8_STAGE_A(PG8_SA(0, 1), cA + (hstep << csh), csh);
        if (wr == 1) PG8_BAR;
        PG8_WAIT_V(4); PG8_BAR;
        PG8_STAGE(PG8_SB(1, 0), cB + kstep, voffB); PG8_STAGE_A(PG8_SA(1, 0), cA + kstep, csh); PG8_STAGE(PG8_SB(1, 1), cB + hstep + kstep, voffB);
        PG8_WAIT_V(6); PG8_BAR;
    }
    asm volatile(".p2align 8" ::: "memory");
    for (;;) {
        const bool has_next = S.next(ui + 1, nxt);
        const char* nA; if constexpr (STRIDED_A) { nsh = csh; nA = has_next ? S.a_base(nxt, nsh) : cA; } else nA = has_next ? (const char*)g.A + (size_t)nxt.pm * tstep : cA;
        const char* nB = has_next ? (const char*)g.Bt + (size_t)nxt.pn * tstep : cB;
        for (int t = 0; t < nt; t += 2) {
            const bool last = (t == nt - 2);
            const char* a1 = cA + (size_t)(t + 1) * kstep;
            const char* a2 = last ? nA : cA + (size_t)(t + 2) * kstep; const char* b2 = last ? nB : cB + (size_t)(t + 2) * kstep;
            const char* a3 = a2 + kstep; const char* b3 = b2 + kstep;
            const int sh2 = last ? nsh : csh; const size_t hA1 = hstep << csh, hA2 = hstep << sh2;
            if (last && has_next) S.a_ready(nxt);
            if constexpr (SP2) {
            PG8_LDB(B0, 0, 0); PG8_LDB(B1, 0, 1); PG8_SCHED; PG8_LDA(At, 0, 0); PG8_STAGE_A(PG8_SA(1, 1), a1 + hA1, csh);
            PG8_WAIT_V(8); PG8_WAIT_L(0); PG8_BAR; PG8_MMA(0, 0, At, B0); PG8_MMA(0, 1, At, B1); PG8_BAR; PG8_SCHED;
            PG8_LDA(At, 0, 1); PG8_STAGE(PG8_SB(0, 0), b2, voffB); PG8_STAGE(PG8_SB(0, 1), b2 + hstep, voffB); PG8_STAGE_A(PG8_SA(0, 0), a2, sh2);
            PG8_WAIT_V(8); PG8_WAIT_L(0); PG8_BAR; PG8_MMA(1, 0, At, B0); PG8_MMA(1, 1, At, B1); PG8_BAR; PG8_SCHED;
            PG8_LDB(B0, 1, 0); PG8_LDB(B1, 1, 1); PG8_SCHED; PG8_LDA(At, 1, 0); PG8_STAGE_A(PG8_SA(0, 1), a2 + hA2, sh2);
            PG8_WAIT_V(8); PG8_WAIT_L(0); PG8_BAR; PG8_MMA(0, 0, At, B0); PG8_MMA(0, 1, At, B1); PG8_BAR; PG8_SCHED;
            PG8_LDA(At, 1, 1); PG8_STAGE(PG8_SB(1, 0), b3, voffB); PG8_STAGE(PG8_SB(1, 1), b3 + hstep, voffB); PG8_STAGE_A(PG8_SA(1, 0), a3, sh2);
            PG8_WAIT_V(8); PG8_WAIT_L(0); PG8_BAR; PG8_MMA(1, 0, At, B0); PG8_MMA(1, 1, At, B1); PG8_BAR; PG8_SCHED;
            } else {
            PG8_LDB(B0, 0, 0); PG8_SCHED; PG8_LDA(At, 0, 0); PG8_STAGE_A(PG8_SA(1, 1), a1 + hA1, csh);
            PG8_WAIT_L(8); PG8_BAR; PG8_WAIT_L(0); PG8_MMA(0, 0, At, B0); PG8_BAR; PG8_SCHED;
            PG8_LDB(B1, 0, 1); PG8_STAGE(PG8_SB(0, 0), b2, voffB);
            PG8_BAR; PG8_WAIT_L(0); PG8_MMA(0, 1, At, B1); PG8_BAR;
            PG8_LDA(At, 0, 1); PG8_STAGE_A(PG8_SA(0, 0), a2, sh2);
            PG8_BAR; PG8_WAIT_L(0); PG8_MMA(1, 0, At, B0); PG8_BAR; PG8_SCHED;
            PG8_STAGE(PG8_SB(0, 1), b2 + hstep, voffB);
            PG8_WAIT_V(6); PG8_BAR; PG8_MMA(1, 1, At, B1); PG8_BAR;
            PG8_LDB(B0, 1, 0); PG8_SCHED; PG8_LDA(At, 1, 0); PG8_STAGE_A(PG8_SA(0, 1), a2 + hA2, sh2);
            PG8_WAIT_L(8); PG8_BAR; PG8_WAIT_L(0); PG8_MMA(0, 0, At, B0); PG8_BAR; PG8_SCHED;
            PG8_LDB(B1, 1, 1); PG8_STAGE(PG8_SB(1, 0), b3, voffB);
            PG8_BAR; PG8_WAIT_L(0); PG8_MMA(0, 1, At, B1); PG8_BAR;
            PG8_LDA(At, 1, 1); PG8_STAGE_A(PG8_SA(1, 0), a3, sh2);
            PG8_BAR; PG8_WAIT_L(0); PG8_MMA(1, 0, At, B0); PG8_BAR; PG8_SCHED;
            PG8_STAGE(PG8_SB(1, 1), b3 + hstep, voffB);
            PG8_WAIT_V(6); PG8_BAR; PG8_MMA(1, 1, At, B1); PG8_BAR;
            }
        }
        if constexpr (ALIGN_EPI) { if (wr == 0) PG8_BAR; }
        if constexpr (I8) {
#pragma unroll
            for (int a = 0; a < 2; ++a)
#pragma unroll
                for (int b = 0; b < 2; ++b)
#pragma unroll
                    for (int m = 0; m < 4; ++m)
#pragma unroll
                        for (int n = 0; n < 2; ++n) { const v4i32_t iv = __builtin_bit_cast(v4i32_t, acc[a][b][m][n]); acc[a][b][m][n] = (f32x4){(float)iv[0], (float)iv[1], (float)iv[2], (float)iv[3]}; }
        }
        if constexpr (!Epi::AFTER_DRAIN) { E(acc, cur, wr, wc, fr, fq); S.done(cur); }
        if (!has_next) break;
#pragma unroll
        for (int a = 0; a < 2; ++a)
#pragma unroll
            for (int b = 0; b < 2; ++b)
#pragma unroll
                for (int m = 0; m < 4; ++m)
#pragma unroll
                    for (int n = 0; n < 2; ++n) acc[a][b][m][n] = (f32x4){0.f, 0.f, 0.f, 0.f};
        cur = nxt; cA = nA; cB = nB; csh = nsh; ++ui;
        if constexpr (ALIGN_EPI) { if (wr == 1) PG8_BAR; }
    }
    PG8_WAIT_V(0);
    if constexpr (!ALIGN_EPI) { if (wr == 0) PG8_BAR; }
    PG8_BAR;
    if constexpr (Epi::AFTER_DRAIN) { E.fused(acc, cur, wr, wc, fr, fq, lds, wid, lane); S.done(cur); }
#undef PG8_SA
#undef PG8_SB
#undef PG8_STAGE
#undef PG8_STAGE_A
#undef PG8_LDA
#undef PG8_LDB
#undef PG8_MMA
#undef PG8_WAIT_V
#undef PG8_WAIT_L
#undef PG8_BAR
#undef PG8_SCHED
}
}

#define GAS __attribute__((address_space(1)))
#define LAS __attribute__((address_space(3)))
typedef unsigned short bf16;
typedef unsigned v4u __attribute__((ext_vector_type(4)));
typedef float f32x4 __attribute__((ext_vector_type(4)));
typedef short bf16x8 __attribute__((ext_vector_type(8)));
typedef GAS unsigned gu32;
typedef GAS unsigned long long gu64;
#define RLX_AGENT __ATOMIC_RELAXED, __HIP_MEMORY_SCOPE_AGENT
#define LDS_WAIT() asm volatile("s_waitcnt lgkmcnt(0)" ::: "memory")
#define VM_WAIT() asm volatile("s_waitcnt vmcnt(0)" ::: "memory")
__device__ __forceinline__ unsigned long long rt() { return __builtin_amdgcn_s_memrealtime(); }
__device__ __forceinline__ unsigned f2bf(float f) { unsigned u = __builtin_bit_cast(unsigned, f); return (u + 0x7fffu + ((u >> 16) & 1u)) >> 16; }
__device__ __forceinline__ unsigned pk2(float lo, float hi) { return f2bf(lo) | (f2bf(hi) << 16); }

#define XB_TMO      128
#define XB_XCNT(j)  (256  + 64 * (j))
#define XB_XSUB(j)  (1280 + 64 * (j))
#define XB_XGEN(j)  (2304 + 64 * (j))
#define XB_TOP      3328
#define XB_TOPGEN   3392
#define XCD_BAR_WORDS 3456
#define XB_SPIN_CAP (1u << 18)

__device__ __forceinline__ unsigned xb_ld(unsigned* p)              { return __hip_atomic_load(p, __ATOMIC_RELAXED, __HIP_MEMORY_SCOPE_AGENT); }
__device__ __forceinline__ unsigned xb_add(unsigned* p, unsigned v) { return __hip_atomic_fetch_add(p, v, __ATOMIC_RELAXED, __HIP_MEMORY_SCOPE_AGENT); }
__device__ __forceinline__ unsigned xb_xcc_id() { return (unsigned)__builtin_amdgcn_s_getreg((3 << 11) | 20) & 0xFu; }
#define XB_SPIN(cond, bar) do { unsigned _sp = 0; while (cond) { __builtin_amdgcn_s_sleep(1); \
    if ((++_sp & 255u) == 0u) { if (xb_ld(&(bar)[XB_TMO])) break; if (_sp > XB_SPIN_CAP) { atomicAdd(&(bar)[XB_TMO], 1u); break; } } } } while (0)

struct XcdBarrier {
    unsigned* bar; unsigned x;
    volatile LAS unsigned* st;
};

__device__ __forceinline__ XcdBarrier xcd_barrier_post(unsigned* bar, volatile LAS unsigned* st) {
    XcdBarrier b; b.bar = bar; b.x = xb_xcc_id(); b.st = st;
    if (threadIdx.x == 0) (void)xb_add(&bar[XB_XCNT(b.x)], 1u);
    return b;
}
__device__ __forceinline__ void xcd_barrier_complete(unsigned* bar, unsigned x, unsigned& nloc, unsigned& nx) {
    const unsigned G = gridDim.x * gridDim.y * gridDim.z;
    unsigned sum, cnt, mine, sp = 0u;
    for (;;) {
        sum = 0u; cnt = 0u; mine = 0u;
#pragma unroll
        for (unsigned j = 0; j < 16; ++j) { const unsigned c = xb_ld(&bar[XB_XCNT(j)]); sum += c; cnt += (c > 0u) ? 1u : 0u; mine = (j == x) ? c : mine; }
        if (sum == G) break;
        __builtin_amdgcn_s_sleep(1);
        if ((++sp & 255u) == 0u) { if (xb_ld(&bar[XB_TMO])) break; if (sp > XB_SPIN_CAP) { atomicAdd(&bar[XB_TMO], 1u); break; } }
    }
    nloc = mine > 0u ? mine : 1u; nx = cnt > 0u ? cnt : 1u;
}

__device__ __forceinline__ void xcd_barrier(const XcdBarrier& b) {
    asm volatile("s_waitcnt vmcnt(0)" ::: "memory");
    __syncthreads();
    if (threadIdx.x == 0) {
        unsigned* bar = b.bar;
        __builtin_amdgcn_s_waitcnt(0);
        unsigned nloc = b.st[0], nx = b.st[1];
        if (nloc == 0u) { xcd_barrier_complete(bar, b.x, nloc, nx); b.st[0] = nloc; b.st[1] = nx; }
        const unsigned old = xb_add(&bar[XB_XSUB(b.x)], 1u);
        const unsigned gen = old / nloc;
        if (old + 1u == (gen + 1u) * nloc) {
            __builtin_amdgcn_fence(__ATOMIC_RELEASE, "agent");
            asm volatile("s_waitcnt vmcnt(0)" ::: "memory");
            const unsigned og = xb_add(&bar[XB_TOP], 1u);
            const unsigned tg = og / nx;
            if (og + 1u == (tg + 1u) * nx) xb_add(&bar[XB_TOPGEN], 1u);
            else XB_SPIN(xb_ld(&bar[XB_TOPGEN]) == tg, bar);
            __builtin_amdgcn_fence(__ATOMIC_ACQUIRE, "agent");
            xb_add(&bar[XB_XGEN(b.x)], 1u);
            asm volatile("s_waitcnt vmcnt(0)" ::: "memory");
        } else {
            XB_SPIN(xb_ld(&bar[XB_XGEN(b.x)]) == gen, bar);
            __builtin_amdgcn_fence(__ATOMIC_ACQUIRE, "agent");
            asm volatile("s_waitcnt vmcnt(0)" ::: "memory");
        }
    }
    __syncthreads();
}


constexpr int NWAVES = 8;
#ifndef MK_N_LAUNCHES
#define MK_N_LAUNCHES 1
#endif
constexpr int N_PHASES = 11;
constexpr int N_LAUNCHES = MK_N_LAUNCHES;
constexpr int BATCH = 2, SEQ = 8192, T = BATCH * SEQ, D = 1024;
constexpr int DIN = 9728, NQKV = 4608, NCG = 5120, GW = 512, DAO = 512;
constexpr int NP1 = NQKV + 512;
constexpr int NEXP = 16384, PEER_H = 8, PEER_K = 16, HK = 128;
constexpr float RMS_EPS = 1e-6f;
constexpr float C2 = 0.125f * 1.4426950408889634f;
constexpr float LN2 = 0.6931471805599453f;

constexpr size_t MiB = 1u << 20;
constexpr size_t WS_CTL = 0, CTL_ZERO_BYTES = 64 * 1024;
constexpr size_t WS_ROPE = 1 * MiB, WS_RSQ = 2 * MiB, WS_LSE = 3 * MiB;
constexpr size_t WS_U8 = 24 * MiB, WS_WQKV8 = 5 * MiB, WS_SU = 15 * MiB, WS_SW = 15 * MiB + 65536;
constexpr size_t WS_Q = 56 * MiB, WS_K = 104 * MiB, WS_V = 152 * MiB, WS_O = 200 * MiB;
constexpr size_t WS_Z = 136 * MiB, WS_SGC = 168 * MiB, WS_SGA = 216 * MiB;
constexpr size_t OS_BB = 0, OS_EDOWN = 32 * MiB, OS_WFOLD = 48 * MiB;
constexpr size_t WS_WCONV = 248 * MiB, WS_WATTN = 250 * MiB, WS_WOUT = 251 * MiB;
constexpr size_t WS_EUP = 104 * MiB, WS_ESCALE = 253 * MiB;
constexpr size_t WS_Y = 136 * MiB, WS_H = 168 * MiB, WS_HG = 24 * MiB;
constexpr size_t WS_IDX = 9 * MiB, WS_GATE = 120 * MiB, WS_WB = 56 * MiB, WS_SS = 64 * MiB, WS_HG8 = 65 * MiB, WS_HSC = 81 * MiB;
constexpr size_t WS_SCR0 = 136 * MiB, WS_SCR1 = 88 * MiB, WS_SCR2 = 232 * MiB;
constexpr size_t WS_END = 256 * MiB;
constexpr int CW_TMO = 0, CW_BAR = 1024, CW_RANK = 8192;

constexpr int RING_BYTES = 131072, MISC_OFF = RING_BYTES + 320, LDS_BYTES = 147456;

using pg8::Unit; using pg8::Gemm; using pg8::StaticOrder; using pg8::gemm_phase; using pg8::cvt_pk_bf16;
typedef unsigned short bf16;
typedef unsigned u32x4 __attribute__((ext_vector_type(4)));
typedef unsigned u32x2 __attribute__((ext_vector_type(2)));
typedef float f32x4 __attribute__((ext_vector_type(4)));
typedef float f32x2 __attribute__((ext_vector_type(2)));
typedef short bf16x8 __attribute__((ext_vector_type(8)));
typedef short s16x4 __attribute__((ext_vector_type(4)));
typedef short v4i16_t __attribute__((ext_vector_type(4)));
#define LAS __attribute__((address_space(3)))

__device__ __forceinline__ float bf_lo(unsigned w) { return __builtin_bit_cast(float, w << 16); }
__device__ __forceinline__ float bf_hi(unsigned w) { return __builtin_bit_cast(float, w & 0xffff0000u); }
__device__ __forceinline__ u32x4 pack8(f32x4 a, f32x4 b) { u32x4 w; w.x = cvt_pk_bf16(a[0], a[1]); w.y = cvt_pk_bf16(a[2], a[3]); w.z = cvt_pk_bf16(b[0], b[1]); w.w = cvt_pk_bf16(b[2], b[3]); return w; }
__device__ __forceinline__ void unpack8(u32x4 w, f32x4& a, f32x4& b) { a = (f32x4){bf_lo(w.x), bf_hi(w.x), bf_lo(w.y), bf_hi(w.y)}; b = (f32x4){bf_lo(w.z), bf_hi(w.z), bf_lo(w.w), bf_hi(w.w)}; }
__device__ __forceinline__ float wave_sum(float v) {
#pragma unroll
    for (int o = 1; o < 64; o <<= 1) v += __shfl_xor(v, o);
    return v;
}
__device__ __forceinline__ unsigned pack4i8(f32x4 v) { const int a = (int)__builtin_rintf(v[0]), b = (int)__builtin_rintf(v[1]), c = (int)__builtin_rintf(v[2]), d = (int)__builtin_rintf(v[3]); return (unsigned)(a & 255) | ((unsigned)(b & 255) << 8) | ((unsigned)(c & 255) << 16) | ((unsigned)d << 24); }
__device__ __forceinline__ f32x4 unpack4u8(unsigned w) { return (f32x4){(float)(w & 255u), (float)((w >> 8) & 255u), (float)((w >> 16) & 255u), (float)(w >> 24)} * (1.f / 255.f); }
__device__ __forceinline__ float xor16(float v, int fq) {
    const unsigned x = __builtin_bit_cast(unsigned, v);
    const auto r = __builtin_amdgcn_permlane16_swap(x, x, false, false);
    const unsigned a = r[0], b = r[1];
    return __builtin_bit_cast(float, (fq & 1) ? a : b);
}
__device__ __forceinline__ float sigmoidf_(float x) { return 1.f / (1.f + __expf(-x)); }

struct QkvOrder : StaticOrder {
    const char* U;
    __device__ __forceinline__ const char* a_base(const Unit& u, int& sh) const {
        const int g = (u.pn < 18) ? u.pn / 6 : 0; sh = 2 * g;
        const int b = u.pm >> 5, lp0 = (u.pm & 31) * 256;
        const int r = lp0 >> (13 - sh), i0 = lp0 & ((SEQ >> sh) - 1);
        const int t0 = b * SEQ + (i0 << sh) + r;
        return U + (size_t)t0 * D;
    }
};
struct EpiQKV {
    static constexpr bool PERM = true, AFTER_DRAIN = false;
    bf16* Q; const float* rope; const float* su; const float* sw; unsigned char* SGA; const float* gbias1;
    __device__ __forceinline__ void operator()(const f32x4 (&acc)[2][2][4][2], const Unit& u, int wr, int wc, int fr, int fq) const {
        if (u.pn >= 18) {
#pragma unroll
            for (int ai = 0; ai < 2; ++ai)
#pragma unroll
                for (int m = 0; m < 4; ++m) { const size_t row = (size_t)u.pm * 256 + ai * 128 + wr * 64 + m * 16 + fr; const float sr = su[row];
#pragma unroll
                    for (int bj = 0; bj < 2; ++bj) { const int col = 512 + (u.pn - 18) * 256 + bj * 128 + wc * 32 + fq * 8;
                        const f32x4 b0 = *(const f32x4*)(gbias1 + col), b1 = *(const f32x4*)(gbias1 + col + 4);
                        const int wcol = u.pn * 256 + bj * 128 + wc * 32 + fq * 8;
                        f32x4 v0 = acc[ai][bj][m][0] * (*(const f32x4*)(sw + wcol) * sr) + b0, v1 = acc[ai][bj][m][1] * (*(const f32x4*)(sw + wcol + 4) * sr) + b1;
#pragma unroll
                        for (int e = 0; e < 4; ++e) { v0[e] = sigmoidf_(v0[e]) * 255.f; v1[e] = sigmoidf_(v1[e]) * 255.f; }
                        u32x2 g8; g8.x = pack4i8(v0); g8.y = pack4i8(v1);
                        *(u32x2*)(SGA + row * D + col) = g8; } }
            return;
        }
        asm volatile("" : "+v"(fr), "+v"(fq));
        const int g = u.pn / 6, kind = (u.pn % 6) >> 1, half = u.pn & 1, sh = 2 * g;
        bf16* base = Q + (size_t)kind * ((WS_K - WS_Q) / 2) + (size_t)g * T * GW;
        const int b = u.pm >> 5, lp0 = (u.pm & 31) * 256;
        const bool rot = (kind < 2) && ((wc & 1) == 0);
        const float sc = (kind == 0) ? C2 : 1.f;
        f32x4 swv[2][2];
#pragma unroll
        for (int bj = 0; bj < 2; ++bj) { const int wcol = u.pn * 256 + bj * 128 + wc * 32 + fq * 8; swv[bj][0] = *(const f32x4*)(sw + wcol) * sc; swv[bj][1] = *(const f32x4*)(sw + wcol + 4) * sc; }
        const float sgn = (fq == 0) ? -1.f : 1.f; const bool use = fq < 2;
#pragma unroll
        for (int ai = 0; ai < 2; ++ai)
#pragma unroll
            for (int m = 0; m < 4; ++m) {
                const int rl = ai * 128 + wr * 64 + m * 16 + fr, lp = lp0 + rl;
                const int tok = b * SEQ + ((lp & ((SEQ >> sh) - 1)) << sh) + (lp >> (13 - sh));
                const float sut = su[tok];
                f32x4 c0 = {1.f, 1.f, 1.f, 1.f}, c1 = c0, s0 = {0.f, 0.f, 0.f, 0.f}, s1 = s0;
                if (rot) { const f32x4* rp = (const f32x4*)(rope + (size_t)tok * 16); c0 = rp[0]; c1 = rp[1]; s0 = rp[2]; s1 = rp[3]; }
                bf16* rowp = base + (size_t)(u.pm * 256 + rl) * GW + half * 256 + wc * 32 + fq * 8;
#pragma unroll
                for (int bj = 0; bj < 2; ++bj) {
                    f32x4 v0 = acc[ai][bj][m][0] * (swv[bj][0] * sut), v1 = acc[ai][bj][m][1] * (swv[bj][1] * sut);
                    if (rot) {
                        f32x4 o0, o1;
#pragma unroll
                        for (int e = 0; e < 4; ++e) { o0[e] = xor16(v0[e], fq); o1[e] = xor16(v1[e], fq); }
                        const f32x4 r0 = v0 * c0 + (o0 * s0) * sgn, r1 = v1 * c1 + (o1 * s1) * sgn;
                        v0 = use ? r0 : v0; v1 = use ? r1 : v1;
                    }
                    *(u32x4*)(rowp + bj * 128) = pack8(v0, v1);
                }
            }
    }
};
struct EpiCG {
    static constexpr bool PERM = true, AFTER_DRAIN = false;
    bf16* Bb; bf16* Z; unsigned char* SGC; unsigned char* SGA; const float* gbias; const float* su; const float* sw;
    __device__ __forceinline__ void operator()(const f32x4 (&accin)[2][2][4][2], const Unit& u, int wr, int wc, int fr, int fq) const {
        const int pn = u.pn;
        f32x4 swv[2][2];
#pragma unroll
        for (int bj = 0; bj < 2; ++bj) { const int wcol = NP1 + pn * 256 + bj * 128 + wc * 32 + fq * 8; swv[bj][0] = *(const f32x4*)(sw + wcol); swv[bj][1] = *(const f32x4*)(sw + wcol + 4); }
        f32x4 acc[2][2][4][2];
#pragma unroll
        for (int ai = 0; ai < 2; ++ai)
#pragma unroll
            for (int m = 0; m < 4; ++m) { const float sr = su[(size_t)u.pm * 256 + ai * 128 + wr * 64 + m * 16 + fr];
#pragma unroll
                for (int bj = 0; bj < 2; ++bj) { acc[ai][bj][m][0] = accin[ai][bj][m][0] * (swv[bj][0] * sr); acc[ai][bj][m][1] = accin[ai][bj][m][1] * (swv[bj][1] * sr); } }
#pragma unroll
        for (int ai = 0; ai < 2; ++ai)
#pragma unroll
            for (int m = 0; m < 4; ++m) {
                const size_t row = (size_t)u.pm * 256 + ai * 128 + wr * 64 + m * 16 + fr;
                if (pn < 4) {
#pragma unroll
                    for (int bj = 0; bj < 2; ++bj) *(u32x4*)(Bb + row * D + pn * 256 + bj * 128 + wc * 32 + fq * 8) = pack8(acc[ai][bj][m][0], acc[ai][bj][m][1]);
                } else if (pn < 12) {
                    const f32x4 z0 = acc[ai][0][m][0] * acc[ai][1][m][0], z1 = acc[ai][0][m][1] * acc[ai][1][m][1];
                    *(u32x4*)(Z + row * D + (pn - 4) * 128 + wc * 32 + fq * 8) = pack8(z0, z1);
                } else {
                    const int gsel = (pn >= 16) ? 1 : 0; unsigned char* out = gsel ? SGA : SGC;
#pragma unroll
                    for (int bj = 0; bj < 2; ++bj) {
                        const int col = (pn - 12 - 4 * gsel) * 256 + bj * 128 + wc * 32 + fq * 8;
                        const f32x4 b0 = *(const f32x4*)(gbias + gsel * D + col), b1 = *(const f32x4*)(gbias + gsel * D + col + 4);
                        f32x4 v0 = acc[ai][bj][m][0] + b0, v1 = acc[ai][bj][m][1] + b1;
#pragma unroll
                        for (int e = 0; e < 4; ++e) { v0[e] = sigmoidf_(v0[e]) * 255.f; v1[e] = sigmoidf_(v1[e]) * 255.f; }
                        u32x2 g8; g8.x = pack4i8(v0); g8.y = pack4i8(v1);
                        *(u32x2*)(out + row * D + col) = g8;
                    }
                }
            }
    }
};
template <int MODE> struct EpiY {
    static constexpr bool PERM = true, AFTER_DRAIN = false;
    bf16* Y; const unsigned char* G;
    __device__ __forceinline__ void operator()(const f32x4 (&acc)[2][2][4][2], const Unit& u, int wr, int wc, int fr, int fq) const {
#pragma unroll
        for (int ai = 0; ai < 2; ++ai)
#pragma unroll
            for (int m = 0; m < 4; ++m) {
                const size_t row = (size_t)u.pm * 256 + ai * 128 + wr * 64 + m * 16 + fr;
#pragma unroll
                for (int bj = 0; bj < 2; ++bj) {
                    const size_t off = row * D + u.pn * 256 + bj * 128 + wc * 32 + fq * 8;
                    const u32x2 g8 = *(const u32x2*)(G + off);
                    const f32x4 g0 = unpack4u8(g8.x), g1 = unpack4u8(g8.y);
                    f32x4 v0 = acc[ai][bj][m][0] * g0, v1 = acc[ai][bj][m][1] * g1;
                    if (MODE == 1) { f32x4 y0, y1; unpack8(*(const u32x4*)(Y + off), y0, y1); v0 = v0 + y0; v1 = v1 + y1; }
                    *(u32x4*)(Y + off) = pack8(v0, v1);
                }
            }
    }
};
struct EpiOut {
    static constexpr bool PERM = true, AFTER_DRAIN = false;
    const float* X; bf16* HG; const float* nffn; float* RSQ; unsigned char* HG8; float* HSC;
    __device__ __forceinline__ void operator()(const f32x4 (&acc)[2][2][4][2], const Unit& u, int wr, int wc, int fr, int fq) const {
#pragma unroll
        for (int ai = 0; ai < 2; ++ai)
#pragma unroll
            for (int m = 0; m < 4; ++m) {
                const size_t row = (size_t)u.pm * 256 + ai * 128 + wr * 64 + m * 16 + fr;
                float ss = 0.f;
#pragma unroll
                for (int bj = 0; bj < 2; ++bj) {
                    const int col = u.pn * 256 + bj * 128 + wc * 32 + fq * 8; const size_t off = row * D + col;
                    const f32x4 h0 = *(const f32x4*)(X + off) + acc[ai][bj][m][0], h1 = *(const f32x4*)(X + off + 4) + acc[ai][bj][m][1];
                    const f32x4 n0 = *(const f32x4*)(nffn + col), n1 = *(const f32x4*)(nffn + col + 4);
                    const f32x4 y0 = h0 * n0, y1 = h1 * n1;
                    *(u32x4*)(HG + off) = pack8(y0, y1);
                    float am = fmaxf(fmaxf(fmaxf(fabsf(y0[0]), fabsf(y0[1])), fmaxf(fabsf(y0[2]), fabsf(y0[3]))), fmaxf(fmaxf(fabsf(y1[0]), fabsf(y1[1])), fmaxf(fabsf(y1[2]), fabsf(y1[3]))));
                    am = fmaxf(am, __shfl_xor(am, 16)); am = fmaxf(am, __shfl_xor(am, 32));
                    const float qs = (am > 0.f) ? 127.f / am : 0.f;
                    u32x2 q8; q8.x = pack4i8(y0 * qs); q8.y = pack4i8(y1 * qs);
                    *(u32x2*)(HG8 + off) = q8;
                    if (fq == 0) HSC[row * 32 + u.pn * 8 + bj * 4 + wc] = am * (1.f / 127.f);
                    ss += (h0[0] * h0[0] + h0[1] * h0[1]) + (h0[2] * h0[2] + h0[3] * h0[3]) + (h1[0] * h1[0] + h1[1] * h1[1]) + (h1[2] * h1[2] + h1[3] * h1[3]);
                }
                ss += __shfl_xor(ss, 16); ss += __shfl_xor(ss, 32);
                if (fq == 0) RSQ[row * 16 + u.pn * 4 + wc] = ss;
            }
    }
};
struct CvCtx { const float* dn; const float* up; unsigned char* ed; unsigned char* eu; float* esc; int lane; };
__device__ __forceinline__ void cv_load(const CvCtx& C, int ru, f32x4 (&v)[4]) {
    const int tb = ru >> 14, e = ru & (NEXP - 1);
    const float* src = (tb ? C.up : C.dn) + (size_t)e * D + 16 * C.lane;
#pragma unroll
    for (int q = 0; q < 4; ++q) v[q] = *(const f32x4*)(src + 4 * q);
}
__device__ __forceinline__ void cv_finish(const CvCtx& C, int ru, const f32x4 (&v)[4]) {
    const int tb = ru >> 14, e = ru & (NEXP - 1);
    float am = 0.f;
#pragma unroll
    for (int q = 0; q < 4; ++q) am = fmaxf(am, fmaxf(fmaxf(fabsf(v[q][0]), fabsf(v[q][1])), fmaxf(fabsf(v[q][2]), fabsf(v[q][3]))));
#pragma unroll
    for (int o = 1; o < 64; o <<= 1) am = fmaxf(am, __shfl_xor(am, o));
    u32x4 w;
    if (tb) {
        const float sc = (am > 0.f) ? 256.f / am : 1.f;
#pragma unroll
        for (int q = 0; q < 4; ++q) { int d = __builtin_amdgcn_cvt_pk_fp8_f32(v[q][0] * sc, v[q][1] * sc, 0, false); d = __builtin_amdgcn_cvt_pk_fp8_f32(v[q][2] * sc, v[q][3] * sc, d, true); w[q] = (unsigned)d; }
        *(u32x4*)(C.eu + (size_t)(C.lane >> 3) * (2 * MiB) + (size_t)e * 128 + 16 * (C.lane & 7)) = w;
    } else {
        const float s8 = (am > 0.f) ? 127.f / am : 0.f;
#pragma unroll
        for (int q = 0; q < 4; ++q) w[q] = pack4i8(v[q] * s8);
        *(u32x4*)(C.ed + (size_t)e * 1024 + 16 * C.lane) = w;
    }
    if (C.lane == 0) C.esc[ru] = tb ? ((am > 0.f) ? am * (1.f / 256.f) : 1.f) : am * (1.f / 127.f);
}
__device__ __forceinline__ int f2key(float f) { const int b = __builtin_bit_cast(int, f); return b ^ ((b >> 31) & 0x7fffffff); }
__device__ __forceinline__ float key2f(int k) { return __builtin_bit_cast(float, k ^ ((k >> 31) & 0x7fffffff)); }
#define TOPK_INS(list, x) do { _Pragma("unroll") for (int _k = 0; _k < 16; ++_k) { const int _hi = max(list[_k], x); x = min(list[_k], x); list[_k] = _hi; } } while (0)
__device__ __forceinline__ unsigned long long pack8idx(const int (&a)[16], int o) { unsigned long long r = 0ull;
#pragma unroll
    for (int k = 0; k < 8; ++k) r |= (unsigned long long)(unsigned)(a[o + k] & 127) << (8 * k);
    return r; }
__device__ __forceinline__ int lut16(unsigned long long lo, unsigned long long hi, int i) { const unsigned long long w = (i < 8) ? lo : hi; return (int)((w >> ((i & 7) * 8)) & 127ull); }
__device__ __forceinline__ void sort16_asc(int (&x)[16]) {
#pragma unroll
    for (int k = 2; k <= 16; k <<= 1)
#pragma unroll
        for (int j = k >> 1; j > 0; j >>= 1)
#pragma unroll
            for (int i = 0; i < 16; ++i) { const int l = i ^ j; if (l > i) { const int lo = min(x[i], x[l]), hi = max(x[i], x[l]); const bool up = (i & k) == 0; x[i] = up ? lo : hi; x[l] = up ? hi : lo; } }
}
__device__ __forceinline__ void merge16(int (&r)[16], const int (&a)[16]) {
#pragma unroll
    for (int i = 0; i < 16; ++i) r[i] = max(r[i], a[i]);
#pragma unroll
    for (int j = 8; j > 0; j >>= 1)
#pragma unroll
        for (int i = 0; i < 16; ++i) { const int l = i ^ j; if (l > i) { const int lo = min(r[i], r[l]), hi = max(r[i], r[l]); r[i] = hi; r[l] = lo; } }
}
struct EpiTopk {
    static constexpr bool PERM = true, AFTER_DRAIN = false;
    float* scr; const float* RSQ; int* IDX; float* GATE; CvCtx CV; mutable int cvr; int cvstep;
    __device__ __forceinline__ void operator()(const f32x4 (&acc)[2][2][4][2], const Unit& u, int wr, int wc, int fr, int fq) const {
        const __amdgpu_buffer_rsrc_t rsrc = __builtin_amdgcn_make_buffer_rsrc(scr, 0, 262144, 0x00020000);
        const int voff = ((wc * 32 + fq * 8) * 256 + wr * 64 + fr) * 4;
#pragma unroll
        for (int ai = 0; ai < 2; ++ai)
#pragma unroll
            for (int m = 0; m < 4; ++m)
#pragma unroll
                for (int bj = 0; bj < 2; ++bj)
#pragma unroll
                    for (int n = 0; n < 2; ++n)
#pragma unroll
                        for (int e = 0; e < 4; ++e)
                        { const float val = acc[ai][bj][m][n][e]; __builtin_amdgcn_raw_buffer_store_b32(__builtin_bit_cast(unsigned, val), rsrc, voff, ((bj * 128 + n * 4 + e) * 256 + ai * 128 + m * 16) * 4, 0); }
        asm volatile("s_waitcnt vmcnt(0)" ::: "memory");
        __builtin_amdgcn_s_barrier();
        asm volatile("" ::: "memory");
        const int tid = threadIdx.x, row = tid >> 1, c = tid & 1;
        int v[16];
#pragma unroll
        for (int k = 0; k < 16; ++k) v[k] = (int)0x80000000;
        const int roff = (c * 128 * 256 + row) * 4;
        const size_t t = (size_t)u.pm * 256 + row;
        f32x4 rq[4];
#pragma unroll
        for (int j = 0; j < 4; ++j) rq[j] = *(const f32x4*)(RSQ + t * 16 + 4 * j);
        float xs[16], xn[16];
#pragma unroll
        for (int j = 0; j < 16; ++j) xs[j] = __builtin_bit_cast(float, __builtin_amdgcn_raw_buffer_load_b32(rsrc, roff, j * 1024, 2));
#pragma unroll 1
        for (int k0 = 0; k0 < 128; k0 += 16) {
            if (k0 + 16 < 128) {
#pragma unroll
                for (int j = 0; j < 16; ++j) xn[j] = __builtin_bit_cast(float, __builtin_amdgcn_raw_buffer_load_b32(rsrc, roff, (k0 + 16 + j) * 1024, 2));
            }
            __builtin_amdgcn_sched_barrier(0);
            int kb[16];
#pragma unroll
            for (int j = 0; j < 16; ++j) kb[j] = (f2key(xs[j]) & ~127) | (k0 + j);
            sort16_asc(kb);
            if (k0 == 0) {
#pragma unroll
                for (int j = 0; j < 16; ++j) v[j] = kb[15 - j];
            } else merge16(v, kb);
            __builtin_amdgcn_sched_barrier(0);
#pragma unroll
            for (int j = 0; j < 16; ++j) xs[j] = xn[j];
        }
        int A[16], B[16];
#pragma unroll
        for (int k = 0; k < 16; ++k) { const int o = __shfl_xor(v[k], 1); A[k] = c ? o : v[k]; B[k] = c ? v[k] : o; }
        int c2[16];
#pragma unroll
        for (int k = 0; k < 16; ++k) c2[k] = (int)0x80000000;
#define CAND(i, j) ((f2key(key2f(A[i]) + key2f(B[j])) & ~255) | ((i) * 16 + (j)))
#pragma unroll
        for (int j = 0; j < 16; ++j) c2[j] = CAND(0, j);
        { int t[16]; t[0] = (int)0x80000000;
#pragma unroll
          for (int i = 1; i < 16; ++i) t[16 - i] = CAND(i, 0);
          merge16(c2, t); }
        { int t[16];
          t[0] = CAND(1, 1); t[1] = CAND(1, 2); t[2] = CAND(1, 3); t[3] = CAND(1, 4); t[4] = CAND(1, 5); t[5] = CAND(1, 6); t[6] = CAND(1, 7);
          t[7] = CAND(2, 1); t[8] = CAND(2, 2); t[9] = CAND(2, 3); t[10] = CAND(2, 4); t[11] = CAND(3, 1); t[12] = CAND(3, 2); t[13] = CAND(3, 3);
          t[14] = CAND(4, 1); t[15] = CAND(4, 2);
          sort16_asc(t); merge16(c2, t); }
        { int x = CAND(5, 1); TOPK_INS(c2, x); x = CAND(6, 1); TOPK_INS(c2, x); x = CAND(7, 1); TOPK_INS(c2, x); }
#undef CAND
        float ssq = 0.f;
#pragma unroll
        for (int j = 0; j < 4; ++j) ssq += (rq[j][0] + rq[j][1]) + (rq[j][2] + rq[j][3]);
        const float rstd = __builtin_amdgcn_rsqf(ssq * (1.f / D) + RMS_EPS);
        const unsigned long long alo = pack8idx(A, 0), ahi = pack8idx(A, 8), blo = pack8idx(B, 0), bhi = pack8idx(B, 8);
        float sc[16]; int id[16]; float smax = 0.f, ssum = 0.f;
#pragma unroll
        for (int k = 0; k < 16; ++k) {
            const int cid = c2[k] & 255, i = cid >> 4, j = cid & 15;
            id[k] = lut16(alo, ahi, i) * 128 + lut16(blo, bhi, j);
            sc[k] = key2f(c2[k]) * rstd;
            if (k == 0) smax = sc[0];
            sc[k] = __expf(sc[k] - smax); ssum += sc[k];
        }
        const float inv = 1.f / ssum;
        int* ip = IDX + t * HK + u.pn * 16; float* gp = GATE + t * HK + u.pn * 16;
#pragma unroll
        for (int k = 0; k < 16; ++k) if ((k >> 3) == c) { ip[k] = id[k]; gp[k] = sc[k] * inv; }
    }
};

struct Frame {
    LAS unsigned char* lds;
    volatile LAS unsigned* MISC;
    gu32* ctl;
    int tid, lane, wave, vcu, G;
    int xcc, xrank;
    unsigned char* ws;
    const float* in[15]; float* out;
};
enum { I_X = 0, I_POS, I_NMIX, I_WIN, I_CONVW, I_WCONV, I_WATTN, I_GBIAS, I_WOUT, I_NFFN, I_WQ, I_SUBK, I_DOWN, I_UP, I_FNORM };

__device__ __forceinline__ void transpose_item(const float* W, int ldw, int k0, int n0, bf16* dst, int ldd, LAS float* scr, int lane) {
#pragma unroll 8
    for (int i = 0; i < 32; ++i) { const int kk = 2 * i + (lane >> 5); scr[kk * 33 + (lane & 31)] = W[(size_t)(k0 + kk) * ldw + n0 + (lane & 31)]; }
    LDS_WAIT(); asm volatile("" ::: "memory");
    const int c = lane & 7;
#pragma unroll
    for (int j = 0; j < 4; ++j) { const int n = (lane >> 3) + 8 * j; const LAS float* s = scr + (8 * c) * 33 + n;
        v4u o; o.x = pk2(s[0 * 33], s[1 * 33]); o.y = pk2(s[2 * 33], s[3 * 33]); o.z = pk2(s[4 * 33], s[5 * 33]); o.w = pk2(s[6 * 33], s[7 * 33]);
        *(GAS v4u*)(dst + (size_t)n * ldd + 8 * c) = o; }
    LDS_WAIT(); asm volatile("" ::: "memory");
}
__device__ __forceinline__ void w8_column_item(const float* W, int ldw, int n0, unsigned char* dst8  , float* swp  , LAS unsigned char* lds, int wave, int lane) {
    LAS float* scr = (LAS float*)(lds + wave * 16384); LAS float* cmx = (LAS float*)(lds + 130048);
    float x[2][32]; float am = 0.f;
#pragma unroll
    for (int b = 0; b < 2; ++b)
#pragma unroll
        for (int i = 0; i < 32; ++i) { const int kk = 64 * (2 * wave + b) + 2 * i + (lane >> 5); x[b][i] = W[(size_t)kk * ldw + n0 + (lane & 31)]; am = fmaxf(am, fabsf(x[b][i])); }
    am = fmaxf(am, __shfl_xor(am, 32));
    if (lane < 32) cmx[wave * 32 + lane] = am;
    __syncthreads();
    float cm = 0.f;
#pragma unroll
    for (int w = 0; w < 8; ++w) cm = fmaxf(cm, cmx[w * 32 + (lane & 31)]);
    const float q8 = (cm > 0.f) ? 127.f / cm : 0.f;
    if (wave == 0 && lane < 32) swp[lane] = cm * (1.f / 127.f);
#pragma unroll
    for (int b = 0; b < 2; ++b) {
#pragma unroll
        for (int i = 0; i < 32; ++i) scr[(2 * i + (lane >> 5)) * 33 + (lane & 31)] = x[b][i] * q8;
        LDS_WAIT(); asm volatile("" ::: "memory");
        const int c = lane & 7;
#pragma unroll
        for (int j = 0; j < 4; ++j) { const int n = (lane >> 3) + 8 * j; const LAS float* s = scr + (8 * c) * 33 + n;
            u32x2 o; o.x = pack4i8((f32x4){s[0 * 33], s[1 * 33], s[2 * 33], s[3 * 33]}); o.y = pack4i8((f32x4){s[4 * 33], s[5 * 33], s[6 * 33], s[7 * 33]});
            *(u32x2*)(dst8 + (size_t)n * D + 64 * (2 * wave + b) + 8 * c) = o; }
        LDS_WAIT(); asm volatile("" ::: "memory");
    }
    __syncthreads();
}
__device__ __forceinline__ int win_w8_row(int n0) {
    if (n0 < 1024) return NP1 + n0;
    if (n0 < 2048) { const int j = n0 - 1024; return NP1 + 1024 + (j >> 7) * 256 + (j & 127); }
    if (n0 < 3072) { const int j = n0 - 2048; return NP1 + 1024 + (j >> 7) * 256 + 128 + (j & 127); }
    if (n0 < 7680) { const int j = n0 - 3072, kind = j / 1536, jj = j % 1536, g = jj >> 9, cc = jj & 511; return g * 1536 + kind * 512 + cc; }
    if (n0 < 8704) return NP1 + 3072 + (n0 - 7680);
    if (n0 < 9216) return NP1 + 4096 + (n0 - 8704);
    return NQKV + (n0 - 9216);
}
__device__ __forceinline__ void p0_prologue(Frame& F) {
    for (int it = F.vcu; it < DIN / 32; it += F.G) {
        const int n0 = 32 * it, drow = win_w8_row(n0);
        w8_column_item(F.in[I_WIN], DIN, n0, F.ws + WS_WQKV8 + (size_t)drow * D, (float*)(F.ws + WS_SW) + drow, F.lds, F.wave, F.lane);
    }
    LAS float* scr = (LAS float*)(F.lds + F.wave * 16384);
    const int gw = F.vcu * NWAVES + F.wave, NGW = F.G * NWAVES;
    constexpr int I_C = 16 * 32, I_A = 8 * 32, I_O = 16 * 32, NITEMS = I_C + I_A + I_O;
    for (int it = gw; it < NITEMS; it += NGW) {
        int r = it;
        if (r < I_C) { const int kb = r / 32, nb = r % 32; transpose_item(F.in[I_WCONV], D, 64 * kb, 32 * nb, (bf16*)(F.ws + WS_WCONV) + (size_t)(32 * nb) * D + 64 * kb, D, scr, F.lane); continue; } r -= I_C;
        if (r < I_A) { const int kb = r / 32, nb = r % 32; transpose_item(F.in[I_WATTN], D, 64 * kb, 32 * nb, (bf16*)(F.ws + WS_WATTN) + (size_t)(32 * nb) * DAO + 64 * kb, DAO, scr, F.lane); continue; } r -= I_A;
        { const int kb = r / 32, nb = r % 32; transpose_item(F.in[I_WOUT], D, 64 * kb, 32 * nb, (bf16*)(F.ws + WS_WOUT) + (size_t)(32 * nb) * D + 64 * kb, D, scr, F.lane); }
    }
    const float* x = F.in[I_X]; const float* nm = F.in[I_NMIX];
    f32x4 gm[4];
#pragma unroll
    for (int j = 0; j < 4; ++j) gm[j] = *((const f32x4*)nm + F.lane + 64 * j);
    for (int m = gw; m < T; m += NGW) {
        const GAS f32x4* xr = (const GAS f32x4*)(x + (size_t)m * D) + F.lane;
        f32x4 v[4]; float s = 0.f;
#pragma unroll
        for (int j = 0; j < 4; ++j) { v[j] = xr[64 * j]; s += (v[j].x * v[j].x + v[j].y * v[j].y) + (v[j].z * v[j].z + v[j].w * v[j].w); }
        const float rstd = 1.f / sqrtf(wave_sum(s) * (1.f / D) + RMS_EPS);
        f32x4 y[4]; float am = 0.f;
#pragma unroll
        for (int j = 0; j < 4; ++j) { y[j] = v[j] * rstd * gm[j];
            am = fmaxf(am, fmaxf(fmaxf(fabsf(y[j].x), fabsf(y[j].y)), fmaxf(fabsf(y[j].z), fabsf(y[j].w)))); }
#pragma unroll
        for (int o = 1; o < 64; o <<= 1) am = fmaxf(am, __shfl_xor(am, o));
        const float q8 = (am > 0.f) ? 127.f / am : 0.f;
#pragma unroll
        for (int j = 0; j < 4; ++j) ((GAS unsigned*)(F.ws + WS_U8 + (size_t)m * D))[F.lane + 64 * j] = pack4i8(y[j] * q8);
        if (F.lane == 0) ((float*)(F.ws + WS_SU))[m] = am * (1.f / 127.f);
    }
    const int* pos = (const int*)F.in[I_POS]; float* rope = (float*)(F.ws + WS_ROPE);
    for (int e = gw * 64 + F.lane; e < T * 8; e += NGW * 64) {
        const int t = e >> 3, j = e & 7;
        const double invf[8] = {1.0, 0.19392274474868576, 0.03760603093086393, 0.007292664737217109, 0.001414213562373095, 0.0002742481756762073, 5.318295896944988e-05, 1.031338537721246e-05};
        double f = 1.0;
#pragma unroll
        for (int q = 1; q < 8; ++q) f = (j == q) ? invf[q] : f;
        const float fi = (float)f;
        const double ang = (double)pos[t] * (double)fi;
        const double k = __builtin_rint(ang * 0.15915494309189535);
        const float r = (float)(ang - k * 6.283185307179586);
        rope[(size_t)t * 16 + j] = __cosf(r); rope[(size_t)t * 16 + 8 + j] = __sinf(r);
    }
}

__device__ __forceinline__ void attn_phase(Frame& F, bf16* OGb, float* LSE) {
    constexpr int SLOT = 128 * 160;
    LAS unsigned char* Ks = F.lds; LAS unsigned char* Vs = F.lds + 3 * SLOT;
    const int lane = F.lane, w = F.wave, ir = lane & 15, gq = lane >> 4;
    const int NU = 3 * 8 * 128, per = (NU + F.G - 1) / F.G;
    const int u0 = F.vcu * per, u1 = (u0 + per < NU) ? u0 + per : NU;
    const bf16* Qb = (const bf16*)(F.ws + WS_Q); const bf16* Kb = (const bf16*)(F.ws + WS_K); const bf16* Vb = (const bf16*)(F.ws + WS_V);
    u32x4 pk[2], pv[2]; bf16x8 nq0, nq1; bool havepre = false;
    for (int uid = u0, n = 0; uid < u1; ++uid, ++n) {
        const int g = uid >> 10, hh = (uid >> 7) & 7, blk = uid & 127, sh = 2 * g;
        const bool first = (blk & ((64 >> sh) - 1)) == 0;
        const size_t gbase = (size_t)g * T * GW;
        const int p0 = blk * 128;
        const int ps = n % 3, cs = (n + 1) % 3, ns = (n + 2) % 3;
        const bf16* qrow = Qb + gbase + (size_t)(p0 + 16 * w + ir) * GW + hh * 64;
        bf16* orow = OGb + gbase + (size_t)(p0 + 16 * w + ir) * GW + hh * 64;
        bf16x8 qf0, qf1;
        if (!havepre) {
            if (n > 0) __syncthreads();
#pragma unroll
            for (int i = 0; i < 4; ++i) {
                const int c = F.tid + 512 * i, row = c >> 3, part = c & 7;
                const bool valid = !first || row >= 128;
                u32x4 kv = {0u, 0u, 0u, 0u}, vv = {0u, 0u, 0u, 0u};
                if (valid) { const size_t off = gbase + (size_t)(p0 - 128 + row) * GW + hh * 64 + part * 8; kv = *(const u32x4*)(Kb + off); vv = *(const u32x4*)(Vb + off); }
                const int so = ((row < 128) ? ps : cs) * SLOT + (row & 127) * 160 + part * 16;
                *(LAS u32x4*)(Ks + so) = kv; *(LAS u32x4*)(Vs + so) = vv;
            }
            qf0 = *(const bf16x8*)(qrow + 8 * gq); qf1 = *(const bf16x8*)(qrow + 32 + 8 * gq);
        } else { qf0 = nq0; qf1 = nq1; }
        __syncthreads();
        havepre = (uid + 1 < u1) && (((uid + 1) & 127) != 0);
        if (havepre) {
#pragma unroll
            for (int i = 0; i < 2; ++i) { const int c = F.tid + 512 * i, row = c >> 3, part = c & 7; const size_t off = gbase + (size_t)(p0 + 128 + row) * GW + hh * 64 + part * 8; pk[i] = *(const u32x4*)(Kb + off); pv[i] = *(const u32x4*)(Vb + off); }
            nq0 = *(const bf16x8*)(qrow + (size_t)128 * GW + 8 * gq); nq1 = *(const bf16x8*)(qrow + (size_t)128 * GW + 32 + 8 * gq);
        }
        f32x4 sacc[9];
#pragma unroll
        for (int a = 0; a < 9; ++a) {
            sacc[a] = (f32x4){0.f, 0.f, 0.f, 0.f};
            const int R0 = 16 * w + 16 * a;
            const LAS unsigned char* kp = Ks + ((R0 < 128) ? ps : cs) * SLOT + ((R0 & 127) + ir) * 160 + gq * 16;
            const bf16x8 k0 = *(const LAS bf16x8*)kp, k1 = *(const LAS bf16x8*)(kp + 64);
            sacc[a] = __builtin_amdgcn_mfma_f32_16x16x32_bf16(k0, qf0, sacc[a], 0, 0, 0);
            sacc[a] = __builtin_amdgcn_mfma_f32_16x16x32_bf16(k1, qf1, sacc[a], 0, 0, 0);
        }
        float mx = -INFINITY;
#pragma unroll
        for (int a = 0; a < 9; ++a)
#pragma unroll
            for (int j = 0; j < 4; ++j) {
                const int jl = 4 * gq + j;
                bool valid = (a == 0) ? (jl >= ir) : ((a == 8) ? (jl <= ir) : true);
                valid = valid && (!first || (16 * w + 16 * a + jl >= 128));
                sacc[a][j] = valid ? sacc[a][j] : -INFINITY;
                mx = fmaxf(mx, sacc[a][j]);
            }
        mx = fmaxf(mx, __shfl_xor(mx, 16)); mx = fmaxf(mx, __shfl_xor(mx, 32));
        float l = 0.f;
#pragma unroll
        for (int a = 0; a < 9; ++a)
#pragma unroll
            for (int j = 0; j < 4; ++j) { sacc[a][j] = __builtin_amdgcn_exp2f(sacc[a][j] - mx); l += sacc[a][j]; }
        l += __shfl_xor(l, 16); l += __shfl_xor(l, 32);
        f32x4 oacc[4];
#pragma unroll
        for (int dt = 0; dt < 4; ++dt) oacc[dt] = (f32x4){0.f, 0.f, 0.f, 0.f};
#pragma unroll
        for (int s = 0; s < 5; ++s) {
            u32x4 pw; pw.x = cvt_pk_bf16(sacc[2 * s][0], sacc[2 * s][1]); pw.y = cvt_pk_bf16(sacc[2 * s][2], sacc[2 * s][3]);
            if (s < 4) { pw.z = cvt_pk_bf16(sacc[2 * s + 1][0], sacc[2 * s + 1][1]); pw.w = cvt_pk_bf16(sacc[2 * s + 1][2], sacc[2 * s + 1][3]); } else { pw.z = 0u; pw.w = 0u; }
            const bf16x8 pb = __builtin_bit_cast(bf16x8, pw);
            const int q = ir >> 2, p = ir & 3;
            const int Ra = 16 * w + 32 * s, Rb = Ra + 16;
            const LAS unsigned char* vpa = Vs + ((Ra < 128) ? ps : cs) * SLOT + ((Ra & 127) + 4 * gq + q) * 160 + p * 8;
            const LAS unsigned char* vpb = Vs + ((Rb < 128) ? ps : cs) * SLOT + ((Rb & 127) + 4 * gq + q) * 160 + p * 8;
#pragma unroll
            for (int dt = 0; dt < 4; ++dt) {
                const s16x4 va = __builtin_bit_cast(s16x4, __builtin_amdgcn_ds_read_tr16_b64_v4i16((LAS v4i16_t*)(vpa + dt * 32)));
                s16x4 vb = {0, 0, 0, 0};
                if (s < 4) vb = __builtin_bit_cast(s16x4, __builtin_amdgcn_ds_read_tr16_b64_v4i16((LAS v4i16_t*)(vpb + dt * 32)));
                const bf16x8 vf = __builtin_shufflevector(va, vb, 0, 1, 2, 3, 4, 5, 6, 7);
                oacc[dt] = __builtin_amdgcn_mfma_f32_16x16x32_bf16(vf, pb, oacc[dt], 0, 0, 0);
            }
        }
        const float inv = 1.f / l;
#pragma unroll
        for (int dt = 0; dt < 4; ++dt) {
            u32x2 o; o.x = cvt_pk_bf16(oacc[dt][0] * inv, oacc[dt][1] * inv); o.y = cvt_pk_bf16(oacc[dt][2] * inv, oacc[dt][3] * inv);
            *(u32x2*)(orow + 16 * dt + 4 * gq) = o;
        }
        if (gq == 0) LSE[((size_t)g * T + p0 + 16 * w + ir) * 8 + hh] = (mx + __builtin_amdgcn_logf(l)) * LN2;
        if (havepre) {
#pragma unroll
            for (int i = 0; i < 2; ++i) { const int c = F.tid + 512 * i, row = c >> 3, part = c & 7; const int so = ns * SLOT + row * 160 + part * 16; *(LAS u32x4*)(Ks + so) = pk[i]; *(LAS u32x4*)(Vs + so) = pv[i]; }
        }
    }
    __syncthreads();
}

__device__ __forceinline__ void combine_phase(Frame& F, int part, int nparts) {
    const int gw = part * NWAVES + F.wave, NGW = nparts * NWAVES, lane = F.lane, hh = lane >> 3;
    const bf16* OG = (const bf16*)(F.ws + WS_Q); const float* LSE = (const float*)(F.ws + WS_LSE); bf16* O = (bf16*)(F.ws + WS_O);
    for (int t0 = gw * 4; t0 < T; t0 += NGW * 4) {
        float ls[4][3]; u32x4 og[4][3];
#pragma unroll
        for (int q = 0; q < 4; ++q) { const int t = t0 + q, b = t / SEQ, s = t % SEQ;
#pragma unroll
            for (int g = 0; g < 3; ++g) {
                const int sh = 2 * g, r = s & ((1 << sh) - 1), i = s >> sh;
                const size_t p = (size_t)g * T + b * SEQ + r * (SEQ >> sh) + i;
                ls[q][g] = LSE[p * 8 + hh]; og[q][g] = *(const u32x4*)(OG + p * GW + lane * 8);
            } }
#pragma unroll
        for (int q = 0; q < 4; ++q) {
            const float m = fmaxf(ls[q][0], fmaxf(ls[q][1], ls[q][2]));
            float e[3], sum = 0.f;
#pragma unroll
            for (int g = 0; g < 3; ++g) { e[g] = __expf(ls[q][g] - m); sum += e[g]; }
            const float inv = 1.f / sum;
            f32x4 a0 = {0.f, 0.f, 0.f, 0.f}, a1 = a0;
#pragma unroll
            for (int g = 0; g < 3; ++g) { f32x4 v0, v1; unpack8(og[q][g], v0, v1); const float wg = e[g] * inv; a0 = a0 + v0 * wg; a1 = a1 + v1 * wg; }
            *(u32x4*)(O + (size_t)(t0 + q) * DAO + lane * 8) = pack8(a0, a1);
        }
    }
}

__device__ __forceinline__ void p4_conv(Frame& F) {
    constexpr int RUN = 16;
    const int gt = (F.vcu * NWAVES + F.wave) * 64 + F.lane, NGT = F.G * NWAVES * 64;
    bf16* Bb = (bf16*)((unsigned char*)F.out + OS_BB); const bf16* Z = (const bf16*)(F.ws + WS_Z); const float* cw = F.in[I_CONVW];
    for (int e = gt; e < (T / RUN) * (D / 8); e += NGT) {
        const int t0 = (e >> 7) * RUN, c8 = (e & 127) * 8, s0 = t0 & (SEQ - 1);
        const f32x4 w0a = *(const f32x4*)(cw + c8), w0b = *(const f32x4*)(cw + c8 + 4), w1a = *(const f32x4*)(cw + D + c8), w1b = *(const f32x4*)(cw + D + c8 + 4), w2a = *(const f32x4*)(cw + 2 * D + c8), w2b = *(const f32x4*)(cw + 2 * D + c8 + 4);
        const size_t off0 = (size_t)t0 * D + c8;
        f32x4 z1a = {0.f, 0.f, 0.f, 0.f}, z1b = z1a, z2a = z1a, z2b = z1a;
        if (s0 >= 2) { unpack8(*(const u32x4*)(Z + off0 - D), z1a, z1b); unpack8(*(const u32x4*)(Z + off0 - 2 * D), z2a, z2b); }
#pragma unroll 4
        for (int r = 0; r < RUN; ++r) {
            const size_t off = off0 + (size_t)r * D;
            f32x4 z0a, z0b, ba, bb;
            unpack8(*(const u32x4*)(Z + off), z0a, z0b); unpack8(*(const u32x4*)(Bb + off), ba, bb);
            const f32x4 ca = w0a * z2a + w1a * z1a + w2a * z0a, cb = w0b * z2b + w1b * z1b + w2b * z0b;
            *(u32x4*)(Bb + off) = pack8(ba * ca, bb * cb);
            z2a = z1a; z2b = z1b; z1a = z0a; z1b = z0b;
        }
    }
}
__device__ __forceinline__ void split8(const f32x4 a, const f32x4 b, bf16x8& hi, bf16x8& lo) {
    const u32x4 h = pack8(a, b); f32x4 ha, hb; unpack8(h, ha, hb);
    hi = __builtin_bit_cast(bf16x8, h); lo = __builtin_bit_cast(bf16x8, pack8(a - ha, b - hb));
}
__device__ __forceinline__ void p4_wfold(Frame& F) {
    const int gw = F.vcu * NWAVES + F.wave, NGW = F.G * NWAVES, i = F.lane & 15, g = F.lane >> 4;
    const float* Wq = F.in[I_WQ]; const float* SK = F.in[I_SUBK]; bf16* WF = (bf16*)((unsigned char*)F.out + OS_WFOLD);
    for (int it = gw; it < 1024; it += NGW) {
        const int itu = __builtin_amdgcn_readfirstlane(it);
        const int hc = itu >> 6, k0 = ((itu >> 1) & 31) * 32, nh = itu & 1;
        bf16x8 ah[2][4], al[2][4];
#pragma unroll
        for (int kt = 0; kt < 2; ++kt)
#pragma unroll
            for (int j = 0; j < 4; ++j) { const float* ap = Wq + (size_t)(k0 + 16 * kt + i) * 2048 + hc * 128 + 32 * j + 8 * g; split8(*(const f32x4*)ap, *(const f32x4*)(ap + 4), ah[kt][j], al[kt][j]); }
#pragma unroll 1
        for (int nt = 0; nt < 4; ++nt) {
            const int n0 = hc * 128 + nh * 64 + 16 * nt;
            bf16x8 bh[4], bl[4];
#pragma unroll
            for (int j = 0; j < 4; ++j) { const float* bp = SK + (size_t)(n0 + i) * 128 + 32 * j + 8 * g; split8(*(const f32x4*)bp, *(const f32x4*)(bp + 4), bh[j], bl[j]); }
#pragma unroll
            for (int kt = 0; kt < 2; ++kt) {
                f32x4 acc = {0.f, 0.f, 0.f, 0.f};
#pragma unroll
                for (int j = 0; j < 4; ++j) { acc = __builtin_amdgcn_mfma_f32_16x16x32_bf16(al[kt][j], bh[j], acc, 0, 0, 0); acc = __builtin_amdgcn_mfma_f32_16x16x32_bf16(ah[kt][j], bl[j], acc, 0, 0, 0); }
#pragma unroll
                for (int j = 0; j < 4; ++j) acc = __builtin_amdgcn_mfma_f32_16x16x32_bf16(ah[kt][j], bh[j], acc, 0, 0, 0);
                u32x2 o; o.x = pk2(acc[0], acc[1]); o.y = pk2(acc[2], acc[3]);
                *(u32x2*)(WF + (size_t)(n0 + i) * D + k0 + 16 * kt + 4 * g) = o;
            }
        }
    }
}
__device__ __forceinline__ float gelu_erf(float v) { return 0.5f * v * (1.f + erff(v * 0.70710678118654752f)); }
__device__ __forceinline__ void peer_down_phase(Frame& F) {
    const int lane = F.lane, sub = lane & 15, gq = lane >> 4;
    const int nloc = (int)F.MISC[8], nxc = (int)F.MISC[9]; const bool byx = (nxc == 8) && (nloc * 8 == F.G) && (F.xcc < 8);
    const int x = byx ? F.xcc : 0, nsh = byx ? 8 : 1, rank = byx ? F.xrank : (int)blockIdx.x, nrank = byx ? nloc : F.G;
    const unsigned char* HG8 = F.ws + WS_HG8; const float* HSC = (const float*)(F.ws + WS_HSC); const float* RSQ = (const float*)(F.ws + WS_RSQ);
    const int* IDX = (const int*)(F.ws + WS_IDX); const float* GATE = (const float*)(F.ws + WS_GATE);
    const unsigned char* dn8 = (const unsigned char*)F.out + OS_EDOWN; const float* esc = (const float*)(F.ws + WS_ESCALE); float* WB = (float*)(F.ws + WS_WB);
    LAS unsigned char* wb = F.lds + F.wave * 10752;
    LAS u32x4* h8s = (LAS u32x4*)wb; LAS float* hss = (LAS float*)(wb + 4096); LAS u32x2* ls = (LAS u32x2*)(wb + 4608); LAS float* av = (LAS float*)(wb + 8704);
    const int tstep = nrank * NWAVES * 4;
    for (int xs = x; xs < 8; xs += nsh) {
        int tb = (rank * NWAVES + F.wave) * 4;
        u32x4 ia, ib, h8[4]; f32x4 ga, gb; float hs[4], pq;
#define PD_META(tt) do { const size_t t_ = (size_t)(tt) + gq; ia = *(const u32x4*)(IDX + t_ * HK + sub * 8); ib = *(const u32x4*)(IDX + t_ * HK + sub * 8 + 4); \
            ga = *(const f32x4*)(GATE + t_ * HK + sub * 8); gb = *(const f32x4*)(GATE + t_ * HK + sub * 8 + 4); pq = RSQ[t_ * 16 + sub]; \
            _Pragma("unroll") for (int j_ = 0; j_ < 4; ++j_) { h8[j_] = *(const u32x4*)(HG8 + t_ * D + 16 * (sub + 16 * j_)); hs[j_] = HSC[t_ * 32 + ((sub + 16 * j_) >> 1)]; } } while (0)
        if (tb < T) PD_META(tb);
        for (; tb < T; tb += tstep) {
#pragma unroll
            for (int j = 0; j < 4; ++j) { h8s[gq * 64 + sub + 16 * j] = h8[j]; if ((sub & 1) == 0) hss[gq * 32 + ((sub + 16 * j) >> 1)] = hs[j]; }
            int total = 0;
#pragma unroll
            for (int k = 0; k < 8; ++k) {
                const int ei = (int)(k < 4 ? ia[k & 3] : ib[k & 3]); const float gk = (k < 4 ? ga[k & 3] : gb[k & 3]);
                const bool f = (ei >> 11) == xs;
                const unsigned long long m = __ballot(f);
                const int pos = total + (int)__builtin_amdgcn_mbcnt_hi((unsigned)(m >> 32), __builtin_amdgcn_mbcnt_lo((unsigned)m, 0u));
                if (f) { u32x2 ent; ent.x = (unsigned)ei | ((unsigned)(sub * 8 + k) << 14) | ((unsigned)gq << 21); ent.y = __builtin_bit_cast(unsigned, gk); ls[pos] = ent; }
                total += __popcll(m);
            }
            float rq = pq; rq += __shfl_xor(rq, 1); rq += __shfl_xor(rq, 2); rq += __shfl_xor(rq, 4); rq += __shfl_xor(rq, 8);
            const float rstd = __builtin_amdgcn_rsqf(rq * (1.f / D) + RMS_EPS);
            const int tcur = tb;
            if (tb + tstep < T) PD_META(tb + tstep);
            LDS_WAIT(); asm volatile("" ::: "memory");
            const int nr = (total + 3) >> 2;
#define PD_ISSUE(R, HH, HS, r0) do { _Pragma("unroll") for (int u_ = 0; u_ < 2; ++u_) { const int k_ = 4 * ((r0) + u_) + gq; const bool v_ = k_ < total; const u32x2 e_ = ls[v_ ? k_ : 0]; const unsigned ex_ = e_.x; \
                const unsigned ro_ = (v_ ? (ex_ & 16383u) : 0u) * 1024u + 16u * (unsigned)sub; const unsigned tk_ = (ex_ >> 21) & 3u; \
                _Pragma("unroll") for (int j_ = 0; j_ < 4; ++j_) { R[u_][j_] = *(const u32x4*)(dn8 + (ro_ + 256u * j_)); HH[u_][j_] = h8s[tk_ * 64 + sub + 16 * j_]; HS[u_][j_] = hss[tk_ * 32 + ((sub + 16 * j_) >> 1)]; } } } while (0)
#define PD_COMPUTE(R, HH, HS, r0) do { _Pragma("unroll") for (int u_ = 0; u_ < 2; ++u_) { const int k_ = 4 * ((r0) + u_) + gq; float af_ = 0.f; \
                _Pragma("unroll") for (int j_ = 0; j_ < 4; ++j_) { int ac_ = 0; _Pragma("unroll") for (int q_ = 0; q_ < 4; ++q_) { const int a_ = (int)R[u_][j_][q_], b_ = (int)HH[u_][j_][q_]; ac_ = __builtin_amdgcn_sdot4(a_, b_, ac_, false); } af_ += (float)ac_ * HS[u_][j_]; } \
                af_ += __shfl_xor(af_, 1); af_ += __shfl_xor(af_, 2); af_ += __shfl_xor(af_, 4); af_ += __shfl_xor(af_, 8); \
                if (k_ < total && sub == 0) av[k_] = af_; } } while (0)
            u32x4 RA[2][4], RB[2][4], HA[2][4], HB[2][4]; float SA[2][4], SB[2][4];
            if (nr > 0) {
                PD_ISSUE(RA, HA, SA, 0);
                int r = 0;
#pragma unroll 1
                for (; r + 4 < nr; r += 4) {
                    PD_ISSUE(RB, HB, SB, r + 2);
                    __builtin_amdgcn_sched_barrier(0);
                    PD_COMPUTE(RA, HA, SA, r);
                    __builtin_amdgcn_sched_barrier(0);
                    PD_ISSUE(RA, HA, SA, r + 4);
                    __builtin_amdgcn_sched_barrier(0);
                    PD_COMPUTE(RB, HB, SB, r + 2);
                    __builtin_amdgcn_sched_barrier(0);
                }
                if (r + 2 < nr) {
                    PD_ISSUE(RB, HB, SB, r + 2);
                    __builtin_amdgcn_sched_barrier(0);
                    PD_COMPUTE(RA, HA, SA, r);
                    __builtin_amdgcn_sched_barrier(0);
                    PD_COMPUTE(RB, HB, SB, r + 2);
                } else {
                    PD_COMPUTE(RA, HA, SA, r);
                }
                __builtin_amdgcn_sched_barrier(0);
            }
#undef PD_ISSUE
#undef PD_COMPUTE
            LDS_WAIT(); asm volatile("" ::: "memory");
            const float rs0 = __builtin_bit_cast(float, __builtin_amdgcn_readlane(__builtin_bit_cast(int, rstd), 0)), rs1 = __builtin_bit_cast(float, __builtin_amdgcn_readlane(__builtin_bit_cast(int, rstd), 16)),
                        rs2 = __builtin_bit_cast(float, __builtin_amdgcn_readlane(__builtin_bit_cast(int, rstd), 32)), rs3 = __builtin_bit_cast(float, __builtin_amdgcn_readlane(__builtin_bit_cast(int, rstd), 48));
            for (int i = lane; i < total; i += 64) {
                const u32x2 e = ls[i]; const unsigned ex = e.x, eg = e.y; const int tk = (int)((ex >> 21) & 3u);
                const float rs = (tk == 0) ? rs0 : ((tk == 1) ? rs1 : ((tk == 2) ? rs2 : rs3));
                const float a = av[i] * esc[ex & 16383u] * rs;
                WB[(size_t)(tcur + tk) * HK + ((ex >> 14) & 127u)] = __builtin_bit_cast(float, eg) * esc[NEXP + (ex & 16383u)] * gelu_erf(a);
            }
            LDS_WAIT(); asm volatile("" ::: "memory");
        }
#undef PD_META
    }
}
__device__ __forceinline__ void peer_up_phase(Frame& F) {
    const int lane = F.lane, g8 = lane >> 3, c = lane & 7;
    const int nloc = (int)F.MISC[8], nxc = (int)F.MISC[9]; const bool byx = (nxc == 8) && (nloc * 8 == F.G) && (F.xcc < 8);
    const int x = byx ? F.xcc : 0, nsh = byx ? 8 : 1, rank = byx ? F.xrank : (int)blockIdx.x, nrank = byx ? nloc : F.G;
    const bf16* HG = (const bf16*)(F.ws + WS_HG); const float* nffn = F.in[I_NFFN];
    float* SS = (float*)(F.ws + WS_SS); float* out = F.out;
    LAS unsigned char* wbuf = F.lds + F.wave * 16384;
    const int tstep = nrank * NWAVES * 8;
    const unsigned char* wsb = F.ws;
    for (int xs = x; xs < 8; xs += nsh) {
    const unsigned char* up8 = F.ws + WS_EUP + (size_t)xs * (2 * MiB);
    int tb = (rank * NWAVES + F.wave) * 8, it = 0;
#define PU_MOFF(tt, j) ((unsigned)(((j) < 4 ? WS_IDX : WS_WB) + (size_t)(tt) * (HK * 4) + ((j) & 3) * 1024) + (unsigned)(lane * 16))
    if (tb < T) {
        u32x4 m0[8];
#pragma unroll
        for (int j = 0; j < 8; ++j) m0[j] = *(const u32x4*)(wsb + PU_MOFF(tb, j));
#pragma unroll
        for (int j = 0; j < 8; ++j) *(LAS u32x4*)(wbuf + j * 1024 + lane * 16) = m0[j];
    }
    for (; tb < T; tb += tstep, ++it) {
        const int t = tb + g8;
        const LAS unsigned char* mi = wbuf + (it & 1) * 8192 + g8 * 512;
        LAS unsigned char* nb = wbuf + ((it + 1) & 1) * 8192 + lane * 16;
        const int tn = (tb + tstep < T) ? tb + tstep : tb;
        f32x4 oa[4];
#pragma unroll
        for (int q = 0; q < 4; ++q) oa[q] = (f32x4){0.f, 0.f, 0.f, 0.f};
#define PU_ISSUE(R, W, st) do { const u32x4 i0_ = *(const LAS u32x4*)(mi + (st) * 32), i1_ = *(const LAS u32x4*)(mi + (st) * 32 + 16); \
            const f32x4 w0_ = *(const LAS f32x4*)(mi + 4096 + (st) * 32), w1_ = *(const LAS f32x4*)(mi + 4096 + (st) * 32 + 16); \
            _Pragma("unroll") for (int k_ = 0; k_ < 8; ++k_) { const unsigned ei_ = (k_ < 4) ? i0_[k_ & 3] : i1_[k_ & 3]; W[k_] = (k_ < 4) ? w0_[k_ & 3] : w1_[k_ & 3]; \
            R[k_] = *(const u32x4*)(up8 + (ei_ * 128u + 16u * (unsigned)c)); } } while (0)
#define PU_COMPUTE(R, W) do { _Pragma("unroll") for (int k_ = 0; k_ < 8; ++k_) { _Pragma("unroll") for (int q_ = 0; q_ < 4; ++q_) { const int d_ = (int)R[k_][q_]; \
            const f32x2 lo_ = __builtin_amdgcn_cvt_pk_f32_fp8(d_, false), hi_ = __builtin_amdgcn_cvt_pk_f32_fp8(d_, true); \
            oa[q_][0] += lo_.x * W[k_]; oa[q_][1] += lo_.y * W[k_]; oa[q_][2] += hi_.x * W[k_]; oa[q_][3] += hi_.y * W[k_]; } \
            if (k_ & 1) { asm volatile("" : "+v"(oa[0]), "+v"(oa[1]), "+v"(oa[2]), "+v"(oa[3])); __builtin_amdgcn_sched_barrier(0); } } } while (0)
        u32x4 RA[8], RB[8]; float WA[8], WBk[8];
        PU_ISSUE(RA, WA, 0);
#define PU_BODY(st, j) do { const u32x4 m_ = *(const u32x4*)(wsb + PU_MOFF(tn, j)); \
            PU_ISSUE(RB, WBk, (st) + 1); __builtin_amdgcn_sched_barrier(0); PU_COMPUTE(RA, WA); __builtin_amdgcn_sched_barrier(0); \
            PU_ISSUE(RA, WA, (st) + 2); __builtin_amdgcn_sched_barrier(0); PU_COMPUTE(RB, WBk); __builtin_amdgcn_sched_barrier(0); \
            *(LAS u32x4*)(nb + (j) * 1024) = m_; __builtin_amdgcn_sched_barrier(0); } while (0)
#pragma unroll 1
        for (int st = 0; st < 14; st += 2) { const int j = st >> 1; PU_BODY(st, j); }
        unsigned hgo = (unsigned)(t * (D * 2) + 256 * xs + 32 * c);
        asm volatile("" : "+v"(hgo));
        const u32x4 m7 = *(const u32x4*)(wsb + PU_MOFF(tn, 7));
        const u32x4 hg0 = *(const u32x4*)((const unsigned char*)HG + hgo), hg1 = *(const u32x4*)((const unsigned char*)HG + (hgo + 16u));
        PU_ISSUE(RB, WBk, 15);
        __builtin_amdgcn_sched_barrier(0);
        PU_COMPUTE(RA, WA);
        __builtin_amdgcn_sched_barrier(0);
        PU_COMPUTE(RB, WBk);
        __builtin_amdgcn_sched_barrier(0);
        *(LAS u32x4*)(nb + 7 * 1024) = m7;
#undef PU_BODY
#undef PU_ISSUE
#undef PU_COMPUTE
        float ss = 0.f;
        const size_t off = (size_t)t * D + 128 * xs + 16 * c;
        f32x4 hv[4]; unpack8(hg0, hv[0], hv[1]); unpack8(hg1, hv[2], hv[3]);
#pragma unroll
        for (int q = 0; q < 4; ++q) { const f32x4 nf = *(const f32x4*)(nffn + 128 * xs + 16 * c + 4 * q); hv[q][0] /= nf[0]; hv[q][1] /= nf[1]; hv[q][2] /= nf[2]; hv[q][3] /= nf[3]; }
#pragma unroll
        for (int q = 0; q < 4; ++q) { oa[q] = oa[q] + hv[q]; ss += (oa[q][0] * oa[q][0] + oa[q][1] * oa[q][1]) + (oa[q][2] * oa[q][2] + oa[q][3] * oa[q][3]); *(f32x4*)(out + off + 4 * q) = oa[q]; }
        ss += __shfl_xor(ss, 1); ss += __shfl_xor(ss, 2); ss += __shfl_xor(ss, 4);
        if (c == 0) SS[(size_t)t * 8 + xs] = ss;
    }
#undef PU_MOFF
    }
}
__device__ __forceinline__ void final_norm_phase(Frame& F) {
    const int gw = F.vcu * NWAVES + F.wave, NGW = F.G * NWAVES, lane = F.lane;
    const float* SS = (const float*)(F.ws + WS_SS); const float* fn = F.in[I_FNORM]; float* out = F.out;
    f32x4 g[4];
#pragma unroll
    for (int q = 0; q < 4; ++q) g[q] = *(const f32x4*)(fn + 4 * (lane + 64 * q));
    for (int t = gw; t < T; t += NGW) {
        const f32x4 s0 = *(const f32x4*)(SS + (size_t)t * 8), s1 = *(const f32x4*)(SS + (size_t)t * 8 + 4);
        const float r2 = __builtin_amdgcn_rsqf((((s0[0] + s0[1]) + (s0[2] + s0[3])) + ((s1[0] + s1[1]) + (s1[2] + s1[3]))) * (1.f / D) + RMS_EPS);
        f32x4* op = (f32x4*)(out + (size_t)t * D) + lane;
#pragma unroll
        for (int q = 0; q < 4; ++q) op[64 * q] = op[64 * q] * r2 * g[q];
    }
}

struct Args { const float* in[15]; float* out; unsigned char* ws; int ph_lo, ph_hi, li, pad; };
__global__ void __launch_bounds__(NWAVES * 64, 2) fwd(Args args) {
    extern __shared__ __attribute__((aligned(16))) unsigned char lds[];
    Frame F;
    F.lds = (LAS unsigned char*)lds;
    F.MISC = (volatile LAS unsigned*)(F.lds + MISC_OFF);
    F.tid = threadIdx.x; F.lane = F.tid & 63; F.wave = __builtin_amdgcn_readfirstlane(F.tid >> 6);
    F.G = gridDim.x; { const int bx = blockIdx.x; F.vcu = (F.G % 8 == 0) ? (bx % 8) * (F.G / 8) + bx / 8 : bx; }
    F.ws = args.ws; F.ctl = (gu32*)(args.ws + WS_CTL);
#pragma unroll
    for (int i = 0; i < 15; ++i) F.in[i] = args.in[i];
    F.out = args.out;
    for (int u = F.tid; u < (LDS_BYTES - RING_BYTES) / 4; u += NWAVES * 64) ((LAS unsigned*)(F.lds + RING_BYTES))[u] = 0u;
    __syncthreads();
    XcdBarrier bar; bar.bar = (unsigned*)(F.ctl + CW_BAR); bar.x = 0; bar.st = nullptr;
    if (N_LAUNCHES == 1) bar = xcd_barrier_post((unsigned*)(F.ctl + CW_BAR), F.MISC + 8);
    F.xcc = (int)xb_xcc_id();
    if (F.tid == 0) F.MISC[16] = xb_add((unsigned*)(F.ctl + CW_RANK + 64 * (F.xcc & 15)), 1u);
    __syncthreads();
    F.xrank = (int)F.MISC[16];
#define GRID_BAR() do { if (N_LAUNCHES == 1) xcd_barrier(bar); } while (0)
    const int lo = args.ph_lo, hi = args.ph_hi, bx = (int)blockIdx.x;
#define IN(k) (lo <= (k) && (k) < hi)
#define BOTH(k) (IN(k) && IN((k) + 1))
    unsigned char* ws = args.ws;

    if (IN(0)) { p0_prologue(F); if (BOTH(0)) GRID_BAR(); }

    if (IN(1)) {
        Gemm g{(const bf16*)(ws + WS_U8), (const bf16*)(ws + WS_WQKV8), T, NP1, D / 2}; QkvOrder S; S.init(T, NP1, F.G, bx); S.U = (const char*)(ws + WS_U8);
        EpiQKV E{(bf16*)(ws + WS_Q), (const float*)(ws + WS_ROPE), (const float*)(ws + WS_SU), (const float*)(ws + WS_SW), ws + WS_SGA, F.in[I_GBIAS] + D};
        gemm_phase<EpiQKV, QkvOrder, true, true, true, true>(F.lds, g, S, E);
        if (BOTH(1)) GRID_BAR();
    }
    if (IN(2)) { attn_phase(F, (bf16*)(ws + WS_Q), (float*)(ws + WS_LSE)); if (BOTH(2)) GRID_BAR(); }
    if (IN(3)) {
        { const int nwg = (T / 256) * ((NCG - 512) / 256), rem = nwg % F.G;
          if (rem == 0) combine_phase(F, F.vcu, F.G); else if (bx >= rem) combine_phase(F, bx - rem, F.G - rem); }
        Gemm g{(const bf16*)(ws + WS_U8), (const bf16*)(ws + WS_WQKV8 + (size_t)NP1 * D), T, NCG - 512, D / 2}; StaticOrder S; S.init(T, NCG - 512, F.G, bx);
        EpiCG E{(bf16*)((unsigned char*)F.out + OS_BB), (bf16*)(ws + WS_Z), ws + WS_SGC, ws + WS_SGA, F.in[I_GBIAS], (const float*)(ws + WS_SU), (const float*)(ws + WS_SW)};
        gemm_phase<EpiCG, StaticOrder, true, true, false, true>(F.lds, g, S, E);
        if (BOTH(3)) GRID_BAR();
    }
    if (IN(4)) { p4_wfold(F); p4_conv(F); if (BOTH(4)) GRID_BAR(); }
    if (IN(5)) {
        Gemm gc{(const bf16*)((unsigned char*)F.out + OS_BB), (const bf16*)(ws + WS_WCONV), T, D, D}, ga{(const bf16*)(ws + WS_O), (const bf16*)(ws + WS_WATTN), T, D, DAO};
        StaticOrder S; S.init(T, D, F.G, bx);
        if ((bx & 8) == 0) {
            { EpiY<0> E{(bf16*)(ws + WS_Y), ws + WS_SGC}; gemm_phase<EpiY<0>, StaticOrder, true, true>(F.lds, gc, S, E); }
            { EpiY<1> E{(bf16*)(ws + WS_Y), ws + WS_SGA}; gemm_phase<EpiY<1>, StaticOrder, true, true>(F.lds, ga, S, E); }
        } else {
            { EpiY<0> E{(bf16*)(ws + WS_Y), ws + WS_SGA}; gemm_phase<EpiY<0>, StaticOrder, true, true>(F.lds, ga, S, E); }
            { EpiY<1> E{(bf16*)(ws + WS_Y), ws + WS_SGC}; gemm_phase<EpiY<1>, StaticOrder, true, true>(F.lds, gc, S, E); }
        }
        if (BOTH(5)) GRID_BAR();
    }
    if (IN(6)) {
        Gemm g{(const bf16*)(ws + WS_Y), (const bf16*)(ws + WS_WOUT), T, D, D}; StaticOrder S; S.init(T, D, F.G, bx);
        EpiOut E{F.in[I_X], (bf16*)(ws + WS_HG), F.in[I_NFFN], (float*)(ws + WS_RSQ), ws + WS_HG8, (float*)(ws + WS_HSC)};
        gemm_phase<EpiOut, StaticOrder, true, true>(F.lds, g, S, E);

        if (BOTH(6)) GRID_BAR();
    }
    if (IN(7)) {
        Gemm g{(const bf16*)(ws + WS_HG), (const bf16*)((unsigned char*)F.out + OS_WFOLD), T, 2048, D}; StaticOrder S; S.init(T, 2048, F.G, bx);
        float* scr = (float*)(ws + (bx < 128 ? WS_SCR0 + (size_t)bx * 262144 : (bx < 192 ? WS_SCR1 + (size_t)(bx - 128) * 262144 : WS_SCR2 + (size_t)(bx - 192) * 262144)));
        EpiTopk E{scr, (const float*)(ws + WS_RSQ), (int*)(ws + WS_IDX), (float*)(ws + WS_GATE),
                  CvCtx{F.in[I_DOWN], F.in[I_UP], (unsigned char*)F.out + OS_EDOWN, ws + WS_EUP, (float*)(ws + WS_ESCALE), F.lane}, F.vcu * NWAVES + F.wave, F.G * NWAVES};
        if ((bx & 8) != 0) { for (; E.cvr < 2 * NEXP; E.cvr += E.cvstep) { f32x4 v[4]; cv_load(E.CV, E.cvr, v); cv_finish(E.CV, E.cvr, v); } }
        const int cvkeep = E.cvr; E.cvr = 2 * NEXP;
        gemm_phase<EpiTopk, StaticOrder, true, true>(F.lds, g, S, E);
        E.cvr = cvkeep;
        for (; E.cvr < 2 * NEXP; E.cvr += E.cvstep) { f32x4 v[4]; cv_load(E.CV, E.cvr, v); cv_finish(E.CV, E.cvr, v); }
        if (BOTH(7)) GRID_BAR();
    }
    if (IN(8)) { peer_down_phase(F); if (BOTH(8)) GRID_BAR(); }
    if (IN(9)) { peer_up_phase(F); if (BOTH(9)) GRID_BAR(); }
    if (IN(10)) { final_norm_phase(F); }
#undef IN
#undef BOTH
}

extern "C" void kernel_launch(void* const* d_in, const int* in_sizes, int n_in, void* d_out, int out_size, void* d_ws, size_t ws_size, hipStream_t stream) {
    static int grid = 0;
    if (grid == 0) {
        if (n_in != 15 || out_size != T * D || ws_size < WS_END) { fprintf(stderr, "kernel_launch: unexpected shapes (n_in %d, out %d, ws %zu)\n", n_in, out_size, ws_size); grid = -1; return; }
        int dev = 0, cus = 0, per_cu = 0;
        if (hipGetDevice(&dev) != hipSuccess || hipDeviceGetAttribute(&cus, hipDeviceAttributeMultiprocessorCount, dev) != hipSuccess) { grid = -1; return; }
        if (hipFuncSetAttribute((const void*)fwd, hipFuncAttributeMaxDynamicSharedMemorySize, LDS_BYTES) != hipSuccess) { fprintf(stderr, "kernel_launch: hipFuncSetAttribute failed\n"); grid = -1; return; }
        if (hipOccupancyMaxActiveBlocksPerMultiprocessor(&per_cu, (const void*)fwd, NWAVES * 64, LDS_BYTES) != hipSuccess || per_cu < 1) fprintf(stderr, "kernel_launch: occupancy query reports %d\n", per_cu);
        (void)hipGetLastError();
        grid = cus > 256 ? 256 : cus;
    }
    if (grid < 0) return;
    if (hipMemsetAsync((char*)d_ws + WS_CTL, 0, CTL_ZERO_BYTES, stream) != hipSuccess) return;
    Args a{};
    for (int i = 0; i < 15; ++i) a.in[i] = (const float*)d_in[i];
    a.out = (float*)d_out; a.ws = (unsigned char*)d_ws;
    for (int li = 0; li < N_LAUNCHES; ++li) {
        a.ph_lo = (N_LAUNCHES == 1) ? 0 : li; a.ph_hi = (N_LAUNCHES == 1) ? N_PHASES : li + 1; a.li = li; a.pad = 0;
        hipLaunchKernelGGL(fwd, dim3(grid), dim3(NWAVES * 64), LDS_BYTES, stream, a);
    }
}
```

```cpp
#include <hip/hip_runtime.h>
#include <cstdio>
#include <cstdint>
namespace pg8 {
#define PG8_LAS __attribute__((address_space(3)))
typedef unsigned short bf16_t;
typedef short bf16x8 __attribute__((ext_vector_type(8)));
typedef float f32x4 __attribute__((ext_vector_type(4)));
typedef unsigned u32x4 __attribute__((ext_vector_type(4)));
typedef int v4i32_t __attribute__((ext_vector_type(4)));
typedef int v8i32_t __attribute__((ext_vector_type(8)));
constexpr int BM = 256, BK = 64, HALF = 128, HTB = HALF * BK * 2  , STAGE_BYTES = 8 * HTB, NXCD = 8, WGM = 8;

__host__ __device__ __forceinline__ int lds_byte(int r, int c) { const int st = (r >> 4) * 2 + (c >> 5), rr = r & 15, cc = c & 31, ob = rr * 64 + cc * 2; return st * 1024 + (ob ^ (((ob >> 9) & 1) << 5)); }
__host__ __device__ __forceinline__ void stage_rc(int b, int& R, int& C) { const int st = b / 1024, sb = b % 1024, swz = sb ^ (((sb >> 9) & 1) << 5); R = (st >> 1) * 16 + swz / 64; C = (st & 1) * 32 + (swz % 64) / 2; }
__host__ __device__ __forceinline__ int perm32(int rho) { const int n = rho >> 4, i = rho & 15; return 8 * (i >> 2) + 4 * n + (i & 3); }

struct Unit { int pm, pn; };
struct Gemm { const bf16_t* A; const bf16_t* Bt; int M, N, K; };

struct StaticOrder {
    int nM, nN, nwg, G, c;
    __host__ __device__ void init(int M, int N, int G_, int c_) { nM = M / BM; nN = N / BM; nwg = nM * nN; G = G_; c = c_; }
    __host__ __device__ bool next(int i, Unit& u) const {
        const long L = (long)i * G + c; if (L >= nwg) return false;
        int wgid = (int)L; { const int q = nwg / NXCD, r = nwg % NXCD, xcd = wgid % NXCD, off = wgid / NXCD; wgid = (xcd < r ? xcd * (q + 1) : r * (q + 1) + (xcd - r) * q) + off; }
        const int nig = WGM * nN, gid = wgid / nig, fm = gid * WGM, gsz = (nM - fm) < WGM ? (nM - fm) : WGM;
        u.pm = fm + ((wgid % nig) % gsz); u.pn = (wgid % nig) / gsz; return true;
    }
    __device__ __forceinline__ void a_ready(const Unit&) const {}
    __device__ __forceinline__ void done(const Unit&) const {}
};

__device__ __forceinline__ unsigned cvt_pk_bf16(float lo, float hi) { unsigned r; asm volatile("v_cvt_pk_bf16_f32 %0, %1, %2" : "=v"(r) : "v"(lo), "v"(hi)); return r; }
typedef float f32x2 __attribute__((ext_vector_type(2)));

template <class Epi, class Sched, bool ALIGN_EPI = false, bool SP2 = false, bool STRIDED_A = false, bool I8 = false>
__device__ __forceinline__ void gemm_phase(PG8_LAS unsigned char* lds, const Gemm g, const Sched& S, const Epi& E) {
    const int tid = threadIdx.x, wid = __builtin_amdgcn_readfirstlane(tid >> 6), lane = tid & 63, wr = wid >> 2, wc = wid & 3, fr = lane & 15, fq = lane >> 4;
    const int K = g.K; int nt = K / BK;
    if constexpr (I8) asm volatile("" : "+s"(nt));
    unsigned voffA[2], voffB[2];
#pragma unroll
    for (int i = 0; i < 2; ++i) { int R, C; stage_rc(tid * 16 + i * 8192, R, C); const int Rb = Epi::PERM ? ((R & ~31) + perm32(R & 31)) : R;
        voffA[i] = (unsigned)(R * K + C) * 2u; voffB[i] = (unsigned)(Rb * K + C) * 2u; }
    unsigned rkA = 0, c2A = 0; const unsigned rk64 = 64u * (unsigned)K * 2u;
    if constexpr (STRIDED_A) { int R, C; stage_rc(tid * 16, R, C); rkA = (unsigned)(R * K) * 2u; c2A = (unsigned)C * 2u; }
    const size_t kstep = (size_t)(BK * 2);
    const size_t hstep = (size_t)HALF * K * 2;
    const size_t tstep = 2 * hstep;
    const unsigned ldsw = (unsigned)wid * 1024u;
    const int aoff = lds_byte(wr * 64 + fr, fq * 8), boff = lds_byte(wc * 32 + fr, fq * 8);
#define PG8_SA(b, h) (((b) * 2 + (h)) * HTB)
#define PG8_SB(b, h) ((4 + (b) * 2 + (h)) * HTB)
#define PG8_STAGE(bufoff, gbase, voff) do { _Pragma("unroll") for (int _i = 0; _i < 2; ++_i) \
        __builtin_amdgcn_global_load_lds((const unsigned*)((const char*)(gbase) + (voff)[_i]), (PG8_LAS unsigned*)(lds + (bufoff) + ldsw + _i * 8192), 16, 0, 0); } while (0)
#define PG8_STAGE_A(bufoff, gbase, sh) do { if constexpr (STRIDED_A) { _Pragma("unroll") for (int _i = 0; _i < 2; ++_i) { const unsigned _vo = ((rkA + _i * rk64) << (sh)) + c2A; \
        __builtin_amdgcn_global_load_lds((const unsigned*)((const char*)(gbase) + _vo), (PG8_LAS unsigned*)(lds + (bufoff) + ldsw + _i * 8192), 16, 0, 0); } } else { PG8_STAGE(bufoff, gbase, voffA); } } while (0)
#define PG8_LDA(dst, b, h) do { _Pragma("unroll") for (int m = 0; m < 4; ++m) _Pragma("unroll") for (int k = 0; k < 2; ++k) dst[m][k] = *(const PG8_LAS bf16x8*)(lds + PG8_SA(b, h) + aoff + m * 2048 + k * 1024); } while (0)
#define PG8_LDB(dst, b, h) do { _Pragma("unroll") for (int n = 0; n < 2; ++n) _Pragma("unroll") for (int k = 0; k < 2; ++k) dst[n][k] = *(const PG8_LAS bf16x8*)(lds + PG8_SB(b, h) + boff + n * 2048 + k * 1024); } while (0)
#define PG8_MMA(ai, bj, At, Bt) do { __builtin_amdgcn_s_setprio(1); _Pragma("unroll") for (int m = 0; m < 4; ++m) _Pragma("unroll") for (int n = 0; n < 2; ++n) _Pragma("unroll") for (int k = 0; k < 2; ++k) \
        { if constexpr (I8) acc[ai][bj][m][n] = __builtin_bit_cast(f32x4, __builtin_amdgcn_mfma_i32_16x16x64_i8(__builtin_bit_cast(v4i32_t, Bt[n][k]), __builtin_bit_cast(v4i32_t, At[m][k]), __builtin_bit_cast(v4i32_t, acc[ai][bj][m][n]), 0, 0, 0)); \
          else acc[ai][bj][m][n] = __builtin_amdgcn_mfma_f32_16x16x32_bf16(Bt[n][k], At[m][k], acc[ai][bj][m][n], 0, 0, 0); } __builtin_amdgcn_s_setprio(0); } while (0)
#define PG8_WAIT_V(n) asm volatile("s_waitcnt vmcnt(" #n ")" ::: "memory")
#define PG8_WAIT_L(n) asm volatile("s_waitcnt lgkmcnt(" #n ")" ::: "memory")
#define PG8_BAR __builtin_amdgcn_s_barrier()
#define PG8_SCHED __builtin_amdgcn_sched_barrier(0)
    Unit cur, nxt; int ui = 0;
    if (!S.next(0, cur)) return;
    f32x4 acc[2][2][4][2];
#pragma unroll
    for (int a = 0; a < 2; ++a)
#pragma unroll
        for (int b = 0; b < 2; ++b)
#pragma unroll
            for (int m = 0; m < 4; ++m)
#pragma unroll
                for (int n = 0; n < 2; ++n) acc[a][b][m][n] = (f32x4){0.f, 0.f, 0.f, 0.f};
    bf16x8 At[4][2], B0[2][2], B1[2][2];
    int csh = 0, nsh = 0;
    const char* cA; if constexpr (STRIDED_A) cA = S.a_base(cur, csh); else cA = (const char*)g.A + (size_t)cur.pm * tstep;
    const char* cB = (const char*)g.Bt + (size_t)cur.pn * tstep;
    S.a_ready(cur);
    if constexpr (SP2) {
        PG8_STAGE(PG8_SB(0, 0), cB, voffB); PG8_STAGE(PG8_SB(0, 1), cB + hstep, voffB); PG8_STAGE_A(PG8_SA(0, 0), cA, csh); PG8_STAGE_A(PG8_SA(0, 1), cA + (hstep << csh), csh);
        if (wr == 1) PG8_BAR;
        PG8_WAIT_V(2); PG8_BAR;
        PG8_STAGE(PG8_SB(1, 0), cB + kstep, voffB); PG8_STAGE_A(PG8_SA(1, 0), cA + kstep, csh); PG8_STAGE(PG8_SB(1, 1), cB + hstep + kstep, voffB);
        PG8_WAIT_V(6); PG8_BAR;
    } else {
        PG8_STAGE(PG8_SB(0, 0), cB, voffB); PG8_STAGE_A(PG8_SA(0, 0), cA, csh); PG8_STAGE(PG8_SB(0, 1), cB + hstep, voffB); PG8_STAGE_A(PG8_SA(0, 1), cA + (hstep << csh), csh);
        if (wr == 1) PG8_BAR;
        PG8_WAIT_V(4); PG8_BAR;
        PG8_STAGE(PG8_SB(1, 0), cB + kstep, voffB); PG8_STAGE_A(PG8_SA(1, 0), cA + kstep, csh); PG8_STAGE(PG8_SB(1, 1), cB + hstep + kstep, voffB);
        PG8_WAIT_V(6); PG8_BAR;
    }
    asm volatile(".p2align 8" ::: "memory");
    for (;;) {
        const bool has_next = S.next(ui + 1, nxt);
        const char* nA; if constexpr (STRIDED_A) { nsh = csh; nA = has_next ? S.a_base(nxt, nsh) : cA; } else nA = has_next ? (const char*)g.A + (size_t)nxt.pm * tstep : cA;
        const char* nB = has_next ? (const char*)g.Bt + (size_t)nxt.pn * tstep : cB;
        for (int t = 0; t < nt; t += 2) {
            const bool last = (t == nt - 2);
            const char* a1 = cA + (size_t)(t + 1) * kstep;
            const char* a2 = last ? nA : cA + (size_t)(t + 2) * kstep; const char* b2 = last ? nB : cB + (size_t)(t + 2) * kstep;
            const char* a3 = a2 + kstep; const char* b3 = b2 + kstep;
            const int sh2 = last ? nsh : csh; const size_t hA1 = hstep << csh, hA2 = hstep << sh2;
            if (last && has_next) S.a_ready(nxt);
            if constexpr (SP2) {
            PG8_LDB(B0, 0, 0); PG8_LDB(B1, 0, 1); PG8_SCHED; PG8_LDA(At, 0, 0); PG8_STAGE_A(PG8_SA(1, 1), a1 + hA1, csh);
            PG8_WAIT_V(8); PG8_WAIT_L(0); PG8_BAR; PG8_MMA(0, 0, At, B0); PG8_MMA(0, 1, At, B1); PG8_BAR; PG8_SCHED;
            PG8_LDA(At, 0, 1); PG8_STAGE(PG8_SB(0, 0), b2, voffB); PG8_STAGE(PG8_SB(0, 1), b2 + hstep, voffB); PG8_STAGE_A(PG8_SA(0, 0), a2, sh2);
            PG8_WAIT_V(8); PG8_WAIT_L(0); PG8_BAR; PG8_MMA(1, 0, At, B0); PG8_MMA(1, 1, At, B1); PG8_BAR; PG8_SCHED;
            PG8_LDB(B0, 1, 0); PG8_LDB(B1, 1, 1); PG8_SCHED; PG8_LDA(At, 1, 0); PG8_STAGE_A(PG8_SA(0, 1), a2 + hA2, sh2);
            PG8_WAIT_V(8); PG8_WAIT_L(0); PG8_BAR; PG8_MMA(0, 0, At, B0); PG8_MMA(0, 1, At, B1); PG8_BAR; PG8_SCHED;
            PG8_LDA(At, 1, 1); PG8_STAGE(PG8_SB(1, 0), b3, voffB); PG8_STAGE(PG8_SB(1, 1), b3 + hstep, voffB); PG8_STAGE_A(PG8_SA(1, 0), a3, sh2);
            PG8_WAIT_V(8); PG8_WAIT_L(0); PG8_BAR; PG8_MMA(1, 0, At, B0); PG8_MMA(1, 1, At, B1); PG8_BAR; PG8_SCHED;
            } else {
            PG8_LDB(B0, 0, 0); PG8_SCHED; PG8_LDA(At, 0, 0); PG8_STAGE_A(PG8_SA(1, 1), a1 + hA1, csh);
            PG8_WAIT_L(8); PG8_BAR; PG8_WAIT_L(0); PG8_MMA(0, 0, At, B0); PG8_BAR; PG8_SCHED;
            PG8_LDB(B1, 0, 1); PG8_STAGE(PG8_SB(0, 0), b2, voffB);
            PG8_BAR; PG8_WAIT_L(0); PG8_MMA(0, 1, At, B1); PG8_BAR;
            PG8_LDA(At, 0, 1); PG8_STAGE_A(PG8_SA(0, 0), a2, sh2);
            PG8_BAR; PG8_WAIT_L(0); PG8_MMA(1, 0, At, B0); PG8_BAR; PG8_SCHED;
            PG8_STAGE(PG8_SB(0, 1), b2 + hstep, voffB);
            PG8_WAIT_V(6); PG8_BAR; PG8_MMA(1, 1, At, B1); PG8_BAR;
            PG8_LDB(B0, 1, 0); PG8_SCHED; PG8_LDA(At, 1, 0); PG8_STAGE_A(PG8_SA(0, 1), a2 + hA2, sh2);
            PG8_WAIT_L(8); PG8_BAR; PG8_WAIT_L(0); PG8_MMA(0, 0, At, B0); PG8_BAR; PG8_SCHED;
            PG8_LDB(B1, 1, 1); PG8_STAGE(PG8_SB(1, 0), b3, voffB);
            PG8_BAR; PG8_WAIT_L(0); PG8_MMA(0, 1, At, B1); PG8_BAR;
            PG8_LDA(At, 1, 1); PG8_STAGE_A(PG8_SA(1, 0), a3, sh2);
            PG8_BAR; PG8_WAIT_L(0); PG8_MMA(1, 0, At, B0); PG8_BAR; PG8_SCHED;
            PG8_STAGE(PG8_SB(1, 1), b3 + hstep, voffB);
            PG8_WAIT_V(6); PG8_BAR; PG8_MMA(1, 1, At, B1); PG8_BAR;
            }
        }
        if constexpr (ALIGN_EPI) { if (wr == 0) PG8_BAR; }
        if constexpr (I8) {
#pragma unroll
            for (int a = 0; a < 2; ++a)
#pragma unroll
                for (int b = 0; b < 2; ++b)
#pragma unroll
                    for (int m = 0; m < 4; ++m)
#pragma unroll
                        for (int n = 0; n < 2; ++n) { const v4i32_t iv = __builtin_bit_cast(v4i32_t, acc[a][b][m][n]); acc[a][b][m][n] = (f32x4){(float)iv[0], (float)iv[1], (float)iv[2], (float)iv[3]}; }
        }
        if constexpr (!Epi::AFTER_DRAIN) { E(acc, cur, wr, wc, fr, fq); S.done(cur); }
        if (!has_next) break;
#pragma unroll
        for (int a = 0; a < 2; ++a)
#pragma unroll
            for (int b = 0; b < 2; ++b)
#pragma unroll
                for (int m = 0; m < 4; ++m)
#pragma unroll
                    for (int n = 0; n < 2; ++n) acc[a][b][m][n] = (f32x4){0.f, 0.f, 0.f, 0.f};
        cur = nxt; cA = nA; cB = nB; csh = nsh; ++ui;
        if constexpr (ALIGN_EPI) { if (wr == 1) PG8_BAR; }
    }
    PG8_WAIT_V(0);
    if constexpr (!ALIGN_EPI) { if (wr == 0) PG8_BAR; }
    PG8_BAR;
    if constexpr (Epi::AFTER_DRAIN) { E.fused(acc, cur, wr, wc, fr, fq, lds, wid, lane); S.done(cur); }
#undef PG8_SA
#undef PG8_SB
#undef PG8_STAGE
#undef PG8_STAGE_A
#undef PG8_LDA
#undef PG8_LDB
#undef PG8_MMA
#undef PG8_WAIT_V
#undef PG8_WAIT_L
#undef PG8_BAR
#undef PG8_SCHED
}
}

#define GAS __attribute__((address_space(1)))
#define LAS __attribute__((address_space(3)))
typedef unsigned short bf16;
typedef unsigned v4u __attribute__((ext_vector_type(4)));
typedef float f32x4 __attribute__((ext_vector_type(4)));
typedef short bf16x8 __attribute__((ext_vector_type(8)));
typedef GAS unsigned gu32;
typedef GAS unsigned long long gu64;
#define RLX_AGENT __ATOMIC_RELAXED, __HIP_MEMORY_SCOPE_AGENT
#define LDS_WAIT() asm volatile("s_waitcnt lgkmcnt(0)" ::: "memory")
#define VM_WAIT() asm volatile("s_waitcnt vmcnt(0)" ::: "memory")
__device__ __forceinline__ unsigned long long rt() { return __builtin_amdgcn_s_memrealtime(); }
__device__ __forceinline__ unsigned f2bf(float f) { unsigned u = __builtin_bit_cast(unsigned, f); return (u + 0x7fffu + ((u >> 16) & 1u)) >> 16; }
__device__ __forceinline__ unsigned pk2(float lo, float hi) { return f2bf(lo) | (f2bf(hi) << 16); }

#define XB_TMO      128
#define XB_XCNT(j)  (256  + 64 * (j))
#define XB_XSUB(j)  (1280 + 64 * (j))
#define XB_XGEN(j)  (2304 + 64 * (j))
#define XB_TOP      3328
#define XB_TOPGEN   3392
#define XCD_BAR_WORDS 3456
#define XB_SPIN_CAP (1u << 18)

__device__ __forceinline__ unsigned xb_ld(unsigned* p)              { return __hip_atomic_load(p, __ATOMIC_RELAXED, __HIP_MEMORY_SCOPE_AGENT); }
__device__ __forceinline__ unsigned xb_add(unsigned* p, unsigned v) { return __hip_atomic_fetch_add(p, v, __ATOMIC_RELAXED, __HIP_MEMORY_SCOPE_AGENT); }
__device__ __forceinline__ unsigned xb_xcc_id() { return (unsigned)__builtin_amdgcn_s_getreg((3 << 11) | 20) & 0xFu; }
#define XB_SPIN(cond, bar) do { unsigned _sp = 0; while (cond) { __builtin_amdgcn_s_sleep(1); \
    if ((++_sp & 255u) == 0u) { if (xb_ld(&(bar)[XB_TMO])) break; if (_sp > XB_SPIN_CAP) { atomicAdd(&(bar)[XB_TMO], 1u); break; } } } } while (0)

struct XcdBarrier {
    unsigned* bar; unsigned x;
    volatile LAS unsigned* st;
};

__device__ __forceinline__ XcdBarrier xcd_barrier_post(unsigned* bar, volatile LAS unsigned* st) {
    XcdBarrier b; b.bar = bar; b.x = xb_xcc_id(); b.st = st;
    if (threadIdx.x == 0) (void)xb_add(&bar[XB_XCNT(b.x)], 1u);
    return b;
}
__device__ __forceinline__ void xcd_barrier_complete(unsigned* bar, unsigned x, unsigned& nloc, unsigned& nx) {
    const unsigned G = gridDim.x * gridDim.y * gridDim.z;
    unsigned sum, cnt, mine, sp = 0u;
    for (;;) {
        sum = 0u; cnt = 0u; mine = 0u;
#pragma unroll
        for (unsigned j = 0; j < 16; ++j) { const unsigned c = xb_ld(&bar[XB_XCNT(j)]); sum += c; cnt += (c > 0u) ? 1u : 0u; mine = (j == x) ? c : mine; }
        if (sum == G) break;
        __builtin_amdgcn_s_sleep(1);
        if ((++sp & 255u) == 0u) { if (xb_ld(&bar[XB_TMO])) break; if (sp > XB_SPIN_CAP) { atomicAdd(&bar[XB_TMO], 1u); break; } }
    }
    nloc = mine > 0u ? mine : 1u; nx = cnt > 0u ? cnt : 1u;
}

__device__ __forceinline__ void xcd_barrier(const XcdBarrier& b) {
    asm volatile("s_waitcnt vmcnt(0)" ::: "memory");
    __syncthreads();
    if (threadIdx.x == 0) {
        unsigned* bar = b.bar;
        __builtin_amdgcn_s_waitcnt(0);
        unsigned nloc = b.st[0], nx = b.st[1];
        if (nloc == 0u) { xcd_barrier_complete(bar, b.x, nloc, nx); b.st[0] = nloc; b.st[1] = nx; }
        const unsigned old = xb_add(&bar[XB_XSUB(b.x)], 1u);
        const unsigned gen = old / nloc;
        if (old + 1u == (gen + 1u) * nloc) {
            __builtin_amdgcn_fence(__ATOMIC_RELEASE, "agent");
            asm volatile("s_waitcnt vmcnt(0)" ::: "memory");
            const unsigned og = xb_add(&bar[XB_TOP], 1u);
            const unsigned tg = og / nx;
            if (og + 1u == (tg + 1u) * nx) xb_add(&bar[XB_TOPGEN], 1u);
            else XB_SPIN(xb_ld(&bar[XB_TOPGEN]) == tg, bar);
            __builtin_amdgcn_fence(__ATOMIC_ACQUIRE, "agent");
            xb_add(&bar[XB_XGEN(b.x)], 1u);
            asm volatile("s_waitcnt vmcnt(0)" ::: "memory");
        } else {
            XB_SPIN(xb_ld(&bar[XB_XGEN(b.x)]) == gen, bar);
            __builtin_amdgcn_fence(__ATOMIC_ACQUIRE, "agent");
            asm volatile("s_waitcnt vmcnt(0)" ::: "memory");
        }
    }
    __syncthreads();
}


constexpr int NWAVES = 8;
#ifndef MK_N_LAUNCHES
#define MK_N_LAUNCHES 1
#endif
constexpr int N_PHASES = 11;
constexpr int N_LAUNCHES = MK_N_LAUNCHES;
constexpr int BATCH = 2, SEQ = 8192, T = BATCH * SEQ, D = 1024;
constexpr int DIN = 9728, NQKV = 4608, NCG = 5120, GW = 512, DAO = 512;
constexpr int NP1 = NQKV + 512;
constexpr int NEXP = 16384, PEER_H = 8, PEER_K = 16, HK = 128;
constexpr float RMS_EPS = 1e-6f;
constexpr float C2 = 0.125f * 1.4426950408889634f;
constexpr float LN2 = 0.6931471805599453f;

constexpr size_t MiB = 1u << 20;
constexpr size_t WS_CTL = 0, CTL_ZERO_BYTES = 64 * 1024;
constexpr size_t WS_ROPE = 1 * MiB, WS_RSQ = 2 * MiB, WS_LSE = 3 * MiB;
constexpr size_t WS_U8 = 24 * MiB, WS_WQKV8 = 5 * MiB, WS_SU = 15 * MiB, WS_SW = 15 * MiB + 65536;
constexpr size_t WS_Q = 56 * MiB, WS_K = 104 * MiB, WS_V = 152 * MiB, WS_O = 200 * MiB;
constexpr size_t WS_Z = 136 * MiB, WS_SGC = 168 * MiB, WS_SGA = 216 * MiB;
constexpr size_t OS_BB = 0, OS_EDOWN = 32 * MiB, OS_WFOLD = 48 * MiB;
constexpr size_t WS_WCONV = 248 * MiB, WS_WATTN = 250 * MiB, WS_WOUT = 251 * MiB;
constexpr size_t WS_EUP = 104 * MiB, WS_ESCALE = 253 * MiB;
constexpr size_t WS_Y = 136 * MiB, WS_H = 168 * MiB, WS_HG = 24 * MiB;
constexpr size_t WS_IDX = 9 * MiB, WS_GATE = 120 * MiB, WS_WB = 56 * MiB, WS_SS = 64 * MiB, WS_HG8 = 65 * MiB, WS_HSC = 81 * MiB;
constexpr size_t WS_SCR0 = 136 * MiB, WS_SCR1 = 88 * MiB, WS_SCR2 = 232 * MiB;
constexpr size_t WS_END = 256 * MiB;
constexpr int CW_TMO = 0, CW_BAR = 1024, CW_RANK = 8192;

constexpr int RING_BYTES = 131072, MISC_OFF = RING_BYTES + 320, LDS_BYTES = 147456;

using pg8::Unit; using pg8::Gemm; using pg8::StaticOrder; using pg8::gemm_phase; using pg8::cvt_pk_bf16;
typedef unsigned short bf16;
typedef unsigned u32x4 __attribute__((ext_vector_type(4)));
typedef unsigned u32x2 __attribute__((ext_vector_type(2)));
typedef float f32x4 __attribute__((ext_vector_type(4)));
typedef float f32x2 __attribute__((ext_vector_type(2)));
typedef short bf16x8 __attribute__((ext_vector_type(8)));
typedef short s16x4 __attribute__((ext_vector_type(4)));
typedef short v4i16_t __attribute__((ext_vector_type(4)));
#define LAS __attribute__((address_space(3)))

__device__ __forceinline__ float bf_lo(unsigned w) { return __builtin_bit_cast(float, w << 16); }
__device__ __forceinline__ float bf_hi(unsigned w) { return __builtin_bit_cast(float, w & 0xffff0000u); }
__device__ __forceinline__ u32x4 pack8(f32x4 a, f32x4 b) { u32x4 w; w.x = cvt_pk_bf16(a[0], a[1]); w.y = cvt_pk_bf16(a[2], a[3]); w.z = cvt_pk_bf16(b[0], b[1]); w.w = cvt_pk_bf16(b[2], b[3]); return w; }
__device__ __forceinline__ void unpack8(u32x4 w, f32x4& a, f32x4& b) { a = (f32x4){bf_lo(w.x), bf_hi(w.x), bf_lo(w.y), bf_hi(w.y)}; b = (f32x4){bf_lo(w.z), bf_hi(w.z), bf_lo(w.w), bf_hi(w.w)}; }
template <int CTRL> __device__ __forceinline__ float dppf(float v) { const int x = __builtin_bit_cast(int, v); return __builtin_bit_cast(float, __builtin_amdgcn_update_dpp(x, x, CTRL, 0xf, 0xf, true)); }
__device__ __forceinline__ float sum4_dpp(float v) { v += dppf<0xB1>(v); v += dppf<0x4E>(v); return v; }
__device__ __forceinline__ float sum8_dpp(float v) { v = sum4_dpp(v); v += dppf<0x141>(v); return v; }
__device__ __forceinline__ float sum16_dpp(float v) { v = sum8_dpp(v); v += dppf<0x140>(v); return v; }
__device__ __forceinline__ float wave_sum(float v) {
#pragma unroll
    for (int o = 1; o < 64; o <<= 1) v += __shfl_xor(v, o);
    return v;
}
__device__ __forceinline__ unsigned pack4i8(f32x4 v) { const int a = (int)__builtin_rintf(v[0]), b = (int)__builtin_rintf(v[1]), c = (int)__builtin_rintf(v[2]), d = (int)__builtin_rintf(v[3]); return (unsigned)(a & 255) | ((unsigned)(b & 255) << 8) | ((unsigned)(c & 255) << 16) | ((unsigned)d << 24); }
__device__ __forceinline__ f32x4 unpack4u8(unsigned w) { return (f32x4){(float)(w & 255u), (float)((w >> 8) & 255u), (float)((w >> 16) & 255u), (float)(w >> 24)} * (1.f / 255.f); }
__device__ __forceinline__ float xor16(float v, int fq) {
    const unsigned x = __builtin_bit_cast(unsigned, v);
    const auto r = __builtin_amdgcn_permlane16_swap(x, x, false, false);
    const unsigned a = r[0], b = r[1];
    return __builtin_bit_cast(float, (fq & 1) ? a : b);
}
__device__ __forceinline__ float sigmoidf_(float x) { return 1.f / (1.f + __expf(-x)); }

struct QkvOrder : StaticOrder {
    const char* U;
    __device__ __forceinline__ const char* a_base(const Unit& u, int& sh) const {
        const int g = (u.pn < 18) ? u.pn / 6 : 0; sh = 2 * g;
        const int b = u.pm >> 5, lp0 = (u.pm & 31) * 256;
        const int r = lp0 >> (13 - sh), i0 = lp0 & ((SEQ >> sh) - 1);
        const int t0 = b * SEQ + (i0 << sh) + r;
        return U + (size_t)t0 * D;
    }
};
struct EpiQKV {
    static constexpr bool PERM = true, AFTER_DRAIN = false;
    bf16* Q; const float* rope; const float* su; const float* sw; unsigned char* SGA; const float* gbias1;
    __device__ __forceinline__ void operator()(const f32x4 (&acc)[2][2][4][2], const Unit& u, int wr, int wc, int fr, int fq) const {
        if (u.pn >= 18) {
#pragma unroll
            for (int ai = 0; ai < 2; ++ai)
#pragma unroll
                for (int m = 0; m < 4; ++m) { const size_t row = (size_t)u.pm * 256 + ai * 128 + wr * 64 + m * 16 + fr; const float sr = su[row];
#pragma unroll
                    for (int bj = 0; bj < 2; ++bj) { const int col = 512 + (u.pn - 18) * 256 + bj * 128 + wc * 32 + fq * 8;
                        const f32x4 b0 = *(const f32x4*)(gbias1 + col), b1 = *(const f32x4*)(gbias1 + col + 4);
                        const int wcol = u.pn * 256 + bj * 128 + wc * 32 + fq * 8;
                        f32x4 v0 = acc[ai][bj][m][0] * (*(const f32x4*)(sw + wcol) * sr) + b0, v1 = acc[ai][bj][m][1] * (*(const f32x4*)(sw + wcol + 4) * sr) + b1;
#pragma unroll
                        for (int e = 0; e < 4; ++e) { v0[e] = sigmoidf_(v0[e]) * 255.f; v1[e] = sigmoidf_(v1[e]) * 255.f; }
                        u32x2 g8; g8.x = pack4i8(v0); g8.y = pack4i8(v1);
                        *(u32x2*)(SGA + row * D + col) = g8; } }
            return;
        }
        asm volatile("" : "+v"(fr), "+v"(fq));
        const int g = u.pn / 6, kind = (u.pn % 6) >> 1, half = u.pn & 1, sh = 2 * g;
        bf16* base = Q + (size_t)kind * ((WS_K - WS_Q) / 2) + (size_t)g * T * GW;
        const int b = u.pm >> 5, lp0 = (u.pm & 31) * 256;
        const bool rot = (kind < 2) && ((wc & 1) == 0);
        const float sc = (kind == 0) ? C2 : 1.f;
        f32x4 swv[2][2];
#pragma unroll
        for (int bj = 0; bj < 2; ++bj) { const int wcol = u.pn * 256 + bj * 128 + wc * 32 + fq * 8; swv[bj][0] = *(const f32x4*)(sw + wcol) * sc; swv[bj][1] = *(const f32x4*)(sw + wcol + 4) * sc; }
        const float sgn = (fq == 0) ? -1.f : 1.f; const bool use = fq < 2;
#pragma unroll
        for (int ai = 0; ai < 2; ++ai)
#pragma unroll
            for (int m = 0; m < 4; ++m) {
                const int rl = ai * 128 + wr * 64 + m * 16 + fr, lp = lp0 + rl;
                const int tok = b * SEQ + ((lp & ((SEQ >> sh) - 1)) << sh) + (lp >> (13 - sh));
                const float sut = su[tok];
                f32x4 c0 = {1.f, 1.f, 1.f, 1.f}, c1 = c0, s0 = {0.f, 0.f, 0.f, 0.f}, s1 = s0;
                if (rot) { const f32x4* rp = (const f32x4*)(rope + (size_t)tok * 16); c0 = rp[0]; c1 = rp[1]; s0 = rp[2]; s1 = rp[3]; }
                bf16* rowp = base + (size_t)(u.pm * 256 + rl) * GW + half * 256 + wc * 32 + fq * 8;
#pragma unroll
                for (int bj = 0; bj < 2; ++bj) {
                    f32x4 v0 = acc[ai][bj][m][0] * (swv[bj][0] * sut), v1 = acc[ai][bj][m][1] * (swv[bj][1] * sut);
                    if (rot) {
                        f32x4 o0, o1;
#pragma unroll
                        for (int e = 0; e < 4; ++e) { o0[e] = xor16(v0[e], fq); o1[e] = xor16(v1[e], fq); }
                        const f32x4 r0 = v0 * c0 + (o0 * s0) * sgn, r1 = v1 * c1 + (o1 * s1) * sgn;
                        v0 = use ? r0 : v0; v1 = use ? r1 : v1;
                    }
                    *(u32x4*)(rowp + bj * 128) = pack8(v0, v1);
                }
            }
    }
};
struct EpiCG {
    static constexpr bool PERM = true, AFTER_DRAIN = false;
    bf16* Bb; bf16* Z; unsigned char* SGC; unsigned char* SGA; const float* gbias; const float* su; const float* sw;
    __device__ __forceinline__ void operator()(const f32x4 (&accin)[2][2][4][2], const Unit& u, int wr, int wc, int fr, int fq) const {
        const int pn = u.pn;
        f32x4 swv[2][2];
#pragma unroll
        for (int bj = 0; bj < 2; ++bj) { const int wcol = NP1 + pn * 256 + bj * 128 + wc * 32 + fq * 8; swv[bj][0] = *(const f32x4*)(sw + wcol); swv[bj][1] = *(const f32x4*)(sw + wcol + 4); }
        f32x4 acc[2][2][4][2];
#pragma unroll
        for (int ai = 0; ai < 2; ++ai)
#pragma unroll
            for (int m = 0; m < 4; ++m) { const float sr = su[(size_t)u.pm * 256 + ai * 128 + wr * 64 + m * 16 + fr];
#pragma unroll
                for (int bj = 0; bj < 2; ++bj) { acc[ai][bj][m][0] = accin[ai][bj][m][0] * (swv[bj][0] * sr); acc[ai][bj][m][1] = accin[ai][bj][m][1] * (swv[bj][1] * sr); } }
#pragma unroll
        for (int ai = 0; ai < 2; ++ai)
#pragma unroll
            for (int m = 0; m < 4; ++m) {
                const size_t row = (size_t)u.pm * 256 + ai * 128 + wr * 64 + m * 16 + fr;
                if (pn < 4) {
#pragma unroll
                    for (int bj = 0; bj < 2; ++bj) *(u32x4*)(Bb + row * D + pn * 256 + bj * 128 + wc * 32 + fq * 8) = pack8(acc[ai][bj][m][0], acc[ai][bj][m][1]);
                } else if (pn < 12) {
                    const f32x4 z0 = acc[ai][0][m][0] * acc[ai][1][m][0], z1 = acc[ai][0][m][1] * acc[ai][1][m][1];
                    *(u32x4*)(Z + row * D + (pn - 4) * 128 + wc * 32 + fq * 8) = pack8(z0, z1);
                } else {
                    const int gsel = (pn >= 16) ? 1 : 0; unsigned char* out = gsel ? SGA : SGC;
#pragma unroll
                    for (int bj = 0; bj < 2; ++bj) {
                        const int col = (pn - 12 - 4 * gsel) * 256 + bj * 128 + wc * 32 + fq * 8;
                        const f32x4 b0 = *(const f32x4*)(gbias + gsel * D + col), b1 = *(const f32x4*)(gbias + gsel * D + col + 4);
                        f32x4 v0 = acc[ai][bj][m][0] + b0, v1 = acc[ai][bj][m][1] + b1;
#pragma unroll
                        for (int e = 0; e < 4; ++e) { v0[e] = sigmoidf_(v0[e]) * 255.f; v1[e] = sigmoidf_(v1[e]) * 255.f; }
                        u32x2 g8; g8.x = pack4i8(v0); g8.y = pack4i8(v1);
                        *(u32x2*)(out + row * D + col) = g8;
                    }
                }
            }
    }
};
template <int MODE> struct EpiY {
    static constexpr bool PERM = true, AFTER_DRAIN = false;
    bf16* Y; const unsigned char* G;
    __device__ __forceinline__ void operator()(const f32x4 (&acc)[2][2][4][2], const Unit& u, int wr, int wc, int fr, int fq) const {
#pragma unroll
        for (int ai = 0; ai < 2; ++ai)
#pragma unroll
            for (int m = 0; m < 4; ++m) {
                const size_t row = (size_t)u.pm * 256 + ai * 128 + wr * 64 + m * 16 + fr;
#pragma unroll
                for (int bj = 0; bj < 2; ++bj) {
                    const size_t off = row * D + u.pn * 256 + bj * 128 + wc * 32 + fq * 8;
                    const u32x2 g8 = *(const u32x2*)(G + off);
                    const f32x4 g0 = unpack4u8(g8.x), g1 = unpack4u8(g8.y);
                    f32x4 v0 = acc[ai][bj][m][0] * g0, v1 = acc[ai][bj][m][1] * g1;
                    if (MODE == 1) { f32x4 y0, y1; unpack8(*(const u32x4*)(Y + off), y0, y1); v0 = v0 + y0; v1 = v1 + y1; }
                    *(u32x4*)(Y + off) = pack8(v0, v1);
                }
            }
    }
};
struct EpiOut {
    static constexpr bool PERM = true, AFTER_DRAIN = false;
    const float* X; bf16* HG; const float* nffn; float* RSQ; unsigned char* HG8; float* HSC;
    __device__ __forceinline__ void operator()(const f32x4 (&acc)[2][2][4][2], const Unit& u, int wr, int wc, int fr, int fq) const {
#pragma unroll
        for (int ai = 0; ai < 2; ++ai)
#pragma unroll
            for (int m = 0; m < 4; ++m) {
                const size_t row = (size_t)u.pm * 256 + ai * 128 + wr * 64 + m * 16 + fr;
                float ss = 0.f;
#pragma unroll
                for (int bj = 0; bj < 2; ++bj) {
                    const int col = u.pn * 256 + bj * 128 + wc * 32 + fq * 8; const size_t off = row * D + col;
                    const f32x4 h0 = *(const f32x4*)(X + off) + acc[ai][bj][m][0], h1 = *(const f32x4*)(X + off + 4) + acc[ai][bj][m][1];
                    const f32x4 n0 = *(const f32x4*)(nffn + col), n1 = *(const f32x4*)(nffn + col + 4);
                    const f32x4 y0 = h0 * n0, y1 = h1 * n1;
                    *(u32x4*)(HG + off) = pack8(y0, y1);
                    float am = fmaxf(fmaxf(fmaxf(fabsf(y0[0]), fabsf(y0[1])), fmaxf(fabsf(y0[2]), fabsf(y0[3]))), fmaxf(fmaxf(fabsf(y1[0]), fabsf(y1[1])), fmaxf(fabsf(y1[2]), fabsf(y1[3]))));
                    am = fmaxf(am, __shfl_xor(am, 16)); am = fmaxf(am, __shfl_xor(am, 32));
                    const float qs = (am > 0.f) ? 127.f / am : 0.f;
                    u32x2 q8; q8.x = pack4i8(y0 * qs); q8.y = pack4i8(y1 * qs);
                    *(u32x2*)(HG8 + off) = q8;
                    if (fq == 0) HSC[row * 32 + u.pn * 8 + bj * 4 + wc] = am * (1.f / 127.f);
                    ss += (h0[0] * h0[0] + h0[1] * h0[1]) + (h0[2] * h0[2] + h0[3] * h0[3]) + (h1[0] * h1[0] + h1[1] * h1[1]) + (h1[2] * h1[2] + h1[3] * h1[3]);
                }
                ss += __shfl_xor(ss, 16); ss += __shfl_xor(ss, 32);
                if (fq == 0) RSQ[row * 16 + u.pn * 4 + wc] = ss;
            }
    }
};
struct CvCtx { const float* dn; const float* up; unsigned char* ed; unsigned char* eu; float* esc; int lane; };
__device__ __forceinline__ void cv_load(const CvCtx& C, int ru, f32x4 (&v)[4]) {
    const int tb = ru >> 14, e = ru & (NEXP - 1);
    const float* src = (tb ? C.up : C.dn) + (size_t)e * D + 16 * C.lane;
#pragma unroll
    for (int q = 0; q < 4; ++q) v[q] = *(const f32x4*)(src + 4 * q);
}
__device__ __forceinline__ void cv_finish(const CvCtx& C, int ru, const f32x4 (&v)[4]) {
    const int tb = ru >> 14, e = ru & (NEXP - 1);
    float am = 0.f;
#pragma unroll
    for (int q = 0; q < 4; ++q) am = fmaxf(am, fmaxf(fmaxf(fabsf(v[q][0]), fabsf(v[q][1])), fmaxf(fabsf(v[q][2]), fabsf(v[q][3]))));
#pragma unroll
    for (int o = 1; o < 64; o <<= 1) am = fmaxf(am, __shfl_xor(am, o));
    u32x4 w;
    if (tb) {
        const float sc = (am > 0.f) ? 256.f / am : 1.f;
#pragma unroll
        for (int q = 0; q < 4; ++q) { int d = __builtin_amdgcn_cvt_pk_fp8_f32(v[q][0] * sc, v[q][1] * sc, 0, false); d = __builtin_amdgcn_cvt_pk_fp8_f32(v[q][2] * sc, v[q][3] * sc, d, true); w[q] = (unsigned)d; }
        *(u32x4*)(C.eu + (size_t)(C.lane >> 3) * (2 * MiB) + (size_t)e * 128 + 16 * (C.lane & 7)) = w;
    } else {
        const float s8 = (am > 0.f) ? 127.f / am : 0.f;
#pragma unroll
        for (int q = 0; q < 4; ++q) w[q] = pack4i8(v[q] * s8);
        *(u32x4*)(C.ed + (size_t)e * 1024 + 16 * C.lane) = w;
    }
    if (C.lane == 0) C.esc[ru] = tb ? ((am > 0.f) ? am * (1.f / 256.f) : 1.f) : am * (1.f / 127.f);
}
__device__ __forceinline__ int f2key(float f) { const int b = __builtin_bit_cast(int, f); return b ^ ((b >> 31) & 0x7fffffff); }
__device__ __forceinline__ float key2f(int k) { return __builtin_bit_cast(float, k ^ ((k >> 31) & 0x7fffffff)); }
#define TOPK_INS(list, x) do { _Pragma("unroll") for (int _k = 0; _k < 16; ++_k) { const int _hi = max(list[_k], x); x = min(list[_k], x); list[_k] = _hi; } } while (0)
__device__ __forceinline__ unsigned long long pack8idx(const int (&a)[16], int o) { unsigned long long r = 0ull;
#pragma unroll
    for (int k = 0; k < 8; ++k) r |= (unsigned long long)(unsigned)(a[o + k] & 127) << (8 * k);
    return r; }
__device__ __forceinline__ int lut16(unsigned long long lo, unsigned long long hi, int i) { const unsigned long long w = (i < 8) ? lo : hi; return (int)((w >> ((i & 7) * 8)) & 127ull); }
__device__ __forceinline__ void sort16_asc(int (&x)[16]) {
#pragma unroll
    for (int k = 2; k <= 16; k <<= 1)
#pragma unroll
        for (int j = k >> 1; j > 0; j >>= 1)
#pragma unroll
            for (int i = 0; i < 16; ++i) { const int l = i ^ j; if (l > i) { const int lo = min(x[i], x[l]), hi = max(x[i], x[l]); const bool up = (i & k) == 0; x[i] = up ? lo : hi; x[l] = up ? hi : lo; } }
}
__device__ __forceinline__ void merge16(int (&r)[16], const int (&a)[16]) {
#pragma unroll
    for (int i = 0; i < 16; ++i) r[i] = max(r[i], a[i]);
#pragma unroll
    for (int j = 8; j > 0; j >>= 1)
#pragma unroll
        for (int i = 0; i < 16; ++i) { const int l = i ^ j; if (l > i) { const int lo = min(r[i], r[l]), hi = max(r[i], r[l]); r[i] = hi; r[l] = lo; } }
}
struct EpiTopk {
    static constexpr bool PERM = true, AFTER_DRAIN = false;
    float* scr; const float* RSQ; int* IDX; float* GATE; CvCtx CV; mutable int cvr; int cvstep;
    __device__ __forceinline__ void operator()(const f32x4 (&acc)[2][2][4][2], const Unit& u, int wr, int wc, int fr, int fq) const {
        const __amdgpu_buffer_rsrc_t rsrc = __builtin_amdgcn_make_buffer_rsrc(scr, 0, 262144, 0x00020000);
        const int voff = ((wc * 32 + fq * 8) * 256 + wr * 64 + fr) * 4;
#pragma unroll
        for (int ai = 0; ai < 2; ++ai)
#pragma unroll
            for (int m = 0; m < 4; ++m)
#pragma unroll
                for (int bj = 0; bj < 2; ++bj)
#pragma unroll
                    for (int n = 0; n < 2; ++n)
#pragma unroll
                        for (int e = 0; e < 4; ++e)
                        { const float val = acc[ai][bj][m][n][e]; __builtin_amdgcn_raw_buffer_store_b32(__builtin_bit_cast(unsigned, val), rsrc, voff, ((bj * 128 + n * 4 + e) * 256 + ai * 128 + m * 16) * 4, 0); }
        asm volatile("s_waitcnt vmcnt(0)" ::: "memory");
        __builtin_amdgcn_s_barrier();
        asm volatile("" ::: "memory");
        const int tid = threadIdx.x, row = tid >> 1, c = tid & 1;
        int v[16];
#pragma unroll
        for (int k = 0; k < 16; ++k) v[k] = (int)0x80000000;
        const int roff = (c * 128 * 256 + row) * 4;
        const size_t t = (size_t)u.pm * 256 + row;
        f32x4 rq[4];
#pragma unroll
        for (int j = 0; j < 4; ++j) rq[j] = *(const f32x4*)(RSQ + t * 16 + 4 * j);
        float xs[16], xn[16];
#pragma unroll
        for (int j = 0; j < 16; ++j) xs[j] = __builtin_bit_cast(float, __builtin_amdgcn_raw_buffer_load_b32(rsrc, roff, j * 1024, 2));
#pragma unroll 1
        for (int k0 = 0; k0 < 128; k0 += 16) {
            if (k0 + 16 < 128) {
#pragma unroll
                for (int j = 0; j < 16; ++j) xn[j] = __builtin_bit_cast(float, __builtin_amdgcn_raw_buffer_load_b32(rsrc, roff, (k0 + 16 + j) * 1024, 2));
            }
            __builtin_amdgcn_sched_barrier(0);
            int kb[16];
#pragma unroll
            for (int j = 0; j < 16; ++j) kb[j] = (f2key(xs[j]) & ~127) | (k0 + j);
            sort16_asc(kb);
            if (k0 == 0) {
#pragma unroll
                for (int j = 0; j < 16; ++j) v[j] = kb[15 - j];
            } else merge16(v, kb);
            __builtin_amdgcn_sched_barrier(0);
#pragma unroll
            for (int j = 0; j < 16; ++j) xs[j] = xn[j];
        }
        int A[16], B[16];
#pragma unroll
        for (int k = 0; k < 16; ++k) { const int o = __shfl_xor(v[k], 1); A[k] = c ? o : v[k]; B[k] = c ? v[k] : o; }
        int c2[16];
#pragma unroll
        for (int k = 0; k < 16; ++k) c2[k] = (int)0x80000000;
#define CAND(i, j) ((f2key(key2f(A[i]) + key2f(B[j])) & ~255) | ((i) * 16 + (j)))
#pragma unroll
        for (int j = 0; j < 16; ++j) c2[j] = CAND(0, j);
        { int t[16]; t[0] = (int)0x80000000;
#pragma unroll
          for (int i = 1; i < 16; ++i) t[16 - i] = CAND(i, 0);
          merge16(c2, t); }
        { int t[16];
          t[0] = CAND(1, 1); t[1] = CAND(1, 2); t[2] = CAND(1, 3); t[3] = CAND(1, 4); t[4] = CAND(1, 5); t[5] = CAND(1, 6); t[6] = CAND(1, 7);
          t[7] = CAND(2, 1); t[8] = CAND(2, 2); t[9] = CAND(2, 3); t[10] = CAND(2, 4); t[11] = CAND(3, 1); t[12] = CAND(3, 2); t[13] = CAND(3, 3);
          t[14] = CAND(4, 1); t[15] = CAND(4, 2);
          sort16_asc(t); merge16(c2, t); }
        { int x = CAND(5, 1); TOPK_INS(c2, x); x = CAND(6, 1); TOPK_INS(c2, x); x = CAND(7, 1); TOPK_INS(c2, x); }
#undef CAND
        float ssq = 0.f;
#pragma unroll
        for (int j = 0; j < 4; ++j) ssq += (rq[j][0] + rq[j][1]) + (rq[j][2] + rq[j][3]);
        const float rstd = __builtin_amdgcn_rsqf(ssq * (1.f / D) + RMS_EPS);
        const unsigned long long alo = pack8idx(A, 0), ahi = pack8idx(A, 8), blo = pack8idx(B, 0), bhi = pack8idx(B, 8);
        float sc[16]; int id[16]; float smax = 0.f, ssum = 0.f;
#pragma unroll
        for (int k = 0; k < 16; ++k) {
            const int cid = c2[k] & 255, i = cid >> 4, j = cid & 15;
            id[k] = lut16(alo, ahi, i) * 128 + lut16(blo, bhi, j);
            sc[k] = key2f(c2[k]) * rstd;
            if (k == 0) smax = sc[0];
            sc[k] = __expf(sc[k] - smax); ssum += sc[k];
        }
        const float inv = 1.f / ssum;
        int* ip = IDX + t * HK + u.pn * 16; float* gp = GATE + t * HK + u.pn * 16;
#pragma unroll
        for (int k = 0; k < 16; ++k) if ((k >> 3) == c) { ip[k] = id[k]; gp[k] = sc[k] * inv; }
    }
};

struct Frame {
    LAS unsigned char* lds;
    volatile LAS unsigned* MISC;
    gu32* ctl;
    int tid, lane, wave, vcu, G;
    int xcc, xrank;
    unsigned char* ws;
    const float* in[15]; float* out;
};
enum { I_X = 0, I_POS, I_NMIX, I_WIN, I_CONVW, I_WCONV, I_WATTN, I_GBIAS, I_WOUT, I_NFFN, I_WQ, I_SUBK, I_DOWN, I_UP, I_FNORM };

__device__ __forceinline__ void transpose_item(const float* W, int ldw, int k0, int n0, bf16* dst, int ldd, LAS float* scr, int lane) {
#pragma unroll 8
    for (int i = 0; i < 32; ++i) { const int kk = 2 * i + (lane >> 5); scr[kk * 33 + (lane & 31)] = W[(size_t)(k0 + kk) * ldw + n0 + (lane & 31)]; }
    LDS_WAIT(); asm volatile("" ::: "memory");
    const int c = lane & 7;
#pragma unroll
    for (int j = 0; j < 4; ++j) { const int n = (lane >> 3) + 8 * j; const LAS float* s = scr + (8 * c) * 33 + n;
        v4u o; o.x = pk2(s[0 * 33], s[1 * 33]); o.y = pk2(s[2 * 33], s[3 * 33]); o.z = pk2(s[4 * 33], s[5 * 33]); o.w = pk2(s[6 * 33], s[7 * 33]);
        *(GAS v4u*)(dst + (size_t)n * ldd + 8 * c) = o; }
    LDS_WAIT(); asm volatile("" ::: "memory");
}
__device__ __forceinline__ void w8_column_item(const float* W, int ldw, int n0, unsigned char* dst8  , float* swp  , LAS unsigned char* lds, int wave, int lane) {
    LAS float* scr = (LAS float*)(lds + wave * 16384); LAS float* cmx = (LAS float*)(lds + 130048);
    float x[2][32]; float am = 0.f;
#pragma unroll
    for (int b = 0; b < 2; ++b)
#pragma unroll
        for (int i = 0; i < 32; ++i) { const int kk = 64 * (2 * wave + b) + 2 * i + (lane >> 5); x[b][i] = W[(size_t)kk * ldw + n0 + (lane & 31)]; am = fmaxf(am, fabsf(x[b][i])); }
    am = fmaxf(am, __shfl_xor(am, 32));
    if (lane < 32) cmx[wave * 32 + lane] = am;
    __syncthreads();
    float cm = 0.f;
#pragma unroll
    for (int w = 0; w < 8; ++w) cm = fmaxf(cm, cmx[w * 32 + (lane & 31)]);
    const float q8 = (cm > 0.f) ? 127.f / cm : 0.f;
    if (wave == 0 && lane < 32) swp[lane] = cm * (1.f / 127.f);
#pragma unroll
    for (int b = 0; b < 2; ++b) {
#pragma unroll
        for (int i = 0; i < 32; ++i) scr[(2 * i + (lane >> 5)) * 33 + (lane & 31)] = x[b][i] * q8;
        LDS_WAIT(); asm volatile("" ::: "memory");
        const int c = lane & 7;
#pragma unroll
        for (int j = 0; j < 4; ++j) { const int n = (lane >> 3) + 8 * j; const LAS float* s = scr + (8 * c) * 33 + n;
            u32x2 o; o.x = pack4i8((f32x4){s[0 * 33], s[1 * 33], s[2 * 33], s[3 * 33]}); o.y = pack4i8((f32x4){s[4 * 33], s[5 * 33], s[6 * 33], s[7 * 33]});
            *(u32x2*)(dst8 + (size_t)n * D + 64 * (2 * wave + b) + 8 * c) = o; }
        LDS_WAIT(); asm volatile("" ::: "memory");
    }
    __syncthreads();
}
__device__ __forceinline__ int win_w8_row(int n0) {
    if (n0 < 1024) return NP1 + n0;
    if (n0 < 2048) { const int j = n0 - 1024; return NP1 + 1024 + (j >> 7) * 256 + (j & 127); }
    if (n0 < 3072) { const int j = n0 - 2048; return NP1 + 1024 + (j >> 7) * 256 + 128 + (j & 127); }
    if (n0 < 7680) { const int j = n0 - 3072, kind = j / 1536, jj = j % 1536, g = jj >> 9, cc = jj & 511; return g * 1536 + kind * 512 + cc; }
    if (n0 < 8704) return NP1 + 3072 + (n0 - 7680);
    if (n0 < 9216) return NP1 + 4096 + (n0 - 8704);
    return NQKV + (n0 - 9216);
}
__device__ __forceinline__ void p0_prologue(Frame& F) {
    for (int it = F.vcu; it < DIN / 32; it += F.G) {
        const int n0 = 32 * it, drow = win_w8_row(n0);
        w8_column_item(F.in[I_WIN], DIN, n0, F.ws + WS_WQKV8 + (size_t)drow * D, (float*)(F.ws + WS_SW) + drow, F.lds, F.wave, F.lane);
    }
    LAS float* scr = (LAS float*)(F.lds + F.wave * 16384);
    const int gw = F.vcu * NWAVES + F.wave, NGW = F.G * NWAVES;
    constexpr int I_C = 16 * 32, I_A = 8 * 32, I_O = 16 * 32, NITEMS = I_C + I_A + I_O;
    for (int it = gw; it < NITEMS; it += NGW) {
        int r = it;
        if (r < I_C) { const int kb = r / 32, nb = r % 32; transpose_item(F.in[I_WCONV], D, 64 * kb, 32 * nb, (bf16*)(F.ws + WS_WCONV) + (size_t)(32 * nb) * D + 64 * kb, D, scr, F.lane); continue; } r -= I_C;
        if (r < I_A) { const int kb = r / 32, nb = r % 32; transpose_item(F.in[I_WATTN], D, 64 * kb, 32 * nb, (bf16*)(F.ws + WS_WATTN) + (size_t)(32 * nb) * DAO + 64 * kb, DAO, scr, F.lane); continue; } r -= I_A;
        { const int kb = r / 32, nb = r % 32; transpose_item(F.in[I_WOUT], D, 64 * kb, 32 * nb, (bf16*)(F.ws + WS_WOUT) + (size_t)(32 * nb) * D + 64 * kb, D, scr, F.lane); }
    }
    const float* x = F.in[I_X]; const float* nm = F.in[I_NMIX];
    f32x4 gm[4];
#pragma unroll
    for (int j = 0; j < 4; ++j) gm[j] = *((const f32x4*)nm + F.lane + 64 * j);
    for (int m = gw; m < T; m += NGW) {
        const GAS f32x4* xr = (const GAS f32x4*)(x + (size_t)m * D) + F.lane;
        f32x4 v[4]; float s = 0.f;
#pragma unroll
        for (int j = 0; j < 4; ++j) { v[j] = xr[64 * j]; s += (v[j].x * v[j].x + v[j].y * v[j].y) + (v[j].z * v[j].z + v[j].w * v[j].w); }
        const float rstd = 1.f / sqrtf(wave_sum(s) * (1.f / D) + RMS_EPS);
        f32x4 y[4]; float am = 0.f;
#pragma unroll
        for (int j = 0; j < 4; ++j) { y[j] = v[j] * rstd * gm[j];
            am = fmaxf(am, fmaxf(fmaxf(fabsf(y[j].x), fabsf(y[j].y)), fmaxf(fabsf(y[j].z), fabsf(y[j].w)))); }
#pragma unroll
        for (int o = 1; o < 64; o <<= 1) am = fmaxf(am, __shfl_xor(am, o));
        const float q8 = (am > 0.f) ? 127.f / am : 0.f;
#pragma unroll
        for (int j = 0; j < 4; ++j) ((GAS unsigned*)(F.ws + WS_U8 + (size_t)m * D))[F.lane + 64 * j] = pack4i8(y[j] * q8);
        if (F.lane == 0) ((float*)(F.ws + WS_SU))[m] = am * (1.f / 127.f);
    }
    const int* pos = (const int*)F.in[I_POS]; float* rope = (float*)(F.ws + WS_ROPE);
    for (int e = gw * 64 + F.lane; e < T * 8; e += NGW * 64) {
        const int t = e >> 3, j = e & 7;
        const double invf[8] = {1.0, 0.19392274474868576, 0.03760603093086393, 0.007292664737217109, 0.001414213562373095, 0.0002742481756762073, 5.318295896944988e-05, 1.031338537721246e-05};
        double f = 1.0;
#pragma unroll
        for (int q = 1; q < 8; ++q) f = (j == q) ? invf[q] : f;
        const float fi = (float)f;
        const double ang = (double)pos[t] * (double)fi;
        const double k = __builtin_rint(ang * 0.15915494309189535);
        const float r = (float)(ang - k * 6.283185307179586);
        rope[(size_t)t * 16 + j] = __cosf(r); rope[(size_t)t * 16 + 8 + j] = __sinf(r);
    }
}

__device__ __forceinline__ void attn_phase(Frame& F, bf16* OGb, float* LSE) {
    constexpr int SLOT = 128 * 160;
    LAS unsigned char* Ks = F.lds; LAS unsigned char* Vs = F.lds + 3 * SLOT;
    const int lane = F.lane, w = F.wave, ir = lane & 15, gq = lane >> 4;
    const int NU = 3 * 8 * 128, per = (NU + F.G - 1) / F.G;
    const int u0 = F.vcu * per, u1 = (u0 + per < NU) ? u0 + per : NU;
    const bf16* Qb = (const bf16*)(F.ws + WS_Q); const bf16* Kb = (const bf16*)(F.ws + WS_K); const bf16* Vb = (const bf16*)(F.ws + WS_V);
    u32x4 pk[2], pv[2]; bf16x8 nq0, nq1; bool havepre = false;
    for (int uid = u0, n = 0; uid < u1; ++uid, ++n) {
        const int g = uid >> 10, hh = (uid >> 7) & 7, blk = uid & 127, sh = 2 * g;
        const bool first = (blk & ((64 >> sh) - 1)) == 0;
        const size_t gbase = (size_t)g * T * GW;
        const int p0 = blk * 128;
        const int ps = n % 3, cs = (n + 1) % 3, ns = (n + 2) % 3;
        const bf16* qrow = Qb + gbase + (size_t)(p0 + 16 * w + ir) * GW + hh * 64;
        bf16* orow = OGb + gbase + (size_t)(p0 + 16 * w + ir) * GW + hh * 64;
        bf16x8 qf0, qf1;
        if (!havepre) {
            if (n > 0) __syncthreads();
#pragma unroll
            for (int i = 0; i < 4; ++i) {
                const int c = F.tid + 512 * i, row = c >> 3, part = c & 7;
                const bool valid = !first || row >= 128;
                u32x4 kv = {0u, 0u, 0u, 0u}, vv = {0u, 0u, 0u, 0u};
                if (valid) { const size_t off = gbase + (size_t)(p0 - 128 + row) * GW + hh * 64 + part * 8; kv = *(const u32x4*)(Kb + off); vv = *(const u32x4*)(Vb + off); }
                const int so = ((row < 128) ? ps : cs) * SLOT + (row & 127) * 160 + part * 16;
                *(LAS u32x4*)(Ks + so) = kv; *(LAS u32x4*)(Vs + so) = vv;
            }
            qf0 = *(const bf16x8*)(qrow + 8 * gq); qf1 = *(const bf16x8*)(qrow + 32 + 8 * gq);
        } else { qf0 = nq0; qf1 = nq1; }
        __syncthreads();
        havepre = (uid + 1 < u1) && (((uid + 1) & 127) != 0);
        if (havepre) {
#pragma unroll
            for (int i = 0; i < 2; ++i) { const int c = F.tid + 512 * i, row = c >> 3, part = c & 7; const size_t off = gbase + (size_t)(p0 + 128 + row) * GW + hh * 64 + part * 8; pk[i] = *(const u32x4*)(Kb + off); pv[i] = *(const u32x4*)(Vb + off); }
            nq0 = *(const bf16x8*)(qrow + (size_t)128 * GW + 8 * gq); nq1 = *(const bf16x8*)(qrow + (size_t)128 * GW + 32 + 8 * gq);
        }
        f32x4 sacc[9];
#pragma unroll
        for (int a = 0; a < 9; ++a) {
            sacc[a] = (f32x4){0.f, 0.f, 0.f, 0.f};
            const int R0 = 16 * w + 16 * a;
            const LAS unsigned char* kp = Ks + ((R0 < 128) ? ps : cs) * SLOT + ((R0 & 127) + ir) * 160 + gq * 16;
            const bf16x8 k0 = *(const LAS bf16x8*)kp, k1 = *(const LAS bf16x8*)(kp + 64);
            sacc[a] = __builtin_amdgcn_mfma_f32_16x16x32_bf16(k0, qf0, sacc[a], 0, 0, 0);
            sacc[a] = __builtin_amdgcn_mfma_f32_16x16x32_bf16(k1, qf1, sacc[a], 0, 0, 0);
        }
        float mx = -INFINITY;
#pragma unroll
        for (int a = 0; a < 9; ++a)
#pragma unroll
            for (int j = 0; j < 4; ++j) {
                const int jl = 4 * gq + j;
                bool valid = (a == 0) ? (jl >= ir) : ((a == 8) ? (jl <= ir) : true);
                valid = valid && (!first || (16 * w + 16 * a + jl >= 128));
                sacc[a][j] = valid ? sacc[a][j] : -INFINITY;
                mx = fmaxf(mx, sacc[a][j]);
            }
        mx = fmaxf(mx, __shfl_xor(mx, 16)); mx = fmaxf(mx, __shfl_xor(mx, 32));
        float l = 0.f;
#pragma unroll
        for (int a = 0; a < 9; ++a)
#pragma unroll
            for (int j = 0; j < 4; ++j) { sacc[a][j] = __builtin_amdgcn_exp2f(sacc[a][j] - mx); l += sacc[a][j]; }
        l += __shfl_xor(l, 16); l += __shfl_xor(l, 32);
        f32x4 oacc[4];
#pragma unroll
        for (int dt = 0; dt < 4; ++dt) oacc[dt] = (f32x4){0.f, 0.f, 0.f, 0.f};
#pragma unroll
        for (int s = 0; s < 5; ++s) {
            u32x4 pw; pw.x = cvt_pk_bf16(sacc[2 * s][0], sacc[2 * s][1]); pw.y = cvt_pk_bf16(sacc[2 * s][2], sacc[2 * s][3]);
            if (s < 4) { pw.z = cvt_pk_bf16(sacc[2 * s + 1][0], sacc[2 * s + 1][1]); pw.w = cvt_pk_bf16(sacc[2 * s + 1][2], sacc[2 * s + 1][3]); } else { pw.z = 0u; pw.w = 0u; }
            const bf16x8 pb = __builtin_bit_cast(bf16x8, pw);
            const int q = ir >> 2, p = ir & 3;
            const int Ra = 16 * w + 32 * s, Rb = Ra + 16;
            const LAS unsigned char* vpa = Vs + ((Ra < 128) ? ps : cs) * SLOT + ((Ra & 127) + 4 * gq + q) * 160 + p * 8;
            const LAS unsigned char* vpb = Vs + ((Rb < 128) ? ps : cs) * SLOT + ((Rb & 127) + 4 * gq + q) * 160 + p * 8;
#pragma unroll
            for (int dt = 0; dt < 4; ++dt) {
                const s16x4 va = __builtin_bit_cast(s16x4, __builtin_amdgcn_ds_read_tr16_b64_v4i16((LAS v4i16_t*)(vpa + dt * 32)));
                s16x4 vb = {0, 0, 0, 0};
                if (s < 4) vb = __builtin_bit_cast(s16x4, __builtin_amdgcn_ds_read_tr16_b64_v4i16((LAS v4i16_t*)(vpb + dt * 32)));
                const bf16x8 vf = __builtin_shufflevector(va, vb, 0, 1, 2, 3, 4, 5, 6, 7);
                oacc[dt] = __builtin_amdgcn_mfma_f32_16x16x32_bf16(vf, pb, oacc[dt], 0, 0, 0);
            }
        }
        const float inv = 1.f / l;
#pragma unroll
        for (int dt = 0; dt < 4; ++dt) {
            u32x2 o; o.x = cvt_pk_bf16(oacc[dt][0] * inv, oacc[dt][1] * inv); o.y = cvt_pk_bf16(oacc[dt][2] * inv, oacc[dt][3] * inv);
            *(u32x2*)(orow + 16 * dt + 4 * gq) = o;
        }
        if (gq == 0) LSE[((size_t)g * T + p0 + 16 * w + ir) * 8 + hh] = (mx + __builtin_amdgcn_logf(l)) * LN2;
        if (havepre) {
#pragma unroll
            for (int i = 0; i < 2; ++i) { const int c = F.tid + 512 * i, row = c >> 3, part = c & 7; const int so = ns * SLOT + row * 160 + part * 16; *(LAS u32x4*)(Ks + so) = pk[i]; *(LAS u32x4*)(Vs + so) = pv[i]; }
        }
    }
    __syncthreads();
}

__device__ __forceinline__ void combine_phase(Frame& F, int part, int nparts) {
    const int gw = part * NWAVES + F.wave, NGW = nparts * NWAVES, lane = F.lane, hh = lane >> 3;
    const bf16* OG = (const bf16*)(F.ws + WS_Q); const float* LSE = (const float*)(F.ws + WS_LSE); bf16* O = (bf16*)(F.ws + WS_O);
    for (int t0 = gw * 4; t0 < T; t0 += NGW * 4) {
        float ls[4][3]; u32x4 og[4][3];
#pragma unroll
        for (int q = 0; q < 4; ++q) { const int t = t0 + q, b = t / SEQ, s = t % SEQ;
#pragma unroll
            for (int g = 0; g < 3; ++g) {
                const int sh = 2 * g, r = s & ((1 << sh) - 1), i = s >> sh;
                const size_t p = (size_t)g * T + b * SEQ + r * (SEQ >> sh) + i;
                ls[q][g] = LSE[p * 8 + hh]; og[q][g] = *(const u32x4*)(OG + p * GW + lane * 8);
            } }
#pragma unroll
        for (int q = 0; q < 4; ++q) {
            const float m = fmaxf(ls[q][0], fmaxf(ls[q][1], ls[q][2]));
            float e[3], sum = 0.f;
#pragma unroll
            for (int g = 0; g < 3; ++g) { e[g] = __expf(ls[q][g] - m); sum += e[g]; }
            const float inv = 1.f / sum;
            f32x4 a0 = {0.f, 0.f, 0.f, 0.f}, a1 = a0;
#pragma unroll
            for (int g = 0; g < 3; ++g) { f32x4 v0, v1; unpack8(og[q][g], v0, v1); const float wg = e[g] * inv; a0 = a0 + v0 * wg; a1 = a1 + v1 * wg; }
            *(u32x4*)(O + (size_t)(t0 + q) * DAO + lane * 8) = pack8(a0, a1);
        }
    }
}

__device__ __forceinline__ void p4_conv(Frame& F) {
    constexpr int RUN = 16;
    const int gt = (F.vcu * NWAVES + F.wave) * 64 + F.lane, NGT = F.G * NWAVES * 64;
    bf16* Bb = (bf16*)((unsigned char*)F.out + OS_BB); const bf16* Z = (const bf16*)(F.ws + WS_Z); const float* cw = F.in[I_CONVW];
    for (int e = gt; e < (T / RUN) * (D / 8); e += NGT) {
        const int t0 = (e >> 7) * RUN, c8 = (e & 127) * 8, s0 = t0 & (SEQ - 1);
        const f32x4 w0a = *(const f32x4*)(cw + c8), w0b = *(const f32x4*)(cw + c8 + 4), w1a = *(const f32x4*)(cw + D + c8), w1b = *(const f32x4*)(cw + D + c8 + 4), w2a = *(const f32x4*)(cw + 2 * D + c8), w2b = *(const f32x4*)(cw + 2 * D + c8 + 4);
        const size_t off0 = (size_t)t0 * D + c8;
        f32x4 z1a = {0.f, 0.f, 0.f, 0.f}, z1b = z1a, z2a = z1a, z2b = z1a;
        if (s0 >= 2) { unpack8(*(const u32x4*)(Z + off0 - D), z1a, z1b); unpack8(*(const u32x4*)(Z + off0 - 2 * D), z2a, z2b); }
#pragma unroll 4
        for (int r = 0; r < RUN; ++r) {
            const size_t off = off0 + (size_t)r * D;
            f32x4 z0a, z0b, ba, bb;
            unpack8(*(const u32x4*)(Z + off), z0a, z0b); unpack8(*(const u32x4*)(Bb + off), ba, bb);
            const f32x4 ca = w0a * z2a + w1a * z1a + w2a * z0a, cb = w0b * z2b + w1b * z1b + w2b * z0b;
            *(u32x4*)(Bb + off) = pack8(ba * ca, bb * cb);
            z2a = z1a; z2b = z1b; z1a = z0a; z1b = z0b;
        }
    }
}
__device__ __forceinline__ void split8(const f32x4 a, const f32x4 b, bf16x8& hi, bf16x8& lo) {
    const u32x4 h = pack8(a, b); f32x4 ha, hb; unpack8(h, ha, hb);
    hi = __builtin_bit_cast(bf16x8, h); lo = __builtin_bit_cast(bf16x8, pack8(a - ha, b - hb));
}
__device__ __forceinline__ void p4_wfold(Frame& F) {
    const int gw = F.vcu * NWAVES + F.wave, NGW = F.G * NWAVES, i = F.lane & 15, g = F.lane >> 4;
    const float* Wq = F.in[I_WQ]; const float* SK = F.in[I_SUBK]; bf16* WF = (bf16*)((unsigned char*)F.out + OS_WFOLD);
    for (int it = gw; it < 1024; it += NGW) {
        const int itu = __builtin_amdgcn_readfirstlane(it);
        const int hc = itu >> 6, k0 = ((itu >> 1) & 31) * 32, nh = itu & 1;
        bf16x8 ah[2][4], al[2][4];
#pragma unroll
        for (int kt = 0; kt < 2; ++kt)
#pragma unroll
            for (int j = 0; j < 4; ++j) { const float* ap = Wq + (size_t)(k0 + 16 * kt + i) * 2048 + hc * 128 + 32 * j + 8 * g; split8(*(const f32x4*)ap, *(const f32x4*)(ap + 4), ah[kt][j], al[kt][j]); }
#pragma unroll 1
        for (int nt = 0; nt < 4; ++nt) {
            const int n0 = hc * 128 + nh * 64 + 16 * nt;
            bf16x8 bh[4], bl[4];
#pragma unroll
            for (int j = 0; j < 4; ++j) { const float* bp = SK + (size_t)(n0 + i) * 128 + 32 * j + 8 * g; split8(*(const f32x4*)bp, *(const f32x4*)(bp + 4), bh[j], bl[j]); }
#pragma unroll
            for (int kt = 0; kt < 2; ++kt) {
                f32x4 acc = {0.f, 0.f, 0.f, 0.f};
#pragma unroll
                for (int j = 0; j < 4; ++j) { acc = __builtin_amdgcn_mfma_f32_16x16x32_bf16(al[kt][j], bh[j], acc, 0, 0, 0); acc = __builtin_amdgcn_mfma_f32_16x16x32_bf16(ah[kt][j], bl[j], acc, 0, 0, 0); }
#pragma unroll
                for (int j = 0; j < 4; ++j) acc = __builtin_amdgcn_mfma_f32_16x16x32_bf16(ah[kt][j], bh[j], acc, 0, 0, 0);
                u32x2 o; o.x = pk2(acc[0], acc[1]); o.y = pk2(acc[2], acc[3]);
                *(u32x2*)(WF + (size_t)(n0 + i) * D + k0 + 16 * kt + 4 * g) = o;
            }
        }
    }
}
__device__ __forceinline__ float gelu_erf(float v) { return 0.5f * v * (1.f + erff(v * 0.70710678118654752f)); }
__device__ __forceinline__ void peer_down_phase(Frame& F) {
    const int lane = F.lane, sub = lane & 15, gq = lane >> 4;
    const int nloc = (int)F.MISC[8], nxc = (int)F.MISC[9]; const bool byx = (nxc == 8) && (nloc * 8 == F.G) && (F.xcc < 8);
    const int x = byx ? F.xcc : 0, nsh = byx ? 8 : 1, rank = byx ? F.xrank : (int)blockIdx.x, nrank = byx ? nloc : F.G;
    const unsigned char* HG8 = F.ws + WS_HG8; const float* HSC = (const float*)(F.ws + WS_HSC); const float* RSQ = (const float*)(F.ws + WS_RSQ);
    const int* IDX = (const int*)(F.ws + WS_IDX); const float* GATE = (const float*)(F.ws + WS_GATE);
    const unsigned char* dn8 = (const unsigned char*)F.out + OS_EDOWN; const float* esc = (const float*)(F.ws + WS_ESCALE); float* WB = (float*)(F.ws + WS_WB);
    LAS unsigned char* wb = F.lds + F.wave * 10752;
    LAS u32x4* h8s = (LAS u32x4*)wb; LAS float* hss = (LAS float*)(wb + 4096); LAS u32x2* ls = (LAS u32x2*)(wb + 4608); LAS float* av = (LAS float*)(wb + 8704);
    const int tstep = nrank * NWAVES * 4;
    for (int xs = x; xs < 8; xs += nsh) {
        int tb = (rank * NWAVES + F.wave) * 4;
        u32x4 ia, ib, h8[4]; f32x4 ga, gb; float hs[4], pq;
#define PD_META(tt) do { const unsigned t_ = (unsigned)((tt) + gq); const unsigned char* wsb_ = F.ws;     \
            ia = *(const u32x4*)(wsb_ + (unsigned)(WS_IDX + t_ * (HK * 4) + sub * 32)); ib = *(const u32x4*)(wsb_ + (unsigned)(WS_IDX + t_ * (HK * 4) + sub * 32 + 16)); \
            ga = *(const f32x4*)(wsb_ + (unsigned)(WS_GATE + t_ * (HK * 4) + sub * 32)); gb = *(const f32x4*)(wsb_ + (unsigned)(WS_GATE + t_ * (HK * 4) + sub * 32 + 16)); pq = *(const float*)(wsb_ + (unsigned)(WS_RSQ + t_ * 64 + sub * 4)); \
            _Pragma("unroll") for (int j_ = 0; j_ < 4; ++j_) { h8[j_] = *(const u32x4*)(wsb_ + (unsigned)(WS_HG8 + t_ * D + 16 * (sub + 16 * j_))); hs[j_] = *(const float*)(wsb_ + (unsigned)(WS_HSC + t_ * 128 + ((sub + 16 * j_) >> 1) * 4)); } } while (0)
        if (tb < T) PD_META(tb);
        for (; tb < T; tb += tstep) {
#pragma unroll
            for (int j = 0; j < 4; ++j) { h8s[gq * 64 + sub + 16 * j] = h8[j]; if ((sub & 1) == 0) hss[gq * 32 + ((sub + 16 * j) >> 1)] = hs[j]; }
            int total = 0;
#pragma unroll
            for (int k = 0; k < 8; ++k) {
                const int ei = (int)(k < 4 ? ia[k & 3] : ib[k & 3]); const float gk = (k < 4 ? ga[k & 3] : gb[k & 3]);
                const bool f = (ei >> 11) == xs;
                const unsigned long long m = __ballot(f);
                const int pos = total + (int)__builtin_amdgcn_mbcnt_hi((unsigned)(m >> 32), __builtin_amdgcn_mbcnt_lo((unsigned)m, 0u));
                if (f) { u32x2 ent; ent.x = (unsigned)ei | ((unsigned)(sub * 8 + k) << 14) | ((unsigned)gq << 21); ent.y = __builtin_bit_cast(unsigned, gk); ls[pos] = ent; }
                total += __popcll(m);
            }
            const float rq = sum16_dpp(pq);
            const float rstd = __builtin_amdgcn_rsqf(rq * (1.f / D) + RMS_EPS);
            const int tcur = tb;
            if (tb + tstep < T) PD_META(tb + tstep);
            LDS_WAIT(); asm volatile("" ::: "memory");
            const int nr = (total + 3) >> 2;
#define PD_ISSUE(R, HH, HS, r0) do { _Pragma("unroll") for (int u_ = 0; u_ < 2; ++u_) { const int k_ = 4 * ((r0) + u_) + gq; const bool v_ = k_ < total; const u32x2 e_ = ls[v_ ? k_ : 0]; const unsigned ex_ = e_.x; \
                const unsigned ro_ = (v_ ? (ex_ & 16383u) : 0u) * 1024u + 16u * (unsigned)sub; const unsigned tk_ = (ex_ >> 21) & 3u; \
                _Pragma("unroll") for (int j_ = 0; j_ < 4; ++j_) { R[u_][j_] = *(const u32x4*)(dn8 + (ro_ + 256u * j_)); HH[u_][j_] = h8s[tk_ * 64 + sub + 16 * j_]; HS[u_][j_] = hss[tk_ * 32 + ((sub + 16 * j_) >> 1)]; } } } while (0)
#define PD_COMPUTE(R, HH, HS, r0) do { _Pragma("unroll") for (int u_ = 0; u_ < 2; ++u_) { const int k_ = 4 * ((r0) + u_) + gq; float af_ = 0.f; \
                _Pragma("unroll") for (int j_ = 0; j_ < 4; ++j_) { int ac_ = 0; _Pragma("unroll") for (int q_ = 0; q_ < 4; ++q_) { const int a_ = (int)R[u_][j_][q_], b_ = (int)HH[u_][j_][q_]; ac_ = __builtin_amdgcn_sdot4(a_, b_, ac_, false); } af_ += (float)ac_ * HS[u_][j_]; } \
                af_ = sum16_dpp(af_); \
                if (k_ < total && sub == 0) av[k_] = af_; } } while (0)
            u32x4 RA[2][4], RB[2][4], HA[2][4], HB[2][4]; float SA[2][4], SB[2][4];
            if (nr > 0) {
                PD_ISSUE(RA, HA, SA, 0);
                int r = 0;
#pragma unroll 1
                for (; r + 4 < nr; r += 4) {
                    PD_ISSUE(RB, HB, SB, r + 2);
                    __builtin_amdgcn_sched_barrier(0);
                    PD_COMPUTE(RA, HA, SA, r);
                    __builtin_amdgcn_sched_barrier(0);
                    PD_ISSUE(RA, HA, SA, r + 4);
                    __builtin_amdgcn_sched_barrier(0);
                    PD_COMPUTE(RB, HB, SB, r + 2);
                    __builtin_amdgcn_sched_barrier(0);
                }
                if (r + 2 < nr) {
                    PD_ISSUE(RB, HB, SB, r + 2);
                    __builtin_amdgcn_sched_barrier(0);
                    PD_COMPUTE(RA, HA, SA, r);
                    __builtin_amdgcn_sched_barrier(0);
                    PD_COMPUTE(RB, HB, SB, r + 2);
                } else {
                    PD_COMPUTE(RA, HA, SA, r);
                }
                __builtin_amdgcn_sched_barrier(0);
            }
#undef PD_ISSUE
#undef PD_COMPUTE
            LDS_WAIT(); asm volatile("" ::: "memory");
            const float rs0 = __builtin_bit_cast(float, __builtin_amdgcn_readlane(__builtin_bit_cast(int, rstd), 0)), rs1 = __builtin_bit_cast(float, __builtin_amdgcn_readlane(__builtin_bit_cast(int, rstd), 16)),
                        rs2 = __builtin_bit_cast(float, __builtin_amdgcn_readlane(__builtin_bit_cast(int, rstd), 32)), rs3 = __builtin_bit_cast(float, __builtin_amdgcn_readlane(__builtin_bit_cast(int, rstd), 48));
            for (int i = lane; i < total; i += 64) {
                const u32x2 e = ls[i]; const unsigned ex = e.x, eg = e.y; const int tk = (int)((ex >> 21) & 3u);
                const float rs = (tk == 0) ? rs0 : ((tk == 1) ? rs1 : ((tk == 2) ? rs2 : rs3));
                const float a = av[i] * esc[ex & 16383u] * rs;
                WB[(size_t)(tcur + tk) * HK + ((ex >> 14) & 127u)] = __builtin_bit_cast(float, eg) * esc[NEXP + (ex & 16383u)] * gelu_erf(a);
            }
            LDS_WAIT(); asm volatile("" ::: "memory");
        }
#undef PD_META
    }
}
__device__ __forceinline__ void peer_up_phase(Frame& F) {
    const int lane = F.lane, g8 = lane >> 3, c = lane & 7;
    const int nloc = (int)F.MISC[8], nxc = (int)F.MISC[9]; const bool byx = (nxc == 8) && (nloc * 8 == F.G) && (F.xcc < 8);
    const int x = byx ? F.xcc : 0, nsh = byx ? 8 : 1, rank = byx ? F.xrank : (int)blockIdx.x, nrank = byx ? nloc : F.G;
    const bf16* HG = (const bf16*)(F.ws + WS_HG); const float* nffn = F.in[I_NFFN];
    float* SS = (float*)(F.ws + WS_SS); float* out = F.out;
    LAS unsigned char* wbuf = F.lds + F.wave * 16384;
    const int tstep = nrank * NWAVES * 8;
    const unsigned char* wsb = F.ws;
    for (int xs = x; xs < 8; xs += nsh) {
    const unsigned char* up8 = F.ws + WS_EUP + (size_t)xs * (2 * MiB);
    int tb = (rank * NWAVES + F.wave) * 8, it = 0;
#define PU_MOFF(tt, j) ((unsigned)(((j) < 4 ? WS_IDX : WS_WB) + (size_t)(tt) * (HK * 4) + ((j) & 3) * 1024) + (unsigned)(lane * 16))
    if (tb < T) {
        u32x4 m0[8];
#pragma unroll
        for (int j = 0; j < 8; ++j) m0[j] = *(const u32x4*)(wsb + PU_MOFF(tb, j));
#pragma unroll
        for (int j = 0; j < 8; ++j) *(LAS u32x4*)(wbuf + j * 1024 + lane * 16) = m0[j];
    }
    for (; tb < T; tb += tstep, ++it) {
        const int t = tb + g8;
        const LAS unsigned char* mi = wbuf + (it & 1) * 8192 + g8 * 512;
        LAS unsigned char* nb = wbuf + ((it + 1) & 1) * 8192 + lane * 16;
        const int tn = (tb + tstep < T) ? tb + tstep : tb;
        f32x4 oa[4];
#pragma unroll
        for (int q = 0; q < 4; ++q) oa[q] = (f32x4){0.f, 0.f, 0.f, 0.f};
#define PU_ISSUE(R, W, st) do { const u32x4 i0_ = *(const LAS u32x4*)(mi + (st) * 32), i1_ = *(const LAS u32x4*)(mi + (st) * 32 + 16); \
            const f32x4 w0_ = *(const LAS f32x4*)(mi + 4096 + (st) * 32), w1_ = *(const LAS f32x4*)(mi + 4096 + (st) * 32 + 16); \
            _Pragma("unroll") for (int k_ = 0; k_ < 8; ++k_) { const unsigned ei_ = (k_ < 4) ? i0_[k_ & 3] : i1_[k_ & 3]; W[k_] = (k_ < 4) ? w0_[k_ & 3] : w1_[k_ & 3]; \
            R[k_] = *(const u32x4*)(up8 + (ei_ * 128u + 16u * (unsigned)c)); } } while (0)
#define PU_COMPUTE(R, W) do { _Pragma("unroll") for (int k_ = 0; k_ < 8; ++k_) { _Pragma("unroll") for (int q_ = 0; q_ < 4; ++q_) { const int d_ = (int)R[k_][q_]; \
            const f32x2 lo_ = __builtin_amdgcn_cvt_pk_f32_fp8(d_, false), hi_ = __builtin_amdgcn_cvt_pk_f32_fp8(d_, true); \
            oa[q_][0] += lo_.x * W[k_]; oa[q_][1] += lo_.y * W[k_]; oa[q_][2] += hi_.x * W[k_]; oa[q_][3] += hi_.y * W[k_]; } \
            if (k_ & 1) { asm volatile("" : "+v"(oa[0]), "+v"(oa[1]), "+v"(oa[2]), "+v"(oa[3])); __builtin_amdgcn_sched_barrier(0); } } } while (0)
        u32x4 RA[8], RB[8]; float WA[8], WBk[8];
        PU_ISSUE(RA, WA, 0);
#define PU_BODY(st, j) do { const u32x4 m_ = *(const u32x4*)(wsb + PU_MOFF(tn, j)); \
            PU_ISSUE(RB, WBk, (st) + 1); __builtin_amdgcn_sched_barrier(0); PU_COMPUTE(RA, WA); __builtin_amdgcn_sched_barrier(0); \
            PU_ISSUE(RA, WA, (st) + 2); __builtin_amdgcn_sched_barrier(0); PU_COMPUTE(RB, WBk); __builtin_amdgcn_sched_barrier(0); \
            *(LAS u32x4*)(nb + (j) * 1024) = m_; __builtin_amdgcn_sched_barrier(0); } while (0)
#pragma unroll 1
        for (int st = 0; st < 14; st += 2) { const int j = st >> 1; PU_BODY(st, j); }
        unsigned hgo = (unsigned)(t * (D * 2) + 256 * xs + 32 * c);
        asm volatile("" : "+v"(hgo));
        const u32x4 m7 = *(const u32x4*)(wsb + PU_MOFF(tn, 7));
        const u32x4 hg0 = *(const u32x4*)((const unsigned char*)HG + hgo), hg1 = *(const u32x4*)((const unsigned char*)HG + (hgo + 16u));
        PU_ISSUE(RB, WBk, 15);
        __builtin_amdgcn_sched_barrier(0);
        PU_COMPUTE(RA, WA);
        __builtin_amdgcn_sched_barrier(0);
        PU_COMPUTE(RB, WBk);
        __builtin_amdgcn_sched_barrier(0);
        *(LAS u32x4*)(nb + 7 * 1024) = m7;
#undef PU_BODY
#undef PU_ISSUE
#undef PU_COMPUTE
        float ss = 0.f;
        const size_t off = (size_t)t * D + 128 * xs + 16 * c;
        f32x4 hv[4]; unpack8(hg0, hv[0], hv[1]); unpack8(hg1, hv[2], hv[3]);
#pragma unroll
        for (int q = 0; q < 4; ++q) { const f32x4 nf = *(const f32x4*)(nffn + 128 * xs + 16 * c + 4 * q); hv[q][0] /= nf[0]; hv[q][1] /= nf[1]; hv[q][2] /= nf[2]; hv[q][3] /= nf[3]; }
#pragma unroll
        for (int q = 0; q < 4; ++q) { oa[q] = oa[q] + hv[q]; ss += (oa[q][0] * oa[q][0] + oa[q][1] * oa[q][1]) + (oa[q][2] * oa[q][2] + oa[q][3] * oa[q][3]); *(f32x4*)(out + off + 4 * q) = oa[q]; }
        ss = sum8_dpp(ss);
        if (c == 0) SS[(size_t)t * 8 + xs] = ss;
    }
#undef PU_MOFF
    }
}
__device__ __forceinline__ void final_norm_phase(Frame& F) {
    const int gw = F.vcu * NWAVES + F.wave, NGW = F.G * NWAVES, lane = F.lane;
    const float* SS = (const float*)(F.ws + WS_SS); const float* fn = F.in[I_FNORM]; float* out = F.out;
    f32x4 g[4];
#pragma unroll
    for (int q = 0; q < 4; ++q) g[q] = *(const f32x4*)(fn + 4 * (lane + 64 * q));
    for (int t = gw; t < T; t += NGW) {
        const f32x4 s0 = *(const f32x4*)(SS + (size_t)t * 8), s1 = *(const f32x4*)(SS + (size_t)t * 8 + 4);
        const float r2 = __builtin_amdgcn_rsqf((((s0[0] + s0[1]) + (s0[2] + s0[3])) + ((s1[0] + s1[1]) + (s1[2] + s1[3]))) * (1.f / D) + RMS_EPS);
        f32x4* op = (f32x4*)(out + (size_t)t * D) + lane;
#pragma unroll
        for (int q = 0; q < 4; ++q) op[64 * q] = op[64 * q] * r2 * g[q];
    }
}

struct Args { const float* in[15]; float* out; unsigned char* ws; int ph_lo, ph_hi, li, pad; };
__global__ void __launch_bounds__(NWAVES * 64, 2) fwd(Args args) {
    extern __shared__ __attribute__((aligned(16))) unsigned char lds[];
    Frame F;
    F.lds = (LAS unsigned char*)lds;
    F.MISC = (volatile LAS unsigned*)(F.lds + MISC_OFF);
    F.tid = threadIdx.x; F.lane = F.tid & 63; F.wave = __builtin_amdgcn_readfirstlane(F.tid >> 6);
    F.G = gridDim.x; { const int bx = blockIdx.x; F.vcu = (F.G % 8 == 0) ? (bx % 8) * (F.G / 8) + bx / 8 : bx; }
    F.ws = args.ws; F.ctl = (gu32*)(args.ws + WS_CTL);
#pragma unroll
    for (int i = 0; i < 15; ++i) F.in[i] = args.in[i];
    F.out = args.out;
    for (int u = F.tid; u < (LDS_BYTES - RING_BYTES) / 4; u += NWAVES * 64) ((LAS unsigned*)(F.lds + RING_BYTES))[u] = 0u;
    __syncthreads();
    XcdBarrier bar; bar.bar = (unsigned*)(F.ctl + CW_BAR); bar.x = 0; bar.st = nullptr;
    if (N_LAUNCHES == 1) bar = xcd_barrier_post((unsigned*)(F.ctl + CW_BAR), F.MISC + 8);
    F.xcc = (int)xb_xcc_id();
    if (F.tid == 0) F.MISC[16] = xb_add((unsigned*)(F.ctl + CW_RANK + 64 * (F.xcc & 15)), 1u);
    __syncthreads();
    F.xrank = (int)F.MISC[16];
#define GRID_BAR() do { if (N_LAUNCHES == 1) xcd_barrier(bar); } while (0)
    const int lo = args.ph_lo, hi = args.ph_hi, bx = (int)blockIdx.x;
#define IN(k) (lo <= (k) && (k) < hi)
#define BOTH(k) (IN(k) && IN((k) + 1))
    unsigned char* ws = args.ws;

    if (IN(0)) { p0_prologue(F); if (BOTH(0)) GRID_BAR(); }

    if (IN(1)) {
        Gemm g{(const bf16*)(ws + WS_U8), (const bf16*)(ws + WS_WQKV8), T, NP1, D / 2}; QkvOrder S; S.init(T, NP1, F.G, bx); S.U = (const char*)(ws + WS_U8);
        EpiQKV E{(bf16*)(ws + WS_Q), (const float*)(ws + WS_ROPE), (const float*)(ws + WS_SU), (const float*)(ws + WS_SW), ws + WS_SGA, F.in[I_GBIAS] + D};
        gemm_phase<EpiQKV, QkvOrder, true, true, true, true>(F.lds, g, S, E);
        if (BOTH(1)) GRID_BAR();
    }
    if (IN(2)) { attn_phase(F, (bf16*)(ws + WS_Q), (float*)(ws + WS_LSE)); if (BOTH(2)) GRID_BAR(); }
    if (IN(3)) {
        { const int nwg = (T / 256) * ((NCG - 512) / 256), rem = nwg % F.G;
          if (rem == 0) combine_phase(F, F.vcu, F.G); else if (bx >= rem) combine_phase(F, bx - rem, F.G - rem); }
        Gemm g{(const bf16*)(ws + WS_U8), (const bf16*)(ws + WS_WQKV8 + (size_t)NP1 * D), T, NCG - 512, D / 2}; StaticOrder S; S.init(T, NCG - 512, F.G, bx);
        EpiCG E{(bf16*)((unsigned char*)F.out + OS_BB), (bf16*)(ws + WS_Z), ws + WS_SGC, ws + WS_SGA, F.in[I_GBIAS], (const float*)(ws + WS_SU), (const float*)(ws + WS_SW)};
        gemm_phase<EpiCG, StaticOrder, true, true, false, true>(F.lds, g, S, E);
        if (BOTH(3)) GRID_BAR();
    }
    if (IN(4)) { p4_wfold(F); p4_conv(F); if (BOTH(4)) GRID_BAR(); }
    if (IN(5)) {
        Gemm gc{(const bf16*)((unsigned char*)F.out + OS_BB), (const bf16*)(ws + WS_WCONV), T, D, D}, ga{(const bf16*)(ws + WS_O), (const bf16*)(ws + WS_WATTN), T, D, DAO};
        StaticOrder S; S.init(T, D, F.G, bx);
        if ((bx & 8) == 0) {
            { EpiY<0> E{(bf16*)(ws + WS_Y), ws + WS_SGC}; gemm_phase<EpiY<0>, StaticOrder, true, true>(F.lds, gc, S, E); }
            { EpiY<1> E{(bf16*)(ws + WS_Y), ws + WS_SGA}; gemm_phase<EpiY<1>, StaticOrder, true, true>(F.lds, ga, S, E); }
        } else {
            { EpiY<0> E{(bf16*)(ws + WS_Y), ws + WS_SGA}; gemm_phase<EpiY<0>, StaticOrder, true, true>(F.lds, ga, S, E); }
            { EpiY<1> E{(bf16*)(ws + WS_Y), ws + WS_SGC}; gemm_phase<EpiY<1>, StaticOrder, true, true>(F.lds, gc, S, E); }
        }
        if (BOTH(5)) GRID_BAR();
    }
    if (IN(6)) {
        Gemm g{(const bf16*)(ws + WS_Y), (const bf16*)(ws + WS_WOUT), T, D, D}; StaticOrder S; S.init(T, D, F.G, bx);
        EpiOut E{F.in[I_X], (bf16*)(ws + WS_HG), F.in[I_NFFN], (float*)(ws + WS_RSQ), ws + WS_HG8, (float*)(ws + WS_HSC)};
        gemm_phase<EpiOut, StaticOrder, true, true>(F.lds, g, S, E);

        if (BOTH(6)) GRID_BAR();
    }
    if (IN(7)) {
        Gemm g{(const bf16*)(ws + WS_HG), (const bf16*)((unsigned char*)F.out + OS_WFOLD), T, 2048, D}; StaticOrder S; S.init(T, 2048, F.G, bx);
        float* scr = (float*)(ws + (bx < 128 ? WS_SCR0 + (size_t)bx * 262144 : (bx < 192 ? WS_SCR1 + (size_t)(bx - 128) * 262144 : WS_SCR2 + (size_t)(bx - 192) * 262144)));
        EpiTopk E{scr, (const float*)(ws + WS_RSQ), (int*)(ws + WS_IDX), (float*)(ws + WS_GATE),
                  CvCtx{F.in[I_DOWN], F.in[I_UP], (unsigned char*)F.out + OS_EDOWN, ws + WS_EUP, (float*)(ws + WS_ESCALE), F.lane}, F.vcu * NWAVES + F.wave, F.G * NWAVES};
        if ((bx & 8) != 0) { for (; E.cvr < 2 * NEXP; E.cvr += E.cvstep) { f32x4 v[4]; cv_load(E.CV, E.cvr, v); cv_finish(E.CV, E.cvr, v); } }
        const int cvkeep = E.cvr; E.cvr = 2 * NEXP;
        gemm_phase<EpiTopk, StaticOrder, true, true>(F.lds, g, S, E);
        E.cvr = cvkeep;
        for (; E.cvr < 2 * NEXP; E.cvr += E.cvstep) { f32x4 v[4]; cv_load(E.CV, E.cvr, v); cv_finish(E.CV, E.cvr, v); }
        if (BOTH(7)) GRID_BAR();
    }
    if (IN(8)) { peer_down_phase(F); if (BOTH(8)) GRID_BAR(); }
    if (IN(9)) { peer_up_phase(F); if (BOTH(9)) GRID_BAR(); }
    if (IN(10)) { final_norm_phase(F); }
#undef IN
#undef BOTH
}

extern "C" void kernel_launch(void* const* d_in, const int* in_sizes, int n_in, void* d_out, int out_size, void* d_ws, size_t ws_size, hipStream_t stream) {
    static int grid = 0;
    if (grid == 0) {
        if (n_in != 15 || out_size != T * D || ws_size < WS_END) { fprintf(stderr, "kernel_launch: unexpected shapes (n_in %d, out %d, ws %zu)\n", n_in, out_size, ws_size); grid = -1; return; }
        int dev = 0, cus = 0, per_cu = 0;
        if (hipGetDevice(&dev) != hipSuccess || hipDeviceGetAttribute(&cus, hipDeviceAttributeMultiprocessorCount, dev) != hipSuccess) { grid = -1; return; }
        if (hipFuncSetAttribute((const void*)fwd, hipFuncAttributeMaxDynamicSharedMemorySize, LDS_BYTES) != hipSuccess) { fprintf(stderr, "kernel_launch: hipFuncSetAttribute failed\n"); grid = -1; return; }
        if (hipOccupancyMaxActiveBlocksPerMultiprocessor(&per_cu, (const void*)fwd, NWAVES * 64, LDS_BYTES) != hipSuccess || per_cu < 1) fprintf(stderr, "kernel_launch: occupancy query reports %d\n", per_cu);
        (void)hipGetLastError();
        grid = cus > 256 ? 256 : cus;
    }
    if (grid < 0) return;
    if (hipMemsetAsync((char*)d_ws + WS_CTL, 0, CTL_ZERO_BYTES, stream) != hipSuccess) return;
    Args a{};
    for (int i = 0; i < 15; ++i) a.in[i] = (const float*)d_in[i];
    a.out = (float*)d_out; a.ws = (unsigned char*)d_ws;
    for (int li = 0; li < N_LAUNCHES; ++li) {
        a.ph_lo = (N_LAUNCHES == 1) ? 0 : li; a.ph_hi = (N_LAUNCHES == 1) ? N_PHASES : li + 1; a.li = li; a.pad = 0;
        hipLaunchKernelGGL(fwd, dim3(grid), dim3(NWAVES * 64), LDS_BYTES, stream, a);
    }
}
```

```cpp
#include <hip/hip_runtime.h>
#include <cstdio>
#include <cstdint>
namespace pg8 {
#define PG8_LAS __attribute__((address_space(3)))
typedef unsigned short bf16_t;
typedef short bf16x8 __attribute__((ext_vector_type(8)));
typedef float f32x4 __attribute__((ext_vector_type(4)));
typedef unsigned u32x4 __attribute__((ext_vector_type(4)));
typedef int v4i32_t __attribute__((ext_vector_type(4)));
typedef int v8i32_t __attribute__((ext_vector_type(8)));
constexpr int BM = 256, BK = 64, HALF = 128, HTB = HALF * BK * 2  , STAGE_BYTES = 8 * HTB, NXCD = 8, WGM = 8;

__host__ __device__ __forceinline__ int lds_byte(int r, int c) { const int st = (r >> 4) * 2 + (c >> 5), rr = r & 15, cc = c & 31, ob = rr * 64 + cc * 2; return st * 1024 + (ob ^ (((ob >> 9) & 1) << 5)); }
__host__ __device__ __forceinline__ void stage_rc(int b, int& R, int& C) { const int st = b / 1024, sb = b % 1024, swz = sb ^ (((sb >> 9) & 1) << 5); R = (st >> 1) * 16 + swz / 64; C = (st & 1) * 32 + (swz % 64) / 2; }
__host__ __device__ __forceinline__ int perm32(int rho) { const int n = rho >> 4, i = rho & 15; return 8 * (i >> 2) + 4 * n + (i & 3); }

struct Unit { int pm, pn; };
struct Gemm { const bf16_t* A; const bf16_t* Bt; int M, N, K; };

struct StaticOrder {
    int nM, nN, nwg, G, c;
    __host__ __device__ void init(int M, int N, int G_, int c_) { nM = M / BM; nN = N / BM; nwg = nM * nN; G = G_; c = c_; }
    __host__ __device__ bool next(int i, Unit& u) const {
        const long L = (long)i * G + c; if (L >= nwg) return false;
        int wgid = (int)L; { const int q = nwg / NXCD, r = nwg % NXCD, xcd = wgid % NXCD, off = wgid / NXCD; wgid = (xcd < r ? xcd * (q + 1) : r * (q + 1) + (xcd - r) * q) + off; }
        const int nig = WGM * nN, gid = wgid / nig, fm = gid * WGM, gsz = (nM - fm) < WGM ? (nM - fm) : WGM;
        u.pm = fm + ((wgid % nig) % gsz); u.pn = (wgid % nig) / gsz; return true;
    }
    __device__ __forceinline__ void a_ready(const Unit&) const {}
    __device__ __forceinline__ void done(const Unit&) const {}
};

__device__ __forceinline__ unsigned cvt_pk_bf16(float lo, float hi) { unsigned r; asm volatile("v_cvt_pk_bf16_f32 %0, %1, %2" : "=v"(r) : "v"(lo), "v"(hi)); return r; }
typedef float f32x2 __attribute__((ext_vector_type(2)));

template <class Epi, class Sched, bool ALIGN_EPI = false, bool SP2 = false, bool STRIDED_A = false, bool I8 = false>
__device__ __forceinline__ void gemm_phase(PG8_LAS unsigned char* lds, const Gemm g, const Sched& S, const Epi& E) {
    const int tid = threadIdx.x, wid = __builtin_amdgcn_readfirstlane(tid >> 6), lane = tid & 63, wr = wid >> 2, wc = wid & 3, fr = lane & 15, fq = lane >> 4;
    const int K = g.K; int nt = K / BK;
    if constexpr (I8) asm volatile("" : "+s"(nt));
    unsigned voffA[2], voffB[2];
#pragma unroll
    for (int i = 0; i < 2; ++i) { int R, C; stage_rc(tid * 16 + i * 8192, R, C); const int Rb = Epi::PERM ? ((R & ~31) + perm32(R & 31)) : R;
        voffA[i] = (unsigned)(R * K + C) * 2u; voffB[i] = (unsigned)(Rb * K + C) * 2u; }
    unsigned rkA = 0, c2A = 0; const unsigned rk64 = 64u * (unsigned)K * 2u;
    if constexpr (STRIDED_A) { int R, C; stage_rc(tid * 16, R, C); rkA = (unsigned)(R * K) * 2u; c2A = (unsigned)C * 2u; }
    const size_t kstep = (size_t)(BK * 2);
    const size_t hstep = (size_t)HALF * K * 2;
    const size_t tstep = 2 * hstep;
    const unsigned ldsw = (unsigned)wid * 1024u;
    const int aoff = lds_byte(wr * 64 + fr, fq * 8), boff = lds_byte(wc * 32 + fr, fq * 8);
#define PG8_SA(b, h) (((b) * 2 + (h)) * HTB)
#define PG8_SB(b, h) ((4 + (b) * 2 + (h)) * HTB)
#define PG8_STAGE(bufoff, gbase, voff) do { _Pragma("unroll") for (int _i = 0; _i < 2; ++_i) \
        __builtin_amdgcn_global_load_lds((const unsigned*)((const char*)(gbase) + (voff)[_i]), (PG8_LAS unsigned*)(lds + (bufoff) + ldsw + _i * 8192), 16, 0, 0); } while (0)
#define PG8_STAGE_A(bufoff, gbase, sh) do { if constexpr (STRIDED_A) { _Pragma("unroll") for (int _i = 0; _i < 2; ++_i) { const unsigned _vo = ((rkA + _i * rk64) << (sh)) + c2A; \
        __builtin_amdgcn_global_load_lds((const unsigned*)((const char*)(gbase) + _vo), (PG8_LAS unsigned*)(lds + (bufoff) + ldsw + _i * 8192), 16, 0, 0); } } else { PG8_STAGE(bufoff, gbase, voffA); } } while (0)
#define PG8_LDA(dst, b, h) do { _Pragma("unroll") for (int m = 0; m < 4; ++m) _Pragma("unroll") for (int k = 0; k < 2; ++k) dst[m][k] = *(const PG8_LAS bf16x8*)(lds + PG8_SA(b, h) + aoff + m * 2048 + k * 1024); } while (0)
#define PG8_LDB(dst, b, h) do { _Pragma("unroll") for (int n = 0; n < 2; ++n) _Pragma("unroll") for (int k = 0; k < 2; ++k) dst[n][k] = *(const PG8_LAS bf16x8*)(lds + PG8_SB(b, h) + boff + n * 2048 + k * 1024); } while (0)
#define PG8_MMA(ai, bj, At, Bt) do { __builtin_amdgcn_s_setprio(1); _Pragma("unroll") for (int m = 0; m < 4; ++m) _Pragma("unroll") for (int n = 0; n < 2; ++n) _Pragma("unroll") for (int k = 0; k < 2; ++k) \
        { if constexpr (I8) acc[ai][bj][m][n] = __builtin_bit_cast(f32x4, __builtin_amdgcn_mfma_i32_16x16x64_i8(__builtin_bit_cast(v4i32_t, Bt[n][k]), __builtin_bit_cast(v4i32_t, At[m][k]), __builtin_bit_cast(v4i32_t, acc[ai][bj][m][n]), 0, 0, 0)); \
          else acc[ai][bj][m][n] = __builtin_amdgcn_mfma_f32_16x16x32_bf16(Bt[n][k], At[m][k], acc[ai][bj][m][n], 0, 0, 0); } __builtin_amdgcn_s_setprio(0); } while (0)
#define PG8_WAIT_V(n) asm volatile("s_waitcnt vmcnt(" #n ")" ::: "memory")
#define PG8_WAIT_L(n) asm volatile("s_waitcnt lgkmcnt(" #n ")" ::: "memory")
#define PG8_BAR __builtin_amdgcn_s_barrier()
#define PG8_SCHED __builtin_amdgcn_sched_barrier(0)
    Unit cur, nxt; int ui = 0;
    if (!S.next(0, cur)) return;
    f32x4 acc[2][2][4][2];
#pragma unroll
    for (int a = 0; a < 2; ++a)
#pragma unroll
        for (int b = 0; b < 2; ++b)
#pragma unroll
            for (int m = 0; m < 4; ++m)
#pragma unroll
                for (int n = 0; n < 2; ++n) acc[a][b][m][n] = (f32x4){0.f, 0.f, 0.f, 0.f};
    bf16x8 At[4][2], B0[2][2], B1[2][2];
    int csh = 0, nsh = 0;
    const char* cA; if constexpr (STRIDED_A) cA = S.a_base(cur, csh); else cA = (const char*)g.A + (size_t)cur.pm * tstep;
    const char* cB = (const char*)g.Bt + (size_t)cur.pn * tstep;
    S.a_ready(cur);
    if constexpr (SP2) {
        PG8_STAGE(PG8_SB(0, 0), cB, voffB); PG8_STAGE(PG8_SB(0, 1), cB + hstep, voffB); PG8_STAGE_A(PG8_SA(0, 0), cA, csh); PG8_STAGE_A(PG8_SA(0, 1), cA + (hstep << csh), csh);
        if (wr == 1) PG8_BAR;
        PG8_WAIT_V(2); PG8_BAR;
        PG8_STAGE(PG8_SB(1, 0), cB + kstep, voffB); PG8_STAGE_A(PG8_SA(1, 0), cA + kstep, csh); PG8_STAGE(PG8_SB(1, 1), cB + hstep + kstep, voffB);
        PG8_WAIT_V(6); PG8_BAR;
    } else {
        PG8_STAGE(PG8_SB(0, 0), cB, voffB); PG8_STAGE_A(PG8_SA(0, 0), cA, csh); PG8_STAGE(PG8_SB(0, 1), cB + hstep, voffB); PG8_STAGE_A(PG8_SA(0, 1), cA + (hstep << csh), csh);
        if (wr == 1) PG8_BAR;
        PG8_WAIT_V(4); PG8_BAR;
        PG8_STAGE(PG8_SB(1, 0), cB + kstep, voffB); PG8_STAGE_A(PG8_SA(1, 0), cA + kstep, csh); PG8_STAGE(PG8_SB(1, 1), cB + hstep + kstep, voffB);
        PG8_WAIT_V(6); PG8_BAR;
    }
    asm volatile(".p2align 8" ::: "memory");
    for (;;) {
        const bool has_next = S.next(ui + 1, nxt);
        const char* nA; if constexpr (STRIDED_A) { nsh = csh; nA = has_next ? S.a_base(nxt, nsh) : cA; } else nA = has_next ? (const char*)g.A + (size_t)nxt.pm * tstep : cA;
        const char* nB = has_next ? (const char*)g.Bt + (size_t)nxt.pn * tstep : cB;
        for (int t = 0; t < nt; t += 2) {
            const bool last = (t == nt - 2);
            const char* a1 = cA + (size_t)(t + 1) * kstep;
            const char* a2 = last ? nA : cA + (size_t)(t + 2) * kstep; const char* b2 = last ? nB : cB + (size_t)(t + 2) * kstep;
            const char* a3 = a2 + kstep; const char* b3 = b2 + kstep;
            const int sh2 = last ? nsh : csh; const size_t hA1 = hstep << csh, hA2 = hstep << sh2;
            if (last && has_next) S.a_ready(nxt);
            if constexpr (SP2) {
            PG8_LDB(B0, 0, 0); PG8_LDB(B1, 0, 1); PG8_SCHED; PG8_LDA(At, 0, 0); PG8_STAGE_A(PG8_SA(1, 1), a1 + hA1, csh);
            PG8_WAIT_V(8); PG8_WAIT_L(0); PG8_BAR; PG8_MMA(0, 0, At, B0); PG8_MMA(0, 1, At, B1); PG8_BAR; PG8_SCHED;
            PG8_LDA(At, 0, 1); PG8_STAGE(PG8_SB(0, 0), b2, voffB); PG8_STAGE(PG8_SB(0, 1), b2 + hstep, voffB); PG8_STAGE_A(PG8_SA(0, 0), a2, sh2);
            PG8_WAIT_V(8); PG8_WAIT_L(0); PG8_BAR; PG8_MMA(1, 0, At, B0); PG8_MMA(1, 1, At, B1); PG8_BAR; PG8_SCHED;
            PG8_LDB(B0, 1, 0); PG8_LDB(B1, 1, 1); PG8_SCHED; PG8_LDA(At, 1, 0); PG8_STAGE_A(PG8_SA(0, 1), a2 + hA2, sh2);
            PG8_WAIT_V(8); PG8_WAIT_L(0); PG8_BAR; PG8_MMA(0, 0, At, B0); PG8_MMA(0, 1, At, B1); PG8_BAR; PG8_SCHED;
            PG8_LDA(At, 1, 1); PG8_STAGE(PG8_SB(1, 0), b3, voffB); PG8_STAGE(PG8_SB(1, 1), b3 + hstep, voffB); PG8_STAGE_A(PG8_SA(1, 0), a3, sh2);
            PG8_WAIT_V(8); PG8_WAIT_L(0); PG8_BAR; PG8_MMA(1, 0, At, B0); PG8_MMA(1, 1, At, B1); PG8_BAR; PG8_SCHED;
            } else {
            PG8_LDB(B0, 0, 0); PG8_SCHED; PG8_LDA(At, 0, 0); PG8_STAGE_A(PG8_SA(1, 1), a1 + hA1, csh);
            PG8_WAIT_L(8); PG8_BAR; PG8_WAIT_L(0); PG8_MMA(0, 0, At, B0); PG8_BAR; PG8_SCHED;
            PG8_LDB(B1, 0, 1); PG8_STAGE(PG8_SB(0, 0), b2, voffB);
            PG8_BAR; PG8_WAIT_L(0); PG8_MMA(0, 1, At, B1); PG8_BAR;
            PG8_LDA(At, 0, 1); PG8_STAGE_A(PG8_SA(0, 0), a2, sh2);
            PG8_BAR; PG8_WAIT_L(0); PG8_MMA(1, 0, At, B0); PG8_BAR; PG8_SCHED;
            PG8_STAGE(PG8_SB(0, 1), b2 + hstep, voffB);
            PG8_WAIT_V(6); PG8_BAR; PG8_MMA(1, 1, At, B1); PG8_BAR;
            PG8_LDB(B0, 1, 0); PG8_SCHED; PG8_LDA(At, 1, 0); PG8_STAGE_A(PG8_SA(0, 1), a2 + hA2, sh2);
            PG8_WAIT_L(8); PG8_BAR; PG8_WAIT_L(0); PG8_MMA(0, 0, At, B0); PG8_BAR; PG8_SCHED;
            PG8_LDB(B1, 1, 1); PG8_STAGE(PG8_SB(1, 0), b3, voffB);
            PG8_BAR; PG8_WAIT_L(0); PG8_MMA(0, 1, At, B1); PG8_BAR;
            PG8_LDA(At, 1, 1); PG8_STAGE_A(PG8_SA(1, 0), a3, sh2);
            PG8_BAR; PG8_WAIT_L(0); PG8_MMA(1, 0, At, B0); PG8_BAR; PG8_SCHED;
            PG8_STAGE(PG8_SB(1, 1), b3 + hstep, voffB);
            PG8_WAIT_V(6); PG8_BAR; PG8_MMA(1, 1, At, B1); PG8_BAR;
            }
        }
        if constexpr (ALIGN_EPI) { if (wr == 0) PG8_BAR; }
        if constexpr (I8) {
#pragma unroll
            for (int a = 0; a < 2; ++a)
#pragma unroll
                for (int b = 0; b < 2; ++b)
#pragma unroll
                    for (int m = 0; m < 4; ++m)
#pragma unroll
                        for (int n = 0; n < 2; ++n) { const v4i32_t iv = __builtin_bit_cast(v4i32_t, acc[a][b][m][n]); acc[a][b][m][n] = (f32x4){(float)iv[0], (float)iv[1], (float)iv[2], (float)iv[3]}; }
        }
        if constexpr (!Epi::AFTER_DRAIN) { E(acc, cur, wr, wc, fr, fq); S.done(cur); }
        if (!has_next) break;
#pragma unroll
        for (int a = 0; a < 2; ++a)
#pragma unroll
            for (int b = 0; b < 2; ++b)
#pragma unroll
                for (int m = 0; m < 4; ++m)
#pragma unroll
                    for (int n = 0; n < 2; ++n) acc[a][b][m][n] = (f32x4){0.f, 0.f, 0.f, 0.f};
        cur = nxt; cA = nA; cB = nB; csh = nsh; ++ui;
        if constexpr (ALIGN_EPI) { if (wr == 1) PG8_BAR; }
    }
    PG8_WAIT_V(0);
    if constexpr (!ALIGN_EPI) { if (wr == 0) PG8_BAR; }
    PG8_BAR;
    if constexpr (Epi::AFTER_DRAIN) { E.fused(acc, cur, wr, wc, fr, fq, lds, wid, lane); S.done(cur); }
#undef PG8_SA
#undef PG8_SB
#undef PG8_STAGE
#undef PG8_STAGE_A
#undef PG8_LDA
#undef PG8_LDB
#undef PG8_MMA
#undef PG8_WAIT_V
#undef PG8_WAIT_L
#undef PG8_BAR
#undef PG8_SCHED
}
}

#define GAS __attribute__((address_space(1)))
#define LAS __attribute__((address_space(3)))
typedef unsigned short bf16;
typedef unsigned v4u __attribute__((ext_vector_type(4)));
typedef float f32x4 __attribute__((ext_vector_type(4)));
typedef short bf16x8 __attribute__((ext_vector_type(8)));
typedef GAS unsigned gu32;
typedef GAS unsigned long long gu64;
#define RLX_AGENT __ATOMIC_RELAXED, __HIP_MEMORY_SCOPE_AGENT
#define LDS_WAIT() asm volatile("s_waitcnt lgkmcnt(0)" ::: "memory")
#define VM_WAIT() asm volatile("s_waitcnt vmcnt(0)" ::: "memory")
__device__ __forceinline__ unsigned long long rt() { return __builtin_amdgcn_s_memrealtime(); }
__device__ __forceinline__ unsigned f2bf(float f) { unsigned u = __builtin_bit_cast(unsigned, f); return (u + 0x7fffu + ((u >> 16) & 1u)) >> 16; }
__device__ __forceinline__ unsigned pk2(float lo, float hi) { return f2bf(lo) | (f2bf(hi) << 16); }

#define XB_TMO      128
#define XB_XCNT(j)  (256  + 64 * (j))
#define XB_XSUB(j)  (1280 + 64 * (j))
#define XB_XGEN(j)  (2304 + 64 * (j))
#define XB_TOP      3328
#define XB_TOPGEN   3392
#define XCD_BAR_WORDS 3456
#define XB_SPIN_CAP (1u << 18)

__device__ __forceinline__ unsigned xb_ld(unsigned* p)              { return __hip_atomic_load(p, __ATOMIC_RELAXED, __HIP_MEMORY_SCOPE_AGENT); }
__device__ __forceinline__ unsigned xb_add(unsigned* p, unsigned v) { return __hip_atomic_fetch_add(p, v, __ATOMIC_RELAXED, __HIP_MEMORY_SCOPE_AGENT); }
__device__ __forceinline__ unsigned xb_xcc_id() { return (unsigned)__builtin_amdgcn_s_getreg((3 << 11) | 20) & 0xFu; }
#define XB_SPIN(cond, bar) do { unsigned _sp = 0; while (cond) { __builtin_amdgcn_s_sleep(1); \
    if ((++_sp & 255u) == 0u) { if (xb_ld(&(bar)[XB_TMO])) break; if (_sp > XB_SPIN_CAP) { atomicAdd(&(bar)[XB_TMO], 1u); break; } } } } while (0)

struct XcdBarrier {
    unsigned* bar; unsigned x;
    volatile LAS unsigned* st;
};

__device__ __forceinline__ XcdBarrier xcd_barrier_post(unsigned* bar, volatile LAS unsigned* st) {
    XcdBarrier b; b.bar = bar; b.x = xb_xcc_id(); b.st = st;
    if (threadIdx.x == 0) (void)xb_add(&bar[XB_XCNT(b.x)], 1u);
    return b;
}
__device__ __forceinline__ void xcd_barrier_complete(unsigned* bar, unsigned x, unsigned& nloc, unsigned& nx) {
    const unsigned G = gridDim.x * gridDim.y * gridDim.z;
    unsigned sum, cnt, mine, sp = 0u;
    for (;;) {
        sum = 0u; cnt = 0u; mine = 0u;
#pragma unroll
        for (unsigned j = 0; j < 16; ++j) { const unsigned c = xb_ld(&bar[XB_XCNT(j)]); sum += c; cnt += (c > 0u) ? 1u : 0u; mine = (j == x) ? c : mine; }
        if (sum == G) break;
        __builtin_amdgcn_s_sleep(1);
        if ((++sp & 255u) == 0u) { if (xb_ld(&bar[XB_TMO])) break; if (sp > XB_SPIN_CAP) { atomicAdd(&bar[XB_TMO], 1u); break; } }
    }
    nloc = mine > 0u ? mine : 1u; nx = cnt > 0u ? cnt : 1u;
}

__device__ __forceinline__ void xcd_barrier(const XcdBarrier& b) {
    asm volatile("s_waitcnt vmcnt(0)" ::: "memory");
    __syncthreads();
    if (threadIdx.x == 0) {
        unsigned* bar = b.bar;
        __builtin_amdgcn_s_waitcnt(0);
        unsigned nloc = b.st[0], nx = b.st[1];
        if (nloc == 0u) { xcd_barrier_complete(bar, b.x, nloc, nx); b.st[0] = nloc; b.st[1] = nx; }
        const unsigned old = xb_add(&bar[XB_XSUB(b.x)], 1u);
        const unsigned gen = old / nloc;
        if (old + 1u == (gen + 1u) * nloc) {
            __builtin_amdgcn_fence(__ATOMIC_RELEASE, "agent");
            asm volatile("s_waitcnt vmcnt(0)" ::: "memory");
            const unsigned og = xb_add(&bar[XB_TOP], 1u);
            const unsigned tg = og / nx;
            if (og + 1u == (tg + 1u) * nx) xb_add(&bar[XB_TOPGEN], 1u);
            else XB_SPIN(xb_ld(&bar[XB_TOPGEN]) == tg, bar);
            __builtin_amdgcn_fence(__ATOMIC_ACQUIRE, "agent");
            xb_add(&bar[XB_XGEN(b.x)], 1u);
            asm volatile("s_waitcnt vmcnt(0)" ::: "memory");
        } else {
            XB_SPIN(xb_ld(&bar[XB_XGEN(b.x)]) == gen, bar);
            __builtin_amdgcn_fence(__ATOMIC_ACQUIRE, "agent");
            asm volatile("s_waitcnt vmcnt(0)" ::: "memory");
        }
    }
    __syncthreads();
}


constexpr int NWAVES = 8;
#ifndef MK_N_LAUNCHES
#define MK_N_LAUNCHES 1
#endif
constexpr int N_PHASES = 11;
constexpr int N_LAUNCHES = MK_N_LAUNCHES;
constexpr int BATCH = 2, SEQ = 8192, T = BATCH * SEQ, D = 1024;
constexpr int DIN = 9728, NQKV = 4608, NCG = 5120, GW = 512, DAO = 512;
constexpr int NP1 = NQKV + 512;
constexpr int NEXP = 16384, PEER_H = 8, PEER_K = 16, HK = 128;
constexpr float RMS_EPS = 1e-6f;
constexpr float C2 = 0.125f * 1.4426950408889634f;
constexpr float LN2 = 0.6931471805599453f;

constexpr size_t MiB = 1u << 20;
constexpr size_t WS_CTL = 0, CTL_ZERO_BYTES = 64 * 1024;
constexpr size_t WS_ROPE = 1 * MiB, WS_RSQ = 2 * MiB, WS_LSE = 3 * MiB;
constexpr size_t WS_U8 = 24 * MiB, WS_WQKV8 = 5 * MiB, WS_SU = 15 * MiB, WS_SW = 15 * MiB + 65536;
constexpr size_t WS_Q = 56 * MiB, WS_K = 104 * MiB, WS_V = 152 * MiB, WS_O = 200 * MiB;
constexpr size_t WS_Z = 136 * MiB, WS_SGC = 168 * MiB, WS_SGA = 216 * MiB;
constexpr size_t OS_BB = 0, OS_EDOWN = 32 * MiB, OS_WFOLD = 48 * MiB;
constexpr size_t WS_WCONV = 248 * MiB, WS_WATTN = 250 * MiB, WS_WOUT = 251 * MiB;
constexpr size_t WS_EUP = 104 * MiB, WS_ESCALE = 253 * MiB;
constexpr size_t WS_Y = 136 * MiB, WS_H = 168 * MiB, WS_HG = 24 * MiB;
constexpr size_t WS_IDX = 9 * MiB, WS_GATE = 120 * MiB, WS_WB = 56 * MiB, WS_SS = 64 * MiB, WS_HG8 = 65 * MiB, WS_HSC = 81 * MiB;
constexpr size_t WS_SCR0 = 136 * MiB, WS_SCR1 = 88 * MiB, WS_SCR2 = 232 * MiB;
constexpr size_t WS_END = 256 * MiB;
constexpr int CW_TMO = 0, CW_BAR = 1024, CW_RANK = 8192;

constexpr int RING_BYTES = 131072, MISC_OFF = RING_BYTES + 320, LDS_BYTES = 147456;

using pg8::Unit; using pg8::Gemm; using pg8::StaticOrder; using pg8::gemm_phase; using pg8::cvt_pk_bf16;
typedef unsigned short bf16;
typedef unsigned u32x4 __attribute__((ext_vector_type(4)));
typedef unsigned u32x2 __attribute__((ext_vector_type(2)));
typedef float f32x4 __attribute__((ext_vector_type(4)));
typedef float f32x2 __attribute__((ext_vector_type(2)));
typedef short bf16x8 __attribute__((ext_vector_type(8)));
typedef short s16x4 __attribute__((ext_vector_type(4)));
typedef short v4i16_t __attribute__((ext_vector_type(4)));
#define LAS __attribute__((address_space(3)))

__device__ __forceinline__ float bf_lo(unsigned w) { return __builtin_bit_cast(float, w << 16); }
__device__ __forceinline__ float bf_hi(unsigned w) { return __builtin_bit_cast(float, w & 0xffff0000u); }
__device__ __forceinline__ u32x4 pack8(f32x4 a, f32x4 b) { u32x4 w; w.x = cvt_pk_bf16(a[0], a[1]); w.y = cvt_pk_bf16(a[2], a[3]); w.z = cvt_pk_bf16(b[0], b[1]); w.w = cvt_pk_bf16(b[2], b[3]); return w; }
__device__ __forceinline__ void unpack8(u32x4 w, f32x4& a, f32x4& b) { a = (f32x4){bf_lo(w.x), bf_hi(w.x), bf_lo(w.y), bf_hi(w.y)}; b = (f32x4){bf_lo(w.z), bf_hi(w.z), bf_lo(w.w), bf_hi(w.w)}; }
template <int CTRL> __device__ __forceinline__ float dppf(float v) { const int x = __builtin_bit_cast(int, v); return __builtin_bit_cast(float, __builtin_amdgcn_update_dpp(x, x, CTRL, 0xf, 0xf, true)); }
__device__ __forceinline__ float sum4_dpp(float v) { v += dppf<0xB1>(v); v += dppf<0x4E>(v); return v; }
__device__ __forceinline__ float sum8_dpp(float v) { v = sum4_dpp(v); v += dppf<0x141>(v); return v; }
__device__ __forceinline__ float sum16_dpp(float v) { v = sum8_dpp(v); v += dppf<0x140>(v); return v; }
__device__ __forceinline__ float max16_dpp(float v) { v = fmaxf(v, dppf<0xB1>(v)); v = fmaxf(v, dppf<0x4E>(v)); v = fmaxf(v, dppf<0x141>(v)); v = fmaxf(v, dppf<0x140>(v)); return v; }
__device__ __forceinline__ float rl_(float v, int l) { return __builtin_bit_cast(float, __builtin_amdgcn_readlane(__builtin_bit_cast(int, v), l)); }
__device__ __forceinline__ float wave_sum(float v) { v = sum16_dpp(v); return (rl_(v, 0) + rl_(v, 16)) + (rl_(v, 32) + rl_(v, 48)); }
__device__ __forceinline__ float wave_max(float v) { v = max16_dpp(v); return fmaxf(fmaxf(rl_(v, 0), rl_(v, 16)), fmaxf(rl_(v, 32), rl_(v, 48))); }
__device__ __forceinline__ unsigned pack4i8(f32x4 v) { const int a = (int)__builtin_rintf(v[0]), b = (int)__builtin_rintf(v[1]), c = (int)__builtin_rintf(v[2]), d = (int)__builtin_rintf(v[3]); return (unsigned)(a & 255) | ((unsigned)(b & 255) << 8) | ((unsigned)(c & 255) << 16) | ((unsigned)d << 24); }
__device__ __forceinline__ f32x4 unpack4u8(unsigned w) { return (f32x4){(float)(w & 255u), (float)((w >> 8) & 255u), (float)((w >> 16) & 255u), (float)(w >> 24)} * (1.f / 255.f); }
__device__ __forceinline__ float xor16(float v, int fq) {
    const unsigned x = __builtin_bit_cast(unsigned, v);
    const auto r = __builtin_amdgcn_permlane16_swap(x, x, false, false);
    const unsigned a = r[0], b = r[1];
    return __builtin_bit_cast(float, (fq & 1) ? a : b);
}
__device__ __forceinline__ float xor32(float v, int fq) {
    const unsigned x = __builtin_bit_cast(unsigned, v);
    const auto r = __builtin_amdgcn_permlane32_swap(x, x, false, false);
    const unsigned a = r[0], b = r[1];
    return __builtin_bit_cast(float, (fq & 2) ? a : b);
}
__device__ __forceinline__ float sigmoidf_(float x) { return 1.f / (1.f + __expf(-x)); }

struct QkvOrder : StaticOrder {
    const char* U;
    __device__ __forceinline__ const char* a_base(const Unit& u, int& sh) const {
        const int g = (u.pn < 18) ? u.pn / 6 : 0; sh = 2 * g;
        const int b = u.pm >> 5, lp0 = (u.pm & 31) * 256;
        const int r = lp0 >> (13 - sh), i0 = lp0 & ((SEQ >> sh) - 1);
        const int t0 = b * SEQ + (i0 << sh) + r;
        return U + (size_t)t0 * D;
    }
};
struct EpiQKV {
    static constexpr bool PERM = true, AFTER_DRAIN = false;
    bf16* Q; const float* rope; const float* su; const float* sw; unsigned char* SGA; const float* gbias1;
    __device__ __forceinline__ void operator()(const f32x4 (&acc)[2][2][4][2], const Unit& u, int wr, int wc, int fr, int fq) const {
        if (u.pn >= 18) {
#pragma unroll
            for (int ai = 0; ai < 2; ++ai)
#pragma unroll
                for (int m = 0; m < 4; ++m) { const size_t row = (size_t)u.pm * 256 + ai * 128 + wr * 64 + m * 16 + fr; const float sr = su[row];
#pragma unroll
                    for (int bj = 0; bj < 2; ++bj) { const int col = 512 + (u.pn - 18) * 256 + bj * 128 + wc * 32 + fq * 8;
                        const f32x4 b0 = *(const f32x4*)(gbias1 + col), b1 = *(const f32x4*)(gbias1 + col + 4);
                        const int wcol = u.pn * 256 + bj * 128 + wc * 32 + fq * 8;
                        f32x4 v0 = acc[ai][bj][m][0] * (*(const f32x4*)(sw + wcol) * sr) + b0, v1 = acc[ai][bj][m][1] * (*(const f32x4*)(sw + wcol + 4) * sr) + b1;
#pragma unroll
                        for (int e = 0; e < 4; ++e) { v0[e] = sigmoidf_(v0[e]) * 255.f; v1[e] = sigmoidf_(v1[e]) * 255.f; }
                        u32x2 g8; g8.x = pack4i8(v0); g8.y = pack4i8(v1);
                        *(u32x2*)(SGA + row * D + col) = g8; } }
            return;
        }
        asm volatile("" : "+v"(fr), "+v"(fq));
        const int g = u.pn / 6, kind = (u.pn % 6) >> 1, half = u.pn & 1, sh = 2 * g;
        bf16* base = Q + (size_t)kind * ((WS_K - WS_Q) / 2) + (size_t)g * T * GW;
        const int b = u.pm >> 5, lp0 = (u.pm & 31) * 256;
        const bool rot = (kind < 2) && ((wc & 1) == 0);
        const float sc = (kind == 0) ? C2 : 1.f;
        f32x4 swv[2][2];
#pragma unroll
        for (int bj = 0; bj < 2; ++bj) { const int wcol = u.pn * 256 + bj * 128 + wc * 32 + fq * 8; swv[bj][0] = *(const f32x4*)(sw + wcol) * sc; swv[bj][1] = *(const f32x4*)(sw + wcol + 4) * sc; }
        const float sgn = (fq == 0) ? -1.f : 1.f; const bool use = fq < 2;
#pragma unroll
        for (int ai = 0; ai < 2; ++ai)
#pragma unroll
            for (int m = 0; m < 4; ++m) {
                const int rl = ai * 128 + wr * 64 + m * 16 + fr, lp = lp0 + rl;
                const int tok = b * SEQ + ((lp & ((SEQ >> sh) - 1)) << sh) + (lp >> (13 - sh));
                const float sut = su[tok];
                f32x4 c0 = {1.f, 1.f, 1.f, 1.f}, c1 = c0, s0 = {0.f, 0.f, 0.f, 0.f}, s1 = s0;
                if (rot) { const f32x4* rp = (const f32x4*)(rope + (size_t)tok * 16); c0 = rp[0]; c1 = rp[1]; s0 = rp[2]; s1 = rp[3]; }
                bf16* rowp = base + (size_t)(u.pm * 256 + rl) * GW + half * 256 + wc * 32 + fq * 8;
#pragma unroll
                for (int bj = 0; bj < 2; ++bj) {
                    f32x4 v0 = acc[ai][bj][m][0] * (swv[bj][0] * sut), v1 = acc[ai][bj][m][1] * (swv[bj][1] * sut);
                    if (rot) {
                        f32x4 o0, o1;
#pragma unroll
                        for (int e = 0; e < 4; ++e) { o0[e] = xor16(v0[e], fq); o1[e] = xor16(v1[e], fq); }
                        const f32x4 r0 = v0 * c0 + (o0 * s0) * sgn, r1 = v1 * c1 + (o1 * s1) * sgn;
                        v0 = use ? r0 : v0; v1 = use ? r1 : v1;
                    }
                    *(u32x4*)(rowp + bj * 128) = pack8(v0, v1);
                }
            }
    }
};
struct EpiCG {
    static constexpr bool PERM = true, AFTER_DRAIN = false;
    bf16* Bb; bf16* Z; unsigned char* SGC; unsigned char* SGA; const float* gbias; const float* su; const float* sw;
    __device__ __forceinline__ void operator()(const f32x4 (&accin)[2][2][4][2], const Unit& u, int wr, int wc, int fr, int fq) const {
        const int pn = u.pn;
        f32x4 swv[2][2];
#pragma unroll
        for (int bj = 0; bj < 2; ++bj) { const int wcol = NP1 + pn * 256 + bj * 128 + wc * 32 + fq * 8; swv[bj][0] = *(const f32x4*)(sw + wcol); swv[bj][1] = *(const f32x4*)(sw + wcol + 4); }
        f32x4 acc[2][2][4][2];
#pragma unroll
        for (int ai = 0; ai < 2; ++ai)
#pragma unroll
            for (int m = 0; m < 4; ++m) { const float sr = su[(size_t)u.pm * 256 + ai * 128 + wr * 64 + m * 16 + fr];
#pragma unroll
                for (int bj = 0; bj < 2; ++bj) { acc[ai][bj][m][0] = accin[ai][bj][m][0] * (swv[bj][0] * sr); acc[ai][bj][m][1] = accin[ai][bj][m][1] * (swv[bj][1] * sr); } }
#pragma unroll
        for (int ai = 0; ai < 2; ++ai)
#pragma unroll
            for (int m = 0; m < 4; ++m) {
                const size_t row = (size_t)u.pm * 256 + ai * 128 + wr * 64 + m * 16 + fr;
                if (pn < 4) {
#pragma unroll
                    for (int bj = 0; bj < 2; ++bj) *(u32x4*)(Bb + row * D + pn * 256 + bj * 128 + wc * 32 + fq * 8) = pack8(acc[ai][bj][m][0], acc[ai][bj][m][1]);
                } else if (pn < 12) {
                    const f32x4 z0 = acc[ai][0][m][0] * acc[ai][1][m][0], z1 = acc[ai][0][m][1] * acc[ai][1][m][1];
                    *(u32x4*)(Z + row * D + (pn - 4) * 128 + wc * 32 + fq * 8) = pack8(z0, z1);
                } else {
                    const int gsel = (pn >= 16) ? 1 : 0; unsigned char* out = gsel ? SGA : SGC;
#pragma unroll
                    for (int bj = 0; bj < 2; ++bj) {
                        const int col = (pn - 12 - 4 * gsel) * 256 + bj * 128 + wc * 32 + fq * 8;
                        const f32x4 b0 = *(const f32x4*)(gbias + gsel * D + col), b1 = *(const f32x4*)(gbias + gsel * D + col + 4);
                        f32x4 v0 = acc[ai][bj][m][0] + b0, v1 = acc[ai][bj][m][1] + b1;
#pragma unroll
                        for (int e = 0; e < 4; ++e) { v0[e] = sigmoidf_(v0[e]) * 255.f; v1[e] = sigmoidf_(v1[e]) * 255.f; }
                        u32x2 g8; g8.x = pack4i8(v0); g8.y = pack4i8(v1);
                        *(u32x2*)(out + row * D + col) = g8;
                    }
                }
            }
    }
};
template <int MODE> struct EpiY {
    static constexpr bool PERM = true, AFTER_DRAIN = false;
    bf16* Y; const unsigned char* G;
    __device__ __forceinline__ void operator()(const f32x4 (&acc)[2][2][4][2], const Unit& u, int wr, int wc, int fr, int fq) const {
#pragma unroll
        for (int ai = 0; ai < 2; ++ai)
#pragma unroll
            for (int m = 0; m < 4; ++m) {
                const size_t row = (size_t)u.pm * 256 + ai * 128 + wr * 64 + m * 16 + fr;
#pragma unroll
                for (int bj = 0; bj < 2; ++bj) {
                    const size_t off = row * D + u.pn * 256 + bj * 128 + wc * 32 + fq * 8;
                    const u32x2 g8 = *(const u32x2*)(G + off);
                    const f32x4 g0 = unpack4u8(g8.x), g1 = unpack4u8(g8.y);
                    f32x4 v0 = acc[ai][bj][m][0] * g0, v1 = acc[ai][bj][m][1] * g1;
                    if (MODE == 1) { f32x4 y0, y1; unpack8(*(const u32x4*)(Y + off), y0, y1); v0 = v0 + y0; v1 = v1 + y1; }
                    *(u32x4*)(Y + off) = pack8(v0, v1);
                }
            }
    }
};
struct EpiOut {
    static constexpr bool PERM = true, AFTER_DRAIN = false;
    const float* X; bf16* HG; const float* nffn; float* RSQ; unsigned char* HG8; float* HSC;
    __device__ __forceinline__ void operator()(const f32x4 (&acc)[2][2][4][2], const Unit& u, int wr, int wc, int fr, int fq) const {
#pragma unroll
        for (int ai = 0; ai < 2; ++ai)
#pragma unroll
            for (int m = 0; m < 4; ++m) {
                const size_t row = (size_t)u.pm * 256 + ai * 128 + wr * 64 + m * 16 + fr;
                float ss = 0.f;
#pragma unroll
                for (int bj = 0; bj < 2; ++bj) {
                    const int col = u.pn * 256 + bj * 128 + wc * 32 + fq * 8; const size_t off = row * D + col;
                    const f32x4 h0 = *(const f32x4*)(X + off) + acc[ai][bj][m][0], h1 = *(const f32x4*)(X + off + 4) + acc[ai][bj][m][1];
                    const f32x4 n0 = *(const f32x4*)(nffn + col), n1 = *(const f32x4*)(nffn + col + 4);
                    const f32x4 y0 = h0 * n0, y1 = h1 * n1;
                    *(u32x4*)(HG + off) = pack8(y0, y1);
                    float am = fmaxf(fmaxf(fmaxf(fabsf(y0[0]), fabsf(y0[1])), fmaxf(fabsf(y0[2]), fabsf(y0[3]))), fmaxf(fmaxf(fabsf(y1[0]), fabsf(y1[1])), fmaxf(fabsf(y1[2]), fabsf(y1[3]))));
                    am = fmaxf(am, xor16(am, fq)); am = fmaxf(am, xor32(am, fq));
                    const float qs = (am > 0.f) ? 127.f / am : 0.f;
                    u32x2 q8; q8.x = pack4i8(y0 * qs); q8.y = pack4i8(y1 * qs);
                    *(u32x2*)(HG8 + off) = q8;
                    if (fq == 0) HSC[row * 32 + u.pn * 8 + bj * 4 + wc] = am * (1.f / 127.f);
                    ss += (h0[0] * h0[0] + h0[1] * h0[1]) + (h0[2] * h0[2] + h0[3] * h0[3]) + (h1[0] * h1[0] + h1[1] * h1[1]) + (h1[2] * h1[2] + h1[3] * h1[3]);
                }
                ss += xor16(ss, fq); ss += xor32(ss, fq);
                if (fq == 0) RSQ[row * 16 + u.pn * 4 + wc] = ss;
            }
    }
};
struct CvCtx { const float* dn; const float* up; unsigned char* ed; unsigned char* eu; float* esc; int lane; };
__device__ __forceinline__ void cv_load(const CvCtx& C, int ru, f32x4 (&v)[4]) {
    const int tb = ru >> 14, e = ru & (NEXP - 1);
    const float* src = (tb ? C.up : C.dn) + (size_t)e * D + 16 * C.lane;
#pragma unroll
    for (int q = 0; q < 4; ++q) v[q] = *(const f32x4*)(src + 4 * q);
}
template <int TB> __device__ __forceinline__ void cv_finish(const CvCtx& C, int ru, const f32x4 (&v)[4]) {
    const int e = ru & (NEXP - 1);
    float am = 0.f;
#pragma unroll
    for (int q = 0; q < 4; ++q) am = fmaxf(am, fmaxf(fmaxf(fabsf(v[q][0]), fabsf(v[q][1])), fmaxf(fabsf(v[q][2]), fabsf(v[q][3]))));
    am = wave_max(am);
    u32x4 w;
    if constexpr (TB) {
        const float sc = (am > 0.f) ? 256.f / am : 1.f;
#pragma unroll
        for (int q = 0; q < 4; ++q) { int d = __builtin_amdgcn_cvt_pk_fp8_f32(v[q][0] * sc, v[q][1] * sc, 0, false); d = __builtin_amdgcn_cvt_pk_fp8_f32(v[q][2] * sc, v[q][3] * sc, d, true); w[q] = (unsigned)d; }
        *(u32x4*)(C.eu + (size_t)(C.lane >> 3) * (2 * MiB) + (size_t)e * 128 + 16 * (C.lane & 7)) = w;
        C.esc[ru] = (am > 0.f) ? am * (1.f / 256.f) : 1.f;
    } else {
        const float s8 = (am > 0.f) ? 127.f / am : 0.f;
#pragma unroll
        for (int q = 0; q < 4; ++q) w[q] = pack4i8(v[q] * s8);
        *(u32x4*)(C.ed + (size_t)e * 1024 + 16 * C.lane) = w;
        C.esc[ru] = am * (1.f / 127.f);
    }
}
template <int TB> __device__ __forceinline__ void cv_rows_t(const CvCtx& C, int r0, int step) {
    const int hi = (TB + 1) * NEXP;
    if (r0 >= hi) return;
    const int last = r0 + ((hi - 1 - r0) / step) * step;
    f32x4 va[4], vb[4];
    cv_load(C, r0, va);
#pragma unroll 1
    for (int r = r0; r < hi; r += 2 * step) {
        const int r1 = min(r + step, last), r2 = min(r + 2 * step, last);
        cv_load(C, r1, vb);
        __builtin_amdgcn_sched_barrier(0);
        cv_finish<TB>(C, r, va);
        __builtin_amdgcn_sched_barrier(0);
        cv_load(C, r2, va);
        __builtin_amdgcn_sched_barrier(0);
        cv_finish<TB>(C, r1, vb);
        __builtin_amdgcn_sched_barrier(0);
    }
}
__device__ __forceinline__ void cv_rows(const CvCtx& C, int r0, int step) {
    int r = r0;
    if (r < NEXP) { cv_rows_t<0>(C, r, step); r += ((NEXP - 1 - r) / step + 1) * step; }
    cv_rows_t<1>(C, r, step);
}
__device__ __forceinline__ int f2key(float f) { const int b = __builtin_bit_cast(int, f); return b ^ ((b >> 31) & 0x7fffffff); }
__device__ __forceinline__ float key2f(int k) { return __builtin_bit_cast(float, k ^ ((k >> 31) & 0x7fffffff)); }
#define TOPK_INS(list, x) do { _Pragma("unroll") for (int _k = 0; _k < 16; ++_k) { const int _hi = max(list[_k], x); x = min(list[_k], x); list[_k] = _hi; } } while (0)
__device__ __forceinline__ unsigned long long pack8idx(const int (&a)[16], int o) { unsigned long long r = 0ull;
#pragma unroll
    for (int k = 0; k < 8; ++k) r |= (unsigned long long)(unsigned)(a[o + k] & 127) << (8 * k);
    return r; }
__device__ __forceinline__ int lut16(unsigned long long lo, unsigned long long hi, int i) { const unsigned long long w = (i < 8) ? lo : hi; return (int)((w >> ((i & 7) * 8)) & 127ull); }
__device__ __forceinline__ void sort16_asc(int (&x)[16]) {
#pragma unroll
    for (int k = 2; k <= 16; k <<= 1)
#pragma unroll
        for (int j = k >> 1; j > 0; j >>= 1)
#pragma unroll
            for (int i = 0; i < 16; ++i) { const int l = i ^ j; if (l > i) { const int lo = min(x[i], x[l]), hi = max(x[i], x[l]); const bool up = (i & k) == 0; x[i] = up ? lo : hi; x[l] = up ? hi : lo; } }
}
__device__ __forceinline__ void merge16(int (&r)[16], const int (&a)[16]) {
#pragma unroll
    for (int i = 0; i < 16; ++i) r[i] = max(r[i], a[i]);
#pragma unroll
    for (int j = 8; j > 0; j >>= 1)
#pragma unroll
        for (int i = 0; i < 16; ++i) { const int l = i ^ j; if (l > i) { const int lo = min(r[i], r[l]), hi = max(r[i], r[l]); r[i] = hi; r[l] = lo; } }
}
struct EpiTopk {
    static constexpr bool PERM = true, AFTER_DRAIN = false;
    float* scr; const float* RSQ; int* IDX; float* GATE; CvCtx CV; mutable int cvr; int cvstep;
    __device__ __forceinline__ void operator()(const f32x4 (&acc)[2][2][4][2], const Unit& u, int wr, int wc, int fr, int fq) const {
        const __amdgpu_buffer_rsrc_t rsrc = __builtin_amdgcn_make_buffer_rsrc(scr, 0, 262144, 0x00020000);
        const int voff = ((wc * 32 + fq * 8) * 256 + wr * 64 + fr) * 4;
#pragma unroll
        for (int ai = 0; ai < 2; ++ai)
#pragma unroll
            for (int m = 0; m < 4; ++m)
#pragma unroll
                for (int bj = 0; bj < 2; ++bj)
#pragma unroll
                    for (int n = 0; n < 2; ++n)
#pragma unroll
                        for (int e = 0; e < 4; ++e)
                        { const float val = acc[ai][bj][m][n][e]; __builtin_amdgcn_raw_buffer_store_b32(__builtin_bit_cast(unsigned, val), rsrc, voff, ((bj * 128 + n * 4 + e) * 256 + ai * 128 + m * 16) * 4, 0); }
        asm volatile("s_waitcnt vmcnt(0)" ::: "memory");
        __builtin_amdgcn_s_barrier();
        asm volatile("" ::: "memory");
        const int tid = threadIdx.x, row = tid >> 1, c = tid & 1;
        int v[16];
#pragma unroll
        for (int k = 0; k < 16; ++k) v[k] = (int)0x80000000;
        const int roff = (c * 128 * 256 + row) * 4;
        const size_t t = (size_t)u.pm * 256 + row;
        f32x4 rq[4];
#pragma unroll
        for (int j = 0; j < 4; ++j) rq[j] = *(const f32x4*)(RSQ + t * 16 + 4 * j);
        float xs[16], xn[16];
#pragma unroll
        for (int j = 0; j < 16; ++j) xs[j] = __builtin_bit_cast(float, __builtin_amdgcn_raw_buffer_load_b32(rsrc, roff, j * 1024, 2));
#pragma unroll 1
        for (int k0 = 0; k0 < 128; k0 += 16) {
            { const int kn = (k0 + 16) & 127;
#pragma unroll
              for (int j = 0; j < 16; ++j) xn[j] = __builtin_bit_cast(float, __builtin_amdgcn_raw_buffer_load_b32(rsrc, roff, (kn + j) * 1024, 2)); }
            __builtin_amdgcn_sched_barrier(0);
            int kb[16];
#pragma unroll
            for (int j = 0; j < 16; ++j) kb[j] = (f2key(xs[j]) & ~127) | (k0 + j);
            sort16_asc(kb);
            if (k0 == 0) {
#pragma unroll
                for (int j = 0; j < 16; ++j) v[j] = kb[15 - j];
            } else merge16(v, kb);
            __builtin_amdgcn_sched_barrier(0);
#pragma unroll
            for (int j = 0; j < 16; ++j) xs[j] = xn[j];
        }
        int A[16], B[16];
#pragma unroll
        for (int k = 0; k < 16; ++k) { const int o = __builtin_amdgcn_update_dpp(v[k], v[k], 0xB1, 0xf, 0xf, true); A[k] = c ? o : v[k]; B[k] = c ? v[k] : o; }
        int c2[16];
#pragma unroll
        for (int k = 0; k < 16; ++k) c2[k] = (int)0x80000000;
#define CAND(i, j) ((f2key(key2f(A[i]) + key2f(B[j])) & ~255) | ((i) * 16 + (j)))
#pragma unroll
        for (int j = 0; j < 16; ++j) c2[j] = CAND(0, j);
        { int t[16]; t[0] = (int)0x80000000;
#pragma unroll
          for (int i = 1; i < 16; ++i) t[16 - i] = CAND(i, 0);
          merge16(c2, t); }
        { int t[16];
          t[0] = CAND(1, 1); t[1] = CAND(1, 2); t[2] = CAND(1, 3); t[3] = CAND(1, 4); t[4] = CAND(1, 5); t[5] = CAND(1, 6); t[6] = CAND(1, 7);
          t[7] = CAND(2, 1); t[8] = CAND(2, 2); t[9] = CAND(2, 3); t[10] = CAND(2, 4); t[11] = CAND(3, 1); t[12] = CAND(3, 2); t[13] = CAND(3, 3);
          t[14] = CAND(4, 1); t[15] = CAND(4, 2);
          sort16_asc(t); merge16(c2, t); }
        { int x = CAND(5, 1); TOPK_INS(c2, x); x = CAND(6, 1); TOPK_INS(c2, x); x = CAND(7, 1); TOPK_INS(c2, x); }
#undef CAND
        float ssq = 0.f;
#pragma unroll
        for (int j = 0; j < 4; ++j) ssq += (rq[j][0] + rq[j][1]) + (rq[j][2] + rq[j][3]);
        const float rstd = __builtin_amdgcn_rsqf(ssq * (1.f / D) + RMS_EPS);
        const unsigned long long alo = pack8idx(A, 0), ahi = pack8idx(A, 8), blo = pack8idx(B, 0), bhi = pack8idx(B, 8);
        float sc[16]; int id[16]; float smax = 0.f, ssum = 0.f;
#pragma unroll
        for (int k = 0; k < 16; ++k) {
            const int cid = c2[k] & 255, i = cid >> 4, j = cid & 15;
            id[k] = lut16(alo, ahi, i) * 128 + lut16(blo, bhi, j);
            sc[k] = key2f(c2[k]) * rstd;
            if (k == 0) smax = sc[0];
            sc[k] = __expf(sc[k] - smax); ssum += sc[k];
        }
        const float inv = 1.f / ssum;
        int* ip = IDX + t * HK + u.pn * 16; float* gp = GATE + t * HK + u.pn * 16;
#pragma unroll
        for (int k = 0; k < 16; ++k) if ((k >> 3) == c) { ip[k] = id[k]; gp[k] = sc[k] * inv; }
    }
};

struct Frame {
    LAS unsigned char* lds;
    volatile LAS unsigned* MISC;
    gu32* ctl;
    int tid, lane, wave, vcu, G;
    int xcc, xrank;
    unsigned char* ws;
    const float* in[15]; float* out;
};
enum { I_X = 0, I_POS, I_NMIX, I_WIN, I_CONVW, I_WCONV, I_WATTN, I_GBIAS, I_WOUT, I_NFFN, I_WQ, I_SUBK, I_DOWN, I_UP, I_FNORM };

__device__ __forceinline__ void transpose_item(const float* W, int ldw, int k0, int n0, bf16* dst, int ldd, LAS float* scr, int lane) {
#pragma unroll 8
    for (int i = 0; i < 32; ++i) { const int kk = 2 * i + (lane >> 5); scr[kk * 33 + (lane & 31)] = W[(size_t)(k0 + kk) * ldw + n0 + (lane & 31)]; }
    LDS_WAIT(); asm volatile("" ::: "memory");
    const int c = lane & 7;
#pragma unroll
    for (int j = 0; j < 4; ++j) { const int n = (lane >> 3) + 8 * j; const LAS float* s = scr + (8 * c) * 33 + n;
        v4u o; o.x = pk2(s[0 * 33], s[1 * 33]); o.y = pk2(s[2 * 33], s[3 * 33]); o.z = pk2(s[4 * 33], s[5 * 33]); o.w = pk2(s[6 * 33], s[7 * 33]);
        *(GAS v4u*)(dst + (size_t)n * ldd + 8 * c) = o; }
    LDS_WAIT(); asm volatile("" ::: "memory");
}
__device__ __forceinline__ void w8_column_item(const float* W, int ldw, int n0, unsigned char* dst8  , float* swp  , LAS unsigned char* lds, int wave, int lane) {
    LAS float* scr = (LAS float*)(lds + wave * 16384); LAS float* cmx = (LAS float*)(lds + 130048);
    float x[2][32]; float am = 0.f;
#pragma unroll
    for (int b = 0; b < 2; ++b)
#pragma unroll
        for (int i = 0; i < 32; ++i) { const int kk = 64 * (2 * wave + b) + 2 * i + (lane >> 5); x[b][i] = W[(size_t)kk * ldw + n0 + (lane & 31)]; am = fmaxf(am, fabsf(x[b][i])); }
    am = fmaxf(am, xor32(am, lane >> 4));
    if (lane < 32) cmx[wave * 32 + lane] = am;
    __syncthreads();
    float cm = 0.f;
#pragma unroll
    for (int w = 0; w < 8; ++w) cm = fmaxf(cm, cmx[w * 32 + (lane & 31)]);
    const float q8 = (cm > 0.f) ? 127.f / cm : 0.f;
    if (wave == 0 && lane < 32) swp[lane] = cm * (1.f / 127.f);
#pragma unroll
    for (int b = 0; b < 2; ++b) {
#pragma unroll
        for (int i = 0; i < 32; ++i) scr[(2 * i + (lane >> 5)) * 33 + (lane & 31)] = x[b][i] * q8;
        LDS_WAIT(); asm volatile("" ::: "memory");
        const int c = lane & 7;
#pragma unroll
        for (int j = 0; j < 4; ++j) { const int n = (lane >> 3) + 8 * j; const LAS float* s = scr + (8 * c) * 33 + n;
            u32x2 o; o.x = pack4i8((f32x4){s[0 * 33], s[1 * 33], s[2 * 33], s[3 * 33]}); o.y = pack4i8((f32x4){s[4 * 33], s[5 * 33], s[6 * 33], s[7 * 33]});
            *(u32x2*)(dst8 + (size_t)n * D + 64 * (2 * wave + b) + 8 * c) = o; }
        LDS_WAIT(); asm volatile("" ::: "memory");
    }
    __syncthreads();
}
__device__ __forceinline__ int win_w8_row(int n0) {
    if (n0 < 1024) return NP1 + n0;
    if (n0 < 2048) { const int j = n0 - 1024; return NP1 + 1024 + (j >> 7) * 256 + (j & 127); }
    if (n0 < 3072) { const int j = n0 - 2048; return NP1 + 1024 + (j >> 7) * 256 + 128 + (j & 127); }
    if (n0 < 7680) { const int j = n0 - 3072, kind = j / 1536, jj = j % 1536, g = jj >> 9, cc = jj & 511; return g * 1536 + kind * 512 + cc; }
    if (n0 < 8704) return NP1 + 3072 + (n0 - 7680);
    if (n0 < 9216) return NP1 + 4096 + (n0 - 8704);
    return NQKV + (n0 - 9216);
}
__device__ __forceinline__ void p0_prologue(Frame& F) {
    for (int it = F.vcu; it < DIN / 32; it += F.G) {
        const int n0 = 32 * it, drow = win_w8_row(n0);
        w8_column_item(F.in[I_WIN], DIN, n0, F.ws + WS_WQKV8 + (size_t)drow * D, (float*)(F.ws + WS_SW) + drow, F.lds, F.wave, F.lane);
    }
    LAS float* scr = (LAS float*)(F.lds + F.wave * 16384);
    const int gw = F.vcu * NWAVES + F.wave, NGW = F.G * NWAVES;
    constexpr int I_C = 16 * 32, I_A = 8 * 32, I_O = 16 * 32, NITEMS = I_C + I_A + I_O;
    for (int it = gw; it < NITEMS; it += NGW) {
        int r = it;
        if (r < I_C) { const int kb = r / 32, nb = r % 32; transpose_item(F.in[I_WCONV], D, 64 * kb, 32 * nb, (bf16*)(F.ws + WS_WCONV) + (size_t)(32 * nb) * D + 64 * kb, D, scr, F.lane); continue; } r -= I_C;
        if (r < I_A) { const int kb = r / 32, nb = r % 32; transpose_item(F.in[I_WATTN], D, 64 * kb, 32 * nb, (bf16*)(F.ws + WS_WATTN) + (size_t)(32 * nb) * DAO + 64 * kb, DAO, scr, F.lane); continue; } r -= I_A;
        { const int kb = r / 32, nb = r % 32; transpose_item(F.in[I_WOUT], D, 64 * kb, 32 * nb, (bf16*)(F.ws + WS_WOUT) + (size_t)(32 * nb) * D + 64 * kb, D, scr, F.lane); }
    }
    const float* x = F.in[I_X]; const float* nm = F.in[I_NMIX];
    f32x4 gm[4];
#pragma unroll
    for (int j = 0; j < 4; ++j) gm[j] = *((const f32x4*)nm + F.lane + 64 * j);
    for (int m = gw; m < T; m += NGW) {
        const GAS f32x4* xr = (const GAS f32x4*)(x + (size_t)m * D) + F.lane;
        f32x4 v[4]; float s = 0.f;
#pragma unroll
        for (int j = 0; j < 4; ++j) { v[j] = xr[64 * j]; s += (v[j].x * v[j].x + v[j].y * v[j].y) + (v[j].z * v[j].z + v[j].w * v[j].w); }
        const float rstd = 1.f / sqrtf(wave_sum(s) * (1.f / D) + RMS_EPS);
        f32x4 y[4]; float am = 0.f;
#pragma unroll
        for (int j = 0; j < 4; ++j) { y[j] = v[j] * rstd * gm[j];
            am = fmaxf(am, fmaxf(fmaxf(fabsf(y[j].x), fabsf(y[j].y)), fmaxf(fabsf(y[j].z), fabsf(y[j].w)))); }
        am = wave_max(am);
        const float q8 = (am > 0.f) ? 127.f / am : 0.f;
#pragma unroll
        for (int j = 0; j < 4; ++j) ((GAS unsigned*)(F.ws + WS_U8 + (size_t)m * D))[F.lane + 64 * j] = pack4i8(y[j] * q8);
        if (F.lane == 0) ((float*)(F.ws + WS_SU))[m] = am * (1.f / 127.f);
    }
    const int* pos = (const int*)F.in[I_POS]; float* rope = (float*)(F.ws + WS_ROPE);
    for (int e = gw * 64 + F.lane; e < T * 8; e += NGW * 64) {
        const int t = e >> 3, j = e & 7;
        const double invf[8] = {1.0, 0.19392274474868576, 0.03760603093086393, 0.007292664737217109, 0.001414213562373095, 0.0002742481756762073, 5.318295896944988e-05, 1.031338537721246e-05};
        double f = 1.0;
#pragma unroll
        for (int q = 1; q < 8; ++q) f = (j == q) ? invf[q] : f;
        const float fi = (float)f;
        const double ang = (double)pos[t] * (double)fi;
        const double k = __builtin_rint(ang * 0.15915494309189535);
        const float r = (float)(ang - k * 6.283185307179586);
        rope[(size_t)t * 16 + j] = __cosf(r); rope[(size_t)t * 16 + 8 + j] = __sinf(r);
    }
}

__device__ __forceinline__ void attn_phase(Frame& F, bf16* OGb, float* LSE) {
    constexpr int SLOT = 128 * 160;
    LAS unsigned char* Ks = F.lds; LAS unsigned char* Vs = F.lds + 3 * SLOT;
    const int lane = F.lane, w = F.wave, ir = lane & 15, gq = lane >> 4;
    const int NU = 3 * 8 * 128, per = (NU + F.G - 1) / F.G;
    const int u0 = F.vcu * per, u1 = (u0 + per < NU) ? u0 + per : NU;
    const bf16* Qb = (const bf16*)(F.ws + WS_Q); const bf16* Kb = (const bf16*)(F.ws + WS_K); const bf16* Vb = (const bf16*)(F.ws + WS_V);
    u32x4 pk[2], pv[2]; bf16x8 nq0, nq1; bool havepre = false;
    for (int uid = u0, n = 0; uid < u1; ++uid, ++n) {
        const int g = uid >> 10, hh = (uid >> 7) & 7, blk = uid & 127, sh = 2 * g;
        const bool first = (blk & ((64 >> sh) - 1)) == 0;
        const size_t gbase = (size_t)g * T * GW;
        const int p0 = blk * 128;
        const int ps = n % 3, cs = (n + 1) % 3, ns = (n + 2) % 3;
        const bf16* qrow = Qb + gbase + (size_t)(p0 + 16 * w + ir) * GW + hh * 64;
        bf16* orow = OGb + gbase + (size_t)(p0 + 16 * w + ir) * GW + hh * 64;
        bf16x8 qf0, qf1;
        if (!havepre) {
            if (n > 0) __syncthreads();
#pragma unroll
            for (int i = 0; i < 4; ++i) {
                const int c = F.tid + 512 * i, row = c >> 3, part = c & 7;
                const bool valid = !first || row >= 128;
                u32x4 kv = {0u, 0u, 0u, 0u}, vv = {0u, 0u, 0u, 0u};
                if (valid) { const size_t off = gbase + (size_t)(p0 - 128 + row) * GW + hh * 64 + part * 8; kv = *(const u32x4*)(Kb + off); vv = *(const u32x4*)(Vb + off); }
                const int so = ((row < 128) ? ps : cs) * SLOT + (row & 127) * 160 + part * 16;
                *(LAS u32x4*)(Ks + so) = kv; *(LAS u32x4*)(Vs + so) = vv;
            }
            qf0 = *(const bf16x8*)(qrow + 8 * gq); qf1 = *(const bf16x8*)(qrow + 32 + 8 * gq);
        } else { qf0 = nq0; qf1 = nq1; }
        __syncthreads();
        havepre = (uid + 1 < u1) && (((uid + 1) & 127) != 0);
        if (havepre) {
#pragma unroll
            for (int i = 0; i < 2; ++i) { const int c = F.tid + 512 * i, row = c >> 3, part = c & 7; const size_t off = gbase + (size_t)(p0 + 128 + row) * GW + hh * 64 + part * 8; pk[i] = *(const u32x4*)(Kb + off); pv[i] = *(const u32x4*)(Vb + off); }
            nq0 = *(const bf16x8*)(qrow + (size_t)128 * GW + 8 * gq); nq1 = *(const bf16x8*)(qrow + (size_t)128 * GW + 32 + 8 * gq);
        }
        f32x4 sacc[9];
#pragma unroll
        for (int a = 0; a < 9; ++a) {
            sacc[a] = (f32x4){0.f, 0.f, 0.f, 0.f};
            const int R0 = 16 * w + 16 * a;
            const LAS unsigned char* kp = Ks + ((R0 < 128) ? ps : cs) * SLOT + ((R0 & 127) + ir) * 160 + gq * 16;
            const bf16x8 k0 = *(const LAS bf16x8*)kp, k1 = *(const LAS bf16x8*)(kp + 64);
            sacc[a] = __builtin_amdgcn_mfma_f32_16x16x32_bf16(k0, qf0, sacc[a], 0, 0, 0);
            sacc[a] = __builtin_amdgcn_mfma_f32_16x16x32_bf16(k1, qf1, sacc[a], 0, 0, 0);
        }
        float mx = -INFINITY;
#pragma unroll
        for (int a = 0; a < 9; ++a)
#pragma unroll
            for (int j = 0; j < 4; ++j) {
                const int jl = 4 * gq + j;
                bool valid = (a == 0) ? (jl >= ir) : ((a == 8) ? (jl <= ir) : true);
                valid = valid && (!first || (16 * w + 16 * a + jl >= 128));
                sacc[a][j] = valid ? sacc[a][j] : -INFINITY;
                mx = fmaxf(mx, sacc[a][j]);
            }
        mx = fmaxf(mx, xor16(mx, gq)); mx = fmaxf(mx, xor32(mx, gq));
        float l = 0.f;
#pragma unroll
        for (int a = 0; a < 9; ++a)
#pragma unroll
            for (int j = 0; j < 4; ++j) { sacc[a][j] = __builtin_amdgcn_exp2f(sacc[a][j] - mx); l += sacc[a][j]; }
        l += xor16(l, gq); l += xor32(l, gq);
        f32x4 oacc[4];
#pragma unroll
        for (int dt = 0; dt < 4; ++dt) oacc[dt] = (f32x4){0.f, 0.f, 0.f, 0.f};
#pragma unroll
        for (int s = 0; s < 5; ++s) {
            u32x4 pw; pw.x = cvt_pk_bf16(sacc[2 * s][0], sacc[2 * s][1]); pw.y = cvt_pk_bf16(sacc[2 * s][2], sacc[2 * s][3]);
            if (s < 4) { pw.z = cvt_pk_bf16(sacc[2 * s + 1][0], sacc[2 * s + 1][1]); pw.w = cvt_pk_bf16(sacc[2 * s + 1][2], sacc[2 * s + 1][3]); } else { pw.z = 0u; pw.w = 0u; }
            const bf16x8 pb = __builtin_bit_cast(bf16x8, pw);
            const int q = ir >> 2, p = ir & 3;
            const int Ra = 16 * w + 32 * s, Rb = Ra + 16;
            const LAS unsigned char* vpa = Vs + ((Ra < 128) ? ps : cs) * SLOT + ((Ra & 127) + 4 * gq + q) * 160 + p * 8;
            const LAS unsigned char* vpb = Vs + ((Rb < 128) ? ps : cs) * SLOT + ((Rb & 127) + 4 * gq + q) * 160 + p * 8;
#pragma unroll
            for (int dt = 0; dt < 4; ++dt) {
                const s16x4 va = __builtin_bit_cast(s16x4, __builtin_amdgcn_ds_read_tr16_b64_v4i16((LAS v4i16_t*)(vpa + dt * 32)));
                s16x4 vb = {0, 0, 0, 0};
                if (s < 4) vb = __builtin_bit_cast(s16x4, __builtin_amdgcn_ds_read_tr16_b64_v4i16((LAS v4i16_t*)(vpb + dt * 32)));
                const bf16x8 vf = __builtin_shufflevector(va, vb, 0, 1, 2, 3, 4, 5, 6, 7);
                oacc[dt] = __builtin_amdgcn_mfma_f32_16x16x32_bf16(vf, pb, oacc[dt], 0, 0, 0);
            }
        }
        const float inv = 1.f / l;
#pragma unroll
        for (int dt = 0; dt < 4; ++dt) {
            u32x2 o; o.x = cvt_pk_bf16(oacc[dt][0] * inv, oacc[dt][1] * inv); o.y = cvt_pk_bf16(oacc[dt][2] * inv, oacc[dt][3] * inv);
            *(u32x2*)(orow + 16 * dt + 4 * gq) = o;
        }
        if (gq == 0) LSE[((size_t)g * T + p0 + 16 * w + ir) * 8 + hh] = (mx + __builtin_amdgcn_logf(l)) * LN2;
        if (havepre) {
#pragma unroll
            for (int i = 0; i < 2; ++i) { const int c = F.tid + 512 * i, row = c >> 3, part = c & 7; const int so = ns * SLOT + row * 160 + part * 16; *(LAS u32x4*)(Ks + so) = pk[i]; *(LAS u32x4*)(Vs + so) = pv[i]; }
        }
    }
    __syncthreads();
}

__device__ __forceinline__ void combine_phase(Frame& F, int part, int nparts) {
    const int gw = part * NWAVES + F.wave, NGW = nparts * NWAVES, lane = F.lane, hh = lane >> 3;
    const bf16* OG = (const bf16*)(F.ws + WS_Q); const float* LSE = (const float*)(F.ws + WS_LSE); bf16* O = (bf16*)(F.ws + WS_O);
    for (int t0 = gw * 4; t0 < T; t0 += NGW * 4) {
        float ls[4][3]; u32x4 og[4][3];
#pragma unroll
        for (int q = 0; q < 4; ++q) { const int t = t0 + q, b = t / SEQ, s = t % SEQ;
#pragma unroll
            for (int g = 0; g < 3; ++g) {
                const int sh = 2 * g, r = s & ((1 << sh) - 1), i = s >> sh;
                const size_t p = (size_t)g * T + b * SEQ + r * (SEQ >> sh) + i;
                ls[q][g] = LSE[p * 8 + hh]; og[q][g] = *(const u32x4*)(OG + p * GW + lane * 8);
            } }
#pragma unroll
        for (int q = 0; q < 4; ++q) {
            const float m = fmaxf(ls[q][0], fmaxf(ls[q][1], ls[q][2]));
            float e[3], sum = 0.f;
#pragma unroll
            for (int g = 0; g < 3; ++g) { e[g] = __expf(ls[q][g] - m); sum += e[g]; }
            const float inv = 1.f / sum;
            f32x4 a0 = {0.f, 0.f, 0.f, 0.f}, a1 = a0;
#pragma unroll
            for (int g = 0; g < 3; ++g) { f32x4 v0, v1; unpack8(og[q][g], v0, v1); const float wg = e[g] * inv; a0 = a0 + v0 * wg; a1 = a1 + v1 * wg; }
            *(u32x4*)(O + (size_t)(t0 + q) * DAO + lane * 8) = pack8(a0, a1);
        }
    }
}

__device__ __forceinline__ void p4_conv(Frame& F) {
    constexpr int RUN = 16;
    const int gt = (F.vcu * NWAVES + F.wave) * 64 + F.lane, NGT = F.G * NWAVES * 64;
    bf16* Bb = (bf16*)((unsigned char*)F.out + OS_BB); const bf16* Z = (const bf16*)(F.ws + WS_Z); const float* cw = F.in[I_CONVW];
    for (int e = gt; e < (T / RUN) * (D / 8); e += NGT) {
        const int t0 = (e >> 7) * RUN, c8 = (e & 127) * 8, s0 = t0 & (SEQ - 1);
        const f32x4 w0a = *(const f32x4*)(cw + c8), w0b = *(const f32x4*)(cw + c8 + 4), w1a = *(const f32x4*)(cw + D + c8), w1b = *(const f32x4*)(cw + D + c8 + 4), w2a = *(const f32x4*)(cw + 2 * D + c8), w2b = *(const f32x4*)(cw + 2 * D + c8 + 4);
        const size_t off0 = (size_t)t0 * D + c8;
        f32x4 z1a = {0.f, 0.f, 0.f, 0.f}, z1b = z1a, z2a = z1a, z2b = z1a;
        if (s0 >= 2) { unpack8(*(const u32x4*)(Z + off0 - D), z1a, z1b); unpack8(*(const u32x4*)(Z + off0 - 2 * D), z2a, z2b); }
#pragma unroll 4
        for (int r = 0; r < RUN; ++r) {
            const size_t off = off0 + (size_t)r * D;
            f32x4 z0a, z0b, ba, bb;
            unpack8(*(const u32x4*)(Z + off), z0a, z0b); unpack8(*(const u32x4*)(Bb + off), ba, bb);
            const f32x4 ca = w0a * z2a + w1a * z1a + w2a * z0a, cb = w0b * z2b + w1b * z1b + w2b * z0b;
            *(u32x4*)(Bb + off) = pack8(ba * ca, bb * cb);
            z2a = z1a; z2b = z1b; z1a = z0a; z1b = z0b;
        }
    }
}
__device__ __forceinline__ void split8(const f32x4 a, const f32x4 b, bf16x8& hi, bf16x8& lo) {
    const u32x4 h = pack8(a, b); f32x4 ha, hb; unpack8(h, ha, hb);
    hi = __builtin_bit_cast(bf16x8, h); lo = __builtin_bit_cast(bf16x8, pack8(a - ha, b - hb));
}
__device__ __forceinline__ void p4_wfold(Frame& F) {
    const int gw = F.vcu * NWAVES + F.wave, NGW = F.G * NWAVES, i = F.lane & 15, g = F.lane >> 4;
    const float* Wq = F.in[I_WQ]; const float* SK = F.in[I_SUBK]; bf16* WF = (bf16*)((unsigned char*)F.out + OS_WFOLD);
    for (int it = gw; it < 1024; it += NGW) {
        const int itu = __builtin_amdgcn_readfirstlane(it);
        const int hc = itu >> 6, k0 = ((itu >> 1) & 31) * 32, nh = itu & 1;
        bf16x8 ah[2][4], al[2][4];
#pragma unroll
        for (int kt = 0; kt < 2; ++kt)
#pragma unroll
            for (int j = 0; j < 4; ++j) { const float* ap = Wq + (size_t)(k0 + 16 * kt + i) * 2048 + hc * 128 + 32 * j + 8 * g; split8(*(const f32x4*)ap, *(const f32x4*)(ap + 4), ah[kt][j], al[kt][j]); }
#pragma unroll 1
        for (int nt = 0; nt < 4; ++nt) {
            const int n0 = hc * 128 + nh * 64 + 16 * nt;
            bf16x8 bh[4], bl[4];
#pragma unroll
            for (int j = 0; j < 4; ++j) { const float* bp = SK + (size_t)(n0 + i) * 128 + 32 * j + 8 * g; split8(*(const f32x4*)bp, *(const f32x4*)(bp + 4), bh[j], bl[j]); }
#pragma unroll
            for (int kt = 0; kt < 2; ++kt) {
                f32x4 acc = {0.f, 0.f, 0.f, 0.f};
#pragma unroll
                for (int j = 0; j < 4; ++j) { acc = __builtin_amdgcn_mfma_f32_16x16x32_bf16(al[kt][j], bh[j], acc, 0, 0, 0); acc = __builtin_amdgcn_mfma_f32_16x16x32_bf16(ah[kt][j], bl[j], acc, 0, 0, 0); }
#pragma unroll
                for (int j = 0; j < 4; ++j) acc = __builtin_amdgcn_mfma_f32_16x16x32_bf16(ah[kt][j], bh[j], acc, 0, 0, 0);
                u32x2 o; o.x = pk2(acc[0], acc[1]); o.y = pk2(acc[2], acc[3]);
                *(u32x2*)(WF + (size_t)(n0 + i) * D + k0 + 16 * kt + 4 * g) = o;
            }
        }
    }
}
__device__ __forceinline__ float gelu_erf(float v) { return 0.5f * v * (1.f + erff(v * 0.70710678118654752f)); }
__device__ __forceinline__ void peer_down_phase(Frame& F) {
    const int lane = F.lane, sub = lane & 15, gq = lane >> 4;
    const int nloc = (int)F.MISC[8], nxc = (int)F.MISC[9]; const bool byx = (nxc == 8) && (nloc * 8 == F.G) && (F.xcc < 8);
    const int x = byx ? F.xcc : 0, nsh = byx ? 8 : 1, rank = byx ? F.xrank : (int)blockIdx.x, nrank = byx ? nloc : F.G;
    const unsigned char* HG8 = F.ws + WS_HG8; const float* HSC = (const float*)(F.ws + WS_HSC); const float* RSQ = (const float*)(F.ws + WS_RSQ);
    const int* IDX = (const int*)(F.ws + WS_IDX); const float* GATE = (const float*)(F.ws + WS_GATE);
    const unsigned char* dn8 = (const unsigned char*)F.out + OS_EDOWN; const float* esc = (const float*)(F.ws + WS_ESCALE); float* WB = (float*)(F.ws + WS_WB);
    LAS unsigned char* wb = F.lds + F.wave * 10752;
    LAS u32x4* h8s = (LAS u32x4*)wb; LAS float* hss = (LAS float*)(wb + 4096); LAS u32x2* ls = (LAS u32x2*)(wb + 4608); LAS float* av = (LAS float*)(wb + 8704);
    const int tstep = nrank * NWAVES * 4;
    for (int xs = x; xs < 8; xs += nsh) {
        int tb = (rank * NWAVES + F.wave) * 4;
        u32x4 ia, ib, h8[4]; f32x4 ga, gb; float hs[4], pq;
#define PD_META(tt) do { const unsigned t_ = (unsigned)((tt) + gq); const unsigned char* wsb_ = F.ws;     \
            ia = *(const u32x4*)(wsb_ + (unsigned)(WS_IDX + t_ * (HK * 4) + sub * 32)); ib = *(const u32x4*)(wsb_ + (unsigned)(WS_IDX + t_ * (HK * 4) + sub * 32 + 16)); \
            ga = *(const f32x4*)(wsb_ + (unsigned)(WS_GATE + t_ * (HK * 4) + sub * 32)); gb = *(const f32x4*)(wsb_ + (unsigned)(WS_GATE + t_ * (HK * 4) + sub * 32 + 16)); pq = *(const float*)(wsb_ + (unsigned)(WS_RSQ + t_ * 64 + sub * 4)); \
            _Pragma("unroll") for (int j_ = 0; j_ < 4; ++j_) { h8[j_] = *(const u32x4*)(wsb_ + (unsigned)(WS_HG8 + t_ * D + 16 * (sub + 16 * j_))); hs[j_] = *(const float*)(wsb_ + (unsigned)(WS_HSC + t_ * 128 + ((sub + 16 * j_) >> 1) * 4)); } } while (0)
        if (tb < T) PD_META(tb);
        for (; tb < T; tb += tstep) {
#pragma unroll
            for (int j = 0; j < 4; ++j) { h8s[gq * 64 + sub + 16 * j] = h8[j]; if ((sub & 1) == 0) hss[gq * 32 + ((sub + 16 * j) >> 1)] = hs[j]; }
            int total = 0;
#pragma unroll
            for (int k = 0; k < 8; ++k) {
                const int ei = (int)(k < 4 ? ia[k & 3] : ib[k & 3]); const float gk = (k < 4 ? ga[k & 3] : gb[k & 3]);
                const bool f = (ei >> 11) == xs;
                const unsigned long long m = __ballot(f);
                const int pos = total + (int)__builtin_amdgcn_mbcnt_hi((unsigned)(m >> 32), __builtin_amdgcn_mbcnt_lo((unsigned)m, 0u));
                if (f) { u32x2 ent; ent.x = (unsigned)ei | ((unsigned)(sub * 8 + k) << 14) | ((unsigned)gq << 21); ent.y = __builtin_bit_cast(unsigned, gk); ls[pos] = ent; }
                total += __popcll(m);
            }
            const float rq = sum16_dpp(pq);
            const float rstd = __builtin_amdgcn_rsqf(rq * (1.f / D) + RMS_EPS);
            const int tcur = tb;
            if (tb + tstep < T) PD_META(tb + tstep);
            LDS_WAIT(); asm volatile("" ::: "memory");
            const int nr = (total + 3) >> 2;
#define PD_ISSUE(R, HH, HS, r0) do { _Pragma("unroll") for (int u_ = 0; u_ < 2; ++u_) { const int k_ = 4 * ((r0) + u_) + gq; const bool v_ = k_ < total; const u32x2 e_ = ls[v_ ? k_ : 0]; const unsigned ex_ = e_.x; \
                const unsigned ro_ = (v_ ? (ex_ & 16383u) : 0u) * 1024u + 16u * (unsigned)sub; const unsigned tk_ = (ex_ >> 21) & 3u; \
                _Pragma("unroll") for (int j_ = 0; j_ < 4; ++j_) { R[u_][j_] = *(const u32x4*)(dn8 + (ro_ + 256u * j_)); HH[u_][j_] = h8s[tk_ * 64 + sub + 16 * j_]; HS[u_][j_] = hss[tk_ * 32 + ((sub + 16 * j_) >> 1)]; } } } while (0)
#define PD_COMPUTE(R, HH, HS, r0) do { _Pragma("unroll") for (int u_ = 0; u_ < 2; ++u_) { const int k_ = 4 * ((r0) + u_) + gq; float af_ = 0.f; \
                _Pragma("unroll") for (int j_ = 0; j_ < 4; ++j_) { int ac_ = 0; _Pragma("unroll") for (int q_ = 0; q_ < 4; ++q_) { const int a_ = (int)R[u_][j_][q_], b_ = (int)HH[u_][j_][q_]; ac_ = __builtin_amdgcn_sdot4(a_, b_, ac_, false); } af_ += (float)ac_ * HS[u_][j_]; } \
                af_ = sum16_dpp(af_); \
                if (k_ < total && sub == 0) av[k_] = af_; } } while (0)
            u32x4 RA[2][4], RB[2][4], HA[2][4], HB[2][4]; float SA[2][4], SB[2][4];
            if (nr > 0) {
                PD_ISSUE(RA, HA, SA, 0);
                int r = 0;
#pragma unroll 1
                for (; r + 4 < nr; r += 4) {
                    PD_ISSUE(RB, HB, SB, r + 2);
                    __builtin_amdgcn_sched_barrier(0);
                    PD_COMPUTE(RA, HA, SA, r);
                    __builtin_amdgcn_sched_barrier(0);
                    PD_ISSUE(RA, HA, SA, r + 4);
                    __builtin_amdgcn_sched_barrier(0);
                    PD_COMPUTE(RB, HB, SB, r + 2);
                    __builtin_amdgcn_sched_barrier(0);
                }
                if (r + 2 < nr) {
                    PD_ISSUE(RB, HB, SB, r + 2);
                    __builtin_amdgcn_sched_barrier(0);
                    PD_COMPUTE(RA, HA, SA, r);
                    __builtin_amdgcn_sched_barrier(0);
                    PD_COMPUTE(RB, HB, SB, r + 2);
                } else {
                    PD_COMPUTE(RA, HA, SA, r);
                }
                __builtin_amdgcn_sched_barrier(0);
            }
#undef PD_ISSUE
#undef PD_COMPUTE
            LDS_WAIT(); asm volatile("" ::: "memory");
            const float rs0 = __builtin_bit_cast(float, __builtin_amdgcn_readlane(__builtin_bit_cast(int, rstd), 0)), rs1 = __builtin_bit_cast(float, __builtin_amdgcn_readlane(__builtin_bit_cast(int, rstd), 16)),
                        rs2 = __builtin_bit_cast(float, __builtin_amdgcn_readlane(__builtin_bit_cast(int, rstd), 32)), rs3 = __builtin_bit_cast(float, __builtin_amdgcn_readlane(__builtin_bit_cast(int, rstd), 48));
            for (int i = lane; i < total; i += 64) {
                const u32x2 e = ls[i]; const unsigned ex = e.x, eg = e.y; const int tk = (int)((ex >> 21) & 3u);
                const float rs = (tk == 0) ? rs0 : ((tk == 1) ? rs1 : ((tk == 2) ? rs2 : rs3));
                const float a = av[i] * esc[ex & 16383u] * rs;
                WB[(size_t)(tcur + tk) * HK + ((ex >> 14) & 127u)] = __builtin_bit_cast(float, eg) * esc[NEXP + (ex & 16383u)] * gelu_erf(a);
            }
            LDS_WAIT(); asm volatile("" ::: "memory");
        }
#undef PD_META
    }
}
__device__ __forceinline__ void peer_up_phase(Frame& F) {
    const int lane = F.lane, g8 = lane >> 3, c = lane & 7;
    const int nloc = (int)F.MISC[8], nxc = (int)F.MISC[9]; const bool byx = (nxc == 8) && (nloc * 8 == F.G) && (F.xcc < 8);
    const int x = byx ? F.xcc : 0, nsh = byx ? 8 : 1, rank = byx ? F.xrank : (int)blockIdx.x, nrank = byx ? nloc : F.G;
    const bf16* HG = (const bf16*)(F.ws + WS_HG); const float* nffn = F.in[I_NFFN];
    float* SS = (float*)(F.ws + WS_SS); float* out = F.out;
    LAS unsigned char* wbuf = F.lds + F.wave * 16384;
    const int tstep = nrank * NWAVES * 8;
    const unsigned char* wsb = F.ws;
    for (int xs = x; xs < 8; xs += nsh) {
    const unsigned char* up8 = F.ws + WS_EUP + (size_t)xs * (2 * MiB);
    int tb = (rank * NWAVES + F.wave) * 8, it = 0;
#define PU_MOFF(tt, j) ((unsigned)(((j) < 4 ? WS_IDX : WS_WB) + (size_t)(tt) * (HK * 4) + ((j) & 3) * 1024) + (unsigned)(lane * 16))
    if (tb < T) {
        u32x4 m0[8];
#pragma unroll
        for (int j = 0; j < 8; ++j) m0[j] = *(const u32x4*)(wsb + PU_MOFF(tb, j));
#pragma unroll
        for (int j = 0; j < 8; ++j) *(LAS u32x4*)(wbuf + j * 1024 + lane * 16) = m0[j];
    }
    for (; tb < T; tb += tstep, ++it) {
        const int t = tb + g8;
        const LAS unsigned char* mi = wbuf + (it & 1) * 8192 + g8 * 512;
        LAS unsigned char* nb = wbuf + ((it + 1) & 1) * 8192 + lane * 16;
        const int tn = (tb + tstep < T) ? tb + tstep : tb;
        f32x4 oa[4];
#pragma unroll
        for (int q = 0; q < 4; ++q) oa[q] = (f32x4){0.f, 0.f, 0.f, 0.f};
#define PU_ISSUE(R, W, st) do { const u32x4 i0_ = *(const LAS u32x4*)(mi + (st) * 32), i1_ = *(const LAS u32x4*)(mi + (st) * 32 + 16); \
            const f32x4 w0_ = *(const LAS f32x4*)(mi + 4096 + (st) * 32), w1_ = *(const LAS f32x4*)(mi + 4096 + (st) * 32 + 16); \
            _Pragma("unroll") for (int k_ = 0; k_ < 8; ++k_) { const unsigned ei_ = (k_ < 4) ? i0_[k_ & 3] : i1_[k_ & 3]; W[k_] = (k_ < 4) ? w0_[k_ & 3] : w1_[k_ & 3]; \
            R[k_] = *(const u32x4*)(up8 + (ei_ * 128u + 16u * (unsigned)c)); } } while (0)
#define PU_COMPUTE(R, W) do { _Pragma("unroll") for (int k_ = 0; k_ < 8; ++k_) { _Pragma("unroll") for (int q_ = 0; q_ < 4; ++q_) { const int d_ = (int)R[k_][q_]; \
            const f32x2 lo_ = __builtin_amdgcn_cvt_pk_f32_fp8(d_, false), hi_ = __builtin_amdgcn_cvt_pk_f32_fp8(d_, true); \
            oa[q_][0] += lo_.x * W[k_]; oa[q_][1] += lo_.y * W[k_]; oa[q_][2] += hi_.x * W[k_]; oa[q_][3] += hi_.y * W[k_]; } \
            if (k_ & 1) { asm volatile("" : "+v"(oa[0]), "+v"(oa[1]), "+v"(oa[2]), "+v"(oa[3])); __builtin_amdgcn_sched_barrier(0); } } } while (0)
        u32x4 RA[8], RB[8]; float WA[8], WBk[8];
        PU_ISSUE(RA, WA, 0);
#define PU_BODY(st, j) do { const u32x4 m_ = *(const u32x4*)(wsb + PU_MOFF(tn, j)); \
            PU_ISSUE(RB, WBk, (st) + 1); __builtin_amdgcn_sched_barrier(0); PU_COMPUTE(RA, WA); __builtin_amdgcn_sched_barrier(0); \
            PU_ISSUE(RA, WA, (st) + 2); __builtin_amdgcn_sched_barrier(0); PU_COMPUTE(RB, WBk); __builtin_amdgcn_sched_barrier(0); \
            *(LAS u32x4*)(nb + (j) * 1024) = m_; __builtin_amdgcn_sched_barrier(0); } while (0)
#pragma unroll 1
        for (int st = 0; st < 14; st += 2) { const int j = st >> 1; PU_BODY(st, j); }
        unsigned hgo = (unsigned)(t * (D * 2) + 256 * xs + 32 * c);
        asm volatile("" : "+v"(hgo));
        const u32x4 m7 = *(const u32x4*)(wsb + PU_MOFF(tn, 7));
        const u32x4 hg0 = *(const u32x4*)((const unsigned char*)HG + hgo), hg1 = *(const u32x4*)((const unsigned char*)HG + (hgo + 16u));
        PU_ISSUE(RB, WBk, 15);
        __builtin_amdgcn_sched_barrier(0);
        PU_COMPUTE(RA, WA);
        __builtin_amdgcn_sched_barrier(0);
        PU_COMPUTE(RB, WBk);
        __builtin_amdgcn_sched_barrier(0);
        *(LAS u32x4*)(nb + 7 * 1024) = m7;
#undef PU_BODY
#undef PU_ISSUE
#undef PU_COMPUTE
        float ss = 0.f;
        const size_t off = (size_t)t * D + 128 * xs + 16 * c;
        f32x4 hv[4]; unpack8(hg0, hv[0], hv[1]); unpack8(hg1, hv[2], hv[3]);
#pragma unroll
        for (int q = 0; q < 4; ++q) { const f32x4 nf = *(const f32x4*)(nffn + 128 * xs + 16 * c + 4 * q); hv[q][0] /= nf[0]; hv[q][1] /= nf[1]; hv[q][2] /= nf[2]; hv[q][3] /= nf[3]; }
#pragma unroll
        for (int q = 0; q < 4; ++q) { oa[q] = oa[q] + hv[q]; ss += (oa[q][0] * oa[q][0] + oa[q][1] * oa[q][1]) + (oa[q][2] * oa[q][2] + oa[q][3] * oa[q][3]); *(f32x4*)(out + off + 4 * q) = oa[q]; }
        ss = sum8_dpp(ss);
        if (c == 0) SS[(size_t)t * 8 + xs] = ss;
    }
#undef PU_MOFF
    }
}
__device__ __forceinline__ void final_norm_phase(Frame& F) {
    const int gw = F.vcu * NWAVES + F.wave, NGW = F.G * NWAVES, lane = F.lane;
    const float* SS = (const float*)(F.ws + WS_SS); const float* fn = F.in[I_FNORM]; float* out = F.out;
    f32x4 g[4];
#pragma unroll
    for (int q = 0; q < 4; ++q) g[q] = *(const f32x4*)(fn + 4 * (lane + 64 * q));
    for (int t = gw; t < T; t += NGW) {
        const f32x4 s0 = *(const f32x4*)(SS + (size_t)t * 8), s1 = *(const f32x4*)(SS + (size_t)t * 8 + 4);
        const float r2 = __builtin_amdgcn_rsqf((((s0[0] + s0[1]) + (s0[2] + s0[3])) + ((s1[0] + s1[1]) + (s1[2] + s1[3]))) * (1.f / D) + RMS_EPS);
        f32x4* op = (f32x4*)(out + (size_t)t * D) + lane;
#pragma unroll
        for (int q = 0; q < 4; ++q) op[64 * q] = op[64 * q] * r2 * g[q];
    }
}

struct Args { const float* in[15]; float* out; unsigned char* ws; int ph_lo, ph_hi, li, pad; };
__global__ void __launch_bounds__(NWAVES * 64, 2) fwd(Args args) {
    extern __shared__ __attribute__((aligned(16))) unsigned char lds[];
    Frame F;
    F.lds = (LAS unsigned char*)lds;
    F.MISC = (volatile LAS unsigned*)(F.lds + MISC_OFF);
    F.tid = threadIdx.x; F.lane = F.tid & 63; F.wave = __builtin_amdgcn_readfirstlane(F.tid >> 6);
    F.G = gridDim.x; { const int bx = blockIdx.x; F.vcu = (F.G % 8 == 0) ? (bx % 8) * (F.G / 8) + bx / 8 : bx; }
    F.ws = args.ws; F.ctl = (gu32*)(args.ws + WS_CTL);
#pragma unroll
    for (int i = 0; i < 15; ++i) F.in[i] = args.in[i];
    F.out = args.out;
    for (int u = F.tid; u < (LDS_BYTES - RING_BYTES) / 4; u += NWAVES * 64) ((LAS unsigned*)(F.lds + RING_BYTES))[u] = 0u;
    __syncthreads();
    XcdBarrier bar; bar.bar = (unsigned*)(F.ctl + CW_BAR); bar.x = 0; bar.st = nullptr;
    if (N_LAUNCHES == 1) bar = xcd_barrier_post((unsigned*)(F.ctl + CW_BAR), F.MISC + 8);
    F.xcc = (int)xb_xcc_id();
    if (F.tid == 0) F.MISC[16] = xb_add((unsigned*)(F.ctl + CW_RANK + 64 * (F.xcc & 15)), 1u);
    __syncthreads();
    F.xrank = (int)F.MISC[16];
#define GRID_BAR() do { if (N_LAUNCHES == 1) xcd_barrier(bar); } while (0)
    const int lo = args.ph_lo, hi = args.ph_hi, bx = (int)blockIdx.x;
#define IN(k) (lo <= (k) && (k) < hi)
#define BOTH(k) (IN(k) && IN((k) + 1))
    unsigned char* ws = args.ws;

    if (IN(0)) { p0_prologue(F); if (BOTH(0)) GRID_BAR(); }

    if (IN(1)) {
        Gemm g{(const bf16*)(ws + WS_U8), (const bf16*)(ws + WS_WQKV8), T, NP1, D / 2}; QkvOrder S; S.init(T, NP1, F.G, bx); S.U = (const char*)(ws + WS_U8);
        EpiQKV E{(bf16*)(ws + WS_Q), (const float*)(ws + WS_ROPE), (const float*)(ws + WS_SU), (const float*)(ws + WS_SW), ws + WS_SGA, F.in[I_GBIAS] + D};
        gemm_phase<EpiQKV, QkvOrder, true, true, true, true>(F.lds, g, S, E);
        if (BOTH(1)) GRID_BAR();
    }
    if (IN(2)) { attn_phase(F, (bf16*)(ws + WS_Q), (float*)(ws + WS_LSE)); if (BOTH(2)) GRID_BAR(); }
    if (IN(3)) {
        { const int nwg = (T / 256) * ((NCG - 512) / 256), rem = nwg % F.G;
          if (rem == 0) combine_phase(F, F.vcu, F.G); else if (bx >= rem) combine_phase(F, bx - rem, F.G - rem); }
        Gemm g{(const bf16*)(ws + WS_U8), (const bf16*)(ws + WS_WQKV8 + (size_t)NP1 * D), T, NCG - 512, D / 2}; StaticOrder S; S.init(T, NCG - 512, F.G, bx);
        EpiCG E{(bf16*)((unsigned char*)F.out + OS_BB), (bf16*)(ws + WS_Z), ws + WS_SGC, ws + WS_SGA, F.in[I_GBIAS], (const float*)(ws + WS_SU), (const float*)(ws + WS_SW)};
        gemm_phase<EpiCG, StaticOrder, true, true, false, true>(F.lds, g, S, E);
        if (BOTH(3)) GRID_BAR();
    }
    if (IN(4)) { p4_wfold(F); p4_conv(F); if (BOTH(4)) GRID_BAR(); }
    if (IN(5)) {
        Gemm gc{(const bf16*)((unsigned char*)F.out + OS_BB), (const bf16*)(ws + WS_WCONV), T, D, D}, ga{(const bf16*)(ws + WS_O), (const bf16*)(ws + WS_WATTN), T, D, DAO};
        StaticOrder S; S.init(T, D, F.G, bx);
        if ((bx & 8) == 0) {
            { EpiY<0> E{(bf16*)(ws + WS_Y), ws + WS_SGC}; gemm_phase<EpiY<0>, StaticOrder, true, true>(F.lds, gc, S, E); }
            { EpiY<1> E{(bf16*)(ws + WS_Y), ws + WS_SGA}; gemm_phase<EpiY<1>, StaticOrder, true, true>(F.lds, ga, S, E); }
        } else {
            { EpiY<0> E{(bf16*)(ws + WS_Y), ws + WS_SGA}; gemm_phase<EpiY<0>, StaticOrder, true, true>(F.lds, ga, S, E); }
            { EpiY<1> E{(bf16*)(ws + WS_Y), ws + WS_SGC}; gemm_phase<EpiY<1>, StaticOrder, true, true>(F.lds, gc, S, E); }
        }
        if (BOTH(5)) GRID_BAR();
    }
    if (IN(6)) {
        Gemm g{(const bf16*)(ws + WS_Y), (const bf16*)(ws + WS_WOUT), T, D, D}; StaticOrder S; S.init(T, D, F.G, bx);
        EpiOut E{F.in[I_X], (bf16*)(ws + WS_HG), F.in[I_NFFN], (float*)(ws + WS_RSQ), ws + WS_HG8, (float*)(ws + WS_HSC)};
        gemm_phase<EpiOut, StaticOrder, true, true>(F.lds, g, S, E);

        if (BOTH(6)) GRID_BAR();
    }
    if (IN(7)) {
        Gemm g{(const bf16*)(ws + WS_HG), (const bf16*)((unsigned char*)F.out + OS_WFOLD), T, 2048, D}; StaticOrder S; S.init(T, 2048, F.G, bx);
        float* scr = (float*)(ws + (bx < 128 ? WS_SCR0 + (size_t)bx * 262144 : (bx < 192 ? WS_SCR1 + (size_t)(bx - 128) * 262144 : WS_SCR2 + (size_t)(bx - 192) * 262144)));
        EpiTopk E{scr, (const float*)(ws + WS_RSQ), (int*)(ws + WS_IDX), (float*)(ws + WS_GATE),
                  CvCtx{F.in[I_DOWN], F.in[I_UP], (unsigned char*)F.out + OS_EDOWN, ws + WS_EUP, (float*)(ws + WS_ESCALE), F.lane}, F.vcu * NWAVES + F.wave, F.G * NWAVES};
        if ((bx & 8) != 0) { cv_rows(E.CV, E.cvr, E.cvstep); E.cvr = 2 * NEXP; }
        const int cvkeep = E.cvr; E.cvr = 2 * NEXP;
        gemm_phase<EpiTopk, StaticOrder, true, true>(F.lds, g, S, E);
        E.cvr = cvkeep;
        cv_rows(E.CV, E.cvr, E.cvstep);
        if (BOTH(7)) GRID_BAR();
    }
    if (IN(8)) { peer_down_phase(F); if (BOTH(8)) GRID_BAR(); }
    if (IN(9)) { peer_up_phase(F); if (BOTH(9)) GRID_BAR(); }
    if (IN(10)) { final_norm_phase(F); }
#undef IN
#undef BOTH
}

extern "C" void kernel_launch(void* const* d_in, const int* in_sizes, int n_in, void* d_out, int out_size, void* d_ws, size_t ws_size, hipStream_t stream) {
    static int grid = 0;
    if (grid == 0) {
        if (n_in != 15 || out_size != T * D || ws_size < WS_END) { fprintf(stderr, "kernel_launch: unexpected shapes (n_in %d, out %d, ws %zu)\n", n_in, out_size, ws_size); grid = -1; return; }
        int dev = 0, cus = 0, per_cu = 0;
        if (hipGetDevice(&dev) != hipSuccess || hipDeviceGetAttribute(&cus, hipDeviceAttributeMultiprocessorCount, dev) != hipSuccess) { grid = -1; return; }
        if (hipFuncSetAttribute((const void*)fwd, hipFuncAttributeMaxDynamicSharedMemorySize, LDS_BYTES) != hipSuccess) { fprintf(stderr, "kernel_launch: hipFuncSetAttribute failed\n"); grid = -1; return; }
        if (hipOccupancyMaxActiveBlocksPerMultiprocessor(&per_cu, (const void*)fwd, NWAVES * 64, LDS_BYTES) != hipSuccess || per_cu < 1) fprintf(stderr, "kernel_launch: occupancy query reports %d\n", per_cu);
        (void)hipGetLastError();
        grid = cus > 256 ? 256 : cus;
    }
    if (grid < 0) return;
    if (hipMemsetAsync((char*)d_ws + WS_CTL, 0, CTL_ZERO_BYTES, stream) != hipSuccess) return;
    Args a{};
    for (int i = 0; i < 15; ++i) a.in[i] = (const float*)d_in[i];
    a.out = (float*)d_out; a.ws = (unsigned char*)d_ws;
    for (int li = 0; li < N_LAUNCHES; ++li) {
        a.ph_lo = (N_LAUNCHES == 1) ? 0 : li; a.ph_hi = (N_LAUNCHES == 1) ? N_PHASES : li + 1; a.li = li; a.pad = 0;
        hipLaunchKernelGGL(fwd, dim3(grid), dim3(NWAVES * 64), LDS_BYTES, stream, a);
    }
}
```

```cpp
#include <hip/hip_runtime.h>
#include <cstdio>
#include <cstdint>
namespace pg8 {
#define PG8_LAS __attribute__((address_space(3)))
typedef unsigned short bf16_t;
typedef short bf16x8 __attribute__((ext_vector_type(8)));
typedef float f32x4 __attribute__((ext_vector_type(4)));
typedef unsigned u32x4 __attribute__((ext_vector_type(4)));
typedef int v4i32_t __attribute__((ext_vector_type(4)));
typedef int v8i32_t __attribute__((ext_vector_type(8)));
constexpr int BM = 256, BK = 64, HALF = 128, HTB = HALF * BK * 2  , STAGE_BYTES = 8 * HTB, NXCD = 8, WGM = 8;

__host__ __device__ __forceinline__ int lds_byte(int r, int c) { const int st = (r >> 4) * 2 + (c >> 5), rr = r & 15, cc = c & 31, ob = rr * 64 + cc * 2; return st * 1024 + (ob ^ (((ob >> 9) & 1) << 5)); }
__host__ __device__ __forceinline__ void stage_rc(int b, int& R, int& C) { const int st = b / 1024, sb = b % 1024, swz = sb ^ (((sb >> 9) & 1) << 5); R = (st >> 1) * 16 + swz / 64; C = (st & 1) * 32 + (swz % 64) / 2; }
__host__ __device__ __forceinline__ int perm32(int rho) { const int n = rho >> 4, i = rho & 15; return 8 * (i >> 2) + 4 * n + (i & 3); }

struct Unit { int pm, pn; };
struct Gemm { const bf16_t* A; const bf16_t* Bt; int M, N, K; };

struct StaticOrder {
    int nM, nN, nwg, G, c;
    __host__ __device__ void init(int M, int N, int G_, int c_) { nM = M / BM; nN = N / BM; nwg = nM * nN; G = G_; c = c_; }
    __host__ __device__ bool next(int i, Unit& u) const {
        const long L = (long)i * G + c; if (L >= nwg) return false;
        int wgid = (int)L; { const int q = nwg / NXCD, r = nwg % NXCD, xcd = wgid % NXCD, off = wgid / NXCD; wgid = (xcd < r ? xcd * (q + 1) : r * (q + 1) + (xcd - r) * q) + off; }
        const int nig = WGM * nN, gid = wgid / nig, fm = gid * WGM, gsz = (nM - fm) < WGM ? (nM - fm) : WGM;
        u.pm = fm + ((wgid % nig) % gsz); u.pn = (wgid % nig) / gsz; return true;
    }
    __device__ __forceinline__ void a_ready(const Unit&) const {}
    __device__ __forceinline__ void done(const Unit&) const {}
};

__device__ __forceinline__ unsigned cvt_pk_bf16(float lo, float hi) { unsigned r; asm volatile("v_cvt_pk_bf16_f32 %0, %1, %2" : "=v"(r) : "v"(lo), "v"(hi)); return r; }
typedef float f32x2 __attribute__((ext_vector_type(2)));

template <class Epi, class Sched, bool ALIGN_EPI = false, bool SP2 = false, bool STRIDED_A = false, bool I8 = false>
__device__ __forceinline__ void gemm_phase(PG8_LAS unsigned char* lds, const Gemm g, const Sched& S, const Epi& E) {
    const int tid = threadIdx.x, wid = __builtin_amdgcn_readfirstlane(tid >> 6), lane = tid & 63, wr = wid >> 2, wc = wid & 3, fr = lane & 15, fq = lane >> 4;
    const int K = g.K; int nt = K / BK;
    if constexpr (I8) asm volatile("" : "+s"(nt));
    unsigned voffA[2], voffB[2];
#pragma unroll
    for (int i = 0; i < 2; ++i) { int R, C; stage_rc(tid * 16 + i * 8192, R, C); const int Rb = Epi::PERM ? ((R & ~31) + perm32(R & 31)) : R;
        voffA[i] = (unsigned)(R * K + C) * 2u; voffB[i] = (unsigned)(Rb * K + C) * 2u; }
    unsigned rkA = 0, c2A = 0; const unsigned rk64 = 64u * (unsigned)K * 2u;
    if constexpr (STRIDED_A) { int R, C; stage_rc(tid * 16, R, C); rkA = (unsigned)(R * K) * 2u; c2A = (unsigned)C * 2u; }
    const size_t kstep = (size_t)(BK * 2);
    const size_t hstep = (size_t)HALF * K * 2;
    const size_t tstep = 2 * hstep;
    const unsigned ldsw = (unsigned)wid * 1024u;
    const int aoff = lds_byte(wr * 64 + fr, fq * 8), boff = lds_byte(wc * 32 + fr, fq * 8);
#define PG8_SA(b, h) (((b) * 2 + (h)) * HTB)
#define PG8_SB(b, h) ((4 + (b) * 2 + (h)) * HTB)
#define PG8_STAGE(bufoff, gbase, voff) do { _Pragma("unroll") for (int _i = 0; _i < 2; ++_i) \
        __builtin_amdgcn_global_load_lds((const unsigned*)((const char*)(gbase) + (voff)[_i]), (PG8_LAS unsigned*)(lds + (bufoff) + ldsw + _i * 8192), 16, 0, 0); } while (0)
#define PG8_STAGE_A(bufoff, gbase, sh) do { if constexpr (STRIDED_A) { _Pragma("unroll") for (int _i = 0; _i < 2; ++_i) { const unsigned _vo = ((rkA + _i * rk64) << (sh)) + c2A; \
        __builtin_amdgcn_global_load_lds((const unsigned*)((const char*)(gbase) + _vo), (PG8_LAS unsigned*)(lds + (bufoff) + ldsw + _i * 8192), 16, 0, 0); } } else { PG8_STAGE(bufoff, gbase, voffA); } } while (0)
#define PG8_LDA(dst, b, h) do { _Pragma("unroll") for (int m = 0; m < 4; ++m) _Pragma("unroll") for (int k = 0; k < 2; ++k) dst[m][k] = *(const PG8_LAS bf16x8*)(lds + PG8_SA(b, h) + aoff + m * 2048 + k * 1024); } while (0)
#define PG8_LDB(dst, b, h) do { _Pragma("unroll") for (int n = 0; n < 2; ++n) _Pragma("unroll") for (int k = 0; k < 2; ++k) dst[n][k] = *(const PG8_LAS bf16x8*)(lds + PG8_SB(b, h) + boff + n * 2048 + k * 1024); } while (0)
#define PG8_MMA(ai, bj, At, Bt) do { __builtin_amdgcn_s_setprio(1); _Pragma("unroll") for (int m = 0; m < 4; ++m) _Pragma("unroll") for (int n = 0; n < 2; ++n) _Pragma("unroll") for (int k = 0; k < 2; ++k) \
        { if constexpr (I8) acc[ai][bj][m][n] = __builtin_bit_cast(f32x4, __builtin_amdgcn_mfma_i32_16x16x64_i8(__builtin_bit_cast(v4i32_t, Bt[n][k]), __builtin_bit_cast(v4i32_t, At[m][k]), __builtin_bit_cast(v4i32_t, acc[ai][bj][m][n]), 0, 0, 0)); \
          else acc[ai][bj][m][n] = __builtin_amdgcn_mfma_f32_16x16x32_bf16(Bt[n][k], At[m][k], acc[ai][bj][m][n], 0, 0, 0); } __builtin_amdgcn_s_setprio(0); } while (0)
#define PG8_WAIT_V(n) asm volatile("s_waitcnt vmcnt(" #n ")" ::: "memory")
#define PG8_WAIT_L(n) asm volatile("s_waitcnt lgkmcnt(" #n ")" ::: "memory")
#define PG8_BAR __builtin_amdgcn_s_barrier()
#define PG8_SCHED __builtin_amdgcn_sched_barrier(0)
    Unit cur, nxt; int ui = 0;
    if (!S.next(0, cur)) return;
    f32x4 acc[2][2][4][2];
#pragma unroll
    for (int a = 0; a < 2; ++a)
#pragma unroll
        for (int b = 0; b < 2; ++b)
#pragma unroll
            for (int m = 0; m < 4; ++m)
#pragma unroll
                for (int n = 0; n < 2; ++n) acc[a][b][m][n] = (f32x4){0.f, 0.f, 0.f, 0.f};
    bf16x8 At[4][2], B0[2][2], B1[2][2];
    int csh = 0, nsh = 0;
    const char* cA; if constexpr (STRIDED_A) cA = S.a_base(cur, csh); else cA = (const char*)g.A + (size_t)cur.pm * tstep;
    const char* cB = (const char*)g.Bt + (size_t)cur.pn * tstep;
    S.a_ready(cur);
    if constexpr (SP2) {
        PG8_STAGE(PG8_SB(0, 0), cB, voffB); PG8_STAGE(PG8_SB(0, 1), cB + hstep, voffB); PG8_STAGE_A(PG8_SA(0, 0), cA, csh); PG8_STAGE_A(PG8_SA(0, 1), cA + (hstep << csh), csh);
        if (wr == 1) PG8_BAR;
        PG8_WAIT_V(2); PG8_BAR;
        PG8_STAGE(PG8_SB(1, 0), cB + kstep, voffB); PG8_STAGE_A(PG8_SA(1, 0), cA + kstep, csh); PG8_STAGE(PG8_SB(1, 1), cB + hstep + kstep, voffB);
        PG8_WAIT_V(6); PG8_BAR;
    } else {
        PG8_STAGE(PG8_SB(0, 0), cB, voffB); PG8_STAGE_A(PG8_SA(0, 0), cA, csh); PG8_STAGE(PG8_SB(0, 1), cB + hstep, voffB); PG8_STAGE_A(PG8_SA(0, 1), cA + (hstep << csh), csh);
        if (wr == 1) PG8_BAR;
        PG8_WAIT_V(4); PG8_BAR;
        PG8_STAGE(PG8_SB(1, 0), cB + kstep, voffB); PG8_STAGE_A(PG8_SA(1, 0), cA + kstep, csh); PG8_STAGE(PG8_SB(1, 1), cB + hstep + kstep, voffB);
        PG8_WAIT_V(6); PG8_BAR;
    }
    asm volatile(".p2align 8" ::: "memory");
    for (;;) {
        const bool has_next = S.next(ui + 1, nxt);
        const char* nA; if constexpr (STRIDED_A) { nsh = csh; nA = has_next ? S.a_base(nxt, nsh) : cA; } else nA = has_next ? (const char*)g.A + (size_t)nxt.pm * tstep : cA;
        const char* nB = has_next ? (const char*)g.Bt + (size_t)nxt.pn * tstep : cB;
        for (int t = 0; t < nt; t += 2) {
            const bool last = (t == nt - 2);
            const char* a1 = cA + (size_t)(t + 1) * kstep;
            const char* a2 = last ? nA : cA + (size_t)(t + 2) * kstep; const char* b2 = last ? nB : cB + (size_t)(t + 2) * kstep;
            const char* a3 = a2 + kstep; const char* b3 = b2 + kstep;
            const int sh2 = last ? nsh : csh; const size_t hA1 = hstep << csh, hA2 = hstep << sh2;
            if (last && has_next) S.a_ready(nxt);
            if constexpr (SP2) {
            PG8_LDB(B0, 0, 0); PG8_LDB(B1, 0, 1); PG8_SCHED; PG8_LDA(At, 0, 0); PG8_STAGE_A(PG8_SA(1, 1), a1 + hA1, csh);
            PG8_WAIT_V(8); PG8_WAIT_L(0); PG8_BAR; PG8_MMA(0, 0, At, B0); PG8_MMA(0, 1, At, B1); PG8_BAR; PG8_SCHED;
            PG8_LDA(At, 0, 1); PG8_STAGE(PG8_SB(0, 0), b2, voffB); PG8_STAGE(PG8_SB(0, 1), b2 + hstep, voffB); PG8_STAGE_A(PG8_SA(0, 0), a2, sh2);
            PG8_WAIT_V(8); PG8_WAIT_L(0); PG8_BAR; PG8_MMA(1, 0, At, B0); PG8_MMA(1, 1, At, B1); PG8_BAR; PG8_SCHED;
            PG8_LDB(B0, 1, 0); PG8_LDB(B1, 1, 1); PG8_SCHED; PG8_LDA(At, 1, 0); PG8_STAGE_A(PG8_SA(0, 1), a2 + hA2, sh2);
            PG8_WAIT_V(8); PG8_WAIT_L(0); PG8_BAR; PG8_MMA(0, 0, At, B0); PG8_MMA(0, 1, At, B1); PG8_BAR; PG8_SCHED;
            PG8_LDA(At, 1, 1); PG8_STAGE(PG8_SB(1, 0), b3, voffB); PG8_STAGE(PG8_SB(1, 1), b3 + hstep, voffB); PG8_STAGE_A(PG8_SA(1, 0), a3, sh2);
            PG8_WAIT_V(8); PG8_WAIT_L(0); PG8_BAR; PG8_MMA(1, 0, At, B0); PG8_MMA(1, 1, At, B1); PG8_BAR; PG8_SCHED;
            } else {
            PG8_LDB(B0, 0, 0); PG8_SCHED; PG8_LDA(At, 0, 0); PG8_STAGE_A(PG8_SA(1, 1), a1 + hA1, csh);
            PG8_WAIT_L(8); PG8_BAR; PG8_WAIT_L(0); PG8_MMA(0, 0, At, B0); PG8_BAR; PG8_SCHED;
            PG8_LDB(B1, 0, 1); PG8_STAGE(PG8_SB(0, 0), b2, voffB);
            PG8_BAR; PG8_WAIT_L(0); PG8_MMA(0, 1, At, B1); PG8_BAR;
            PG8_LDA(At, 0, 1); PG8_STAGE_A(PG8_SA(0, 0), a2, sh2);
            PG8_BAR; PG8_WAIT_L(0); PG8_MMA(1, 0, At, B0); PG8_BAR; PG8_SCHED;
            PG8_STAGE(PG8_SB(0, 1), b2 + hstep, voffB);
            PG8_WAIT_V(6); PG8_BAR; PG8_MMA(1, 1, At, B1); PG8_BAR;
            PG8_LDB(B0, 1, 0); PG8_SCHED; PG8_LDA(At, 1, 0); PG8_STAGE_A(PG8_SA(0, 1), a2 + hA2, sh2);
            PG8_WAIT_L(8); PG8_BAR; PG8_WAIT_L(0); PG8_MMA(0, 0, At, B0); PG8_BAR; PG8_SCHED;
            PG8_LDB(B1, 1, 1); PG8_STAGE(PG8_SB(1, 0), b3, voffB);
            PG8_BAR; PG8_WAIT_L(0); PG8_MMA(0, 1, At, B1); PG8_BAR;
            PG8_LDA(At, 1, 1); PG8_STAGE_A(PG8_SA(1, 0), a3, sh2);
            PG8_BAR; PG8_WAIT_L(0); PG8_MMA(1, 0, At, B0); PG8_BAR; PG8_SCHED;
            PG8_STAGE(PG8_SB(1, 1), b3 + hstep, voffB);
            PG8_WAIT_V(6); PG8_BAR; PG8_MMA(1, 1, At, B1); PG8_BAR;
            }
        }
        if constexpr (ALIGN_EPI) { if (wr == 0) PG8_BAR; }
        if constexpr (I8) {
#pragma unroll
            for (int a = 0; a < 2; ++a)
#pragma unroll
                for (int b = 0; b < 2; ++b)
#pragma unroll
                    for (int m = 0; m < 4; ++m)
#pragma unroll
                        for (int n = 0; n < 2; ++n) { const v4i32_t iv = __builtin_bit_cast(v4i32_t, acc[a][b][m][n]); acc[a][b][m][n] = (f32x4){(float)iv[0], (float)iv[1], (float)iv[2], (float)iv[3]}; }
        }
        if constexpr (!Epi::AFTER_DRAIN) { E(acc, cur, wr, wc, fr, fq); S.done(cur); }
        if (!has_next) break;
#pragma unroll
        for (int a = 0; a < 2; ++a)
#pragma unroll
            for (int b = 0; b < 2; ++b)
#pragma unroll
                for (int m = 0; m < 4; ++m)
#pragma unroll
                    for (int n = 0; n < 2; ++n) acc[a][b][m][n] = (f32x4){0.f, 0.f, 0.f, 0.f};
        cur = nxt; cA = nA; cB = nB; csh = nsh; ++ui;
        if constexpr (ALIGN_EPI) { if (wr == 1) PG8_BAR; }
    }
    PG8_WAIT_V(0);
    if constexpr (!ALIGN_EPI) { if (wr == 0) PG8_BAR; }
    PG8_BAR;
    if constexpr (Epi::AFTER_DRAIN) { E.fused(acc, cur, wr, wc, fr, fq, lds, wid, lane); S.done(cur); }
#undef PG8_SA
#undef PG8_SB
#undef PG8_STAGE
#undef PG8_STAGE_A
#undef PG8_LDA
#undef PG8_LDB
#undef PG8_MMA
#undef PG8_WAIT_V
#undef PG8_WAIT_L
#undef PG8_BAR
#undef PG8_SCHED
}
}

#define GAS __attribute__((address_space(1)))
#define LAS __attribute__((address_space(3)))
typedef unsigned short bf16;
typedef unsigned v4u __attribute__((ext_vector_type(4)));
typedef float f32x4 __attribute__((ext_vector_type(4)));
typedef short bf16x8 __attribute__((ext_vector_type(8)));
typedef GAS unsigned gu32;
typedef GAS unsigned long long gu64;
#define RLX_AGENT __ATOMIC_RELAXED, __HIP_MEMORY_SCOPE_AGENT
#define LDS_WAIT() asm volatile("s_waitcnt lgkmcnt(0)" ::: "memory")
#define VM_WAIT() asm volatile("s_waitcnt vmcnt(0)" ::: "memory")
__device__ __forceinline__ unsigned long long rt() { return __builtin_amdgcn_s_memrealtime(); }
__device__ __forceinline__ unsigned f2bf(float f) { unsigned u = __builtin_bit_cast(unsigned, f); return (u + 0x7fffu + ((u >> 16) & 1u)) >> 16; }
__device__ __forceinline__ unsigned pk2(float lo, float hi) { return f2bf(lo) | (f2bf(hi) << 16); }

#define XB_TMO      128
#define XB_XCNT(j)  (256  + 64 * (j))
#define XB_XSUB(j)  (1280 + 64 * (j))
#define XB_XGEN(j)  (2304 + 64 * (j))
#define XB_TOP      3328
#define XB_TOPGEN   3392
#define XCD_BAR_WORDS 3456
#define XB_SPIN_CAP (1u << 18)

__device__ __forceinline__ unsigned xb_ld(unsigned* p)              { return __hip_atomic_load(p, __ATOMIC_RELAXED, __HIP_MEMORY_SCOPE_AGENT); }
__device__ __forceinline__ unsigned xb_add(unsigned* p, unsigned v) { return __hip_atomic_fetch_add(p, v, __ATOMIC_RELAXED, __HIP_MEMORY_SCOPE_AGENT); }
__device__ __forceinline__ unsigned xb_xcc_id() { return (unsigned)__builtin_amdgcn_s_getreg((3 << 11) | 20) & 0xFu; }
#define XB_SPIN(cond, bar) do { unsigned _sp = 0; while (cond) { __builtin_amdgcn_s_sleep(1); \
    if ((++_sp & 255u) == 0u) { if (xb_ld(&(bar)[XB_TMO])) break; if (_sp > XB_SPIN_CAP) { atomicAdd(&(bar)[XB_TMO], 1u); break; } } } } while (0)

struct XcdBarrier {
    unsigned* bar; unsigned x;
    volatile LAS unsigned* st;
};

__device__ __forceinline__ XcdBarrier xcd_barrier_post(unsigned* bar, volatile LAS unsigned* st) {
    XcdBarrier b; b.bar = bar; b.x = xb_xcc_id(); b.st = st;
    if (threadIdx.x == 0) (void)xb_add(&bar[XB_XCNT(b.x)], 1u);
    return b;
}
__device__ __forceinline__ void xcd_barrier_complete(unsigned* bar, unsigned x, unsigned& nloc, unsigned& nx) {
    const unsigned G = gridDim.x * gridDim.y * gridDim.z;
    unsigned sum, cnt, mine, sp = 0u;
    for (;;) {
        sum = 0u; cnt = 0u; mine = 0u;
#pragma unroll
        for (unsigned j = 0; j < 16; ++j) { const unsigned c = xb_ld(&bar[XB_XCNT(j)]); sum += c; cnt += (c > 0u) ? 1u : 0u; mine = (j == x) ? c : mine; }
        if (sum == G) break;
        __builtin_amdgcn_s_sleep(1);
        if ((++sp & 255u) == 0u) { if (xb_ld(&bar[XB_TMO])) break; if (sp > XB_SPIN_CAP) { atomicAdd(&bar[XB_TMO], 1u); break; } }
    }
    nloc = mine > 0u ? mine : 1u; nx = cnt > 0u ? cnt : 1u;
}

__device__ __forceinline__ void xcd_barrier(const XcdBarrier& b) {
    asm volatile("s_waitcnt vmcnt(0)" ::: "memory");
    __syncthreads();
    if (threadIdx.x == 0) {
        unsigned* bar = b.bar;
        __builtin_amdgcn_s_waitcnt(0);
        unsigned nloc = b.st[0], nx = b.st[1];
        if (nloc == 0u) { xcd_barrier_complete(bar, b.x, nloc, nx); b.st[0] = nloc; b.st[1] = nx; }
        const unsigned old = xb_add(&bar[XB_XSUB(b.x)], 1u);
        const unsigned gen = old / nloc;
        if (old + 1u == (gen + 1u) * nloc) {
            __builtin_amdgcn_fence(__ATOMIC_RELEASE, "agent");
            asm volatile("s_waitcnt vmcnt(0)" ::: "memory");
            const unsigned og = xb_add(&bar[XB_TOP], 1u);
            const unsigned tg = og / nx;
            if (og + 1u == (tg + 1u) * nx) xb_add(&bar[XB_TOPGEN], 1u);
            else XB_SPIN(xb_ld(&bar[XB_TOPGEN]) == tg, bar);
            __builtin_amdgcn_fence(__ATOMIC_ACQUIRE, "agent");
            xb_add(&bar[XB_XGEN(b.x)], 1u);
            asm volatile("s_waitcnt vmcnt(0)" ::: "memory");
        } else {
            XB_SPIN(xb_ld(&bar[XB_XGEN(b.x)]) == gen, bar);
            __builtin_amdgcn_fence(__ATOMIC_ACQUIRE, "agent");
            asm volatile("s_waitcnt vmcnt(0)" ::: "memory");
        }
    }
    __syncthreads();
}


constexpr int NWAVES = 8;
#ifndef MK_N_LAUNCHES
#define MK_N_LAUNCHES 1
#endif
constexpr int N_PHASES = 11;
constexpr int N_LAUNCHES = MK_N_LAUNCHES;
constexpr int BATCH = 2, SEQ = 8192, T = BATCH * SEQ, D = 1024;
constexpr int DIN = 9728, NQKV = 4608, NCG = 5120, GW = 512, DAO = 512;
constexpr int NP1 = NQKV + 512;
constexpr int NEXP = 16384, PEER_H = 8, PEER_K = 16, HK = 128;
constexpr float RMS_EPS = 1e-6f;
constexpr float C2 = 0.125f * 1.4426950408889634f;
constexpr float LN2 = 0.6931471805599453f;

constexpr size_t MiB = 1u << 20;
constexpr size_t WS_CTL = 0, CTL_ZERO_BYTES = 64 * 1024;
constexpr size_t WS_ROPE = 1 * MiB, WS_RSQ = 2 * MiB, WS_LSE = 3 * MiB;
constexpr size_t WS_U8 = 24 * MiB, WS_WQKV8 = 5 * MiB, WS_SU = 15 * MiB, WS_SW = 15 * MiB + 65536;
constexpr size_t WS_Q = 56 * MiB, WS_K = 104 * MiB, WS_V = 152 * MiB, WS_O = 200 * MiB;
constexpr size_t WS_Z = 136 * MiB, WS_SGC = 168 * MiB, WS_SGA = 216 * MiB;
constexpr size_t OS_BB = 0, OS_EDOWN = 32 * MiB, OS_WFOLD = 48 * MiB;
constexpr size_t WS_WCONV = 248 * MiB, WS_WATTN = 250 * MiB, WS_WOUT = 251 * MiB;
constexpr size_t WS_EUP = 104 * MiB, WS_ESCALE = 253 * MiB;
constexpr size_t WS_Y = 136 * MiB, WS_H = 168 * MiB, WS_HG = 24 * MiB;
constexpr size_t WS_IDX = 9 * MiB, WS_GATE = 120 * MiB, WS_WB = 56 * MiB, WS_SS = 64 * MiB, WS_HG8 = 65 * MiB, WS_HSC = 81 * MiB;
constexpr size_t WS_SCR0 = 136 * MiB, WS_SCR1 = 88 * MiB, WS_SCR2 = 232 * MiB;
constexpr size_t WS_END = 256 * MiB;
constexpr int CW_TMO = 0, CW_BAR = 1024, CW_RANK = 8192;

constexpr int RING_BYTES = 131072, MISC_OFF = RING_BYTES + 320, LDS_BYTES = 147456;

using pg8::Unit; using pg8::Gemm; using pg8::StaticOrder; using pg8::gemm_phase; using pg8::cvt_pk_bf16;
typedef unsigned short bf16;
typedef unsigned u32x4 __attribute__((ext_vector_type(4)));
typedef unsigned u32x2 __attribute__((ext_vector_type(2)));
typedef float f32x4 __attribute__((ext_vector_type(4)));
typedef float f32x2 __attribute__((ext_vector_type(2)));
typedef short bf16x8 __attribute__((ext_vector_type(8)));
typedef short s16x4 __attribute__((ext_vector_type(4)));
typedef short v4i16_t __attribute__((ext_vector_type(4)));
#define LAS __attribute__((address_space(3)))

__device__ __forceinline__ float bf_lo(unsigned w) { return __builtin_bit_cast(float, w << 16); }
__device__ __forceinline__ float bf_hi(unsigned w) { return __builtin_bit_cast(float, w & 0xffff0000u); }
__device__ __forceinline__ u32x4 pack8(f32x4 a, f32x4 b) { u32x4 w; w.x = cvt_pk_bf16(a[0], a[1]); w.y = cvt_pk_bf16(a[2], a[3]); w.z = cvt_pk_bf16(b[0], b[1]); w.w = cvt_pk_bf16(b[2], b[3]); return w; }
__device__ __forceinline__ void unpack8(u32x4 w, f32x4& a, f32x4& b) { a = (f32x4){bf_lo(w.x), bf_hi(w.x), bf_lo(w.y), bf_hi(w.y)}; b = (f32x4){bf_lo(w.z), bf_hi(w.z), bf_lo(w.w), bf_hi(w.w)}; }
template <int CTRL> __device__ __forceinline__ float dppf(float v) { const int x = __builtin_bit_cast(int, v); return __builtin_bit_cast(float, __builtin_amdgcn_update_dpp(x, x, CTRL, 0xf, 0xf, true)); }
__device__ __forceinline__ float sum4_dpp(float v) { v += dppf<0xB1>(v); v += dppf<0x4E>(v); return v; }
__device__ __forceinline__ float sum8_dpp(float v) { v = sum4_dpp(v); v += dppf<0x141>(v); return v; }
__device__ __forceinline__ float sum16_dpp(float v) { v = sum8_dpp(v); v += dppf<0x140>(v); return v; }
__device__ __forceinline__ float max16_dpp(float v) { v = fmaxf(v, dppf<0xB1>(v)); v = fmaxf(v, dppf<0x4E>(v)); v = fmaxf(v, dppf<0x141>(v)); v = fmaxf(v, dppf<0x140>(v)); return v; }
__device__ __forceinline__ float rl_(float v, int l) { return __builtin_bit_cast(float, __builtin_amdgcn_readlane(__builtin_bit_cast(int, v), l)); }
__device__ __forceinline__ float wave_sum(float v) { v = sum16_dpp(v); return (rl_(v, 0) + rl_(v, 16)) + (rl_(v, 32) + rl_(v, 48)); }
__device__ __forceinline__ float wave_max(float v) { v = max16_dpp(v); return fmaxf(fmaxf(rl_(v, 0), rl_(v, 16)), fmaxf(rl_(v, 32), rl_(v, 48))); }
__device__ __forceinline__ unsigned pack4i8(f32x4 v) { const int a = (int)__builtin_rintf(v[0]), b = (int)__builtin_rintf(v[1]), c = (int)__builtin_rintf(v[2]), d = (int)__builtin_rintf(v[3]); return (unsigned)(a & 255) | ((unsigned)(b & 255) << 8) | ((unsigned)(c & 255) << 16) | ((unsigned)d << 24); }
__device__ __forceinline__ f32x4 unpack4u8(unsigned w) { return (f32x4){(float)(w & 255u), (float)((w >> 8) & 255u), (float)((w >> 16) & 255u), (float)(w >> 24)} * (1.f / 255.f); }
__device__ __forceinline__ float xor16(float v, int fq) {
    const unsigned x = __builtin_bit_cast(unsigned, v);
    const auto r = __builtin_amdgcn_permlane16_swap(x, x, false, false);
    const unsigned a = r[0], b = r[1];
    return __builtin_bit_cast(float, (fq & 1) ? a : b);
}
__device__ __forceinline__ float xor32(float v, int fq) {
    const unsigned x = __builtin_bit_cast(unsigned, v);
    const auto r = __builtin_amdgcn_permlane32_swap(x, x, false, false);
    const unsigned a = r[0], b = r[1];
    return __builtin_bit_cast(float, (fq & 2) ? a : b);
}
__device__ __forceinline__ float sigmoidf_(float x) { return 1.f / (1.f + __expf(-x)); }

struct QkvOrder : StaticOrder {
    const char* U;
    __device__ __forceinline__ const char* a_base(const Unit& u, int& sh) const {
        const int g = (u.pn < 18) ? u.pn / 6 : 0; sh = 2 * g;
        const int b = u.pm >> 5, lp0 = (u.pm & 31) * 256;
        const int r = lp0 >> (13 - sh), i0 = lp0 & ((SEQ >> sh) - 1);
        const int t0 = b * SEQ + (i0 << sh) + r;
        return U + (size_t)t0 * D;
    }
};
struct EpiQKV {
    static constexpr bool PERM = true, AFTER_DRAIN = false;
    bf16* Q; const float* rope; const float* su; const float* sw; unsigned char* SGA; const float* gbias1;
    __device__ __forceinline__ void operator()(const f32x4 (&acc)[2][2][4][2], const Unit& u, int wr, int wc, int fr, int fq) const {
        asm volatile("" : "+v"(fr), "+v"(fq));
        if (u.pn >= 18) {
            float srv[2][4]; f32x4 bv[2][2], wv[2][2];
#pragma unroll
            for (int ai = 0; ai < 2; ++ai)
#pragma unroll
                for (int m = 0; m < 4; ++m) srv[ai][m] = *(const float*)((const unsigned char*)su + (unsigned)((u.pm * 256 + ai * 128 + wr * 64 + m * 16 + fr) * 4));
#pragma unroll
            for (int bj = 0; bj < 2; ++bj) { const int col = 512 + (u.pn - 18) * 256 + bj * 128 + wc * 32 + fq * 8, wcol = u.pn * 256 + bj * 128 + wc * 32 + fq * 8;
                bv[bj][0] = *(const f32x4*)((const unsigned char*)gbias1 + (unsigned)(col * 4)); bv[bj][1] = *(const f32x4*)((const unsigned char*)gbias1 + (unsigned)(col * 4 + 16));
                wv[bj][0] = *(const f32x4*)((const unsigned char*)sw + (unsigned)(wcol * 4)); wv[bj][1] = *(const f32x4*)((const unsigned char*)sw + (unsigned)(wcol * 4 + 16)); }
#pragma unroll
            for (int ai = 0; ai < 2; ++ai)
#pragma unroll
                for (int m = 0; m < 4; ++m) { const unsigned row = (unsigned)(u.pm * 256 + ai * 128 + wr * 64 + m * 16 + fr); const float sr = srv[ai][m];
#pragma unroll
                    for (int bj = 0; bj < 2; ++bj) { const unsigned col = (unsigned)(512 + (u.pn - 18) * 256 + bj * 128 + wc * 32 + fq * 8);
                        f32x4 v0 = acc[ai][bj][m][0] * (wv[bj][0] * sr) + bv[bj][0], v1 = acc[ai][bj][m][1] * (wv[bj][1] * sr) + bv[bj][1];
#pragma unroll
                        for (int e = 0; e < 4; ++e) { v0[e] = sigmoidf_(v0[e]) * 255.f; v1[e] = sigmoidf_(v1[e]) * 255.f; }
                        u32x2 g8; g8.x = pack4i8(v0); g8.y = pack4i8(v1);
                        *(u32x2*)(SGA + (row * (unsigned)D + col)) = g8; } }
            return;
        }
        const int g = u.pn / 6, kind = (u.pn % 6) >> 1, half = u.pn & 1, sh = 2 * g;
        bf16* base = Q + (size_t)kind * ((WS_K - WS_Q) / 2) + (size_t)g * T * GW;
        const int b = u.pm >> 5, lp0 = (u.pm & 31) * 256;
        const bool rot = (kind < 2) && ((wc & 1) == 0);
        const float sc = (kind == 0) ? C2 : 1.f;
        f32x4 swv[2][2];
#pragma unroll
        for (int bj = 0; bj < 2; ++bj) { const unsigned wco = (unsigned)((u.pn * 256 + bj * 128 + wc * 32 + fq * 8) * 4); swv[bj][0] = *(const f32x4*)((const unsigned char*)sw + wco) * sc; swv[bj][1] = *(const f32x4*)((const unsigned char*)sw + (wco + 16u)) * sc; }
        const float sgn = (fq == 0) ? -1.f : 1.f; const bool use = fq < 2;
        const unsigned char* sub = (const unsigned char*)su; const unsigned char* rpb = (const unsigned char*)rope; unsigned char* outb = (unsigned char*)base;
        const unsigned colo = (unsigned)((half * 256 + wc * 32 + fq * 8) * 2);
#pragma unroll
        for (int ai = 0; ai < 2; ++ai)
#pragma unroll
        for (int mh = 0; mh < 2; ++mh) {
            float sutv[4]; f32x4 rpv[4][4];
#pragma unroll
            for (int m = 2 * mh; m < 2 * mh + 2; ++m) {
                const int rl = ai * 128 + wr * 64 + m * 16 + fr, lp = lp0 + rl;
                const unsigned tok = (unsigned)(b * SEQ + ((lp & ((SEQ >> sh) - 1)) << sh) + (lp >> (13 - sh)));
                sutv[m] = *(const float*)(sub + tok * 4u);
                if (rot) { rpv[m][0] = *(const f32x4*)(rpb + tok * 64u); rpv[m][1] = *(const f32x4*)(rpb + (tok * 64u + 16u)); rpv[m][2] = *(const f32x4*)(rpb + (tok * 64u + 32u)); rpv[m][3] = *(const f32x4*)(rpb + (tok * 64u + 48u)); }
            }
#pragma unroll
            for (int m = 2 * mh; m < 2 * mh + 2; ++m) {
                const int rl = ai * 128 + wr * 64 + m * 16 + fr;
                const float sut = sutv[m];
                const unsigned ro = (unsigned)((u.pm * 256 + rl) * (GW * 2)) + colo;
#pragma unroll
                for (int bj = 0; bj < 2; ++bj) {
                    f32x4 v0 = acc[ai][bj][m][0] * (swv[bj][0] * sut), v1 = acc[ai][bj][m][1] * (swv[bj][1] * sut);
                    if (rot) {
                        f32x4 o0, o1;
#pragma unroll
                        for (int e = 0; e < 4; ++e) { o0[e] = xor16(v0[e], fq); o1[e] = xor16(v1[e], fq); }
                        const f32x4 r0 = v0 * rpv[m][0] + (o0 * rpv[m][2]) * sgn, r1 = v1 * rpv[m][1] + (o1 * rpv[m][3]) * sgn;
                        v0 = use ? r0 : v0; v1 = use ? r1 : v1;
                    }
                    *(u32x4*)(outb + (ro + (unsigned)(bj * 256))) = pack8(v0, v1);
                }
            }
        }
    }
};
struct EpiCG {
    static constexpr bool PERM = true, AFTER_DRAIN = false;
    bf16* Bb; bf16* Z; unsigned char* SGC; unsigned char* SGA; const float* gbias; const float* su; const float* sw;
    __device__ __forceinline__ void operator()(const f32x4 (&accin)[2][2][4][2], const Unit& u, int wr, int wc, int fr, int fq) const {
        const int pn = u.pn;
        f32x4 swv[2][2];
#pragma unroll
        for (int bj = 0; bj < 2; ++bj) { const int wcol = NP1 + pn * 256 + bj * 128 + wc * 32 + fq * 8; swv[bj][0] = *(const f32x4*)(sw + wcol); swv[bj][1] = *(const f32x4*)(sw + wcol + 4); }
        f32x4 gbv[2][2];
        if (pn >= 12) { const int gsel = (pn >= 16) ? 1 : 0;
#pragma unroll
            for (int bj = 0; bj < 2; ++bj) { const int col = (pn - 12 - 4 * gsel) * 256 + bj * 128 + wc * 32 + fq * 8; gbv[bj][0] = *(const f32x4*)(gbias + gsel * D + col); gbv[bj][1] = *(const f32x4*)(gbias + gsel * D + col + 4); } }
        f32x4 acc[2][2][4][2];
#pragma unroll
        for (int ai = 0; ai < 2; ++ai)
#pragma unroll
            for (int m = 0; m < 4; ++m) { const float sr = su[(size_t)u.pm * 256 + ai * 128 + wr * 64 + m * 16 + fr];
#pragma unroll
                for (int bj = 0; bj < 2; ++bj) { acc[ai][bj][m][0] = accin[ai][bj][m][0] * (swv[bj][0] * sr); acc[ai][bj][m][1] = accin[ai][bj][m][1] * (swv[bj][1] * sr); } }
#pragma unroll
        for (int ai = 0; ai < 2; ++ai)
#pragma unroll
            for (int m = 0; m < 4; ++m) {
                const size_t row = (size_t)u.pm * 256 + ai * 128 + wr * 64 + m * 16 + fr;
                if (pn < 4) {
#pragma unroll
                    for (int bj = 0; bj < 2; ++bj) *(u32x4*)(Bb + row * D + pn * 256 + bj * 128 + wc * 32 + fq * 8) = pack8(acc[ai][bj][m][0], acc[ai][bj][m][1]);
                } else if (pn < 12) {
                    const f32x4 z0 = acc[ai][0][m][0] * acc[ai][1][m][0], z1 = acc[ai][0][m][1] * acc[ai][1][m][1];
                    *(u32x4*)(Z + row * D + (pn - 4) * 128 + wc * 32 + fq * 8) = pack8(z0, z1);
                } else {
                    const int gsel = (pn >= 16) ? 1 : 0; unsigned char* out = gsel ? SGA : SGC;
#pragma unroll
                    for (int bj = 0; bj < 2; ++bj) {
                        const int col = (pn - 12 - 4 * gsel) * 256 + bj * 128 + wc * 32 + fq * 8;
                        f32x4 v0 = acc[ai][bj][m][0] + gbv[bj][0], v1 = acc[ai][bj][m][1] + gbv[bj][1];
#pragma unroll
                        for (int e = 0; e < 4; ++e) { v0[e] = sigmoidf_(v0[e]) * 255.f; v1[e] = sigmoidf_(v1[e]) * 255.f; }
                        u32x2 g8; g8.x = pack4i8(v0); g8.y = pack4i8(v1);
                        *(u32x2*)(out + row * D + col) = g8;
                    }
                }
            }
    }
};
template <int MODE> struct EpiY {
    static constexpr bool PERM = true, AFTER_DRAIN = false;
    bf16* Y; const unsigned char* G;
    __device__ __forceinline__ void operator()(const f32x4 (&acc)[2][2][4][2], const Unit& u, int wr, int wc, int fr, int fq) const {
#pragma unroll
        for (int ai = 0; ai < 2; ++ai) {
            u32x2 g8[4][2]; u32x4 yv[4][2];
#pragma unroll
            for (int m = 0; m < 4; ++m)
#pragma unroll
                for (int bj = 0; bj < 2; ++bj) {
                    const size_t off = ((size_t)u.pm * 256 + ai * 128 + wr * 64 + m * 16 + fr) * D + u.pn * 256 + bj * 128 + wc * 32 + fq * 8;
                    g8[m][bj] = *(const u32x2*)(G + off);
                    if (MODE == 1) yv[m][bj] = *(const u32x4*)(Y + off);
                }
#pragma unroll
            for (int m = 0; m < 4; ++m)
#pragma unroll
                for (int bj = 0; bj < 2; ++bj) {
                    const size_t off = ((size_t)u.pm * 256 + ai * 128 + wr * 64 + m * 16 + fr) * D + u.pn * 256 + bj * 128 + wc * 32 + fq * 8;
                    const f32x4 g0 = unpack4u8(g8[m][bj].x), g1 = unpack4u8(g8[m][bj].y);
                    f32x4 v0 = acc[ai][bj][m][0] * g0, v1 = acc[ai][bj][m][1] * g1;
                    if (MODE == 1) { f32x4 y0, y1; unpack8(yv[m][bj], y0, y1); v0 = v0 + y0; v1 = v1 + y1; }
                    *(u32x4*)(Y + off) = pack8(v0, v1);
                }
        }
    }
};
struct EpiOut {
    static constexpr bool PERM = true, AFTER_DRAIN = false;
    const float* X; bf16* HG; const float* nffn; float* RSQ; unsigned char* HG8; float* HSC;
    __device__ __forceinline__ void operator()(const f32x4 (&acc)[2][2][4][2], const Unit& u, int wr, int wc, int fr, int fq) const {
        f32x4 nf[2][2];
#pragma unroll
        for (int bj = 0; bj < 2; ++bj) { const int col = u.pn * 256 + bj * 128 + wc * 32 + fq * 8; nf[bj][0] = *(const f32x4*)(nffn + col); nf[bj][1] = *(const f32x4*)(nffn + col + 4); }
#pragma unroll
        for (int ai = 0; ai < 2; ++ai) {
            f32x4 xv[4][2][2];
#pragma unroll
            for (int m = 0; m < 4; ++m)
#pragma unroll
                for (int bj = 0; bj < 2; ++bj) {
                    const size_t off = ((size_t)u.pm * 256 + ai * 128 + wr * 64 + m * 16 + fr) * D + u.pn * 256 + bj * 128 + wc * 32 + fq * 8;
                    xv[m][bj][0] = *(const f32x4*)(X + off); xv[m][bj][1] = *(const f32x4*)(X + off + 4);
                }
#pragma unroll
            for (int m = 0; m < 4; ++m) {
                const size_t row = (size_t)u.pm * 256 + ai * 128 + wr * 64 + m * 16 + fr;
                float ss = 0.f;
#pragma unroll
                for (int bj = 0; bj < 2; ++bj) {
                    const int col = u.pn * 256 + bj * 128 + wc * 32 + fq * 8; const size_t off = row * D + col;
                    const f32x4 h0 = xv[m][bj][0] + acc[ai][bj][m][0], h1 = xv[m][bj][1] + acc[ai][bj][m][1];
                    const f32x4 y0 = h0 * nf[bj][0], y1 = h1 * nf[bj][1];
                    *(u32x4*)(HG + off) = pack8(y0, y1);
                    float am = fmaxf(fmaxf(fmaxf(fabsf(y0[0]), fabsf(y0[1])), fmaxf(fabsf(y0[2]), fabsf(y0[3]))), fmaxf(fmaxf(fabsf(y1[0]), fabsf(y1[1])), fmaxf(fabsf(y1[2]), fabsf(y1[3]))));
                    am = fmaxf(am, xor16(am, fq)); am = fmaxf(am, xor32(am, fq));
                    const float qs = (am > 0.f) ? 127.f / am : 0.f;
                    u32x2 q8; q8.x = pack4i8(y0 * qs); q8.y = pack4i8(y1 * qs);
                    *(u32x2*)(HG8 + off) = q8;
                    if (fq == 0) HSC[row * 32 + u.pn * 8 + bj * 4 + wc] = am * (1.f / 127.f);
                    ss += (h0[0] * h0[0] + h0[1] * h0[1]) + (h0[2] * h0[2] + h0[3] * h0[3]) + (h1[0] * h1[0] + h1[1] * h1[1]) + (h1[2] * h1[2] + h1[3] * h1[3]);
                }
                ss += xor16(ss, fq); ss += xor32(ss, fq);
                if (fq == 0) RSQ[row * 16 + u.pn * 4 + wc] = ss;
            }
        }
    }
};
struct CvCtx { const float* dn; const float* up; unsigned char* ed; unsigned char* eu; float* esc; int lane; };
__device__ __forceinline__ void cv_load(const CvCtx& C, int ru, f32x4 (&v)[4]) {
    const int tb = ru >> 14, e = ru & (NEXP - 1);
    const float* src = (tb ? C.up : C.dn) + (size_t)e * D + 16 * C.lane;
#pragma unroll
    for (int q = 0; q < 4; ++q) v[q] = *(const f32x4*)(src + 4 * q);
}
template <int TB> __device__ __forceinline__ void cv_finish(const CvCtx& C, int ru, const f32x4 (&v)[4]) {
    const int e = ru & (NEXP - 1);
    float am = 0.f;
#pragma unroll
    for (int q = 0; q < 4; ++q) am = fmaxf(am, fmaxf(fmaxf(fabsf(v[q][0]), fabsf(v[q][1])), fmaxf(fabsf(v[q][2]), fabsf(v[q][3]))));
    am = wave_max(am);
    u32x4 w;
    if constexpr (TB) {
        const float sc = (am > 0.f) ? 256.f / am : 1.f;
#pragma unroll
        for (int q = 0; q < 4; ++q) { int d = __builtin_amdgcn_cvt_pk_fp8_f32(v[q][0] * sc, v[q][1] * sc, 0, false); d = __builtin_amdgcn_cvt_pk_fp8_f32(v[q][2] * sc, v[q][3] * sc, d, true); w[q] = (unsigned)d; }
        *(u32x4*)(C.eu + (size_t)(C.lane >> 3) * (2 * MiB) + (size_t)e * 128 + 16 * (C.lane & 7)) = w;
        C.esc[ru] = (am > 0.f) ? am * (1.f / 256.f) : 1.f;
    } else {
        const float s8 = (am > 0.f) ? 127.f / am : 0.f;
#pragma unroll
        for (int q = 0; q < 4; ++q) w[q] = pack4i8(v[q] * s8);
        *(u32x4*)(C.ed + (size_t)e * 1024 + 16 * C.lane) = w;
        C.esc[ru] = am * (1.f / 127.f);
    }
}
template <int TB> __device__ __forceinline__ void cv_rows_t(const CvCtx& C, int r0, int step) {
    const int hi = (TB + 1) * NEXP;
    if (r0 >= hi) return;
    const int last = r0 + ((hi - 1 - r0) / step) * step;
    f32x4 va[4], vb[4];
    cv_load(C, r0, va);
#pragma unroll 1
    for (int r = r0; r < hi; r += 2 * step) {
        const int r1 = min(r + step, last), r2 = min(r + 2 * step, last);
        cv_load(C, r1, vb);
        __builtin_amdgcn_sched_barrier(0);
        cv_finish<TB>(C, r, va);
        __builtin_amdgcn_sched_barrier(0);
        cv_load(C, r2, va);
        __builtin_amdgcn_sched_barrier(0);
        cv_finish<TB>(C, r1, vb);
        __builtin_amdgcn_sched_barrier(0);
    }
}
__device__ __forceinline__ void cv_rows(const CvCtx& C, int r0, int step) {
    int r = r0;
    if (r < NEXP) { cv_rows_t<0>(C, r, step); r += ((NEXP - 1 - r) / step + 1) * step; }
    cv_rows_t<1>(C, r, step);
}
__device__ __forceinline__ int f2key(float f) { const int b = __builtin_bit_cast(int, f); return b ^ ((b >> 31) & 0x7fffffff); }
__device__ __forceinline__ float key2f(int k) { return __builtin_bit_cast(float, k ^ ((k >> 31) & 0x7fffffff)); }
#define TOPK_INS(list, x) do { _Pragma("unroll") for (int _k = 0; _k < 16; ++_k) { const int _hi = max(list[_k], x); x = min(list[_k], x); list[_k] = _hi; } } while (0)
__device__ __forceinline__ unsigned long long pack8idx(const int (&a)[16], int o) { unsigned long long r = 0ull;
#pragma unroll
    for (int k = 0; k < 8; ++k) r |= (unsigned long long)(unsigned)(a[o + k] & 127) << (8 * k);
    return r; }
__device__ __forceinline__ int lut16(unsigned long long lo, unsigned long long hi, int i) { const unsigned long long w = (i < 8) ? lo : hi; return (int)((w >> ((i & 7) * 8)) & 127ull); }
__device__ __forceinline__ void sort16_asc(int (&x)[16]) {
#pragma unroll
    for (int k = 2; k <= 16; k <<= 1)
#pragma unroll
        for (int j = k >> 1; j > 0; j >>= 1)
#pragma unroll
            for (int i = 0; i < 16; ++i) { const int l = i ^ j; if (l > i) { const int lo = min(x[i], x[l]), hi = max(x[i], x[l]); const bool up = (i & k) == 0; x[i] = up ? lo : hi; x[l] = up ? hi : lo; } }
}
__device__ __forceinline__ void merge16(int (&r)[16], const int (&a)[16]) {
#pragma unroll
    for (int i = 0; i < 16; ++i) r[i] = max(r[i], a[i]);
#pragma unroll
    for (int j = 8; j > 0; j >>= 1)
#pragma unroll
        for (int i = 0; i < 16; ++i) { const int l = i ^ j; if (l > i) { const int lo = min(r[i], r[l]), hi = max(r[i], r[l]); r[i] = hi; r[l] = lo; } }
}
struct EpiTopk {
    static constexpr bool PERM = true, AFTER_DRAIN = false;
    float* scr; const float* RSQ; int* IDX; float* GATE; CvCtx CV; mutable int cvr; int cvstep;
    __device__ __forceinline__ void operator()(const f32x4 (&acc)[2][2][4][2], const Unit& u, int wr, int wc, int fr, int fq) const {
        const __amdgpu_buffer_rsrc_t rsrc = __builtin_amdgcn_make_buffer_rsrc(scr, 0, 262144, 0x00020000);
        const int voff = ((wc * 32 + fq * 8) * 256 + wr * 64 + fr) * 4;
#pragma unroll
        for (int ai = 0; ai < 2; ++ai)
#pragma unroll
            for (int m = 0; m < 4; ++m)
#pragma unroll
                for (int bj = 0; bj < 2; ++bj)
#pragma unroll
                    for (int n = 0; n < 2; ++n)
#pragma unroll
                        for (int e = 0; e < 4; ++e)
                        { const float val = acc[ai][bj][m][n][e]; __builtin_amdgcn_raw_buffer_store_b32(__builtin_bit_cast(unsigned, val), rsrc, voff, ((bj * 128 + n * 4 + e) * 256 + ai * 128 + m * 16) * 4, 0); }
        asm volatile("s_waitcnt vmcnt(0)" ::: "memory");
        __builtin_amdgcn_s_barrier();
        asm volatile("" ::: "memory");
        const int tid = threadIdx.x, row = tid >> 1, c = tid & 1;
        int v[16];
#pragma unroll
        for (int k = 0; k < 16; ++k) v[k] = (int)0x80000000;
        const int roff = (c * 128 * 256 + row) * 4;
        const size_t t = (size_t)u.pm * 256 + row;
        f32x4 rq[4];
#pragma unroll
        for (int j = 0; j < 4; ++j) rq[j] = *(const f32x4*)(RSQ + t * 16 + 4 * j);
        float xs[16], xn[16];
#pragma unroll
        for (int j = 0; j < 16; ++j) xs[j] = __builtin_bit_cast(float, __builtin_amdgcn_raw_buffer_load_b32(rsrc, roff, j * 1024, 2));
#pragma unroll 1
        for (int k0 = 0; k0 < 128; k0 += 16) {
            { const int kn = (k0 + 16) & 127;
#pragma unroll
              for (int j = 0; j < 16; ++j) xn[j] = __builtin_bit_cast(float, __builtin_amdgcn_raw_buffer_load_b32(rsrc, roff, (kn + j) * 1024, 2)); }
            __builtin_amdgcn_sched_barrier(0);
            int kb[16];
#pragma unroll
            for (int j = 0; j < 16; ++j) kb[j] = (f2key(xs[j]) & ~127) | (k0 + j);
            sort16_asc(kb);
            if (k0 == 0) {
#pragma unroll
                for (int j = 0; j < 16; ++j) v[j] = kb[15 - j];
            } else merge16(v, kb);
            __builtin_amdgcn_sched_barrier(0);
#pragma unroll
            for (int j = 0; j < 16; ++j) xs[j] = xn[j];
        }
        int A[16], B[16];
#pragma unroll
        for (int k = 0; k < 16; ++k) { const int o = __builtin_amdgcn_update_dpp(v[k], v[k], 0xB1, 0xf, 0xf, true); A[k] = c ? o : v[k]; B[k] = c ? v[k] : o; }
        int c2[16];
#pragma unroll
        for (int k = 0; k < 16; ++k) c2[k] = (int)0x80000000;
#define CAND(i, j) ((f2key(key2f(A[i]) + key2f(B[j])) & ~255) | ((i) * 16 + (j)))
#pragma unroll
        for (int j = 0; j < 16; ++j) c2[j] = CAND(0, j);
        { int t[16]; t[0] = (int)0x80000000;
#pragma unroll
          for (int i = 1; i < 16; ++i) t[16 - i] = CAND(i, 0);
          merge16(c2, t); }
        { int t[16];
          t[0] = CAND(1, 1); t[1] = CAND(1, 2); t[2] = CAND(1, 3); t[3] = CAND(1, 4); t[4] = CAND(1, 5); t[5] = CAND(1, 6); t[6] = CAND(1, 7);
          t[7] = CAND(2, 1); t[8] = CAND(2, 2); t[9] = CAND(2, 3); t[10] = CAND(2, 4); t[11] = CAND(3, 1); t[12] = CAND(3, 2); t[13] = CAND(3, 3);
          t[14] = CAND(4, 1); t[15] = CAND(4, 2);
          sort16_asc(t); merge16(c2, t); }
        { int x = CAND(5, 1); TOPK_INS(c2, x); x = CAND(6, 1); TOPK_INS(c2, x); x = CAND(7, 1); TOPK_INS(c2, x); }
#undef CAND
        float ssq = 0.f;
#pragma unroll
        for (int j = 0; j < 4; ++j) ssq += (rq[j][0] + rq[j][1]) + (rq[j][2] + rq[j][3]);
        const float rstd = __builtin_amdgcn_rsqf(ssq * (1.f / D) + RMS_EPS);
        const unsigned long long alo = pack8idx(A, 0), ahi = pack8idx(A, 8), blo = pack8idx(B, 0), bhi = pack8idx(B, 8);
        float sc[16]; int id[16]; float smax = 0.f, ssum = 0.f;
#pragma unroll
        for (int k = 0; k < 16; ++k) {
            const int cid = c2[k] & 255, i = cid >> 4, j = cid & 15;
            id[k] = lut16(alo, ahi, i) * 128 + lut16(blo, bhi, j);
            sc[k] = key2f(c2[k]) * rstd;
            if (k == 0) smax = sc[0];
            sc[k] = __expf(sc[k] - smax); ssum += sc[k];
        }
        const float inv = 1.f / ssum;
        int* ip = IDX + t * HK + u.pn * 16; float* gp = GATE + t * HK + u.pn * 16;
#pragma unroll
        for (int k = 0; k < 16; ++k) if ((k >> 3) == c) { ip[k] = id[k]; gp[k] = sc[k] * inv; }
    }
};

struct Frame {
    LAS unsigned char* lds;
    volatile LAS unsigned* MISC;
    gu32* ctl;
    int tid, lane, wave, vcu, G;
    int xcc, xrank;
    unsigned char* ws;
    const float* in[15]; float* out;
};
enum { I_X = 0, I_POS, I_NMIX, I_WIN, I_CONVW, I_WCONV, I_WATTN, I_GBIAS, I_WOUT, I_NFFN, I_WQ, I_SUBK, I_DOWN, I_UP, I_FNORM };

__device__ __forceinline__ void transpose_item(const float* W, int ldw, int k0, int n0, bf16* dst, int ldd, LAS float* scr, int lane) {
#pragma unroll 8
    for (int i = 0; i < 32; ++i) { const int kk = 2 * i + (lane >> 5); scr[kk * 33 + (lane & 31)] = W[(size_t)(k0 + kk) * ldw + n0 + (lane & 31)]; }
    LDS_WAIT(); asm volatile("" ::: "memory");
    const int c = lane & 7;
#pragma unroll
    for (int j = 0; j < 4; ++j) { const int n = (lane >> 3) + 8 * j; const LAS float* s = scr + (8 * c) * 33 + n;
        v4u o; o.x = pk2(s[0 * 33], s[1 * 33]); o.y = pk2(s[2 * 33], s[3 * 33]); o.z = pk2(s[4 * 33], s[5 * 33]); o.w = pk2(s[6 * 33], s[7 * 33]);
        *(GAS v4u*)(dst + (size_t)n * ldd + 8 * c) = o; }
    LDS_WAIT(); asm volatile("" ::: "memory");
}
__device__ __forceinline__ void w8_column_item(const float* W, int ldw, int n0, unsigned char* dst8  , float* swp  , LAS unsigned char* lds, int wave, int lane) {
    LAS float* scr = (LAS float*)(lds + wave * 16384); LAS float* cmx = (LAS float*)(lds + 130048);
    float x[2][32]; float am = 0.f;
#pragma unroll
    for (int b = 0; b < 2; ++b)
#pragma unroll
        for (int i = 0; i < 32; ++i) { const int kk = 64 * (2 * wave + b) + 2 * i + (lane >> 5); x[b][i] = W[(size_t)kk * ldw + n0 + (lane & 31)]; am = fmaxf(am, fabsf(x[b][i])); }
    am = fmaxf(am, xor32(am, lane >> 4));
    if (lane < 32) cmx[wave * 32 + lane] = am;
    __syncthreads();
    float cm = 0.f;
#pragma unroll
    for (int w = 0; w < 8; ++w) cm = fmaxf(cm, cmx[w * 32 + (lane & 31)]);
    const float q8 = (cm > 0.f) ? 127.f / cm : 0.f;
    if (wave == 0 && lane < 32) swp[lane] = cm * (1.f / 127.f);
#pragma unroll
    for (int b = 0; b < 2; ++b) {
#pragma unroll
        for (int i = 0; i < 32; ++i) scr[(2 * i + (lane >> 5)) * 33 + (lane & 31)] = x[b][i] * q8;
        LDS_WAIT(); asm volatile("" ::: "memory");
        const int c = lane & 7;
#pragma unroll
        for (int j = 0; j < 4; ++j) { const int n = (lane >> 3) + 8 * j; const LAS float* s = scr + (8 * c) * 33 + n;
            u32x2 o; o.x = pack4i8((f32x4){s[0 * 33], s[1 * 33], s[2 * 33], s[3 * 33]}); o.y = pack4i8((f32x4){s[4 * 33], s[5 * 33], s[6 * 33], s[7 * 33]});
            *(u32x2*)(dst8 + (size_t)n * D + 64 * (2 * wave + b) + 8 * c) = o; }
        LDS_WAIT(); asm volatile("" ::: "memory");
    }
    __syncthreads();
}
__device__ __forceinline__ int win_w8_row(int n0) {
    if (n0 < 1024) return NP1 + n0;
    if (n0 < 2048) { const int j = n0 - 1024; return NP1 + 1024 + (j >> 7) * 256 + (j & 127); }
    if (n0 < 3072) { const int j = n0 - 2048; return NP1 + 1024 + (j >> 7) * 256 + 128 + (j & 127); }
    if (n0 < 7680) { const int j = n0 - 3072, kind = j / 1536, jj = j % 1536, g = jj >> 9, cc = jj & 511; return g * 1536 + kind * 512 + cc; }
    if (n0 < 8704) return NP1 + 3072 + (n0 - 7680);
    if (n0 < 9216) return NP1 + 4096 + (n0 - 8704);
    return NQKV + (n0 - 9216);
}
__device__ __forceinline__ void p0_prologue(Frame& F) {
    for (int it = F.vcu; it < DIN / 32; it += F.G) {
        const int n0 = 32 * it, drow = win_w8_row(n0);
        w8_column_item(F.in[I_WIN], DIN, n0, F.ws + WS_WQKV8 + (size_t)drow * D, (float*)(F.ws + WS_SW) + drow, F.lds, F.wave, F.lane);
    }
    LAS float* scr = (LAS float*)(F.lds + F.wave * 16384);
    const int gw = F.vcu * NWAVES + F.wave, NGW = F.G * NWAVES;
    constexpr int I_C = 16 * 32, I_A = 8 * 32, I_O = 16 * 32, NITEMS = I_C + I_A + I_O;
    for (int it = gw; it < NITEMS; it += NGW) {
        int r = it;
        if (r < I_C) { const int kb = r / 32, nb = r % 32; transpose_item(F.in[I_WCONV], D, 64 * kb, 32 * nb, (bf16*)(F.ws + WS_WCONV) + (size_t)(32 * nb) * D + 64 * kb, D, scr, F.lane); continue; } r -= I_C;
        if (r < I_A) { const int kb = r / 32, nb = r % 32; transpose_item(F.in[I_WATTN], D, 64 * kb, 32 * nb, (bf16*)(F.ws + WS_WATTN) + (size_t)(32 * nb) * DAO + 64 * kb, DAO, scr, F.lane); continue; } r -= I_A;
        { const int kb = r / 32, nb = r % 32; transpose_item(F.in[I_WOUT], D, 64 * kb, 32 * nb, (bf16*)(F.ws + WS_WOUT) + (size_t)(32 * nb) * D + 64 * kb, D, scr, F.lane); }
    }
    const float* x = F.in[I_X]; const float* nm = F.in[I_NMIX];
    f32x4 gm[4];
#pragma unroll
    for (int j = 0; j < 4; ++j) gm[j] = *((const f32x4*)nm + F.lane + 64 * j);
    const int nlong = (DIN / 32) % F.G;
    constexpr int RSH = 2;
    const int nsl = (nlong == 0) ? 1 : ((F.vcu < nlong) ? 1 : RSH), V = (nlong == 0) ? NGW : (nlong * NWAVES + (F.G - nlong) * NWAVES * RSH);
    const int w0 = (nlong == 0) ? gw : ((F.vcu < nlong) ? gw : nlong * NWAVES + ((F.vcu - nlong) * NWAVES + F.wave) * RSH);
    for (int sl = 0; sl < nsl; ++sl)
    for (int m = w0 + sl; m < T; m += V) {
        const GAS f32x4* xr = (const GAS f32x4*)(x + (size_t)m * D) + F.lane;
        f32x4 v[4]; float s = 0.f;
#pragma unroll
        for (int j = 0; j < 4; ++j) { v[j] = xr[64 * j]; s += (v[j].x * v[j].x + v[j].y * v[j].y) + (v[j].z * v[j].z + v[j].w * v[j].w); }
        const float rstd = 1.f / sqrtf(wave_sum(s) * (1.f / D) + RMS_EPS);
        f32x4 y[4]; float am = 0.f;
#pragma unroll
        for (int j = 0; j < 4; ++j) { y[j] = v[j] * rstd * gm[j];
            am = fmaxf(am, fmaxf(fmaxf(fabsf(y[j].x), fabsf(y[j].y)), fmaxf(fabsf(y[j].z), fabsf(y[j].w)))); }
        am = wave_max(am);
        const float q8 = (am > 0.f) ? 127.f / am : 0.f;
#pragma unroll
        for (int j = 0; j < 4; ++j) ((GAS unsigned*)(F.ws + WS_U8 + (size_t)m * D))[F.lane + 64 * j] = pack4i8(y[j] * q8);
        if (F.lane == 0) ((float*)(F.ws + WS_SU))[m] = am * (1.f / 127.f);
    }
    const int* pos = (const int*)F.in[I_POS]; float* rope = (float*)(F.ws + WS_ROPE);
    for (int e = gw * 64 + F.lane; e < T * 8; e += NGW * 64) {
        const int t = e >> 3, j = e & 7;
        const double invf[8] = {1.0, 0.19392274474868576, 0.03760603093086393, 0.007292664737217109, 0.001414213562373095, 0.0002742481756762073, 5.318295896944988e-05, 1.031338537721246e-05};
        double f = 1.0;
#pragma unroll
        for (int q = 1; q < 8; ++q) f = (j == q) ? invf[q] : f;
        const float fi = (float)f;
        const double ang = (double)pos[t] * (double)fi;
        const double k = __builtin_rint(ang * 0.15915494309189535);
        const float r = (float)(ang - k * 6.283185307179586);
        rope[(size_t)t * 16 + j] = __cosf(r); rope[(size_t)t * 16 + 8 + j] = __sinf(r);
    }
}

__device__ __forceinline__ void attn_phase(Frame& F, bf16* OGb, float* LSE) {
    constexpr int SLOT = 128 * 160;
    LAS unsigned char* Ks = F.lds; LAS unsigned char* Vs = F.lds + 3 * SLOT;
    const int lane = F.lane, w = F.wave, ir = lane & 15, gq = lane >> 4;
    const int NU = 3 * 8 * 128, per = (NU + F.G - 1) / F.G;
    const int u0 = F.vcu * per, u1 = (u0 + per < NU) ? u0 + per : NU;
    const bf16* Qb = (const bf16*)(F.ws + WS_Q); const bf16* Kb = (const bf16*)(F.ws + WS_K); const bf16* Vb = (const bf16*)(F.ws + WS_V);
    u32x4 pk[2], pv[2]; bf16x8 nq0, nq1; bool havepre = false;
    for (int uid = u0, n = 0; uid < u1; ++uid, ++n) {
        const int g = uid >> 10, hh = (uid >> 7) & 7, blk = uid & 127, sh = 2 * g;
        const bool first = (blk & ((64 >> sh) - 1)) == 0;
        const size_t gbase = (size_t)g * T * GW;
        const int p0 = blk * 128;
        const int ps = n % 3, cs = (n + 1) % 3, ns = (n + 2) % 3;
        const bf16* qrow = Qb + gbase + (size_t)(p0 + 16 * w + ir) * GW + hh * 64;
        bf16* orow = OGb + gbase + (size_t)(p0 + 16 * w + ir) * GW + hh * 64;
        bf16x8 qf0, qf1;
        if (!havepre) {
            if (n > 0) __syncthreads();
#pragma unroll
            for (int i = 0; i < 4; ++i) {
                const int c = F.tid + 512 * i, row = c >> 3, part = c & 7;
                const bool valid = !first || row >= 128;
                u32x4 kv = {0u, 0u, 0u, 0u}, vv = {0u, 0u, 0u, 0u};
                if (valid) { const size_t off = gbase + (size_t)(p0 - 128 + row) * GW + hh * 64 + part * 8; kv = *(const u32x4*)(Kb + off); vv = *(const u32x4*)(Vb + off); }
                const int so = ((row < 128) ? ps : cs) * SLOT + (row & 127) * 160 + part * 16;
                *(LAS u32x4*)(Ks + so) = kv; *(LAS u32x4*)(Vs + so) = vv;
            }
            qf0 = *(const bf16x8*)(qrow + 8 * gq); qf1 = *(const bf16x8*)(qrow + 32 + 8 * gq);
        } else { qf0 = nq0; qf1 = nq1; }
        __syncthreads();
        havepre = (uid + 1 < u1) && (((uid + 1) & 127) != 0);
        if (havepre) {
#pragma unroll
            for (int i = 0; i < 2; ++i) { const int c = F.tid + 512 * i, row = c >> 3, part = c & 7; const size_t off = gbase + (size_t)(p0 + 128 + row) * GW + hh * 64 + part * 8; pk[i] = *(const u32x4*)(Kb + off); pv[i] = *(const u32x4*)(Vb + off); }
            nq0 = *(const bf16x8*)(qrow + (size_t)128 * GW + 8 * gq); nq1 = *(const bf16x8*)(qrow + (size_t)128 * GW + 32 + 8 * gq);
        }
        f32x4 sacc[9];
#pragma unroll
        for (int a = 0; a < 9; ++a) {
            sacc[a] = (f32x4){0.f, 0.f, 0.f, 0.f};
            const int R0 = 16 * w + 16 * a;
            const LAS unsigned char* kp = Ks + ((R0 < 128) ? ps : cs) * SLOT + ((R0 & 127) + ir) * 160 + gq * 16;
            const bf16x8 k0 = *(const LAS bf16x8*)kp, k1 = *(const LAS bf16x8*)(kp + 64);
            sacc[a] = __builtin_amdgcn_mfma_f32_16x16x32_bf16(k0, qf0, sacc[a], 0, 0, 0);
            sacc[a] = __builtin_amdgcn_mfma_f32_16x16x32_bf16(k1, qf1, sacc[a], 0, 0, 0);
        }
        float mx = -INFINITY;
#pragma unroll
        for (int a = 0; a < 9; ++a)
#pragma unroll
            for (int j = 0; j < 4; ++j) {
                const int jl = 4 * gq + j;
                bool valid = (a == 0) ? (jl >= ir) : ((a == 8) ? (jl <= ir) : true);
                valid = valid && (!first || (16 * w + 16 * a + jl >= 128));
                sacc[a][j] = valid ? sacc[a][j] : -INFINITY;
                mx = fmaxf(mx, sacc[a][j]);
            }
        mx = fmaxf(mx, xor16(mx, gq)); mx = fmaxf(mx, xor32(mx, gq));
        float l = 0.f;
#pragma unroll
        for (int a = 0; a < 9; ++a)
#pragma unroll
            for (int j = 0; j < 4; ++j) { sacc[a][j] = __builtin_amdgcn_exp2f(sacc[a][j] - mx); l += sacc[a][j]; }
        l += xor16(l, gq); l += xor32(l, gq);
        f32x4 oacc[4];
#pragma unroll
        for (int dt = 0; dt < 4; ++dt) oacc[dt] = (f32x4){0.f, 0.f, 0.f, 0.f};
#pragma unroll
        for (int s = 0; s < 5; ++s) {
            u32x4 pw; pw.x = cvt_pk_bf16(sacc[2 * s][0], sacc[2 * s][1]); pw.y = cvt_pk_bf16(sacc[2 * s][2], sacc[2 * s][3]);
            if (s < 4) { pw.z = cvt_pk_bf16(sacc[2 * s + 1][0], sacc[2 * s + 1][1]); pw.w = cvt_pk_bf16(sacc[2 * s + 1][2], sacc[2 * s + 1][3]); } else { pw.z = 0u; pw.w = 0u; }
            const bf16x8 pb = __builtin_bit_cast(bf16x8, pw);
            const int q = ir >> 2, p = ir & 3;
            const int Ra = 16 * w + 32 * s, Rb = Ra + 16;
            const LAS unsigned char* vpa = Vs + ((Ra < 128) ? ps : cs) * SLOT + ((Ra & 127) + 4 * gq + q) * 160 + p * 8;
            const LAS unsigned char* vpb = Vs + ((Rb < 128) ? ps : cs) * SLOT + ((Rb & 127) + 4 * gq + q) * 160 + p * 8;
#pragma unroll
            for (int dt = 0; dt < 4; ++dt) {
                const s16x4 va = __builtin_bit_cast(s16x4, __builtin_amdgcn_ds_read_tr16_b64_v4i16((LAS v4i16_t*)(vpa + dt * 32)));
                s16x4 vb = {0, 0, 0, 0};
                if (s < 4) vb = __builtin_bit_cast(s16x4, __builtin_amdgcn_ds_read_tr16_b64_v4i16((LAS v4i16_t*)(vpb + dt * 32)));
                const bf16x8 vf = __builtin_shufflevector(va, vb, 0, 1, 2, 3, 4, 5, 6, 7);
                oacc[dt] = __builtin_amdgcn_mfma_f32_16x16x32_bf16(vf, pb, oacc[dt], 0, 0, 0);
            }
        }
        const float inv = 1.f / l;
#pragma unroll
        for (int dt = 0; dt < 4; ++dt) {
            u32x2 o; o.x = cvt_pk_bf16(oacc[dt][0] * inv, oacc[dt][1] * inv); o.y = cvt_pk_bf16(oacc[dt][2] * inv, oacc[dt][3] * inv);
            *(u32x2*)(orow + 16 * dt + 4 * gq) = o;
        }
        if (gq == 0) LSE[((size_t)g * T + p0 + 16 * w + ir) * 8 + hh] = (mx + __builtin_amdgcn_logf(l)) * LN2;
        if (havepre) {
#pragma unroll
            for (int i = 0; i < 2; ++i) { const int c = F.tid + 512 * i, row = c >> 3, part = c & 7; const int so = ns * SLOT + row * 160 + part * 16; *(LAS u32x4*)(Ks + so) = pk[i]; *(LAS u32x4*)(Vs + so) = pv[i]; }
        }
    }
    __syncthreads();
}

__device__ __forceinline__ void combine_phase(Frame& F, int part, int nparts) {
    const int gw = part * NWAVES + F.wave, NGW = nparts * NWAVES, lane = F.lane, hh = lane >> 3;
    const bf16* OG = (const bf16*)(F.ws + WS_Q); const float* LSE = (const float*)(F.ws + WS_LSE); bf16* O = (bf16*)(F.ws + WS_O);
    for (int t0 = gw * 4; t0 < T; t0 += NGW * 4) {
        float ls[4][3]; u32x4 og[4][3];
#pragma unroll
        for (int q = 0; q < 4; ++q) { const int t = t0 + q, b = t / SEQ, s = t % SEQ;
#pragma unroll
            for (int g = 0; g < 3; ++g) {
                const int sh = 2 * g, r = s & ((1 << sh) - 1), i = s >> sh;
                const size_t p = (size_t)g * T + b * SEQ + r * (SEQ >> sh) + i;
                ls[q][g] = LSE[p * 8 + hh]; og[q][g] = *(const u32x4*)(OG + p * GW + lane * 8);
            } }
#pragma unroll
        for (int q = 0; q < 4; ++q) {
            const float m = fmaxf(ls[q][0], fmaxf(ls[q][1], ls[q][2]));
            float e[3], sum = 0.f;
#pragma unroll
            for (int g = 0; g < 3; ++g) { e[g] = __expf(ls[q][g] - m); sum += e[g]; }
            const float inv = 1.f / sum;
            f32x4 a0 = {0.f, 0.f, 0.f, 0.f}, a1 = a0;
#pragma unroll
            for (int g = 0; g < 3; ++g) { f32x4 v0, v1; unpack8(og[q][g], v0, v1); const float wg = e[g] * inv; a0 = a0 + v0 * wg; a1 = a1 + v1 * wg; }
            *(u32x4*)(O + (size_t)(t0 + q) * DAO + lane * 8) = pack8(a0, a1);
        }
    }
}

__device__ __forceinline__ void p4_conv(Frame& F) {
    constexpr int RUN = 16;
    const int gt = (F.vcu * NWAVES + F.wave) * 64 + F.lane, NGT = F.G * NWAVES * 64;
    bf16* Bb = (bf16*)((unsigned char*)F.out + OS_BB); const bf16* Z = (const bf16*)(F.ws + WS_Z); const float* cw = F.in[I_CONVW];
    for (int e = gt; e < (T / RUN) * (D / 8); e += NGT) {
        const int t0 = (e >> 7) * RUN, c8 = (e & 127) * 8, s0 = t0 & (SEQ - 1);
        const f32x4 w0a = *(const f32x4*)(cw + c8), w0b = *(const f32x4*)(cw + c8 + 4), w1a = *(const f32x4*)(cw + D + c8), w1b = *(const f32x4*)(cw + D + c8 + 4), w2a = *(const f32x4*)(cw + 2 * D + c8), w2b = *(const f32x4*)(cw + 2 * D + c8 + 4);
        const size_t off0 = (size_t)t0 * D + c8;
        f32x4 z1a = {0.f, 0.f, 0.f, 0.f}, z1b = z1a, z2a = z1a, z2b = z1a;
        if (s0 >= 2) { unpack8(*(const u32x4*)(Z + off0 - D), z1a, z1b); unpack8(*(const u32x4*)(Z + off0 - 2 * D), z2a, z2b); }
#pragma unroll 4
        for (int r = 0; r < RUN; ++r) {
            const size_t off = off0 + (size_t)r * D;
            f32x4 z0a, z0b, ba, bb;
            unpack8(*(const u32x4*)(Z + off), z0a, z0b); unpack8(*(const u32x4*)(Bb + off), ba, bb);
            const f32x4 ca = w0a * z2a + w1a * z1a + w2a * z0a, cb = w0b * z2b + w1b * z1b + w2b * z0b;
            *(u32x4*)(Bb + off) = pack8(ba * ca, bb * cb);
            z2a = z1a; z2b = z1b; z1a = z0a; z1b = z0b;
        }
    }
}
__device__ __forceinline__ void split8(const f32x4 a, const f32x4 b, bf16x8& hi, bf16x8& lo) {
    const u32x4 h = pack8(a, b); f32x4 ha, hb; unpack8(h, ha, hb);
    hi = __builtin_bit_cast(bf16x8, h); lo = __builtin_bit_cast(bf16x8, pack8(a - ha, b - hb));
}
__device__ __forceinline__ void p4_wfold(Frame& F) {
    const int gw = F.vcu * NWAVES + F.wave, NGW = F.G * NWAVES, i = F.lane & 15, g = F.lane >> 4;
    const float* Wq = F.in[I_WQ]; const float* SK = F.in[I_SUBK]; bf16* WF = (bf16*)((unsigned char*)F.out + OS_WFOLD);
    for (int it = gw; it < 1024; it += NGW) {
        const int itu = __builtin_amdgcn_readfirstlane(it);
        const int hc = itu >> 6, k0 = ((itu >> 1) & 31) * 32, nh = itu & 1;
        bf16x8 ah[2][4], al[2][4];
#pragma unroll
        for (int kt = 0; kt < 2; ++kt)
#pragma unroll
            for (int j = 0; j < 4; ++j) { const float* ap = Wq + (size_t)(k0 + 16 * kt + i) * 2048 + hc * 128 + 32 * j + 8 * g; split8(*(const f32x4*)ap, *(const f32x4*)(ap + 4), ah[kt][j], al[kt][j]); }
#pragma unroll 1
        for (int nt = 0; nt < 4; ++nt) {
            const int n0 = hc * 128 + nh * 64 + 16 * nt;
            bf16x8 bh[4], bl[4];
#pragma unroll
            for (int j = 0; j < 4; ++j) { const float* bp = SK + (size_t)(n0 + i) * 128 + 32 * j + 8 * g; split8(*(const f32x4*)bp, *(const f32x4*)(bp + 4), bh[j], bl[j]); }
#pragma unroll
            for (int kt = 0; kt < 2; ++kt) {
                f32x4 acc = {0.f, 0.f, 0.f, 0.f};
#pragma unroll
                for (int j = 0; j < 4; ++j) { acc = __builtin_amdgcn_mfma_f32_16x16x32_bf16(al[kt][j], bh[j], acc, 0, 0, 0); acc = __builtin_amdgcn_mfma_f32_16x16x32_bf16(ah[kt][j], bl[j], acc, 0, 0, 0); }
#pragma unroll
                for (int j = 0; j < 4; ++j) acc = __builtin_amdgcn_mfma_f32_16x16x32_bf16(ah[kt][j], bh[j], acc, 0, 0, 0);
                u32x2 o; o.x = pk2(acc[0], acc[1]); o.y = pk2(acc[2], acc[3]);
                *(u32x2*)(WF + (size_t)(n0 + i) * D + k0 + 16 * kt + 4 * g) = o;
            }
        }
    }
}
__device__ __forceinline__ float gelu_erf(float v) { return 0.5f * v * (1.f + erff(v * 0.70710678118654752f)); }
__device__ __forceinline__ void peer_down_phase(Frame& F) {
    const int lane = F.lane, sub = lane & 15, gq = lane >> 4;
    const int nloc = (int)F.MISC[8], nxc = (int)F.MISC[9]; const bool byx = (nxc == 8) && (nloc * 8 == F.G) && (F.xcc < 8);
    const int x = byx ? F.xcc : 0, nsh = byx ? 8 : 1, rank = byx ? F.xrank : (int)blockIdx.x, nrank = byx ? nloc : F.G;
    const unsigned char* HG8 = F.ws + WS_HG8; const float* HSC = (const float*)(F.ws + WS_HSC); const float* RSQ = (const float*)(F.ws + WS_RSQ);
    const int* IDX = (const int*)(F.ws + WS_IDX); const float* GATE = (const float*)(F.ws + WS_GATE);
    const unsigned char* dn8 = (const unsigned char*)F.out + OS_EDOWN; const float* esc = (const float*)(F.ws + WS_ESCALE); float* WB = (float*)(F.ws + WS_WB);
    LAS unsigned char* wb = F.lds + F.wave * 10752;
    LAS u32x4* h8s = (LAS u32x4*)wb; LAS float* hss = (LAS float*)(wb + 4096); LAS u32x2* ls = (LAS u32x2*)(wb + 4608); LAS float* av = (LAS float*)(wb + 8704);
    const int tstep = nrank * NWAVES * 4;
    for (int xs = x; xs < 8; xs += nsh) {
        int tb = (rank * NWAVES + F.wave) * 4;
        u32x4 ia, ib, h8[4]; f32x4 ga, gb; float hs[4], pq;
#define PD_META(tt) do { const unsigned t_ = (unsigned)((tt) + gq); const unsigned char* wsb_ = F.ws;     \
            ia = *(const u32x4*)(wsb_ + (unsigned)(WS_IDX + t_ * (HK * 4) + sub * 32)); ib = *(const u32x4*)(wsb_ + (unsigned)(WS_IDX + t_ * (HK * 4) + sub * 32 + 16)); \
            ga = *(const f32x4*)(wsb_ + (unsigned)(WS_GATE + t_ * (HK * 4) + sub * 32)); gb = *(const f32x4*)(wsb_ + (unsigned)(WS_GATE + t_ * (HK * 4) + sub * 32 + 16)); pq = *(const float*)(wsb_ + (unsigned)(WS_RSQ + t_ * 64 + sub * 4)); \
            _Pragma("unroll") for (int j_ = 0; j_ < 4; ++j_) { h8[j_] = *(const u32x4*)(wsb_ + (unsigned)(WS_HG8 + t_ * D + 16 * (sub + 16 * j_))); hs[j_] = *(const float*)(wsb_ + (unsigned)(WS_HSC + t_ * 128 + ((sub + 16 * j_) >> 1) * 4)); } } while (0)
        if (tb < T) PD_META(tb);
        for (; tb < T; tb += tstep) {
#pragma unroll
            for (int j = 0; j < 4; ++j) { h8s[gq * 64 + sub + 16 * j] = h8[j]; if ((sub & 1) == 0) hss[gq * 32 + ((sub + 16 * j) >> 1)] = hs[j]; }
            int total = 0;
#pragma unroll
            for (int k = 0; k < 8; ++k) {
                const int ei = (int)(k < 4 ? ia[k & 3] : ib[k & 3]); const float gk = (k < 4 ? ga[k & 3] : gb[k & 3]);
                const bool f = (ei >> 11) == xs;
                const unsigned long long m = __ballot(f);
                const int pos = total + (int)__builtin_amdgcn_mbcnt_hi((unsigned)(m >> 32), __builtin_amdgcn_mbcnt_lo((unsigned)m, 0u));
                if (f) { u32x2 ent; ent.x = (unsigned)ei | ((unsigned)(sub * 8 + k) << 14) | ((unsigned)gq << 21); ent.y = __builtin_bit_cast(unsigned, gk); ls[pos] = ent; }
                total += __popcll(m);
            }
            const float rq = sum16_dpp(pq);
            const float rstd = __builtin_amdgcn_rsqf(rq * (1.f / D) + RMS_EPS);
            const int tcur = tb;
            if (tb + tstep < T) PD_META(tb + tstep);
            LDS_WAIT(); asm volatile("" ::: "memory");
            const int nr = (total + 3) >> 2;
#define PD_ISSUE(R, HH, HS, r0) do { _Pragma("unroll") for (int u_ = 0; u_ < 2; ++u_) { const int k_ = 4 * ((r0) + u_) + gq; const bool v_ = k_ < total; const u32x2 e_ = ls[v_ ? k_ : 0]; const unsigned ex_ = e_.x; \
                const unsigned ro_ = (v_ ? (ex_ & 16383u) : 0u) * 1024u + 16u * (unsigned)sub; const unsigned tk_ = (ex_ >> 21) & 3u; \
                _Pragma("unroll") for (int j_ = 0; j_ < 4; ++j_) { R[u_][j_] = *(const u32x4*)(dn8 + (ro_ + 256u * j_)); HH[u_][j_] = h8s[tk_ * 64 + sub + 16 * j_]; HS[u_][j_] = hss[tk_ * 32 + ((sub + 16 * j_) >> 1)]; } } } while (0)
#define PD_COMPUTE(R, HH, HS, r0) do { _Pragma("unroll") for (int u_ = 0; u_ < 2; ++u_) { const int k_ = 4 * ((r0) + u_) + gq; float af_ = 0.f; \
                _Pragma("unroll") for (int j_ = 0; j_ < 4; ++j_) { int ac_ = 0; _Pragma("unroll") for (int q_ = 0; q_ < 4; ++q_) { const int a_ = (int)R[u_][j_][q_], b_ = (int)HH[u_][j_][q_]; ac_ = __builtin_amdgcn_sdot4(a_, b_, ac_, false); } af_ += (float)ac_ * HS[u_][j_]; } \
                af_ = sum16_dpp(af_); \
                if (k_ < total && sub == 0) av[k_] = af_; } } while (0)
            u32x4 RA[2][4], RB[2][4], HA[2][4], HB[2][4]; float SA[2][4], SB[2][4];
            if (nr > 0) {
                PD_ISSUE(RA, HA, SA, 0);
                int r = 0;
#pragma unroll 1
                for (; r + 4 < nr; r += 4) {
                    PD_ISSUE(RB, HB, SB, r + 2);
                    __builtin_amdgcn_sched_barrier(0);
                    PD_COMPUTE(RA, HA, SA, r);
                    __builtin_amdgcn_sched_barrier(0);
                    PD_ISSUE(RA, HA, SA, r + 4);
                    __builtin_amdgcn_sched_barrier(0);
                    PD_COMPUTE(RB, HB, SB, r + 2);
                    __builtin_amdgcn_sched_barrier(0);
                }
                if (r + 2 < nr) {
                    PD_ISSUE(RB, HB, SB, r + 2);
                    __builtin_amdgcn_sched_barrier(0);
                    PD_COMPUTE(RA, HA, SA, r);
                    __builtin_amdgcn_sched_barrier(0);
                    PD_COMPUTE(RB, HB, SB, r + 2);
                } else {
                    PD_COMPUTE(RA, HA, SA, r);
                }
                __builtin_amdgcn_sched_barrier(0);
            }
#undef PD_ISSUE
#undef PD_COMPUTE
            LDS_WAIT(); asm volatile("" ::: "memory");
            const float rs0 = __builtin_bit_cast(float, __builtin_amdgcn_readlane(__builtin_bit_cast(int, rstd), 0)), rs1 = __builtin_bit_cast(float, __builtin_amdgcn_readlane(__builtin_bit_cast(int, rstd), 16)),
                        rs2 = __builtin_bit_cast(float, __builtin_amdgcn_readlane(__builtin_bit_cast(int, rstd), 32)), rs3 = __builtin_bit_cast(float, __builtin_amdgcn_readlane(__builtin_bit_cast(int, rstd), 48));
            for (int i = lane; i < total; i += 64) {
                const u32x2 e = ls[i]; const unsigned ex = e.x, eg = e.y; const int tk = (int)((ex >> 21) & 3u);
                const float rs = (tk == 0) ? rs0 : ((tk == 1) ? rs1 : ((tk == 2) ? rs2 : rs3));
                const float a = av[i] * esc[ex & 16383u] * rs;
                WB[(size_t)(tcur + tk) * HK + ((ex >> 14) & 127u)] = __builtin_bit_cast(float, eg) * esc[NEXP + (ex & 16383u)] * gelu_erf(a);
            }
            LDS_WAIT(); asm volatile("" ::: "memory");
        }
#undef PD_META
    }
}
__device__ __forceinline__ void peer_up_phase(Frame& F) {
    const int lane = F.lane, g8 = lane >> 3, c = lane & 7;
    const int nloc = (int)F.MISC[8], nxc = (int)F.MISC[9]; const bool byx = (nxc == 8) && (nloc * 8 == F.G) && (F.xcc < 8);
    const int x = byx ? F.xcc : 0, nsh = byx ? 8 : 1, rank = byx ? F.xrank : (int)blockIdx.x, nrank = byx ? nloc : F.G;
    const bf16* HG = (const bf16*)(F.ws + WS_HG); const float* nffn = F.in[I_NFFN];
    float* SS = (float*)(F.ws + WS_SS); float* out = F.out;
    LAS unsigned char* wbuf = F.lds + F.wave * 16384;
    const int tstep = nrank * NWAVES * 8;
    const unsigned char* wsb = F.ws;
    for (int xs = x; xs < 8; xs += nsh) {
    const unsigned char* up8 = F.ws + WS_EUP + (size_t)xs * (2 * MiB);
    int tb = (rank * NWAVES + F.wave) * 8, it = 0;
#define PU_MOFF(tt, j) ((unsigned)(((j) < 4 ? WS_IDX : WS_WB) + (size_t)(tt) * (HK * 4) + ((j) & 3) * 1024) + (unsigned)(lane * 16))
    if (tb < T) {
        u32x4 m0[8];
#pragma unroll
        for (int j = 0; j < 8; ++j) m0[j] = *(const u32x4*)(wsb + PU_MOFF(tb, j));
#pragma unroll
        for (int j = 0; j < 8; ++j) *(LAS u32x4*)(wbuf + j * 1024 + lane * 16) = m0[j];
    }
    for (; tb < T; tb += tstep, ++it) {
        const int t = tb + g8;
        const LAS unsigned char* mi = wbuf + (it & 1) * 8192 + g8 * 512;
        LAS unsigned char* nb = wbuf + ((it + 1) & 1) * 8192 + lane * 16;
        const int tn = (tb + tstep < T) ? tb + tstep : tb;
        f32x4 oa[4];
#pragma unroll
        for (int q = 0; q < 4; ++q) oa[q] = (f32x4){0.f, 0.f, 0.f, 0.f};
#define PU_ISSUE(R, W, st) do { const u32x4 i0_ = *(const LAS u32x4*)(mi + (st) * 32), i1_ = *(const LAS u32x4*)(mi + (st) * 32 + 16); \
            const f32x4 w0_ = *(const LAS f32x4*)(mi + 4096 + (st) * 32), w1_ = *(const LAS f32x4*)(mi + 4096 + (st) * 32 + 16); \
            _Pragma("unroll") for (int k_ = 0; k_ < 8; ++k_) { const unsigned ei_ = (k_ < 4) ? i0_[k_ & 3] : i1_[k_ & 3]; W[k_] = (k_ < 4) ? w0_[k_ & 3] : w1_[k_ & 3]; \
            R[k_] = *(const u32x4*)(up8 + (ei_ * 128u + 16u * (unsigned)c)); } } while (0)
#define PU_COMPUTE(R, W) do { _Pragma("unroll") for (int k_ = 0; k_ < 8; ++k_) { _Pragma("unroll") for (int q_ = 0; q_ < 4; ++q_) { const int d_ = (int)R[k_][q_]; \
            const f32x2 lo_ = __builtin_amdgcn_cvt_pk_f32_fp8(d_, false), hi_ = __builtin_amdgcn_cvt_pk_f32_fp8(d_, true); \
            oa[q_][0] += lo_.x * W[k_]; oa[q_][1] += lo_.y * W[k_]; oa[q_][2] += hi_.x * W[k_]; oa[q_][3] += hi_.y * W[k_]; } \
            if (k_ & 1) { asm volatile("" : "+v"(oa[0]), "+v"(oa[1]), "+v"(oa[2]), "+v"(oa[3])); __builtin_amdgcn_sched_barrier(0); } } } while (0)
        u32x4 RA[8], RB[8]; float WA[8], WBk[8];
        PU_ISSUE(RA, WA, 0);
#define PU_BODY(st, j) do { const u32x4 m_ = *(const u32x4*)(wsb + PU_MOFF(tn, j)); \
            PU_ISSUE(RB, WBk, (st) + 1); __builtin_amdgcn_sched_barrier(0); PU_COMPUTE(RA, WA); __builtin_amdgcn_sched_barrier(0); \
            PU_ISSUE(RA, WA, (st) + 2); __builtin_amdgcn_sched_barrier(0); PU_COMPUTE(RB, WBk); __builtin_amdgcn_sched_barrier(0); \
            *(LAS u32x4*)(nb + (j) * 1024) = m_; __builtin_amdgcn_sched_barrier(0); } while (0)
#pragma unroll 1
        for (int st = 0; st < 14; st += 2) { const int j = st >> 1; PU_BODY(st, j); }
        unsigned hgo = (unsigned)(t * (D * 2) + 256 * xs + 32 * c);
        asm volatile("" : "+v"(hgo));
        const u32x4 m7 = *(const u32x4*)(wsb + PU_MOFF(tn, 7));
        const u32x4 hg0 = *(const u32x4*)((const unsigned char*)HG + hgo), hg1 = *(const u32x4*)((const unsigned char*)HG + (hgo + 16u));
        PU_ISSUE(RB, WBk, 15);
        __builtin_amdgcn_sched_barrier(0);
        PU_COMPUTE(RA, WA);
        __builtin_amdgcn_sched_barrier(0);
        PU_COMPUTE(RB, WBk);
        __builtin_amdgcn_sched_barrier(0);
        *(LAS u32x4*)(nb + 7 * 1024) = m7;
#undef PU_BODY
#undef PU_ISSUE
#undef PU_COMPUTE
        float ss = 0.f;
        const size_t off = (size_t)t * D + 128 * xs + 16 * c;
        f32x4 hv[4]; unpack8(hg0, hv[0], hv[1]); unpack8(hg1, hv[2], hv[3]);
#pragma unroll
        for (int q = 0; q < 4; ++q) { const f32x4 nf = *(const f32x4*)(nffn + 128 * xs + 16 * c + 4 * q); hv[q][0] /= nf[0]; hv[q][1] /= nf[1]; hv[q][2] /= nf[2]; hv[q][3] /= nf[3]; }
#pragma unroll
        for (int q = 0; q < 4; ++q) { oa[q] = oa[q] + hv[q]; ss += (oa[q][0] * oa[q][0] + oa[q][1] * oa[q][1]) + (oa[q][2] * oa[q][2] + oa[q][3] * oa[q][3]); *(f32x4*)(out + off + 4 * q) = oa[q]; }
        ss = sum8_dpp(ss);
        if (c == 0) SS[(size_t)t * 8 + xs] = ss;
    }
#undef PU_MOFF
    }
}
__device__ __forceinline__ void final_norm_phase(Frame& F) {
    const int gw = F.vcu * NWAVES + F.wave, NGW = F.G * NWAVES, lane = F.lane;
    const float* SS = (const float*)(F.ws + WS_SS); const float* fn = F.in[I_FNORM]; float* out = F.out;
    f32x4 g[4];
#pragma unroll
    for (int q = 0; q < 4; ++q) g[q] = *(const f32x4*)(fn + 4 * (lane + 64 * q));
    for (int t = gw; t < T; t += NGW) {
        const f32x4 s0 = *(const f32x4*)(SS + (size_t)t * 8), s1 = *(const f32x4*)(SS + (size_t)t * 8 + 4);
        const float r2 = __builtin_amdgcn_rsqf((((s0[0] + s0[1]) + (s0[2] + s0[3])) + ((s1[0] + s1[1]) + (s1[2] + s1[3]))) * (1.f / D) + RMS_EPS);
        f32x4* op = (f32x4*)(out + (size_t)t * D) + lane;
#pragma unroll
        for (int q = 0; q < 4; ++q) op[64 * q] = op[64 * q] * r2 * g[q];
    }
}

struct Args { const float* in[15]; float* out; unsigned char* ws; int ph_lo, ph_hi, li, pad; };
__global__ void __launch_bounds__(NWAVES * 64, 2) fwd(Args args) {
    extern __shared__ __attribute__((aligned(16))) unsigned char lds[];
    Frame F;
    F.lds = (LAS unsigned char*)lds;
    F.MISC = (volatile LAS unsigned*)(F.lds + MISC_OFF);
    F.tid = threadIdx.x; F.lane = F.tid & 63; F.wave = __builtin_amdgcn_readfirstlane(F.tid >> 6);
    F.G = gridDim.x; { const int bx = blockIdx.x; F.vcu = (F.G % 8 == 0) ? (bx % 8) * (F.G / 8) + bx / 8 : bx; }
    F.ws = args.ws; F.ctl = (gu32*)(args.ws + WS_CTL);
#pragma unroll
    for (int i = 0; i < 15; ++i) F.in[i] = args.in[i];
    F.out = args.out;
    for (int u = F.tid; u < (LDS_BYTES - RING_BYTES) / 4; u += NWAVES * 64) ((LAS unsigned*)(F.lds + RING_BYTES))[u] = 0u;
    __syncthreads();
    XcdBarrier bar; bar.bar = (unsigned*)(F.ctl + CW_BAR); bar.x = 0; bar.st = nullptr;
    if (N_LAUNCHES == 1) bar = xcd_barrier_post((unsigned*)(F.ctl + CW_BAR), F.MISC + 8);
    F.xcc = (int)xb_xcc_id();
    if (F.tid == 0) F.MISC[16] = xb_add((unsigned*)(F.ctl + CW_RANK + 64 * (F.xcc & 15)), 1u);
    __syncthreads();
    F.xrank = (int)F.MISC[16];
#define GRID_BAR() do { if (N_LAUNCHES == 1) xcd_barrier(bar); } while (0)
    const int lo = args.ph_lo, hi = args.ph_hi, bx = (int)blockIdx.x;
#define IN(k) (lo <= (k) && (k) < hi)
#define BOTH(k) (IN(k) && IN((k) + 1))
    unsigned char* ws = args.ws;

    if (IN(0)) { p0_prologue(F); if (BOTH(0)) GRID_BAR(); }

    if (IN(1)) {
        Gemm g{(const bf16*)(ws + WS_U8), (const bf16*)(ws + WS_WQKV8), T, NP1, D / 2}; QkvOrder S; S.init(T, NP1, F.G, bx); S.U = (const char*)(ws + WS_U8);
        EpiQKV E{(bf16*)(ws + WS_Q), (const float*)(ws + WS_ROPE), (const float*)(ws + WS_SU), (const float*)(ws + WS_SW), ws + WS_SGA, F.in[I_GBIAS] + D};
        gemm_phase<EpiQKV, QkvOrder, true, true, true, true>(F.lds, g, S, E);
        if (BOTH(1)) GRID_BAR();
    }
    if (IN(2)) { attn_phase(F, (bf16*)(ws + WS_Q), (float*)(ws + WS_LSE)); if (BOTH(2)) GRID_BAR(); }
    if (IN(3)) {
        { const int nwg = (T / 256) * ((NCG - 512) / 256), rem = nwg % F.G;
          if (rem == 0) combine_phase(F, F.vcu, F.G); else if (bx >= rem) combine_phase(F, bx - rem, F.G - rem); }
        Gemm g{(const bf16*)(ws + WS_U8), (const bf16*)(ws + WS_WQKV8 + (size_t)NP1 * D), T, NCG - 512, D / 2}; StaticOrder S; S.init(T, NCG - 512, F.G, bx);
        EpiCG E{(bf16*)((unsigned char*)F.out + OS_BB), (bf16*)(ws + WS_Z), ws + WS_SGC, ws + WS_SGA, F.in[I_GBIAS], (const float*)(ws + WS_SU), (const float*)(ws + WS_SW)};
        gemm_phase<EpiCG, StaticOrder, true, true, false, true>(F.lds, g, S, E);
        if (BOTH(3)) GRID_BAR();
    }
    if (IN(4)) { p4_wfold(F); p4_conv(F); if (BOTH(4)) GRID_BAR(); }
    if (IN(5)) {
        Gemm gc{(const bf16*)((unsigned char*)F.out + OS_BB), (const bf16*)(ws + WS_WCONV), T, D, D}, ga{(const bf16*)(ws + WS_O), (const bf16*)(ws + WS_WATTN), T, D, DAO};
        StaticOrder S; S.init(T, D, F.G, bx);
        if ((bx & 8) == 0) {
            { EpiY<0> E{(bf16*)(ws + WS_Y), ws + WS_SGC}; gemm_phase<EpiY<0>, StaticOrder, true, true>(F.lds, gc, S, E); }
            { EpiY<1> E{(bf16*)(ws + WS_Y), ws + WS_SGA}; gemm_phase<EpiY<1>, StaticOrder, true, true>(F.lds, ga, S, E); }
        } else {
            { EpiY<0> E{(bf16*)(ws + WS_Y), ws + WS_SGA}; gemm_phase<EpiY<0>, StaticOrder, true, true>(F.lds, ga, S, E); }
            { EpiY<1> E{(bf16*)(ws + WS_Y), ws + WS_SGC}; gemm_phase<EpiY<1>, StaticOrder, true, true>(F.lds, gc, S, E); }
        }
        if (BOTH(5)) GRID_BAR();
    }
    if (IN(6)) {
        Gemm g{(const bf16*)(ws + WS_Y), (const bf16*)(ws + WS_WOUT), T, D, D}; StaticOrder S; S.init(T, D, F.G, bx);
        EpiOut E{F.in[I_X], (bf16*)(ws + WS_HG), F.in[I_NFFN], (float*)(ws + WS_RSQ), ws + WS_HG8, (float*)(ws + WS_HSC)};
        gemm_phase<EpiOut, StaticOrder, true, true>(F.lds, g, S, E);

        if (BOTH(6)) GRID_BAR();
    }
    if (IN(7)) {
        Gemm g{(const bf16*)(ws + WS_HG), (const bf16*)((unsigned char*)F.out + OS_WFOLD), T, 2048, D}; StaticOrder S; S.init(T, 2048, F.G, bx);
        float* scr = (float*)(ws + (bx < 128 ? WS_SCR0 + (size_t)bx * 262144 : (bx < 192 ? WS_SCR1 + (size_t)(bx - 128) * 262144 : WS_SCR2 + (size_t)(bx - 192) * 262144)));
        EpiTopk E{scr, (const float*)(ws + WS_RSQ), (int*)(ws + WS_IDX), (float*)(ws + WS_GATE),
                  CvCtx{F.in[I_DOWN], F.in[I_UP], (unsigned char*)F.out + OS_EDOWN, ws + WS_EUP, (float*)(ws + WS_ESCALE), F.lane}, F.vcu * NWAVES + F.wave, F.G * NWAVES};
        if ((bx & 8) != 0) { cv_rows(E.CV, E.cvr, E.cvstep); E.cvr = 2 * NEXP; }
        const int cvkeep = E.cvr; E.cvr = 2 * NEXP;
        gemm_phase<EpiTopk, StaticOrder, true, true>(F.lds, g, S, E);
        E.cvr = cvkeep;
        cv_rows(E.CV, E.cvr, E.cvstep);
        if (BOTH(7)) GRID_BAR();
    }
    if (IN(8)) { peer_down_phase(F); if (BOTH(8)) GRID_BAR(); }
    if (IN(9)) { peer_up_phase(F); if (BOTH(9)) GRID_BAR(); }
    if (IN(10)) { final_norm_phase(F); }
#undef IN
#undef BOTH
}

extern "C" void kernel_launch(void* const* d_in, const int* in_sizes, int n_in, void* d_out, int out_size, void* d_ws, size_t ws_size, hipStream_t stream) {
    static int grid = 0;
    if (grid == 0) {
        if (n_in != 15 || out_size != T * D || ws_size < WS_END) { fprintf(stderr, "kernel_launch: unexpected shapes (n_in %d, out %d, ws %zu)\n", n_in, out_size, ws_size); grid = -1; return; }
        int dev = 0, cus = 0, per_cu = 0;
        if (hipGetDevice(&dev) != hipSuccess || hipDeviceGetAttribute(&cus, hipDeviceAttributeMultiprocessorCount, dev) != hipSuccess) { grid = -1; return; }
        if (hipFuncSetAttribute((const void*)fwd, hipFuncAttributeMaxDynamicSharedMemorySize, LDS_BYTES) != hipSuccess) { fprintf(stderr, "kernel_launch: hipFuncSetAttribute failed\n"); grid = -1; return; }
        if (hipOccupancyMaxActiveBlocksPerMultiprocessor(&per_cu, (const void*)fwd, NWAVES * 64, LDS_BYTES) != hipSuccess || per_cu < 1) fprintf(stderr, "kernel_launch: occupancy query reports %d\n", per_cu);
        (void)hipGetLastError();
        grid = cus > 256 ? 256 : cus;
    }
    if (grid < 0) return;
    if (hipMemsetAsync((char*)d_ws + WS_CTL, 0, CTL_ZERO_BYTES, stream) != hipSuccess) return;
    Args a{};
    for (int i = 0; i < 15; ++i) a.in[i] = (const float*)d_in[i];
    a.out = (float*)d_out; a.ws = (unsigned char*)d_ws;
    for (int li = 0; li < N_LAUNCHES; ++li) {
        a.ph_lo = (N_LAUNCHES == 1) ? 0 : li; a.ph_hi = (N_LAUNCHES == 1) ? N_PHASES : li + 1; a.li = li; a.pad = 0;
        hipLaunchKernelGGL(fwd, dim3(grid), dim3(NWAVES * 64), LDS_BYTES, stream, a);
    }
}
```

```cpp
#include <hip/hip_runtime.h>
#include <cstdio>
#include <cstdint>
namespace pg8 {
#define PG8_LAS __attribute__((address_space(3)))
typedef unsigned short bf16_t;
typedef short bf16x8 __attribute__((ext_vector_type(8)));
typedef float f32x4 __attribute__((ext_vector_type(4)));
typedef unsigned u32x4 __attribute__((ext_vector_type(4)));
typedef int v4i32_t __attribute__((ext_vector_type(4)));
typedef int v8i32_t __attribute__((ext_vector_type(8)));
constexpr int BM = 256, BK = 64, HALF = 128, HTB = HALF * BK * 2  , STAGE_BYTES = 8 * HTB, NXCD = 8, WGM = 8;

__host__ __device__ __forceinline__ int lds_byte(int r, int c) { const int st = (r >> 4) * 2 + (c >> 5), rr = r & 15, cc = c & 31, ob = rr * 64 + cc * 2; return st * 1024 + (ob ^ (((ob >> 9) & 1) << 5)); }
__host__ __device__ __forceinline__ void stage_rc(int b, int& R, int& C) { const int st = b / 1024, sb = b % 1024, swz = sb ^ (((sb >> 9) & 1) << 5); R = (st >> 1) * 16 + swz / 64; C = (st & 1) * 32 + (swz % 64) / 2; }
__host__ __device__ __forceinline__ int perm32(int rho) { const int n = rho >> 4, i = rho & 15; return 8 * (i >> 2) + 4 * n + (i & 3); }

struct Unit { int pm, pn; };
struct Gemm { const bf16_t* A; const bf16_t* Bt; int M, N, K; };

struct StaticOrder {
    int nM, nN, nwg, G, c;
    __host__ __device__ void init(int M, int N, int G_, int c_) { nM = M / BM; nN = N / BM; nwg = nM * nN; G = G_; c = c_; }
    __host__ __device__ bool next(int i, Unit& u) const {
        const long L = (long)i * G + c; if (L >= nwg) return false;
        int wgid = (int)L; { const int q = nwg / NXCD, r = nwg % NXCD, xcd = wgid % NXCD, off = wgid / NXCD; wgid = (xcd < r ? xcd * (q + 1) : r * (q + 1) + (xcd - r) * q) + off; }
        const int nig = WGM * nN, gid = wgid / nig, fm = gid * WGM, gsz = (nM - fm) < WGM ? (nM - fm) : WGM;
        u.pm = fm + ((wgid % nig) % gsz); u.pn = (wgid % nig) / gsz; return true;
    }
    __device__ __forceinline__ void a_ready(const Unit&) const {}
    __device__ __forceinline__ void done(const Unit&) const {}
};

__device__ __forceinline__ unsigned cvt_pk_bf16(float lo, float hi) { unsigned r; asm volatile("v_cvt_pk_bf16_f32 %0, %1, %2" : "=v"(r) : "v"(lo), "v"(hi)); return r; }
typedef float f32x2 __attribute__((ext_vector_type(2)));

template <class Epi, class Sched, bool ALIGN_EPI = false, bool SP2 = false, bool STRIDED_A = false, bool I8 = false>
__device__ __forceinline__ void gemm_phase(PG8_LAS unsigned char* lds, const Gemm g, const Sched& S, const Epi& E) {
    const int tid = threadIdx.x, wid = __builtin_amdgcn_readfirstlane(tid >> 6), lane = tid & 63, wr = wid >> 2, wc = wid & 3, fr = lane & 15, fq = lane >> 4;
    const int K = g.K; int nt = K / BK;
    if constexpr (I8) asm volatile("" : "+s"(nt));
    unsigned voffA[2], voffB[2];
#pragma unroll
    for (int i = 0; i < 2; ++i) { int R, C; stage_rc(tid * 16 + i * 8192, R, C); const int Rb = Epi::PERM ? ((R & ~31) + perm32(R & 31)) : R;
        voffA[i] = (unsigned)(R * K + C) * 2u; voffB[i] = (unsigned)(Rb * K + C) * 2u; }
    unsigned rkA = 0, c2A = 0; const unsigned rk64 = 64u * (unsigned)K * 2u;
    if constexpr (STRIDED_A) { int R, C; stage_rc(tid * 16, R, C); rkA = (unsigned)(R * K) * 2u; c2A = (unsigned)C * 2u; }
    const size_t kstep = (size_t)(BK * 2);
    const size_t hstep = (size_t)HALF * K * 2;
    const size_t tstep = 2 * hstep;
    const unsigned ldsw = (unsigned)wid * 1024u;
    const int aoff = lds_byte(wr * 64 + fr, fq * 8), boff = lds_byte(wc * 32 + fr, fq * 8);
#define PG8_SA(b, h) (((b) * 2 + (h)) * HTB)
#define PG8_SB(b, h) ((4 + (b) * 2 + (h)) * HTB)
#define PG8_STAGE(bufoff, gbase, voff) do { _Pragma("unroll") for (int _i = 0; _i < 2; ++_i) \
        __builtin_amdgcn_global_load_lds((const unsigned*)((const char*)(gbase) + (voff)[_i]), (PG8_LAS unsigned*)(lds + (bufoff) + ldsw + _i * 8192), 16, 0, 0); } while (0)
#define PG8_STAGE_A(bufoff, gbase, sh) do { if constexpr (STRIDED_A) { _Pragma("unroll") for (int _i = 0; _i < 2; ++_i) { const unsigned _vo = ((rkA + _i * rk64) << (sh)) + c2A; \
        __builtin_amdgcn_global_load_lds((const unsigned*)((const char*)(gbase) + _vo), (PG8_LAS unsigned*)(lds + (bufoff) + ldsw + _i * 8192), 16, 0, 0); } } else { PG8_STAGE(bufoff, gbase, voffA); } } while (0)
#define PG8_LDA(dst, b, h) do { _Pragma("unroll") for (int m = 0; m < 4; ++m) _Pragma("unroll") for (int k = 0; k < 2; ++k) dst[m][k] = *(const PG8_LAS bf16x8*)(lds + PG8_SA(b, h) + aoff + m * 2048 + k * 1024); } while (0)
#define PG8_LDB(dst, b, h) do { _Pragma("unroll") for (int n = 0; n < 2; ++n) _Pragma("unroll") for (int k = 0; k < 2; ++k) dst[n][k] = *(const PG8_LAS bf16x8*)(lds + PG8_SB(b, h) + boff + n * 2048 + k * 1024); } while (0)
#define PG8_MMA(ai, bj, At, Bt) do { __builtin_amdgcn_s_setprio(1); _Pragma("unroll") for (int m = 0; m < 4; ++m) _Pragma("unroll") for (int n = 0; n < 2; ++n) _Pragma("unroll") for (int k = 0; k < 2; ++k) \
        { if constexpr (I8) acc[ai][bj][m][n] = __builtin_bit_cast(f32x4, __builtin_amdgcn_mfma_i32_16x16x64_i8(__builtin_bit_cast(v4i32_t, Bt[n][k]), __builtin_bit_cast(v4i32_t, At[m][k]), __builtin_bit_cast(v4i32_t, acc[ai][bj][m][n]), 0, 0, 0)); \
          else acc[ai][bj][m][n] = __builtin_amdgcn_mfma_f32_16x16x32_bf16(Bt[n][k], At[m][k], acc[ai][bj][m][n], 0, 0, 0); } __builtin_amdgcn_s_setprio(0); } while (0)
#define PG8_WAIT_V(n) asm volatile("s_waitcnt vmcnt(" #n ")" ::: "memory")
#define PG8_WAIT_L(n) asm volatile("s_waitcnt lgkmcnt(" #n ")" ::: "memory")
#define PG8_BAR __builtin_amdgcn_s_barrier()
#define PG8_SCHED __builtin_amdgcn_sched_barrier(0)
    Unit cur, nxt; int ui = 0;
    if (!S.next(0, cur)) return;
    f32x4 acc[2][2][4][2];
#pragma unroll
    for (int a = 0; a < 2; ++a)
#pragma unroll
        for (int b = 0; b < 2; ++b)
#pragma unroll
            for (int m = 0; m < 4; ++m)
#pragma unroll
                for (int n = 0; n < 2; ++n) acc[a][b][m][n] = (f32x4){0.f, 0.f, 0.f, 0.f};
    bf16x8 At[4][2], B0[2][2], B1[2][2];
    int csh = 0, nsh = 0;
    const char* cA; if constexpr (STRIDED_A) cA = S.a_base(cur, csh); else cA = (const char*)g.A + (size_t)cur.pm * tstep;
    const char* cB = (const char*)g.Bt + (size_t)cur.pn * tstep;
    S.a_ready(cur);
    if constexpr (SP2) {
        PG8_STAGE(PG8_SB(0, 0), cB, voffB); PG8_STAGE(PG8_SB(0, 1), cB + hstep, voffB); PG8_STAGE_A(PG8_SA(0, 0), cA, csh); PG8_STAGE_A(PG8_SA(0, 1), cA + (hstep << csh), csh);
        if (wr == 1) PG8_BAR;
        PG8_WAIT_V(2); PG8_BAR;
        PG8_STAGE(PG8_SB(1, 0), cB + kstep, voffB); PG8_STAGE_A(PG8_SA(1, 0), cA + kstep, csh); PG8_STAGE(PG8_SB(1, 1), cB + hstep + kstep, voffB);
        PG8_WAIT_V(6); PG8_BAR;
    } else {
        PG8_STAGE(PG8_SB(0, 0), cB, voffB); PG8_STAGE_A(PG8_SA(0, 0), cA, csh); PG8_STAGE(PG8_SB(0, 1), cB + hstep, voffB); PG8_STAGE_A(PG8_SA(0, 1), cA + (hstep << csh), csh);
        if (wr == 1) PG8_BAR;
        PG8_WAIT_V(4); PG8_BAR;
        PG8_STAGE(PG8_SB(1, 0), cB + kstep, voffB); PG8_STAGE_A(PG8_SA(1, 0), cA + kstep, csh); PG8_STAGE(PG8_SB(1, 1), cB + hstep + kstep, voffB);
        PG8_WAIT_V(6); PG8_BAR;
    }
    asm volatile(".p2align 8" ::: "memory");
    for (;;) {
        const bool has_next = S.next(ui + 1, nxt);
        const char* nA; if constexpr (STRIDED_A) { nsh = csh; nA = has_next ? S.a_base(nxt, nsh) : cA; } else nA = has_next ? (const char*)g.A + (size_t)nxt.pm * tstep : cA;
        const char* nB = has_next ? (const char*)g.Bt + (size_t)nxt.pn * tstep : cB;
        for (int t = 0; t < nt; t += 2) {
            const bool last = (t == nt - 2);
            const char* a1 = cA + (size_t)(t + 1) * kstep;
            const char* a2 = last ? nA : cA + (size_t)(t + 2) * kstep; const char* b2 = last ? nB : cB + (size_t)(t + 2) * kstep;
            const char* a3 = a2 + kstep; const char* b3 = b2 + kstep;
            const int sh2 = last ? nsh : csh; const size_t hA1 = hstep << csh, hA2 = hstep << sh2;
            if (last && has_next) S.a_ready(nxt);
            if constexpr (SP2) {
            PG8_LDB(B0, 0, 0); PG8_LDB(B1, 0, 1); PG8_SCHED; PG8_LDA(At, 0, 0); PG8_STAGE_A(PG8_SA(1, 1), a1 + hA1, csh);
            PG8_WAIT_V(8); PG8_WAIT_L(0); PG8_BAR; PG8_MMA(0, 0, At, B0); PG8_MMA(0, 1, At, B1); PG8_BAR; PG8_SCHED;
            PG8_LDA(At, 0, 1); PG8_STAGE(PG8_SB(0, 0), b2, voffB); PG8_STAGE(PG8_SB(0, 1), b2 + hstep, voffB); PG8_STAGE_A(PG8_SA(0, 0), a2, sh2);
            PG8_WAIT_V(8); PG8_WAIT_L(0); PG8_BAR; PG8_MMA(1, 0, At, B0); PG8_MMA(1, 1, At, B1); PG8_BAR; PG8_SCHED;
            PG8_LDB(B0, 1, 0); PG8_LDB(B1, 1, 1); PG8_SCHED; PG8_LDA(At, 1, 0); PG8_STAGE_A(PG8_SA(0, 1), a2 + hA2, sh2);
            PG8_WAIT_V(8); PG8_WAIT_L(0); PG8_BAR; PG8_MMA(0, 0, At, B0); PG8_MMA(0, 1, At, B1); PG8_BAR; PG8_SCHED;
            PG8_LDA(At, 1, 1); PG8_STAGE(PG8_SB(1, 0), b3, voffB); PG8_STAGE(PG8_SB(1, 1), b3 + hstep, voffB); PG8_STAGE_A(PG8_SA(1, 0), a3, sh2);
            PG8_WAIT_V(8); PG8_WAIT_L(0); PG8_BAR; PG8_MMA(1, 0, At, B0); PG8_MMA(1, 1, At, B1); PG8_BAR; PG8_SCHED;
            } else {
            PG8_LDB(B0, 0, 0); PG8_SCHED; PG8_LDA(At, 0, 0); PG8_STAGE_A(PG8_SA(1, 1), a1 + hA1, csh);
            PG8_WAIT_L(8); PG8_BAR; PG8_WAIT_L(0); PG8_MMA(0, 0, At, B0); PG8_BAR; PG8_SCHED;
            PG8_LDB(B1, 0, 1); PG8_STAGE(PG8_SB(0, 0), b2, voffB);
            PG8_BAR; PG8_WAIT_L(0); PG8_MMA(0, 1, At, B1); PG8_BAR;
            PG8_LDA(At, 0, 1); PG8_STAGE_A(PG8_SA(0, 0), a2, sh2);
            PG8_BAR; PG8_WAIT_L(0); PG8_MMA(1, 0, At, B0); PG8_BAR; PG8_SCHED;
            PG8_STAGE(PG8_SB(0, 1), b2 + hstep, voffB);
            PG8_WAIT_V(6); PG8_BAR; PG8_MMA(1, 1, At, B1); PG8_BAR;
            PG8_LDB(B0, 1, 0); PG8_SCHED; PG8_LDA(At, 1, 0); PG8_STAGE_A(PG8_SA(0, 1), a2 + hA2, sh2);
            PG8_WAIT_L(8); PG8_BAR; PG8_WAIT_L(0); PG8_MMA(0, 0, At, B0); PG8_BAR; PG8_SCHED;
            PG8_LDB(B1, 1, 1); PG8_STAGE(PG8_SB(1, 0), b3, voffB);
            PG8_BAR; PG8_WAIT_L(0); PG8_MMA(0, 1, At, B1); PG8_BAR;
            PG8_LDA(At, 1, 1); PG8_STAGE_A(PG8_SA(1, 0), a3, sh2);
            PG8_BAR; PG8_WAIT_L(0); PG8_MMA(1, 0, At, B0); PG8_BAR; PG8_SCHED;
            PG8_STAGE(PG8_SB(1, 1), b3 + hstep, voffB);
            PG8_WAIT_V(6); PG8_BAR; PG8_MMA(1, 1, At, B1); PG8_BAR;
            }
        }
        if constexpr (ALIGN_EPI) { if (wr == 0) PG8_BAR; }
        if constexpr (I8) {
#pragma unroll
            for (int a = 0; a < 2; ++a)
#pragma unroll
                for (int b = 0; b < 2; ++b)
#pragma unroll
                    for (int m = 0; m < 4; ++m)
#pragma unroll
                        for (int n = 0; n < 2; ++n) { const v4i32_t iv = __builtin_bit_cast(v4i32_t, acc[a][b][m][n]); acc[a][b][m][n] = (f32x4){(float)iv[0], (float)iv[1], (float)iv[2], (float)iv[3]}; }
        }
        if constexpr (!Epi::AFTER_DRAIN) { E(acc, cur, wr, wc, fr, fq); S.done(cur); }
        if (!has_next) break;
#pragma unroll
        for (int a = 0; a < 2; ++a)
#pragma unroll
            for (int b = 0; b < 2; ++b)
#pragma unroll
                for (int m = 0; m < 4; ++m)
#pragma unroll
                    for (int n = 0; n < 2; ++n) acc[a][b][m][n] = (f32x4){0.f, 0.f, 0.f, 0.f};
        cur = nxt; cA = nA; cB = nB; csh = nsh; ++ui;
        if constexpr (ALIGN_EPI) { if (wr == 1) PG8_BAR; }
    }
    PG8_WAIT_V(0);
    if constexpr (!ALIGN_EPI) { if (wr == 0) PG8_BAR; }
    PG8_BAR;
    if constexpr (Epi::AFTER_DRAIN) { E.fused(acc, cur, wr, wc, fr, fq, lds, wid, lane); S.done(cur); }
#undef PG8_SA
#undef PG8_SB
#undef PG8_STAGE
#undef PG8_STAGE_A
#undef PG8_LDA
#undef PG8_LDB
#undef PG8_MMA
#undef PG8_WAIT_V
#undef PG8_WAIT_L
#undef PG8_BAR
#undef PG8_SCHED
}
}

#define GAS __attribute__((address_space(1)))
#define LAS __attribute__((address_space(3)))
typedef unsigned short bf16;
typedef unsigned v4u __attribute__((ext_vector_type(4)));
typedef float f32x4 __attribute__((ext_vector_type(4)));
typedef short bf16x8 __attribute__((ext_vector_type(8)));
typedef GAS unsigned gu32;
typedef GAS unsigned long long gu64;
#define RLX_AGENT __ATOMIC_RELAXED, __HIP_MEMORY_SCOPE_AGENT
#define LDS_WAIT() asm volatile("s_waitcnt lgkmcnt(0)" ::: "memory")
#define VM_WAIT() asm volatile("s_waitcnt vmcnt(0)" ::: "memory")
__device__ __forceinline__ unsigned long long rt() { return __builtin_amdgcn_s_memrealtime(); }
__device__ __forceinline__ unsigned f2bf(float f) { unsigned u = __builtin_bit_cast(unsigned, f); return (u + 0x7fffu + ((u >> 16) & 1u)) >> 16; }
__device__ __forceinline__ unsigned pk2(float lo, float hi) { return f2bf(lo) | (f2bf(hi) << 16); }

#define XB_TMO      128
#define XB_XCNT(j)  (256  + 64 * (j))
#define XB_XSUB(j)  (1280 + 64 * (j))
#define XB_XGEN(j)  (2304 + 64 * (j))
#define XB_TOP      3328
#define XB_TOPGEN   3392
#define XCD_BAR_WORDS 3456
#define XB_SPIN_CAP (1u << 18)

__device__ __forceinline__ unsigned xb_ld(unsigned* p)              { return __hip_atomic_load(p, __ATOMIC_RELAXED, __HIP_MEMORY_SCOPE_AGENT); }
__device__ __forceinline__ unsigned xb_add(unsigned* p, unsigned v) { return __hip_atomic_fetch_add(p, v, __ATOMIC_RELAXED, __HIP_MEMORY_SCOPE_AGENT); }
__device__ __forceinline__ unsigned xb_xcc_id() { return (unsigned)__builtin_amdgcn_s_getreg((3 << 11) | 20) & 0xFu; }
#define XB_SPIN(cond, bar) do { unsigned _sp = 0; while (cond) { __builtin_amdgcn_s_sleep(1); \
    if ((++_sp & 255u) == 0u) { if (xb_ld(&(bar)[XB_TMO])) break; if (_sp > XB_SPIN_CAP) { atomicAdd(&(bar)[XB_TMO], 1u); break; } } } } while (0)

struct XcdBarrier {
    unsigned* bar; unsigned x;
    volatile LAS unsigned* st;
};

__device__ __forceinline__ XcdBarrier xcd_barrier_post(unsigned* bar, volatile LAS unsigned* st) {
    XcdBarrier b; b.bar = bar; b.x = xb_xcc_id(); b.st = st;
    if (threadIdx.x == 0) (void)xb_add(&bar[XB_XCNT(b.x)], 1u);
    return b;
}
__device__ __forceinline__ void xcd_barrier_complete(unsigned* bar, unsigned x, unsigned& nloc, unsigned& nx) {
    const unsigned G = gridDim.x * gridDim.y * gridDim.z;
    unsigned sum, cnt, mine, sp = 0u;
    for (;;) {
        sum = 0u; cnt = 0u; mine = 0u;
#pragma unroll
        for (unsigned j = 0; j < 16; ++j) { const unsigned c = xb_ld(&bar[XB_XCNT(j)]); sum += c; cnt += (c > 0u) ? 1u : 0u; mine = (j == x) ? c : mine; }
        if (sum == G) break;
        __builtin_amdgcn_s_sleep(1);
        if ((++sp & 255u) == 0u) { if (xb_ld(&bar[XB_TMO])) break; if (sp > XB_SPIN_CAP) { atomicAdd(&bar[XB_TMO], 1u); break; } }
    }
    nloc = mine > 0u ? mine : 1u; nx = cnt > 0u ? cnt : 1u;
}

__device__ __forceinline__ void xcd_barrier(const XcdBarrier& b) {
    asm volatile("s_waitcnt vmcnt(0)" ::: "memory");
    __syncthreads();
    if (threadIdx.x == 0) {
        unsigned* bar = b.bar;
        __builtin_amdgcn_s_waitcnt(0);
        unsigned nloc = b.st[0], nx = b.st[1];
        if (nloc == 0u) { xcd_barrier_complete(bar, b.x, nloc, nx); b.st[0] = nloc; b.st[1] = nx; }
        const unsigned old = xb_add(&bar[XB_XSUB(b.x)], 1u);
        const unsigned gen = old / nloc;
        if (old + 1u == (gen + 1u) * nloc) {
            __builtin_amdgcn_fence(__ATOMIC_RELEASE, "agent");
            asm volatile("s_waitcnt vmcnt(0)" ::: "memory");
            const unsigned og = xb_add(&bar[XB_TOP], 1u);
            const unsigned tg = og / nx;
            if (og + 1u == (tg + 1u) * nx) xb_add(&bar[XB_TOPGEN], 1u);
            else XB_SPIN(xb_ld(&bar[XB_TOPGEN]) == tg, bar);
            __builtin_amdgcn_fence(__ATOMIC_ACQUIRE, "agent");
            xb_add(&bar[XB_XGEN(b.x)], 1u);
            asm volatile("s_waitcnt vmcnt(0)" ::: "memory");
        } else {
            XB_SPIN(xb_ld(&bar[XB_XGEN(b.x)]) == gen, bar);
            __builtin_amdgcn_fence(__ATOMIC_ACQUIRE, "agent");
            asm volatile("s_waitcnt vmcnt(0)" ::: "memory");
        }
    }
    __syncthreads();
}


constexpr int NWAVES = 8;
#ifndef MK_N_LAUNCHES
#define MK_N_LAUNCHES 1
#endif
constexpr int N_PHASES = 11;
constexpr int N_LAUNCHES = MK_N_LAUNCHES;
constexpr int BATCH = 2, SEQ = 8192, T = BATCH * SEQ, D = 1024;
constexpr int DIN = 9728, NQKV = 4608, NCG = 5120, GW = 512, DAO = 512;
constexpr int NP1 = NQKV + 512;
constexpr int NEXP = 16384, PEER_H = 8, PEER_K = 16, HK = 128;
constexpr float RMS_EPS = 1e-6f;
constexpr float C2 = 0.125f * 1.4426950408889634f;
constexpr float LN2 = 0.6931471805599453f;

constexpr size_t MiB = 1u << 20;
constexpr size_t WS_CTL = 0, CTL_ZERO_BYTES = 64 * 1024;
constexpr size_t WS_ROPE = 1 * MiB, WS_RSQ = 2 * MiB, WS_LSE = 3 * MiB;
constexpr size_t WS_U8 = 24 * MiB, WS_WQKV8 = 5 * MiB, WS_SU = 15 * MiB, WS_SW = 15 * MiB + 65536;
constexpr size_t WS_Q = 56 * MiB, WS_K = 104 * MiB, WS_V = 152 * MiB, WS_O = 200 * MiB;
constexpr size_t WS_Z = 136 * MiB, WS_SGC = 168 * MiB, WS_SGA = 216 * MiB;
constexpr size_t OS_BB = 0, OS_EDOWN = 32 * MiB, OS_WFOLD = 48 * MiB;
constexpr size_t WS_WCONV = 248 * MiB, WS_WATTN = 250 * MiB, WS_WOUT = 251 * MiB;
constexpr size_t WS_EUP = 104 * MiB, WS_ESCALE = 253 * MiB;
constexpr size_t WS_Y = 136 * MiB, WS_H = 168 * MiB, WS_HG = 24 * MiB;
constexpr size_t WS_IDX = 9 * MiB, WS_GATE = 120 * MiB, WS_WB = 56 * MiB, WS_SS = 64 * MiB, WS_HG8 = 65 * MiB, WS_HSC = 81 * MiB;
constexpr size_t WS_SCR0 = 136 * MiB, WS_SCR1 = 88 * MiB, WS_SCR2 = 232 * MiB;
constexpr size_t WS_END = 256 * MiB;
constexpr int CW_TMO = 0, CW_BAR = 1024, CW_RANK = 8192;

constexpr int RING_BYTES = 131072, MISC_OFF = RING_BYTES + 320, LDS_BYTES = 147456;

using pg8::Unit; using pg8::Gemm; using pg8::StaticOrder; using pg8::gemm_phase; using pg8::cvt_pk_bf16;
typedef unsigned short bf16;
typedef unsigned u32x4 __attribute__((ext_vector_type(4)));
typedef unsigned u32x2 __attribute__((ext_vector_type(2)));
typedef float f32x4 __attribute__((ext_vector_type(4)));
typedef float f32x2 __attribute__((ext_vector_type(2)));
typedef short bf16x8 __attribute__((ext_vector_type(8)));
typedef short s16x4 __attribute__((ext_vector_type(4)));
typedef short v4i16_t __attribute__((ext_vector_type(4)));
#define LAS __attribute__((address_space(3)))

__device__ __forceinline__ float bf_lo(unsigned w) { return __builtin_bit_cast(float, w << 16); }
__device__ __forceinline__ float bf_hi(unsigned w) { return __builtin_bit_cast(float, w & 0xffff0000u); }
__device__ __forceinline__ u32x4 pack8(f32x4 a, f32x4 b) { u32x4 w; w.x = cvt_pk_bf16(a[0], a[1]); w.y = cvt_pk_bf16(a[2], a[3]); w.z = cvt_pk_bf16(b[0], b[1]); w.w = cvt_pk_bf16(b[2], b[3]); return w; }
__device__ __forceinline__ void unpack8(u32x4 w, f32x4& a, f32x4& b) { a = (f32x4){bf_lo(w.x), bf_hi(w.x), bf_lo(w.y), bf_hi(w.y)}; b = (f32x4){bf_lo(w.z), bf_hi(w.z), bf_lo(w.w), bf_hi(w.w)}; }
template <int CTRL> __device__ __forceinline__ float dppf(float v) { const int x = __builtin_bit_cast(int, v); return __builtin_bit_cast(float, __builtin_amdgcn_update_dpp(x, x, CTRL, 0xf, 0xf, true)); }
__device__ __forceinline__ float sum4_dpp(float v) { v += dppf<0xB1>(v); v += dppf<0x4E>(v); return v; }
__device__ __forceinline__ float sum8_dpp(float v) { v = sum4_dpp(v); v += dppf<0x141>(v); return v; }
__device__ __forceinline__ float sum16_dpp(float v) { v = sum8_dpp(v); v += dppf<0x140>(v); return v; }
__device__ __forceinline__ float max16_dpp(float v) { v = fmaxf(v, dppf<0xB1>(v)); v = fmaxf(v, dppf<0x4E>(v)); v = fmaxf(v, dppf<0x141>(v)); v = fmaxf(v, dppf<0x140>(v)); return v; }
__device__ __forceinline__ float rl_(float v, int l) { return __builtin_bit_cast(float, __builtin_amdgcn_readlane(__builtin_bit_cast(int, v), l)); }
__device__ __forceinline__ float wave_sum(float v) { v = sum16_dpp(v); return (rl_(v, 0) + rl_(v, 16)) + (rl_(v, 32) + rl_(v, 48)); }
__device__ __forceinline__ float wave_max(float v) { v = max16_dpp(v); return fmaxf(fmaxf(rl_(v, 0), rl_(v, 16)), fmaxf(rl_(v, 32), rl_(v, 48))); }
__device__ __forceinline__ unsigned pack4i8(f32x4 v) { const int a = (int)__builtin_rintf(v[0]), b = (int)__builtin_rintf(v[1]), c = (int)__builtin_rintf(v[2]), d = (int)__builtin_rintf(v[3]); return (unsigned)(a & 255) | ((unsigned)(b & 255) << 8) | ((unsigned)(c & 255) << 16) | ((unsigned)d << 24); }
__device__ __forceinline__ f32x4 unpack4u8(unsigned w) { return (f32x4){(float)(w & 255u), (float)((w >> 8) & 255u), (float)((w >> 16) & 255u), (float)(w >> 24)} * (1.f / 255.f); }
__device__ __forceinline__ float xor16(float v, int fq) {
    const unsigned x = __builtin_bit_cast(unsigned, v);
    const auto r = __builtin_amdgcn_permlane16_swap(x, x, false, false);
    const unsigned a = r[0], b = r[1];
    return __builtin_bit_cast(float, (fq & 1) ? a : b);
}
__device__ __forceinline__ float xor32(float v, int fq) {
    const unsigned x = __builtin_bit_cast(unsigned, v);
    const auto r = __builtin_amdgcn_permlane32_swap(x, x, false, false);
    const unsigned a = r[0], b = r[1];
    return __builtin_bit_cast(float, (fq & 2) ? a : b);
}
__device__ __forceinline__ float sigmoidf_(float x) { return 1.f / (1.f + __expf(-x)); }

struct QkvOrder : StaticOrder {
    const char* U;
    __device__ __forceinline__ const char* a_base(const Unit& u, int& sh) const {
        const int g = (u.pn < 18) ? u.pn / 6 : 0; sh = 2 * g;
        const int b = u.pm >> 5, lp0 = (u.pm & 31) * 256;
        const int r = lp0 >> (13 - sh), i0 = lp0 & ((SEQ >> sh) - 1);
        const int t0 = b * SEQ + (i0 << sh) + r;
        return U + (size_t)t0 * D;
    }
};
struct EpiQKV {
    static constexpr bool PERM = true, AFTER_DRAIN = false;
    bf16* Q; const float* rope; const float* su; const float* sw; unsigned char* SGA; const float* gbias1;
    __device__ __forceinline__ void operator()(const f32x4 (&acc)[2][2][4][2], const Unit& u, int wr, int wc, int fr, int fq) const {
        asm volatile("" : "+v"(fr), "+v"(fq));
        if (u.pn >= 18) {
            float srv[2][4]; f32x4 bv[2][2], wv[2][2];
#pragma unroll
            for (int ai = 0; ai < 2; ++ai)
#pragma unroll
                for (int m = 0; m < 4; ++m) srv[ai][m] = *(const float*)((const unsigned char*)su + (unsigned)((u.pm * 256 + ai * 128 + wr * 64 + m * 16 + fr) * 4));
#pragma unroll
            for (int bj = 0; bj < 2; ++bj) { const int col = 512 + (u.pn - 18) * 256 + bj * 128 + wc * 32 + fq * 8, wcol = u.pn * 256 + bj * 128 + wc * 32 + fq * 8;
                bv[bj][0] = *(const f32x4*)((const unsigned char*)gbias1 + (unsigned)(col * 4)); bv[bj][1] = *(const f32x4*)((const unsigned char*)gbias1 + (unsigned)(col * 4 + 16));
                wv[bj][0] = *(const f32x4*)((const unsigned char*)sw + (unsigned)(wcol * 4)); wv[bj][1] = *(const f32x4*)((const unsigned char*)sw + (unsigned)(wcol * 4 + 16)); }
#pragma unroll
            for (int ai = 0; ai < 2; ++ai)
#pragma unroll
                for (int m = 0; m < 4; ++m) { const unsigned row = (unsigned)(u.pm * 256 + ai * 128 + wr * 64 + m * 16 + fr); const float sr = srv[ai][m];
#pragma unroll
                    for (int bj = 0; bj < 2; ++bj) { const unsigned col = (unsigned)(512 + (u.pn - 18) * 256 + bj * 128 + wc * 32 + fq * 8);
                        f32x4 v0 = acc[ai][bj][m][0] * (wv[bj][0] * sr) + bv[bj][0], v1 = acc[ai][bj][m][1] * (wv[bj][1] * sr) + bv[bj][1];
#pragma unroll
                        for (int e = 0; e < 4; ++e) { v0[e] = sigmoidf_(v0[e]) * 255.f; v1[e] = sigmoidf_(v1[e]) * 255.f; }
                        u32x2 g8; g8.x = pack4i8(v0); g8.y = pack4i8(v1);
                        *(u32x2*)(SGA + (row * (unsigned)D + col)) = g8; } }
            return;
        }
        const int g = u.pn / 6, kind = (u.pn % 6) >> 1, half = u.pn & 1, sh = 2 * g;
        bf16* base = Q + (size_t)kind * ((WS_K - WS_Q) / 2) + (size_t)g * T * GW;
        const int b = u.pm >> 5, lp0 = (u.pm & 31) * 256;
        const bool rot = (kind < 2) && ((wc & 1) == 0);
        const float sc = (kind == 0) ? C2 : 1.f;
        f32x4 swv[2][2];
#pragma unroll
        for (int bj = 0; bj < 2; ++bj) { const unsigned wco = (unsigned)((u.pn * 256 + bj * 128 + wc * 32 + fq * 8) * 4); swv[bj][0] = *(const f32x4*)((const unsigned char*)sw + wco) * sc; swv[bj][1] = *(const f32x4*)((const unsigned char*)sw + (wco + 16u)) * sc; }
        const float sgn = (fq == 0) ? -1.f : 1.f; const bool use = fq < 2;
        const unsigned char* sub = (const unsigned char*)su; const unsigned char* rpb = (const unsigned char*)rope; unsigned char* outb = (unsigned char*)base;
        const unsigned colo = (unsigned)((half * 256 + wc * 32 + fq * 8) * 2);
#pragma unroll
        for (int ai = 0; ai < 2; ++ai)
#pragma unroll
        for (int mh = 0; mh < 2; ++mh) {
            float sutv[4]; f32x4 rpv[4][4];
#pragma unroll
            for (int m = 2 * mh; m < 2 * mh + 2; ++m) {
                const int rl = ai * 128 + wr * 64 + m * 16 + fr, lp = lp0 + rl;
                const unsigned tok = (unsigned)(b * SEQ + ((lp & ((SEQ >> sh) - 1)) << sh) + (lp >> (13 - sh)));
                sutv[m] = *(const float*)(sub + tok * 4u);
                if (rot) { rpv[m][0] = *(const f32x4*)(rpb + tok * 64u); rpv[m][1] = *(const f32x4*)(rpb + (tok * 64u + 16u)); rpv[m][2] = *(const f32x4*)(rpb + (tok * 64u + 32u)); rpv[m][3] = *(const f32x4*)(rpb + (tok * 64u + 48u)); }
            }
#pragma unroll
            for (int m = 2 * mh; m < 2 * mh + 2; ++m) {
                const int rl = ai * 128 + wr * 64 + m * 16 + fr;
                const float sut = sutv[m];
                const unsigned ro = (unsigned)((u.pm * 256 + rl) * (GW * 2)) + colo;
#pragma unroll
                for (int bj = 0; bj < 2; ++bj) {
                    f32x4 v0 = acc[ai][bj][m][0] * (swv[bj][0] * sut), v1 = acc[ai][bj][m][1] * (swv[bj][1] * sut);
                    if (rot) {
                        f32x4 o0, o1;
#pragma unroll
                        for (int e = 0; e < 4; ++e) { o0[e] = xor16(v0[e], fq); o1[e] = xor16(v1[e], fq); }
                        const f32x4 r0 = v0 * rpv[m][0] + (o0 * rpv[m][2]) * sgn, r1 = v1 * rpv[m][1] + (o1 * rpv[m][3]) * sgn;
                        v0 = use ? r0 : v0; v1 = use ? r1 : v1;
                    }
                    *(u32x4*)(outb + (ro + (unsigned)(bj * 256))) = pack8(v0, v1);
                }
            }
        }
    }
};
struct EpiCG {
    static constexpr bool PERM = true, AFTER_DRAIN = false;
    bf16* Bb; bf16* Z; unsigned char* SGC; unsigned char* SGA; const float* gbias; const float* su; const float* sw;
    __device__ __forceinline__ void operator()(const f32x4 (&accin)[2][2][4][2], const Unit& u, int wr, int wc, int fr, int fq) const {
        const int pn = u.pn;
        f32x4 swv[2][2];
#pragma unroll
        for (int bj = 0; bj < 2; ++bj) { const int wcol = NP1 + pn * 256 + bj * 128 + wc * 32 + fq * 8; swv[bj][0] = *(const f32x4*)(sw + wcol); swv[bj][1] = *(const f32x4*)(sw + wcol + 4); }
        f32x4 gbv[2][2];
        if (pn >= 12) { const int gsel = (pn >= 16) ? 1 : 0;
#pragma unroll
            for (int bj = 0; bj < 2; ++bj) { const int col = (pn - 12 - 4 * gsel) * 256 + bj * 128 + wc * 32 + fq * 8; gbv[bj][0] = *(const f32x4*)(gbias + gsel * D + col); gbv[bj][1] = *(const f32x4*)(gbias + gsel * D + col + 4); } }
        f32x4 acc[2][2][4][2];
#pragma unroll
        for (int ai = 0; ai < 2; ++ai)
#pragma unroll
            for (int m = 0; m < 4; ++m) { const float sr = su[(size_t)u.pm * 256 + ai * 128 + wr * 64 + m * 16 + fr];
#pragma unroll
                for (int bj = 0; bj < 2; ++bj) { acc[ai][bj][m][0] = accin[ai][bj][m][0] * (swv[bj][0] * sr); acc[ai][bj][m][1] = accin[ai][bj][m][1] * (swv[bj][1] * sr); } }
#pragma unroll
        for (int ai = 0; ai < 2; ++ai)
#pragma unroll
            for (int m = 0; m < 4; ++m) {
                const size_t row = (size_t)u.pm * 256 + ai * 128 + wr * 64 + m * 16 + fr;
                if (pn < 4) {
#pragma unroll
                    for (int bj = 0; bj < 2; ++bj) *(u32x4*)(Bb + row * D + pn * 256 + bj * 128 + wc * 32 + fq * 8) = pack8(acc[ai][bj][m][0], acc[ai][bj][m][1]);
                } else if (pn < 12) {
                    const f32x4 z0 = acc[ai][0][m][0] * acc[ai][1][m][0], z1 = acc[ai][0][m][1] * acc[ai][1][m][1];
                    *(u32x4*)(Z + row * D + (pn - 4) * 128 + wc * 32 + fq * 8) = pack8(z0, z1);
                } else {
                    const int gsel = (pn >= 16) ? 1 : 0; unsigned char* out = gsel ? SGA : SGC;
#pragma unroll
                    for (int bj = 0; bj < 2; ++bj) {
                        const int col = (pn - 12 - 4 * gsel) * 256 + bj * 128 + wc * 32 + fq * 8;
                        f32x4 v0 = acc[ai][bj][m][0] + gbv[bj][0], v1 = acc[ai][bj][m][1] + gbv[bj][1];
#pragma unroll
                        for (int e = 0; e < 4; ++e) { v0[e] = sigmoidf_(v0[e]) * 255.f; v1[e] = sigmoidf_(v1[e]) * 255.f; }
                        u32x2 g8; g8.x = pack4i8(v0); g8.y = pack4i8(v1);
                        *(u32x2*)(out + row * D + col) = g8;
                    }
                }
            }
    }
};
template <int MODE> struct EpiY {
    static constexpr bool PERM = true, AFTER_DRAIN = false;
    bf16* Y; const unsigned char* G;
    __device__ __forceinline__ void operator()(const f32x4 (&acc)[2][2][4][2], const Unit& u, int wr, int wc, int fr, int fq) const {
#pragma unroll
        for (int ai = 0; ai < 2; ++ai) {
            u32x2 g8[4][2]; u32x4 yv[4][2];
#pragma unroll
            for (int m = 0; m < 4; ++m)
#pragma unroll
                for (int bj = 0; bj < 2; ++bj) {
                    const size_t off = ((size_t)u.pm * 256 + ai * 128 + wr * 64 + m * 16 + fr) * D + u.pn * 256 + bj * 128 + wc * 32 + fq * 8;
                    g8[m][bj] = *(const u32x2*)(G + off);
                    if (MODE == 1) yv[m][bj] = *(const u32x4*)(Y + off);
                }
#pragma unroll
            for (int m = 0; m < 4; ++m)
#pragma unroll
                for (int bj = 0; bj < 2; ++bj) {
                    const size_t off = ((size_t)u.pm * 256 + ai * 128 + wr * 64 + m * 16 + fr) * D + u.pn * 256 + bj * 128 + wc * 32 + fq * 8;
                    const f32x4 g0 = unpack4u8(g8[m][bj].x), g1 = unpack4u8(g8[m][bj].y);
                    f32x4 v0 = acc[ai][bj][m][0] * g0, v1 = acc[ai][bj][m][1] * g1;
                    if (MODE == 1) { f32x4 y0, y1; unpack8(yv[m][bj], y0, y1); v0 = v0 + y0; v1 = v1 + y1; }
                    *(u32x4*)(Y + off) = pack8(v0, v1);
                }
        }
    }
};
struct EpiOut {
    static constexpr bool PERM = true, AFTER_DRAIN = false;
    const float* X; bf16* HG; const float* nffn; float* RSQ; unsigned char* HG8; float* HSC;
    __device__ __forceinline__ void operator()(const f32x4 (&acc)[2][2][4][2], const Unit& u, int wr, int wc, int fr, int fq) const {
        f32x4 nf[2][2];
#pragma unroll
        for (int bj = 0; bj < 2; ++bj) { const int col = u.pn * 256 + bj * 128 + wc * 32 + fq * 8; nf[bj][0] = *(const f32x4*)(nffn + col); nf[bj][1] = *(const f32x4*)(nffn + col + 4); }
#pragma unroll
        for (int ai = 0; ai < 2; ++ai) {
            f32x4 xv[4][2][2];
#pragma unroll
            for (int m = 0; m < 4; ++m)
#pragma unroll
                for (int bj = 0; bj < 2; ++bj) {
                    const size_t off = ((size_t)u.pm * 256 + ai * 128 + wr * 64 + m * 16 + fr) * D + u.pn * 256 + bj * 128 + wc * 32 + fq * 8;
                    xv[m][bj][0] = *(const f32x4*)(X + off); xv[m][bj][1] = *(const f32x4*)(X + off + 4);
                }
#pragma unroll
            for (int m = 0; m < 4; ++m) {
                const size_t row = (size_t)u.pm * 256 + ai * 128 + wr * 64 + m * 16 + fr;
                float ss = 0.f;
#pragma unroll
                for (int bj = 0; bj < 2; ++bj) {
                    const int col = u.pn * 256 + bj * 128 + wc * 32 + fq * 8; const size_t off = row * D + col;
                    const f32x4 h0 = xv[m][bj][0] + acc[ai][bj][m][0], h1 = xv[m][bj][1] + acc[ai][bj][m][1];
                    const f32x4 y0 = h0 * nf[bj][0], y1 = h1 * nf[bj][1];
                    *(u32x4*)(HG + off) = pack8(y0, y1);
                    float am = fmaxf(fmaxf(fmaxf(fabsf(y0[0]), fabsf(y0[1])), fmaxf(fabsf(y0[2]), fabsf(y0[3]))), fmaxf(fmaxf(fabsf(y1[0]), fabsf(y1[1])), fmaxf(fabsf(y1[2]), fabsf(y1[3]))));
                    am = fmaxf(am, xor16(am, fq)); am = fmaxf(am, xor32(am, fq));
                    const float qs = (am > 0.f) ? 127.f / am : 0.f;
                    u32x2 q8; q8.x = pack4i8(y0 * qs); q8.y = pack4i8(y1 * qs);
                    *(u32x2*)(HG8 + off) = q8;
                    if (fq == 0) HSC[row * 32 + u.pn * 8 + bj * 4 + wc] = am * (1.f / 127.f);
                    ss += (h0[0] * h0[0] + h0[1] * h0[1]) + (h0[2] * h0[2] + h0[3] * h0[3]) + (h1[0] * h1[0] + h1[1] * h1[1]) + (h1[2] * h1[2] + h1[3] * h1[3]);
                }
                ss += xor16(ss, fq); ss += xor32(ss, fq);
                if (fq == 0) RSQ[row * 16 + u.pn * 4 + wc] = ss;
            }
        }
    }
};
struct CvCtx { const float* dn; const float* up; unsigned char* ed; unsigned char* eu; float* esc; int lane; };
__device__ __forceinline__ void cv_load(const CvCtx& C, int ru, f32x4 (&v)[4]) {
    const int tb = ru >> 14, e = ru & (NEXP - 1);
    const float* src = (tb ? C.up : C.dn) + (size_t)e * D + 16 * C.lane;
#pragma unroll
    for (int q = 0; q < 4; ++q) v[q] = *(const f32x4*)(src + 4 * q);
}
template <int TB> __device__ __forceinline__ void cv_finish(const CvCtx& C, int ru, const f32x4 (&v)[4]) {
    const int e = ru & (NEXP - 1);
    float am = 0.f;
#pragma unroll
    for (int q = 0; q < 4; ++q) am = fmaxf(am, fmaxf(fmaxf(fabsf(v[q][0]), fabsf(v[q][1])), fmaxf(fabsf(v[q][2]), fabsf(v[q][3]))));
    am = wave_max(am);
    u32x4 w;
    if constexpr (TB) {
        const float sc = (am > 0.f) ? 256.f / am : 1.f;
#pragma unroll
        for (int q = 0; q < 4; ++q) { int d = __builtin_amdgcn_cvt_pk_fp8_f32(v[q][0] * sc, v[q][1] * sc, 0, false); d = __builtin_amdgcn_cvt_pk_fp8_f32(v[q][2] * sc, v[q][3] * sc, d, true); w[q] = (unsigned)d; }
        *(u32x4*)(C.eu + (size_t)(C.lane >> 3) * (2 * MiB) + (size_t)e * 128 + 16 * (C.lane & 7)) = w;
        C.esc[ru] = (am > 0.f) ? am * (1.f / 256.f) : 1.f;
    } else {
        const float s8 = (am > 0.f) ? 127.f / am : 0.f;
#pragma unroll
        for (int q = 0; q < 4; ++q) w[q] = pack4i8(v[q] * s8);
        *(u32x4*)(C.ed + (size_t)e * 1024 + 16 * C.lane) = w;
        C.esc[ru] = am * (1.f / 127.f);
    }
}
template <int TB> __device__ __forceinline__ void cv_rows_t(const CvCtx& C, int r0, int step) {
    const int hi = (TB + 1) * NEXP;
    if (r0 >= hi) return;
    const int last = r0 + ((hi - 1 - r0) / step) * step;
    f32x4 va[4], vb[4];
    cv_load(C, r0, va);
#pragma unroll 1
    for (int r = r0; r < hi; r += 2 * step) {
        const int r1 = min(r + step, last), r2 = min(r + 2 * step, last);
        cv_load(C, r1, vb);
        __builtin_amdgcn_sched_barrier(0);
        cv_finish<TB>(C, r, va);
        __builtin_amdgcn_sched_barrier(0);
        cv_load(C, r2, va);
        __builtin_amdgcn_sched_barrier(0);
        cv_finish<TB>(C, r1, vb);
        __builtin_amdgcn_sched_barrier(0);
    }
}
__device__ __forceinline__ void cv_rows(const CvCtx& C, int r0, int step) {
    int r = r0;
    if (r < NEXP) { cv_rows_t<0>(C, r, step); r += ((NEXP - 1 - r) / step + 1) * step; }
    cv_rows_t<1>(C, r, step);
}
__device__ __forceinline__ int f2key(float f) { const int b = __builtin_bit_cast(int, f); return b ^ ((b >> 31) & 0x7fffffff); }
__device__ __forceinline__ float key2f(int k) { return __builtin_bit_cast(float, k ^ ((k >> 31) & 0x7fffffff)); }
#define TOPK_INS(list, x) do { _Pragma("unroll") for (int _k = 0; _k < 16; ++_k) { const int _hi = max(list[_k], x); x = min(list[_k], x); list[_k] = _hi; } } while (0)
__device__ __forceinline__ unsigned long long pack8idx(const int (&a)[16], int o) { unsigned long long r = 0ull;
#pragma unroll
    for (int k = 0; k < 8; ++k) r |= (unsigned long long)(unsigned)(a[o + k] & 127) << (8 * k);
    return r; }
__device__ __forceinline__ int lut16(unsigned long long lo, unsigned long long hi, int i) { const unsigned long long w = (i < 8) ? lo : hi; return (int)((w >> ((i & 7) * 8)) & 127ull); }
__device__ __forceinline__ void sort16_asc(int (&x)[16]) {
#pragma unroll
    for (int k = 2; k <= 16; k <<= 1)
#pragma unroll
        for (int j = k >> 1; j > 0; j >>= 1)
#pragma unroll
            for (int i = 0; i < 16; ++i) { const int l = i ^ j; if (l > i) { const int lo = min(x[i], x[l]), hi = max(x[i], x[l]); const bool up = (i & k) == 0; x[i] = up ? lo : hi; x[l] = up ? hi : lo; } }
}
__device__ __forceinline__ void merge16(int (&r)[16], const int (&a)[16]) {
#pragma unroll
    for (int i = 0; i < 16; ++i) r[i] = max(r[i], a[i]);
#pragma unroll
    for (int j = 8; j > 0; j >>= 1)
#pragma unroll
        for (int i = 0; i < 16; ++i) { const int l = i ^ j; if (l > i) { const int lo = min(r[i], r[l]), hi = max(r[i], r[l]); r[i] = hi; r[l] = lo; } }
}
struct EpiTopk {
    static constexpr bool PERM = true, AFTER_DRAIN = false;
    float* scr; const float* RSQ; int* IDX; float* GATE; CvCtx CV; mutable int cvr; int cvstep;
    __device__ __forceinline__ void operator()(const f32x4 (&acc)[2][2][4][2], const Unit& u, int wr, int wc, int fr, int fq) const {
        const __amdgpu_buffer_rsrc_t rsrc = __builtin_amdgcn_make_buffer_rsrc(scr, 0, 262144, 0x00020000);
        const int voff = ((wc * 32 + fq * 8) * 256 + wr * 64 + fr) * 4;
#pragma unroll
        for (int ai = 0; ai < 2; ++ai)
#pragma unroll
            for (int m = 0; m < 4; ++m)
#pragma unroll
                for (int bj = 0; bj < 2; ++bj)
#pragma unroll
                    for (int n = 0; n < 2; ++n)
#pragma unroll
                        for (int e = 0; e < 4; ++e)
                        { const float val = acc[ai][bj][m][n][e]; __builtin_amdgcn_raw_buffer_store_b32(__builtin_bit_cast(unsigned, val), rsrc, voff, ((bj * 128 + n * 4 + e) * 256 + ai * 128 + m * 16) * 4, 0); }
        asm volatile("s_waitcnt vmcnt(0)" ::: "memory");
        __builtin_amdgcn_s_barrier();
        asm volatile("" ::: "memory");
        const int tid = threadIdx.x, row = tid >> 1, c = tid & 1;
        int v[16];
#pragma unroll
        for (int k = 0; k < 16; ++k) v[k] = (int)0x80000000;
        const int roff = (c * 128 * 256 + row) * 4;
        const size_t t = (size_t)u.pm * 256 + row;
        f32x4 rq[4];
#pragma unroll
        for (int j = 0; j < 4; ++j) rq[j] = *(const f32x4*)(RSQ + t * 16 + 4 * j);
        float xs[16], xn[16];
#pragma unroll
        for (int j = 0; j < 16; ++j) xs[j] = __builtin_bit_cast(float, __builtin_amdgcn_raw_buffer_load_b32(rsrc, roff, j * 1024, 0));
#pragma unroll 1
        for (int k0 = 0; k0 < 128; k0 += 16) {
            { const int kn = (k0 + 16) & 127;
#pragma unroll
              for (int j = 0; j < 16; ++j) xn[j] = __builtin_bit_cast(float, __builtin_amdgcn_raw_buffer_load_b32(rsrc, roff, (kn + j) * 1024, 0)); }
            __builtin_amdgcn_sched_barrier(0);
            int kb[16];
#pragma unroll
            for (int j = 0; j < 16; ++j) kb[j] = (f2key(xs[j]) & ~127) | (k0 + j);
            sort16_asc(kb);
            if (k0 == 0) {
#pragma unroll
                for (int j = 0; j < 16; ++j) v[j] = kb[15 - j];
            } else merge16(v, kb);
            __builtin_amdgcn_sched_barrier(0);
#pragma unroll
            for (int j = 0; j < 16; ++j) xs[j] = xn[j];
        }
        int A[16], B[16];
#pragma unroll
        for (int k = 0; k < 16; ++k) { const int o = __builtin_amdgcn_update_dpp(v[k], v[k], 0xB1, 0xf, 0xf, true); A[k] = c ? o : v[k]; B[k] = c ? v[k] : o; }
        int c2[16];
#pragma unroll
        for (int k = 0; k < 16; ++k) c2[k] = (int)0x80000000;
#define CAND(i, j) ((f2key(key2f(A[i]) + key2f(B[j])) & ~255) | ((i) * 16 + (j)))
#pragma unroll
        for (int j = 0; j < 16; ++j) c2[j] = CAND(0, j);
        { int t[16]; t[0] = (int)0x80000000;
#pragma unroll
          for (int i = 1; i < 16; ++i) t[16 - i] = CAND(i, 0);
          merge16(c2, t); }
        { int t[16];
          t[0] = CAND(1, 1); t[1] = CAND(1, 2); t[2] = CAND(1, 3); t[3] = CAND(1, 4); t[4] = CAND(1, 5); t[5] = CAND(1, 6); t[6] = CAND(1, 7);
          t[7] = CAND(2, 1); t[8] = CAND(2, 2); t[9] = CAND(2, 3); t[10] = CAND(2, 4); t[11] = CAND(3, 1); t[12] = CAND(3, 2); t[13] = CAND(3, 3);
          t[14] = CAND(4, 1); t[15] = CAND(4, 2);
          sort16_asc(t); merge16(c2, t); }
        { int x = CAND(5, 1); TOPK_INS(c2, x); x = CAND(6, 1); TOPK_INS(c2, x); x = CAND(7, 1); TOPK_INS(c2, x); }
#undef CAND
        float ssq = 0.f;
#pragma unroll
        for (int j = 0; j < 4; ++j) ssq += (rq[j][0] + rq[j][1]) + (rq[j][2] + rq[j][3]);
        const float rstd = __builtin_amdgcn_rsqf(ssq * (1.f / D) + RMS_EPS);
        const unsigned long long alo = pack8idx(A, 0), ahi = pack8idx(A, 8), blo = pack8idx(B, 0), bhi = pack8idx(B, 8);
        float sc[16]; int id[16]; float smax = 0.f, ssum = 0.f;
#pragma unroll
        for (int k = 0; k < 16; ++k) {
            const int cid = c2[k] & 255, i = cid >> 4, j = cid & 15;
            id[k] = lut16(alo, ahi, i) * 128 + lut16(blo, bhi, j);
            sc[k] = key2f(c2[k]) * rstd;
            if (k == 0) smax = sc[0];
            sc[k] = __expf(sc[k] - smax); ssum += sc[k];
        }
        const float inv = 1.f / ssum;
        int* ip = IDX + t * HK + u.pn * 16; float* gp = GATE + t * HK + u.pn * 16;
#pragma unroll
        for (int k = 0; k < 16; ++k) if ((k >> 3) == c) { ip[k] = id[k]; gp[k] = sc[k] * inv; }
    }
};

struct Frame {
    LAS unsigned char* lds;
    volatile LAS unsigned* MISC;
    gu32* ctl;
    int tid, lane, wave, vcu, G;
    int xcc, xrank;
    unsigned char* ws;
    const float* in[15]; float* out;
};
enum { I_X = 0, I_POS, I_NMIX, I_WIN, I_CONVW, I_WCONV, I_WATTN, I_GBIAS, I_WOUT, I_NFFN, I_WQ, I_SUBK, I_DOWN, I_UP, I_FNORM };

__device__ __forceinline__ void transpose_item(const float* W, int ldw, int k0, int n0, bf16* dst, int ldd, LAS float* scr, int lane) {
#pragma unroll 8
    for (int i = 0; i < 32; ++i) { const int kk = 2 * i + (lane >> 5); scr[kk * 33 + (lane & 31)] = W[(size_t)(k0 + kk) * ldw + n0 + (lane & 31)]; }
    LDS_WAIT(); asm volatile("" ::: "memory");
    const int c = lane & 7;
#pragma unroll
    for (int j = 0; j < 4; ++j) { const int n = (lane >> 3) + 8 * j; const LAS float* s = scr + (8 * c) * 33 + n;
        v4u o; o.x = pk2(s[0 * 33], s[1 * 33]); o.y = pk2(s[2 * 33], s[3 * 33]); o.z = pk2(s[4 * 33], s[5 * 33]); o.w = pk2(s[6 * 33], s[7 * 33]);
        *(GAS v4u*)(dst + (size_t)n * ldd + 8 * c) = o; }
    LDS_WAIT(); asm volatile("" ::: "memory");
}
__device__ __forceinline__ void w8_column_item(const float* W, int ldw, int n0, unsigned char* dst8  , float* swp  , LAS unsigned char* lds, int wave, int lane) {
    LAS float* scr = (LAS float*)(lds + wave * 16384); LAS float* cmx = (LAS float*)(lds + 130048);
    float x[2][32]; float am = 0.f;
#pragma unroll
    for (int b = 0; b < 2; ++b)
#pragma unroll
        for (int i = 0; i < 32; ++i) { const int kk = 64 * (2 * wave + b) + 2 * i + (lane >> 5); x[b][i] = W[(size_t)kk * ldw + n0 + (lane & 31)]; am = fmaxf(am, fabsf(x[b][i])); }
    am = fmaxf(am, xor32(am, lane >> 4));
    if (lane < 32) cmx[wave * 32 + lane] = am;
    __syncthreads();
    float cm = 0.f;
#pragma unroll
    for (int w = 0; w < 8; ++w) cm = fmaxf(cm, cmx[w * 32 + (lane & 31)]);
    const float q8 = (cm > 0.f) ? 127.f / cm : 0.f;
    if (wave == 0 && lane < 32) swp[lane] = cm * (1.f / 127.f);
#pragma unroll
    for (int b = 0; b < 2; ++b) {
#pragma unroll
        for (int i = 0; i < 32; ++i) scr[(2 * i + (lane >> 5)) * 33 + (lane & 31)] = x[b][i] * q8;
        LDS_WAIT(); asm volatile("" ::: "memory");
        const int c = lane & 7;
#pragma unroll
        for (int j = 0; j < 4; ++j) { const int n = (lane >> 3) + 8 * j; const LAS float* s = scr + (8 * c) * 33 + n;
            u32x2 o; o.x = pack4i8((f32x4){s[0 * 33], s[1 * 33], s[2 * 33], s[3 * 33]}); o.y = pack4i8((f32x4){s[4 * 33], s[5 * 33], s[6 * 33], s[7 * 33]});
            *(u32x2*)(dst8 + (size_t)n * D + 64 * (2 * wave + b) + 8 * c) = o; }
        LDS_WAIT(); asm volatile("" ::: "memory");
    }
    __syncthreads();
}
__device__ __forceinline__ int win_w8_row(int n0) {
    if (n0 < 1024) return NP1 + n0;
    if (n0 < 2048) { const int j = n0 - 1024; return NP1 + 1024 + (j >> 7) * 256 + (j & 127); }
    if (n0 < 3072) { const int j = n0 - 2048; return NP1 + 1024 + (j >> 7) * 256 + 128 + (j & 127); }
    if (n0 < 7680) { const int j = n0 - 3072, kind = j / 1536, jj = j % 1536, g = jj >> 9, cc = jj & 511; return g * 1536 + kind * 512 + cc; }
    if (n0 < 8704) return NP1 + 3072 + (n0 - 7680);
    if (n0 < 9216) return NP1 + 4096 + (n0 - 8704);
    return NQKV + (n0 - 9216);
}
__device__ __forceinline__ void p0_prologue(Frame& F) {
    for (int it = F.vcu; it < DIN / 32; it += F.G) {
        const int n0 = 32 * it, drow = win_w8_row(n0);
        w8_column_item(F.in[I_WIN], DIN, n0, F.ws + WS_WQKV8 + (size_t)drow * D, (float*)(F.ws + WS_SW) + drow, F.lds, F.wave, F.lane);
    }
    LAS float* scr = (LAS float*)(F.lds + F.wave * 16384);
    const int gw = F.vcu * NWAVES + F.wave, NGW = F.G * NWAVES;
    constexpr int I_C = 16 * 32, I_A = 8 * 32, I_O = 16 * 32, NITEMS = I_C + I_A + I_O;
    for (int it = gw; it < NITEMS; it += NGW) {
        int r = it;
        if (r < I_C) { const int kb = r / 32, nb = r % 32; transpose_item(F.in[I_WCONV], D, 64 * kb, 32 * nb, (bf16*)(F.ws + WS_WCONV) + (size_t)(32 * nb) * D + 64 * kb, D, scr, F.lane); continue; } r -= I_C;
        if (r < I_A) { const int kb = r / 32, nb = r % 32; transpose_item(F.in[I_WATTN], D, 64 * kb, 32 * nb, (bf16*)(F.ws + WS_WATTN) + (size_t)(32 * nb) * DAO + 64 * kb, DAO, scr, F.lane); continue; } r -= I_A;
        { const int kb = r / 32, nb = r % 32; transpose_item(F.in[I_WOUT], D, 64 * kb, 32 * nb, (bf16*)(F.ws + WS_WOUT) + (size_t)(32 * nb) * D + 64 * kb, D, scr, F.lane); }
    }
    const float* x = F.in[I_X]; const float* nm = F.in[I_NMIX];
    f32x4 gm[4];
#pragma unroll
    for (int j = 0; j < 4; ++j) gm[j] = *((const f32x4*)nm + F.lane + 64 * j);
    const int nlong = (DIN / 32) % F.G;
    constexpr int RSH = 2;
    const int nsl = (nlong == 0) ? 1 : ((F.vcu < nlong) ? 1 : RSH), V = (nlong == 0) ? NGW : (nlong * NWAVES + (F.G - nlong) * NWAVES * RSH);
    const int w0 = (nlong == 0) ? gw : ((F.vcu < nlong) ? gw : nlong * NWAVES + ((F.vcu - nlong) * NWAVES + F.wave) * RSH);
#define P0_ROW_LOAD(m_, v_, s_) do { const GAS f32x4* xr_ = (const GAS f32x4*)(x + (size_t)(m_) * D) + F.lane; s_ = 0.f; \
        _Pragma("unroll") for (int j = 0; j < 4; ++j) { v_[j] = xr_[64 * j]; s_ += (v_[j].x * v_[j].x + v_[j].y * v_[j].y) + (v_[j].z * v_[j].z + v_[j].w * v_[j].w); } } while (0)
#define P0_ROW_FINISH(m_, v_, s_) do { const float rstd_ = 1.f / sqrtf(wave_sum(s_) * (1.f / D) + RMS_EPS); f32x4 y_[4]; float am_ = 0.f; \
        _Pragma("unroll") for (int j = 0; j < 4; ++j) { y_[j] = v_[j] * rstd_ * gm[j]; am_ = fmaxf(am_, fmaxf(fmaxf(fabsf(y_[j].x), fabsf(y_[j].y)), fmaxf(fabsf(y_[j].z), fabsf(y_[j].w)))); } \
        am_ = wave_max(am_); const float q8_ = (am_ > 0.f) ? 127.f / am_ : 0.f;     \
        _Pragma("unroll") for (int j = 0; j < 4; ++j) ((GAS unsigned*)(F.ws + WS_U8 + (size_t)(m_) * D))[F.lane + 64 * j] = pack4i8(y_[j] * q8_); \
        if (F.lane == 0) ((float*)(F.ws + WS_SU))[m_] = am_ * (1.f / 127.f); } while (0)
    for (int sl = 0; sl < nsl; ++sl) {
        int m = w0 + sl;
        for (; m + V < T; m += 2 * V) {
            f32x4 va[4], vb[4]; float sa, sb;
            P0_ROW_LOAD(m, va, sa); P0_ROW_LOAD(m + V, vb, sb);
            P0_ROW_FINISH(m, va, sa); P0_ROW_FINISH(m + V, vb, sb);
        }
        if (m < T) { f32x4 va[4]; float sa; P0_ROW_LOAD(m, va, sa); P0_ROW_FINISH(m, va, sa); }
    }
#undef P0_ROW_LOAD
#undef P0_ROW_FINISH
    const int* pos = (const int*)F.in[I_POS]; float* rope = (float*)(F.ws + WS_ROPE);
    for (int e = gw * 64 + F.lane; e < T * 8; e += NGW * 64) {
        const int t = e >> 3, j = e & 7;
        const double invf[8] = {1.0, 0.19392274474868576, 0.03760603093086393, 0.007292664737217109, 0.001414213562373095, 0.0002742481756762073, 5.318295896944988e-05, 1.031338537721246e-05};
        double f = 1.0;
#pragma unroll
        for (int q = 1; q < 8; ++q) f = (j == q) ? invf[q] : f;
        const float fi = (float)f;
        const double ang = (double)pos[t] * (double)fi;
        const double k = __builtin_rint(ang * 0.15915494309189535);
        const float r = (float)(ang - k * 6.283185307179586);
        rope[(size_t)t * 16 + j] = __cosf(r); rope[(size_t)t * 16 + 8 + j] = __sinf(r);
    }
}

__device__ __forceinline__ void attn_phase(Frame& F, bf16* OGb, float* LSE) {
    constexpr int SLOT = 128 * 160;
    LAS unsigned char* Ks = F.lds; LAS unsigned char* Vs = F.lds + 3 * SLOT;
    const int lane = F.lane, w = F.wave, ir = lane & 15, gq = lane >> 4;
    const int NU = 3 * 8 * 128, per = (NU + F.G - 1) / F.G;
    const int u0 = F.vcu * per, u1 = (u0 + per < NU) ? u0 + per : NU;
    const bf16* Qb = (const bf16*)(F.ws + WS_Q); const bf16* Kb = (const bf16*)(F.ws + WS_K); const bf16* Vb = (const bf16*)(F.ws + WS_V);
    u32x4 pk[2], pv[2]; bf16x8 nq0, nq1; bool havepre = false;
    for (int uid = u0, n = 0; uid < u1; ++uid, ++n) {
        const int g = uid >> 10, hh = (uid >> 7) & 7, blk = uid & 127, sh = 2 * g;
        const bool first = (blk & ((64 >> sh) - 1)) == 0;
        const size_t gbase = (size_t)g * T * GW;
        const int p0 = blk * 128;
        const int ps = n % 3, cs = (n + 1) % 3, ns = (n + 2) % 3;
        const bf16* qrow = Qb + gbase + (size_t)(p0 + 16 * w + ir) * GW + hh * 64;
        bf16* orow = OGb + gbase + (size_t)(p0 + 16 * w + ir) * GW + hh * 64;
        bf16x8 qf0, qf1;
        if (!havepre) {
            if (n > 0) __syncthreads();
#pragma unroll
            for (int i = 0; i < 4; ++i) {
                const int c = F.tid + 512 * i, row = c >> 3, part = c & 7;
                const bool valid = !first || row >= 128;
                u32x4 kv = {0u, 0u, 0u, 0u}, vv = {0u, 0u, 0u, 0u};
                if (valid) { const size_t off = gbase + (size_t)(p0 - 128 + row) * GW + hh * 64 + part * 8; kv = *(const u32x4*)(Kb + off); vv = *(const u32x4*)(Vb + off); }
                const int so = ((row < 128) ? ps : cs) * SLOT + (row & 127) * 160 + part * 16;
                *(LAS u32x4*)(Ks + so) = kv; *(LAS u32x4*)(Vs + so) = vv;
            }
            qf0 = *(const bf16x8*)(qrow + 8 * gq); qf1 = *(const bf16x8*)(qrow + 32 + 8 * gq);
        } else { qf0 = nq0; qf1 = nq1; }
        __syncthreads();
        havepre = (uid + 1 < u1) && (((uid + 1) & 127) != 0);
        if (havepre) {
#pragma unroll
            for (int i = 0; i < 2; ++i) { const int c = F.tid + 512 * i, row = c >> 3, part = c & 7; const size_t off = gbase + (size_t)(p0 + 128 + row) * GW + hh * 64 + part * 8; pk[i] = *(const u32x4*)(Kb + off); pv[i] = *(const u32x4*)(Vb + off); }
            nq0 = *(const bf16x8*)(qrow + (size_t)128 * GW + 8 * gq); nq1 = *(const bf16x8*)(qrow + (size_t)128 * GW + 32 + 8 * gq);
        }
        f32x4 sacc[9];
#pragma unroll
        for (int a = 0; a < 9; ++a) {
            sacc[a] = (f32x4){0.f, 0.f, 0.f, 0.f};
            const int R0 = 16 * w + 16 * a;
            const LAS unsigned char* kp = Ks + ((R0 < 128) ? ps : cs) * SLOT + ((R0 & 127) + ir) * 160 + gq * 16;
            const bf16x8 k0 = *(const LAS bf16x8*)kp, k1 = *(const LAS bf16x8*)(kp + 64);
            sacc[a] = __builtin_amdgcn_mfma_f32_16x16x32_bf16(k0, qf0, sacc[a], 0, 0, 0);
            sacc[a] = __builtin_amdgcn_mfma_f32_16x16x32_bf16(k1, qf1, sacc[a], 0, 0, 0);
        }
        float mx = -INFINITY;
#pragma unroll
        for (int a = 0; a < 9; ++a)
#pragma unroll
            for (int j = 0; j < 4; ++j) {
                const int jl = 4 * gq + j;
                bool valid = (a == 0) ? (jl >= ir) : ((a == 8) ? (jl <= ir) : true);
                valid = valid && (!first || (16 * w + 16 * a + jl >= 128));
                sacc[a][j] = valid ? sacc[a][j] : -INFINITY;
                mx = fmaxf(mx, sacc[a][j]);
            }
        mx = fmaxf(mx, xor16(mx, gq)); mx = fmaxf(mx, xor32(mx, gq));
        float l = 0.f;
#pragma unroll
        for (int a = 0; a < 9; ++a)
#pragma unroll
            for (int j = 0; j < 4; ++j) { sacc[a][j] = __builtin_amdgcn_exp2f(sacc[a][j] - mx); l += sacc[a][j]; }
        l += xor16(l, gq); l += xor32(l, gq);
        f32x4 oacc[4];
#pragma unroll
        for (int dt = 0; dt < 4; ++dt) oacc[dt] = (f32x4){0.f, 0.f, 0.f, 0.f};
#pragma unroll
        for (int s = 0; s < 5; ++s) {
            u32x4 pw; pw.x = cvt_pk_bf16(sacc[2 * s][0], sacc[2 * s][1]); pw.y = cvt_pk_bf16(sacc[2 * s][2], sacc[2 * s][3]);
            if (s < 4) { pw.z = cvt_pk_bf16(sacc[2 * s + 1][0], sacc[2 * s + 1][1]); pw.w = cvt_pk_bf16(sacc[2 * s + 1][2], sacc[2 * s + 1][3]); } else { pw.z = 0u; pw.w = 0u; }
            const bf16x8 pb = __builtin_bit_cast(bf16x8, pw);
            const int q = ir >> 2, p = ir & 3;
            const int Ra = 16 * w + 32 * s, Rb = Ra + 16;
            const LAS unsigned char* vpa = Vs + ((Ra < 128) ? ps : cs) * SLOT + ((Ra & 127) + 4 * gq + q) * 160 + p * 8;
            const LAS unsigned char* vpb = Vs + ((Rb < 128) ? ps : cs) * SLOT + ((Rb & 127) + 4 * gq + q) * 160 + p * 8;
#pragma unroll
            for (int dt = 0; dt < 4; ++dt) {
                const s16x4 va = __builtin_bit_cast(s16x4, __builtin_amdgcn_ds_read_tr16_b64_v4i16((LAS v4i16_t*)(vpa + dt * 32)));
                s16x4 vb = {0, 0, 0, 0};
                if (s < 4) vb = __builtin_bit_cast(s16x4, __builtin_amdgcn_ds_read_tr16_b64_v4i16((LAS v4i16_t*)(vpb + dt * 32)));
                const bf16x8 vf = __builtin_shufflevector(va, vb, 0, 1, 2, 3, 4, 5, 6, 7);
                oacc[dt] = __builtin_amdgcn_mfma_f32_16x16x32_bf16(vf, pb, oacc[dt], 0, 0, 0);
            }
        }
        const float inv = 1.f / l;
#pragma unroll
        for (int dt = 0; dt < 4; ++dt) {
            u32x2 o; o.x = cvt_pk_bf16(oacc[dt][0] * inv, oacc[dt][1] * inv); o.y = cvt_pk_bf16(oacc[dt][2] * inv, oacc[dt][3] * inv);
            *(u32x2*)(orow + 16 * dt + 4 * gq) = o;
        }
        if (gq == 0) LSE[((size_t)g * T + p0 + 16 * w + ir) * 8 + hh] = (mx + __builtin_amdgcn_logf(l)) * LN2;
        if (havepre) {
#pragma unroll
            for (int i = 0; i < 2; ++i) { const int c = F.tid + 512 * i, row = c >> 3, part = c & 7; const int so = ns * SLOT + row * 160 + part * 16; *(LAS u32x4*)(Ks + so) = pk[i]; *(LAS u32x4*)(Vs + so) = pv[i]; }
        }
    }
    __syncthreads();
}

__device__ __forceinline__ void combine_phase(Frame& F, int part, int nparts) {
    const int gw = part * NWAVES + F.wave, NGW = nparts * NWAVES, lane = F.lane, hh = lane >> 3;
    const bf16* OG = (const bf16*)(F.ws + WS_Q); const float* LSE = (const float*)(F.ws + WS_LSE); bf16* O = (bf16*)(F.ws + WS_O);
    for (int t0 = gw * 4; t0 < T; t0 += NGW * 4) {
        float ls[4][3]; u32x4 og[4][3];
#pragma unroll
        for (int q = 0; q < 4; ++q) { const int t = t0 + q, b = t / SEQ, s = t % SEQ;
#pragma unroll
            for (int g = 0; g < 3; ++g) {
                const int sh = 2 * g, r = s & ((1 << sh) - 1), i = s >> sh;
                const size_t p = (size_t)g * T + b * SEQ + r * (SEQ >> sh) + i;
                ls[q][g] = LSE[p * 8 + hh]; og[q][g] = *(const u32x4*)(OG + p * GW + lane * 8);
            } }
#pragma unroll
        for (int q = 0; q < 4; ++q) {
            const float m = fmaxf(ls[q][0], fmaxf(ls[q][1], ls[q][2]));
            float e[3], sum = 0.f;
#pragma unroll
            for (int g = 0; g < 3; ++g) { e[g] = __expf(ls[q][g] - m); sum += e[g]; }
            const float inv = 1.f / sum;
            f32x4 a0 = {0.f, 0.f, 0.f, 0.f}, a1 = a0;
#pragma unroll
            for (int g = 0; g < 3; ++g) { f32x4 v0, v1; unpack8(og[q][g], v0, v1); const float wg = e[g] * inv; a0 = a0 + v0 * wg; a1 = a1 + v1 * wg; }
            *(u32x4*)(O + (size_t)(t0 + q) * DAO + lane * 8) = pack8(a0, a1);
        }
    }
}

__device__ __forceinline__ void p4_conv(Frame& F) {
    constexpr int RUN = 16;
    const int gt = (F.vcu * NWAVES + F.wave) * 64 + F.lane, NGT = F.G * NWAVES * 64;
    bf16* Bb = (bf16*)((unsigned char*)F.out + OS_BB); const bf16* Z = (const bf16*)(F.ws + WS_Z); const float* cw = F.in[I_CONVW];
    for (int e = gt; e < (T / RUN) * (D / 8); e += NGT) {
        const int t0 = (e >> 7) * RUN, c8 = (e & 127) * 8, s0 = t0 & (SEQ - 1);
        const f32x4 w0a = *(const f32x4*)(cw + c8), w0b = *(const f32x4*)(cw + c8 + 4), w1a = *(const f32x4*)(cw + D + c8), w1b = *(const f32x4*)(cw + D + c8 + 4), w2a = *(const f32x4*)(cw + 2 * D + c8), w2b = *(const f32x4*)(cw + 2 * D + c8 + 4);
        const size_t off0 = (size_t)t0 * D + c8;
        f32x4 z1a = {0.f, 0.f, 0.f, 0.f}, z1b = z1a, z2a = z1a, z2b = z1a;
        if (s0 >= 2) { unpack8(*(const u32x4*)(Z + off0 - D), z1a, z1b); unpack8(*(const u32x4*)(Z + off0 - 2 * D), z2a, z2b); }
#pragma unroll
        for (int rb = 0; rb < RUN; rb += 8) {
            u32x4 zr[8], br[8];
#pragma unroll
            for (int r = 0; r < 8; ++r) { const size_t off = off0 + (size_t)(rb + r) * D; zr[r] = *(const u32x4*)(Z + off); br[r] = *(const u32x4*)(Bb + off); }
#pragma unroll
            for (int r = 0; r < 8; ++r) {
                const size_t off = off0 + (size_t)(rb + r) * D;
                f32x4 z0a, z0b, ba, bb;
                unpack8(zr[r], z0a, z0b); unpack8(br[r], ba, bb);
                const f32x4 ca = w0a * z2a + w1a * z1a + w2a * z0a, cb = w0b * z2b + w1b * z1b + w2b * z0b;
                *(u32x4*)(Bb + off) = pack8(ba * ca, bb * cb);
                z2a = z1a; z2b = z1b; z1a = z0a; z1b = z0b;
            }
        }
    }
}
__device__ __forceinline__ void split8(const f32x4 a, const f32x4 b, bf16x8& hi, bf16x8& lo) {
    const u32x4 h = pack8(a, b); f32x4 ha, hb; unpack8(h, ha, hb);
    hi = __builtin_bit_cast(bf16x8, h); lo = __builtin_bit_cast(bf16x8, pack8(a - ha, b - hb));
}
__device__ __forceinline__ void p4_wfold(Frame& F) {
    const int gw = F.vcu * NWAVES + F.wave, NGW = F.G * NWAVES, i = F.lane & 15, g = F.lane >> 4;
    const float* Wq = F.in[I_WQ]; const float* SK = F.in[I_SUBK]; bf16* WF = (bf16*)((unsigned char*)F.out + OS_WFOLD);
    for (int it = gw; it < 1024; it += NGW) {
        const int itu = __builtin_amdgcn_readfirstlane(it);
        const int hc = itu >> 6, k0 = ((itu >> 1) & 31) * 32, nh = itu & 1;
        bf16x8 ah[2][4], al[2][4];
#pragma unroll
        for (int kt = 0; kt < 2; ++kt)
#pragma unroll
            for (int j = 0; j < 4; ++j) { const float* ap = Wq + (size_t)(k0 + 16 * kt + i) * 2048 + hc * 128 + 32 * j + 8 * g; split8(*(const f32x4*)ap, *(const f32x4*)(ap + 4), ah[kt][j], al[kt][j]); }
#pragma unroll 1
        for (int nt = 0; nt < 4; ++nt) {
            const int n0 = hc * 128 + nh * 64 + 16 * nt;
            bf16x8 bh[4], bl[4];
#pragma unroll
            for (int j = 0; j < 4; ++j) { const float* bp = SK + (size_t)(n0 + i) * 128 + 32 * j + 8 * g; split8(*(const f32x4*)bp, *(const f32x4*)(bp + 4), bh[j], bl[j]); }
#pragma unroll
            for (int kt = 0; kt < 2; ++kt) {
                f32x4 acc = {0.f, 0.f, 0.f, 0.f};
#pragma unroll
                for (int j = 0; j < 4; ++j) { acc = __builtin_amdgcn_mfma_f32_16x16x32_bf16(al[kt][j], bh[j], acc, 0, 0, 0); acc = __builtin_amdgcn_mfma_f32_16x16x32_bf16(ah[kt][j], bl[j], acc, 0, 0, 0); }
#pragma unroll
                for (int j = 0; j < 4; ++j) acc = __builtin_amdgcn_mfma_f32_16x16x32_bf16(ah[kt][j], bh[j], acc, 0, 0, 0);
                u32x2 o; o.x = pk2(acc[0], acc[1]); o.y = pk2(acc[2], acc[3]);
                *(u32x2*)(WF + (size_t)(n0 + i) * D + k0 + 16 * kt + 4 * g) = o;
            }
        }
    }
}
__device__ __forceinline__ float gelu_erf(float v) { return 0.5f * v * (1.f + erff(v * 0.70710678118654752f)); }
__device__ __forceinline__ void peer_down_phase(Frame& F) {
    const int lane = F.lane, sub = lane & 15, gq = lane >> 4;
    const int nloc = (int)F.MISC[8], nxc = (int)F.MISC[9]; const bool byx = (nxc == 8) && (nloc * 8 == F.G) && (F.xcc < 8);
    const int x = byx ? F.xcc : 0, nsh = byx ? 8 : 1, rank = byx ? F.xrank : (int)blockIdx.x, nrank = byx ? nloc : F.G;
    const unsigned char* HG8 = F.ws + WS_HG8; const float* HSC = (const float*)(F.ws + WS_HSC); const float* RSQ = (const float*)(F.ws + WS_RSQ);
    const int* IDX = (const int*)(F.ws + WS_IDX); const float* GATE = (const float*)(F.ws + WS_GATE);
    const unsigned char* dn8 = (const unsigned char*)F.out + OS_EDOWN; const float* esc = (const float*)(F.ws + WS_ESCALE); float* WB = (float*)(F.ws + WS_WB);
    LAS unsigned char* wb = F.lds + F.wave * 10752;
    LAS u32x4* h8s = (LAS u32x4*)wb; LAS float* hss = (LAS float*)(wb + 4096); LAS u32x2* ls = (LAS u32x2*)(wb + 4608); LAS float* av = (LAS float*)(wb + 8704);
    const int tstep = nrank * NWAVES * 4;
    for (int xs = x; xs < 8; xs += nsh) {
        int tb = (rank * NWAVES + F.wave) * 4;
        u32x4 ia, ib, h8[4]; f32x4 ga, gb; float hs[4], pq;
#define PD_META(tt) do { const unsigned t_ = (unsigned)((tt) + gq); const unsigned char* wsb_ = F.ws;     \
            ia = *(const u32x4*)(wsb_ + (unsigned)(WS_IDX + t_ * (HK * 4) + sub * 32)); ib = *(const u32x4*)(wsb_ + (unsigned)(WS_IDX + t_ * (HK * 4) + sub * 32 + 16)); \
            ga = *(const f32x4*)(wsb_ + (unsigned)(WS_GATE + t_ * (HK * 4) + sub * 32)); gb = *(const f32x4*)(wsb_ + (unsigned)(WS_GATE + t_ * (HK * 4) + sub * 32 + 16)); pq = *(const float*)(wsb_ + (unsigned)(WS_RSQ + t_ * 64 + sub * 4)); \
            _Pragma("unroll") for (int j_ = 0; j_ < 4; ++j_) { h8[j_] = *(const u32x4*)(wsb_ + (unsigned)(WS_HG8 + t_ * D + 16 * (sub + 16 * j_))); hs[j_] = *(const float*)(wsb_ + (unsigned)(WS_HSC + t_ * 128 + ((sub + 16 * j_) >> 1) * 4)); } } while (0)
        if (tb < T) PD_META(tb);
        for (; tb < T; tb += tstep) {
#pragma unroll
            for (int j = 0; j < 4; ++j) { h8s[gq * 64 + sub + 16 * j] = h8[j]; if ((sub & 1) == 0) hss[gq * 32 + ((sub + 16 * j) >> 1)] = hs[j]; }
            int total = 0;
#pragma unroll
            for (int k = 0; k < 8; ++k) {
                const int ei = (int)(k < 4 ? ia[k & 3] : ib[k & 3]); const float gk = (k < 4 ? ga[k & 3] : gb[k & 3]);
                const bool f = (ei >> 11) == xs;
                const unsigned long long m = __ballot(f);
                const int pos = total + (int)__builtin_amdgcn_mbcnt_hi((unsigned)(m >> 32), __builtin_amdgcn_mbcnt_lo((unsigned)m, 0u));
                if (f) { u32x2 ent; ent.x = (unsigned)ei | ((unsigned)(sub * 8 + k) << 14) | ((unsigned)gq << 21); ent.y = __builtin_bit_cast(unsigned, gk); ls[pos] = ent; }
                total += __popcll(m);
            }
            const float rq = sum16_dpp(pq);
            const float rstd = __builtin_amdgcn_rsqf(rq * (1.f / D) + RMS_EPS);
            const int tcur = tb;
            if (tb + tstep < T) PD_META(tb + tstep);
            LDS_WAIT(); asm volatile("" ::: "memory");
            const int nr = (total + 3) >> 2;
#define PD_ISSUE(R, HH, HS, r0) do { _Pragma("unroll") for (int u_ = 0; u_ < 2; ++u_) { const int k_ = 4 * ((r0) + u_) + gq; const bool v_ = k_ < total; const u32x2 e_ = ls[v_ ? k_ : 0]; const unsigned ex_ = e_.x; \
                const unsigned ro_ = (v_ ? (ex_ & 16383u) : 0u) * 1024u + 16u * (unsigned)sub; const unsigned tk_ = (ex_ >> 21) & 3u; \
                _Pragma("unroll") for (int j_ = 0; j_ < 4; ++j_) { R[u_][j_] = *(const u32x4*)(dn8 + (ro_ + 256u * j_)); HH[u_][j_] = h8s[tk_ * 64 + sub + 16 * j_]; HS[u_][j_] = hss[tk_ * 32 + ((sub + 16 * j_) >> 1)]; } } } while (0)
#define PD_COMPUTE(R, HH, HS, r0) do { _Pragma("unroll") for (int u_ = 0; u_ < 2; ++u_) { const int k_ = 4 * ((r0) + u_) + gq; float af_ = 0.f; \
                _Pragma("unroll") for (int j_ = 0; j_ < 4; ++j_) { int ac_ = 0; _Pragma("unroll") for (int q_ = 0; q_ < 4; ++q_) { const int a_ = (int)R[u_][j_][q_], b_ = (int)HH[u_][j_][q_]; ac_ = __builtin_amdgcn_sdot4(a_, b_, ac_, false); } af_ += (float)ac_ * HS[u_][j_]; } \
                af_ = sum16_dpp(af_); \
                if (k_ < total && sub == 0) av[k_] = af_; } } while (0)
            u32x4 RA[2][4], RB[2][4], HA[2][4], HB[2][4]; float SA[2][4], SB[2][4];
            if (nr > 0) {
                PD_ISSUE(RA, HA, SA, 0);
                int r = 0;
#pragma unroll 1
                for (; r + 4 < nr; r += 4) {
                    PD_ISSUE(RB, HB, SB, r + 2);
                    __builtin_amdgcn_sched_barrier(0);
                    PD_COMPUTE(RA, HA, SA, r);
                    __builtin_amdgcn_sched_barrier(0);
                    PD_ISSUE(RA, HA, SA, r + 4);
                    __builtin_amdgcn_sched_barrier(0);
                    PD_COMPUTE(RB, HB, SB, r + 2);
                    __builtin_amdgcn_sched_barrier(0);
                }
                if (r + 2 < nr) {
                    PD_ISSUE(RB, HB, SB, r + 2);
                    __builtin_amdgcn_sched_barrier(0);
                    PD_COMPUTE(RA, HA, SA, r);
                    __builtin_amdgcn_sched_barrier(0);
                    PD_COMPUTE(RB, HB, SB, r + 2);
                } else {
                    PD_COMPUTE(RA, HA, SA, r);
                }
                __builtin_amdgcn_sched_barrier(0);
            }
#undef PD_ISSUE
#undef PD_COMPUTE
            LDS_WAIT(); asm volatile("" ::: "memory");
            const float rs0 = __builtin_bit_cast(float, __builtin_amdgcn_readlane(__builtin_bit_cast(int, rstd), 0)), rs1 = __builtin_bit_cast(float, __builtin_amdgcn_readlane(__builtin_bit_cast(int, rstd), 16)),
                        rs2 = __builtin_bit_cast(float, __builtin_amdgcn_readlane(__builtin_bit_cast(int, rstd), 32)), rs3 = __builtin_bit_cast(float, __builtin_amdgcn_readlane(__builtin_bit_cast(int, rstd), 48));
            for (int i = lane; i < total; i += 64) {
                const u32x2 e = ls[i]; const unsigned ex = e.x, eg = e.y; const int tk = (int)((ex >> 21) & 3u);
                const float rs = (tk == 0) ? rs0 : ((tk == 1) ? rs1 : ((tk == 2) ? rs2 : rs3));
                const float a = av[i] * esc[ex & 16383u] * rs;
                WB[(size_t)(tcur + tk) * HK + ((ex >> 14) & 127u)] = __builtin_bit_cast(float, eg) * esc[NEXP + (ex & 16383u)] * gelu_erf(a);
            }
            LDS_WAIT(); asm volatile("" ::: "memory");
        }
#undef PD_META
    }
}
__device__ __forceinline__ void peer_up_phase(Frame& F) {
    const int lane = F.lane, g8 = lane >> 3, c = lane & 7;
    const int nloc = (int)F.MISC[8], nxc = (int)F.MISC[9]; const bool byx = (nxc == 8) && (nloc * 8 == F.G) && (F.xcc < 8);
    const int x = byx ? F.xcc : 0, nsh = byx ? 8 : 1, rank = byx ? F.xrank : (int)blockIdx.x, nrank = byx ? nloc : F.G;
    const bf16* HG = (const bf16*)(F.ws + WS_HG); const float* nffn = F.in[I_NFFN];
    float* SS = (float*)(F.ws + WS_SS); float* out = F.out;
    LAS unsigned char* wbuf = F.lds + F.wave * 16384;
    const int tstep = nrank * NWAVES * 8;
    const unsigned char* wsb = F.ws;
    for (int xs = x; xs < 8; xs += nsh) {
    const unsigned char* up8 = F.ws + WS_EUP + (size_t)xs * (2 * MiB);
    int tb = (rank * NWAVES + F.wave) * 8, it = 0;
#define PU_MOFF(tt, j) ((unsigned)(((j) < 4 ? WS_IDX : WS_WB) + (size_t)(tt) * (HK * 4) + ((j) & 3) * 1024) + (unsigned)(lane * 16))
    if (tb < T) {
        u32x4 m0[8];
#pragma unroll
        for (int j = 0; j < 8; ++j) m0[j] = *(const u32x4*)(wsb + PU_MOFF(tb, j));
#pragma unroll
        for (int j = 0; j < 8; ++j) *(LAS u32x4*)(wbuf + j * 1024 + lane * 16) = m0[j];
    }
    for (; tb < T; tb += tstep, ++it) {
        const int t = tb + g8;
        const LAS unsigned char* mi = wbuf + (it & 1) * 8192 + g8 * 512;
        LAS unsigned char* nb = wbuf + ((it + 1) & 1) * 8192 + lane * 16;
        const int tn = (tb + tstep < T) ? tb + tstep : tb;
        f32x4 oa[4];
#pragma unroll
        for (int q = 0; q < 4; ++q) oa[q] = (f32x4){0.f, 0.f, 0.f, 0.f};
#define PU_ISSUE(R, W, st) do { const u32x4 i0_ = *(const LAS u32x4*)(mi + (st) * 32), i1_ = *(const LAS u32x4*)(mi + (st) * 32 + 16); \
            const f32x4 w0_ = *(const LAS f32x4*)(mi + 4096 + (st) * 32), w1_ = *(const LAS f32x4*)(mi + 4096 + (st) * 32 + 16); \
            _Pragma("unroll") for (int k_ = 0; k_ < 8; ++k_) { const unsigned ei_ = (k_ < 4) ? i0_[k_ & 3] : i1_[k_ & 3]; W[k_] = (k_ < 4) ? w0_[k_ & 3] : w1_[k_ & 3]; \
            R[k_] = *(const u32x4*)(up8 + (ei_ * 128u + 16u * (unsigned)c)); } } while (0)
#define PU_COMPUTE(R, W) do { _Pragma("unroll") for (int k_ = 0; k_ < 8; ++k_) { _Pragma("unroll") for (int q_ = 0; q_ < 4; ++q_) { const int d_ = (int)R[k_][q_]; \
            const f32x2 lo_ = __builtin_amdgcn_cvt_pk_f32_fp8(d_, false), hi_ = __builtin_amdgcn_cvt_pk_f32_fp8(d_, true); \
            oa[q_][0] += lo_.x * W[k_]; oa[q_][1] += lo_.y * W[k_]; oa[q_][2] += hi_.x * W[k_]; oa[q_][3] += hi_.y * W[k_]; } \
            if (k_ & 1) { asm volatile("" : "+v"(oa[0]), "+v"(oa[1]), "+v"(oa[2]), "+v"(oa[3])); __builtin_amdgcn_sched_barrier(0); } } } while (0)
        u32x4 RA[8], RB[8]; float WA[8], WBk[8];
        PU_ISSUE(RA, WA, 0);
#define PU_BODY(st, j) do { const u32x4 m_ = *(const u32x4*)(wsb + PU_MOFF(tn, j)); \
            PU_ISSUE(RB, WBk, (st) + 1); __builtin_amdgcn_sched_barrier(0); PU_COMPUTE(RA, WA); __builtin_amdgcn_sched_barrier(0); \
            PU_ISSUE(RA, WA, (st) + 2); __builtin_amdgcn_sched_barrier(0); PU_COMPUTE(RB, WBk); __builtin_amdgcn_sched_barrier(0); \
            *(LAS u32x4*)(nb + (j) * 1024) = m_; __builtin_amdgcn_sched_barrier(0); } while (0)
#pragma unroll 1
        for (int st = 0; st < 14; st += 2) { const int j = st >> 1; PU_BODY(st, j); }
        unsigned hgo = (unsigned)(t * (D * 2) + 256 * xs + 32 * c);
        asm volatile("" : "+v"(hgo));
        const u32x4 m7 = *(const u32x4*)(wsb + PU_MOFF(tn, 7));
        const u32x4 hg0 = *(const u32x4*)((const unsigned char*)HG + hgo), hg1 = *(const u32x4*)((const unsigned char*)HG + (hgo + 16u));
        PU_ISSUE(RB, WBk, 15);
        __builtin_amdgcn_sched_barrier(0);
        PU_COMPUTE(RA, WA);
        __builtin_amdgcn_sched_barrier(0);
        PU_COMPUTE(RB, WBk);
        __builtin_amdgcn_sched_barrier(0);
        *(LAS u32x4*)(nb + 7 * 1024) = m7;
#undef PU_BODY
#undef PU_ISSUE
#undef PU_COMPUTE
        float ss = 0.f;
        const size_t off = (size_t)t * D + 128 * xs + 16 * c;
        f32x4 hv[4]; unpack8(hg0, hv[0], hv[1]); unpack8(hg1, hv[2], hv[3]);
#pragma unroll
        for (int q = 0; q < 4; ++q) { const f32x4 nf = *(const f32x4*)(nffn + 128 * xs + 16 * c + 4 * q); hv[q][0] /= nf[0]; hv[q][1] /= nf[1]; hv[q][2] /= nf[2]; hv[q][3] /= nf[3]; }
#pragma unroll
        for (int q = 0; q < 4; ++q) { oa[q] = oa[q] + hv[q]; ss += (oa[q][0] * oa[q][0] + oa[q][1] * oa[q][1]) + (oa[q][2] * oa[q][2] + oa[q][3] * oa[q][3]); *(f32x4*)(out + off + 4 * q) = oa[q]; }
        ss = sum8_dpp(ss);
        if (c == 0) SS[(size_t)t * 8 + xs] = ss;
    }
#undef PU_MOFF
    }
}
__device__ __forceinline__ void final_norm_phase(Frame& F) {
    const int gw = F.vcu * NWAVES + F.wave, NGW = F.G * NWAVES, lane = F.lane;
    const float* SS = (const float*)(F.ws + WS_SS); const float* fn = F.in[I_FNORM]; float* out = F.out;
    f32x4 g[4];
#pragma unroll
    for (int q = 0; q < 4; ++q) g[q] = *(const f32x4*)(fn + 4 * (lane + 64 * q));
    int t = gw;
    for (; t + 3 * NGW < T; t += 4 * NGW) {
        f32x4 s0[4], s1[4], v[4][4];
#pragma unroll
        for (int r = 0; r < 4; ++r) { const size_t tt = (size_t)t + (size_t)r * NGW; s0[r] = *(const f32x4*)(SS + tt * 8); s1[r] = *(const f32x4*)(SS + tt * 8 + 4);
#pragma unroll
            for (int q = 0; q < 4; ++q) v[r][q] = ((const f32x4*)(out + tt * D) + lane)[64 * q]; }
#pragma unroll
        for (int r = 0; r < 4; ++r) { const size_t tt = (size_t)t + (size_t)r * NGW;
            const float r2 = __builtin_amdgcn_rsqf((((s0[r][0] + s0[r][1]) + (s0[r][2] + s0[r][3])) + ((s1[r][0] + s1[r][1]) + (s1[r][2] + s1[r][3]))) * (1.f / D) + RMS_EPS);
#pragma unroll
            for (int q = 0; q < 4; ++q) ((f32x4*)(out + tt * D) + lane)[64 * q] = v[r][q] * r2 * g[q]; }
    }
    for (; t < T; t += NGW) {
        const f32x4 s0 = *(const f32x4*)(SS + (size_t)t * 8), s1 = *(const f32x4*)(SS + (size_t)t * 8 + 4);
        const float r2 = __builtin_amdgcn_rsqf((((s0[0] + s0[1]) + (s0[2] + s0[3])) + ((s1[0] + s1[1]) + (s1[2] + s1[3]))) * (1.f / D) + RMS_EPS);
        f32x4* op = (f32x4*)(out + (size_t)t * D) + lane;
#pragma unroll
        for (int q = 0; q < 4; ++q) op[64 * q] = op[64 * q] * r2 * g[q];
    }
}

struct Args { const float* in[15]; float* out; unsigned char* ws; int ph_lo, ph_hi, li, pad; };
__global__ void __launch_bounds__(NWAVES * 64, 2) fwd(Args args) {
    extern __shared__ __attribute__((aligned(16))) unsigned char lds[];
    Frame F;
    F.lds = (LAS unsigned char*)lds;
    F.MISC = (volatile LAS unsigned*)(F.lds + MISC_OFF);
    F.tid = threadIdx.x; F.lane = F.tid & 63; F.wave = __builtin_amdgcn_readfirstlane(F.tid >> 6);
    F.G = gridDim.x; { const int bx = blockIdx.x; F.vcu = (F.G % 8 == 0) ? (bx % 8) * (F.G / 8) + bx / 8 : bx; }
    F.ws = args.ws; F.ctl = (gu32*)(args.ws + WS_CTL);
#pragma unroll
    for (int i = 0; i < 15; ++i) F.in[i] = args.in[i];
    F.out = args.out;
    for (int u = F.tid; u < (LDS_BYTES - RING_BYTES) / 4; u += NWAVES * 64) ((LAS unsigned*)(F.lds + RING_BYTES))[u] = 0u;
    __syncthreads();
    XcdBarrier bar; bar.bar = (unsigned*)(F.ctl + CW_BAR); bar.x = 0; bar.st = nullptr;
    if (N_LAUNCHES == 1) bar = xcd_barrier_post((unsigned*)(F.ctl + CW_BAR), F.MISC + 8);
    F.xcc = (int)xb_xcc_id();
    if (F.tid == 0) F.MISC[16] = xb_add((unsigned*)(F.ctl + CW_RANK + 64 * (F.xcc & 15)), 1u);
    __syncthreads();
    F.xrank = (int)F.MISC[16];
#define GRID_BAR() do { if (N_LAUNCHES == 1) xcd_barrier(bar); } while (0)
    const int lo = args.ph_lo, hi = args.ph_hi, bx = (int)blockIdx.x;
#define IN(k) (lo <= (k) && (k) < hi)
#define BOTH(k) (IN(k) && IN((k) + 1))
    unsigned char* ws = args.ws;

    if (IN(0)) { p0_prologue(F); if (BOTH(0)) GRID_BAR(); }

    if (IN(1)) {
        Gemm g{(const bf16*)(ws + WS_U8), (const bf16*)(ws + WS_WQKV8), T, NP1, D / 2}; QkvOrder S; S.init(T, NP1, F.G, bx); S.U = (const char*)(ws + WS_U8);
        EpiQKV E{(bf16*)(ws + WS_Q), (const float*)(ws + WS_ROPE), (const float*)(ws + WS_SU), (const float*)(ws + WS_SW), ws + WS_SGA, F.in[I_GBIAS] + D};
        gemm_phase<EpiQKV, QkvOrder, true, true, true, true>(F.lds, g, S, E);
        if (BOTH(1)) GRID_BAR();
    }
    if (IN(2)) { attn_phase(F, (bf16*)(ws + WS_Q), (float*)(ws + WS_LSE)); if (BOTH(2)) GRID_BAR(); }
    if (IN(3)) {
        { const int nwg = (T / 256) * ((NCG - 512) / 256), rem = nwg % F.G;
          if (rem == 0) combine_phase(F, F.vcu, F.G); else if (bx >= rem) combine_phase(F, bx - rem, F.G - rem); }
        Gemm g{(const bf16*)(ws + WS_U8), (const bf16*)(ws + WS_WQKV8 + (size_t)NP1 * D), T, NCG - 512, D / 2}; StaticOrder S; S.init(T, NCG - 512, F.G, bx);
        EpiCG E{(bf16*)((unsigned char*)F.out + OS_BB), (bf16*)(ws + WS_Z), ws + WS_SGC, ws + WS_SGA, F.in[I_GBIAS], (const float*)(ws + WS_SU), (const float*)(ws + WS_SW)};
        gemm_phase<EpiCG, StaticOrder, true, true, false, true>(F.lds, g, S, E);
        if (BOTH(3)) GRID_BAR();
    }
    if (IN(4)) { p4_wfold(F); p4_conv(F); if (BOTH(4)) GRID_BAR(); }
    if (IN(5)) {
        Gemm gc{(const bf16*)((unsigned char*)F.out + OS_BB), (const bf16*)(ws + WS_WCONV), T, D, D}, ga{(const bf16*)(ws + WS_O), (const bf16*)(ws + WS_WATTN), T, D, DAO};
        StaticOrder S; S.init(T, D, F.G, bx);
        if ((bx & 8) == 0) {
            { EpiY<0> E{(bf16*)(ws + WS_Y), ws + WS_SGC}; gemm_phase<EpiY<0>, StaticOrder, true, true>(F.lds, gc, S, E); }
            { EpiY<1> E{(bf16*)(ws + WS_Y), ws + WS_SGA}; gemm_phase<EpiY<1>, StaticOrder, true, true>(F.lds, ga, S, E); }
        } else {
            { EpiY<0> E{(bf16*)(ws + WS_Y), ws + WS_SGA}; gemm_phase<EpiY<0>, StaticOrder, true, true>(F.lds, ga, S, E); }
            { EpiY<1> E{(bf16*)(ws + WS_Y), ws + WS_SGC}; gemm_phase<EpiY<1>, StaticOrder, true, true>(F.lds, gc, S, E); }
        }
        if (BOTH(5)) GRID_BAR();
    }
    if (IN(6)) {
        Gemm g{(const bf16*)(ws + WS_Y), (const bf16*)(ws + WS_WOUT), T, D, D}; StaticOrder S; S.init(T, D, F.G, bx);
        EpiOut E{F.in[I_X], (bf16*)(ws + WS_HG), F.in[I_NFFN], (float*)(ws + WS_RSQ), ws + WS_HG8, (float*)(ws + WS_HSC)};
        gemm_phase<EpiOut, StaticOrder, true, true>(F.lds, g, S, E);

        if (BOTH(6)) GRID_BAR();
    }
    if (IN(7)) {
        Gemm g{(const bf16*)(ws + WS_HG), (const bf16*)((unsigned char*)F.out + OS_WFOLD), T, 2048, D}; StaticOrder S; S.init(T, 2048, F.G, bx);
        float* scr = (float*)(ws + (bx < 128 ? WS_SCR0 + (size_t)bx * 262144 : (bx < 192 ? WS_SCR1 + (size_t)(bx - 128) * 262144 : WS_SCR2 + (size_t)(bx - 192) * 262144)));
        EpiTopk E{scr, (const float*)(ws + WS_RSQ), (int*)(ws + WS_IDX), (float*)(ws + WS_GATE),
                  CvCtx{F.in[I_DOWN], F.in[I_UP], (unsigned char*)F.out + OS_EDOWN, ws + WS_EUP, (float*)(ws + WS_ESCALE), F.lane}, F.vcu * NWAVES + F.wave, F.G * NWAVES};
        if ((bx & 8) != 0) { cv_rows(E.CV, E.cvr, E.cvstep); E.cvr = 2 * NEXP; }
        const int cvkeep = E.cvr; E.cvr = 2 * NEXP;
        gemm_phase<EpiTopk, StaticOrder, true, true>(F.lds, g, S, E);
        E.cvr = cvkeep;
        cv_rows(E.CV, E.cvr, E.cvstep);
        if (BOTH(7)) GRID_BAR();
    }
    if (IN(8)) { peer_down_phase(F); if (BOTH(8)) GRID_BAR(); }
    if (IN(9)) { peer_up_phase(F); if (BOTH(9)) GRID_BAR(); }
    if (IN(10)) { final_norm_phase(F); }
#undef IN
#undef BOTH
}

extern "C" void kernel_launch(void* const* d_in, const int* in_sizes, int n_in, void* d_out, int out_size, void* d_ws, size_t ws_size, hipStream_t stream) {
    static int grid = 0;
    if (grid == 0) {
        if (n_in != 15 || out_size != T * D || ws_size < WS_END) { fprintf(stderr, "kernel_launch: unexpected shapes (n_in %d, out %d, ws %zu)\n", n_in, out_size, ws_size); grid = -1; return; }
        int dev = 0, cus = 0, per_cu = 0;
        if (hipGetDevice(&dev) != hipSuccess || hipDeviceGetAttribute(&cus, hipDeviceAttributeMultiprocessorCount, dev) != hipSuccess) { grid = -1; return; }
        if (hipFuncSetAttribute((const void*)fwd, hipFuncAttributeMaxDynamicSharedMemorySize, LDS_BYTES) != hipSuccess) { fprintf(stderr, "kernel_launch: hipFuncSetAttribute failed\n"); grid = -1; return; }
        if (hipOccupancyMaxActiveBlocksPerMultiprocessor(&per_cu, (const void*)fwd, NWAVES * 64, LDS_BYTES) != hipSuccess || per_cu < 1) fprintf(stderr, "kernel_launch: occupancy query reports %d\n", per_cu);
        (void)hipGetLastError();
        grid = cus > 256 ? 256 : cus;
    }
    if (grid < 0) return;
    if (hipMemsetAsync((char*)d_ws + WS_CTL, 0, CTL_ZERO_BYTES, stream) != hipSuccess) return;
    Args a{};
    for (int i = 0; i < 15; ++i) a.in[i] = (const float*)d_in[i];
    a.out = (float*)d_out; a.ws = (unsigned char*)d_ws;
    for (int li = 0; li < N_LAUNCHES; ++li) {
        a.ph_lo = (N_LAUNCHES == 1) ? 0 : li; a.ph_hi = (N_LAUNCHES == 1) ? N_PHASES : li + 1; a.li = li; a.pad = 0;
        hipLaunchKernelGGL(fwd, dim3(grid), dim3(NWAVES * 64), LDS_BYTES, stream, a);
    }
}
```
